# Optimizing an MI355X kernel written in HIP

```python
import math
import jax, jax.numpy as jnp
from jax import lax
import numpy as np

D_MODEL = 1024
BATCH = 4
SEQ = 4096
DEPTH = 2
DEC_BATCH = 128
DEC_SEQ = 4
PAST_LEN = 8192
PAGE_SIZE = 128

N_MIXERS = 2
N_ATTN_LAYERS = (DEPTH + N_MIXERS - 1) // N_MIXERS
N_RWKV_LAYERS = DEPTH // N_MIXERS
N_META = 16
RMS_EPS = 1e-6

A_HEADS = 16
A_KV_HEADS = 4
A_GROUP = A_HEADS // A_KV_HEADS
A_HEAD_DIM = 64
A_WIDTH = A_HEADS * A_HEAD_DIM
A_KV_WIDTH = A_KV_HEADS * A_HEAD_DIM
WINDOW = 128
BLOCK = 128
N_BUCKETS = 32
MAX_DISTANCE = 128

R_HEAD_DIM = 64
R_HEADS = D_MODEL // R_HEAD_DIM
R_WIDTH = R_HEADS * R_HEAD_DIM
DECAY_LORA = 64
ICLR_LORA = 64
GN_EPS = 64e-5
N_SHIFT_MIX = 6

kernel_name = "hybrid_swa_sink_rwkv7_step"


def rmsnorm(x, g):
    xf = x.astype(jnp.float32)
    y = xf * lax.rsqrt(jnp.mean(xf * xf, axis=-1, keepdims=True) + RMS_EPS)
    return (y * g.astype(jnp.float32)).astype(x.dtype)


def t5_bucket(rel):
    n = jnp.maximum(rel, 0)
    max_exact = N_BUCKETS // 2
    nf = jnp.maximum(n, max_exact).astype(jnp.float32)
    large = max_exact + (jnp.log(nf / max_exact) / math.log(MAX_DISTANCE / max_exact)
                         * (N_BUCKETS - max_exact)).astype(jnp.int32)
    large = jnp.minimum(large, N_BUCKETS - 1)
    return jnp.where(n < max_exact, n, large)


def rel_bias(table, rel):
    b = table[t5_bucket(rel)].astype(jnp.float32)
    return jnp.moveaxis(b, -1, 0).reshape(A_KV_HEADS, A_GROUP, *rel.shape)


def sink_attend(q, k, v, bias, valid, sinks):
    s = jnp.einsum('...qkgd,...skd->...kgqs', q, k).astype(jnp.float32) * (A_HEAD_DIM ** -0.5) + bias
    s = jnp.where(valid[..., None, None, :, :], s, -jnp.inf)
    sink = sinks.astype(jnp.float32).reshape(A_KV_HEADS, A_GROUP, 1, 1)
    m = jnp.maximum(jnp.max(s, axis=-1, keepdims=True), sink)
    p = jnp.exp(s - m)
    denom = jnp.sum(p, axis=-1, keepdims=True) + jnp.exp(sink - m)
    o = jnp.einsum('...kgqs,...skd->...qkgd', (p / denom).astype(v.dtype), v)
    return o.reshape(*o.shape[:-3], A_WIDTH)


def attn_project(xn, w_in):
    B, T = xn.shape[:2]
    proj = jnp.einsum('btd,de->bte', xn, w_in)
    q, k, v, g = jnp.split(proj, [A_WIDTH, A_WIDTH + A_KV_WIDTH, A_WIDTH + 2 * A_KV_WIDTH], axis=-1)
    return (q.reshape(B, T, A_KV_HEADS, A_GROUP, A_HEAD_DIM),
            k.reshape(B, T, A_KV_HEADS, A_HEAD_DIM),
            v.reshape(B, T, A_KV_HEADS, A_HEAD_DIM), g)


def attn_prompt(xn, w_in, sinks, w_out, table):
    q, k, v, g = attn_project(xn, w_in)
    B, L = xn.shape[:2]
    pad = BLOCK - N_META
    nb = (L + pad) // BLOCK

    def blocks(t):
        t = jnp.pad(t, [(0, 0), (pad, 0)] + [(0, 0)] * (t.ndim - 2))
        return t.reshape(B, nb, BLOCK, *t.shape[2:])

    def with_prev(t):
        prev = jnp.pad(t, [(0, 0), (1, 0)] + [(0, 0)] * (t.ndim - 2))[:, :-1]
        return jnp.concatenate([prev, t], axis=2)

    qb = blocks(q)
    kc = with_prev(blocks(k))
    vc = with_prev(blocks(v))
    qi = jnp.arange(BLOCK)[:, None]
    kj = jnp.arange(2 * BLOCK)[None, :]
    rel = BLOCK + qi - kj
    kpos = (jnp.arange(nb)[:, None, None] - 1) * BLOCK + kj[None] - pad
    valid = (rel >= 0) & (rel < WINDOW) & (kpos >= 0)
    o = sink_attend(qb, kc, vc, rel_bias(table, rel), valid, sinks)
    o = o.reshape(B, nb * BLOCK, A_WIDTH)[:, pad:]
    y = jnp.einsum('bte,ed->btd', o * jax.nn.silu(g), w_out)
    return y, k[:, -WINDOW:], v[:, -WINDOW:]


def attn_sample(xn, cache_k, cache_v, w_in, sinks, w_out, table):
    q, k, v, g = attn_project(xn, w_in)
    T = xn.shape[1]
    keep = cache_k.shape[1]
    kc = jnp.concatenate([cache_k.astype(k.dtype), k], axis=1)
    vc = jnp.concatenate([cache_v.astype(v.dtype), v], axis=1)
    rel = keep + jnp.arange(T)[:, None] - jnp.arange(keep + T)[None, :]
    valid = (rel >= 0) & (rel < WINDOW)
    o = sink_attend(q, kc, vc, rel_bias(table, rel), valid, sinks)
    y = jnp.einsum('bte,ed->btd', o * jax.nn.silu(g), w_out)
    return y, kc[:, -keep:], vc[:, -keep:]


def wkv_scan(S0, r, w, k, v, a, b):
    xs = tuple(jnp.moveaxis(t.astype(jnp.float32), 1, 0) for t in (r, w, k, v, a, b))

    def step(S, inp):
        r_t, w_t, k_t, v_t, a_t, b_t = inp
        sa = jnp.einsum('bhvk,bhk->bhv', S, a_t)
        S = S * w_t[:, :, None, :] + sa[..., None] * b_t[:, :, None, :] + v_t[..., None] * k_t[:, :, None, :]
        return S, jnp.einsum('bhvk,bhk->bhv', S, r_t)

    S, ys = lax.scan(step, S0, xs)
    return S, jnp.moveaxis(ys, 0, 1)


def rwkv_time_mix(xn, wkv0, shift0, mu, w_in, w0, w1, w2, a0, a1, a2, k_k, k_a, r_k,
                  ln_g, ln_b, w_out):
    B, T, _ = xn.shape
    f32 = jnp.float32
    xprev = jnp.concatenate([shift0[:, None].astype(xn.dtype), xn[:, :-1]], axis=1)
    xmix = xn[None] + (xprev - xn)[None] * mu[:, None, None, :].astype(xn.dtype)
    proj = jnp.einsum('cbtd,cdw->cbtw', xmix[:4], w_in)
    r, k, v, g = proj[0], proj[1], proj[2], proj[3]
    xw, xa = xmix[4], xmix[5]
    z = (w0 + jnp.tanh(xw @ w1) @ w2).astype(f32)
    log_w = -jax.nn.softplus(-z) - 0.5
    decay = jnp.exp(-jnp.exp(log_w))
    a = jax.nn.sigmoid((a0 + (xa @ a1) @ a2).astype(f32))

    def hd(t):
        return t.reshape(B, T, R_HEADS, R_HEAD_DIM)

    kk = hd((k * k_k).astype(f32))
    kk = kk / jnp.maximum(jnp.sqrt(jnp.sum(kk * kk, axis=-1, keepdims=True)), 1e-12)
    k_h = hd((k.astype(f32) * (1.0 + (a - 1.0) * k_a.astype(f32))))
    r_h, v_h, a_h, w_h = hd(r.astype(f32)), hd(v.astype(f32)), hd(a), hd(decay)
    S, y = wkv_scan(wkv0.astype(f32), r_h, w_h, k_h, v_h, -kk, kk * a_h)
    mean = jnp.mean(y, axis=-1, keepdims=True)
    var = jnp.mean(jnp.square(y - mean), axis=-1, keepdims=True)
    y = ((y - mean) * lax.rsqrt(var + GN_EPS)).reshape(B, T, R_WIDTH)
    y = y * ln_g.astype(f32) + ln_b.astype(f32)
    bonus = jnp.sum(r_h * k_h * r_k.astype(f32), axis=-1, keepdims=True) * v_h
    y = (y + bonus.reshape(B, T, R_WIDTH)) * jax.nn.silu(g.astype(f32))
    out = jnp.einsum('btw,wd->btd', y.astype(xn.dtype), w_out)
    return out, S, xn[:, -1]


def run_trunk(h, p, win_k, win_v, wkv, shift, is_prompt):
    new_k, new_v, new_wkv, new_shift = [], [], [], []
    for i in range(DEPTH):
        j = i // N_MIXERS
        xn = rmsnorm(h, p['norm_gain'][i])
        if i % N_MIXERS == 0:
            if is_prompt:
                y, ck, cv = attn_prompt(xn, p['attn_w_in'][j], p['attn_sinks'][j], p['attn_w_out'][j], p['table'])
            else:
                y, ck, cv = attn_sample(xn, win_k[j], win_v[j], p['attn_w_in'][j], p['attn_sinks'][j],
                                        p['attn_w_out'][j], p['table'])
            new_k.append(ck)
            new_v.append(cv)
        else:
            y, s, sh = rwkv_time_mix(xn, wkv[j], shift[j], p['mu'][j], p['r_w_in'][j], p['w0'][j], p['w1'][j],
                                     p['w2'][j], p['a0'][j], p['a1'][j], p['a2'][j], p['k_k'][j], p['k_a'][j],
                                     p['r_k'][j], p['ln_g'][j], p['ln_b'][j], p['r_w_out'][j])
            new_wkv.append(s)
            new_shift.append(sh)
        h = h + y
    return (rmsnorm(h, p['final_gain']), jnp.stack(new_k), jnp.stack(new_v),
            jnp.stack(new_wkv), jnp.stack(new_shift))


def setup_inputs(seed: int = 0) -> dict:
    key = jax.random.key(seed)
    ks = jax.random.split(key, 32)
    nrm = jax.random.normal
    f32 = jnp.float32
    NA, NR = N_ATTN_LAYERS, N_RWKV_LAYERS
    return {
        "x_prompt": nrm(ks[0], (BATCH, SEQ, D_MODEL), f32),
        "x_sample": nrm(ks[1], (DEC_BATCH, DEC_SEQ, D_MODEL), f32),
        "cache_win_k": nrm(ks[2], (NA, DEC_BATCH, min(WINDOW, PAST_LEN), A_KV_HEADS, A_HEAD_DIM), f32),
        "cache_win_v": nrm(ks[3], (NA, DEC_BATCH, min(WINDOW, PAST_LEN), A_KV_HEADS, A_HEAD_DIM), f32),
        "state_wkv": 0.3 * nrm(ks[4], (NR, DEC_BATCH, R_HEADS, R_HEAD_DIM, R_HEAD_DIM), f32),
        "state_shift": nrm(ks[5], (NR, DEC_BATCH, D_MODEL), f32),
        "meta_tokens": nrm(ks[6], (N_META, D_MODEL), f32),
        "rel_bias_table": 0.5 * nrm(ks[7], (N_BUCKETS, A_HEADS), f32),
        "norm_gain": 1.0 + 0.05 * nrm(ks[8], (DEPTH, D_MODEL), f32),
        "final_gain": 1.0 + 0.05 * nrm(ks[9], (D_MODEL,), f32),
        "attn_w_in": nrm(ks[10], (NA, D_MODEL, 2 * A_WIDTH + 2 * A_KV_WIDTH), f32) * D_MODEL ** -0.5,
        "attn_sinks": 0.5 * nrm(ks[11], (NA, A_HEADS), f32),
        "attn_w_out": nrm(ks[12], (NA, A_WIDTH, D_MODEL), f32) * A_WIDTH ** -0.5,
        "rwkv_mu": jax.random.uniform(ks[13], (NR, N_SHIFT_MIX, D_MODEL), f32),
        "rwkv_w_in": nrm(ks[14], (NR, 4, D_MODEL, R_WIDTH), f32) * D_MODEL ** -0.5,
        "rwkv_w0": -1.0 + 0.5 * nrm(ks[15], (NR, R_WIDTH), f32),
        "rwkv_w1": nrm(ks[16], (NR, D_MODEL, DECAY_LORA), f32) * D_MODEL ** -0.5,
        "rwkv_w2": 0.5 * nrm(ks[17], (NR, DECAY_LORA, R_WIDTH), f32) * DECAY_LORA ** -0.5,
        "rwkv_a0": 0.5 * nrm(ks[18], (NR, R_WIDTH), f32),
        "rwkv_a1": nrm(ks[19], (NR, D_MODEL, ICLR_LORA), f32) * D_MODEL ** -0.5,
        "rwkv_a2": 0.5 * nrm(ks[20], (NR, ICLR_LORA, R_WIDTH), f32) * ICLR_LORA ** -0.5,
        "rwkv_k_k": 0.85 + 0.05 * nrm(ks[21], (NR, R_WIDTH), f32),
        "rwkv_k_a": 1.0 + 0.05 * nrm(ks[22], (NR, R_WIDTH), f32),
        "rwkv_r_k": 0.1 * nrm(ks[23], (NR, R_HEADS, R_HEAD_DIM), f32),
        "rwkv_ln_gamma": 1.0 + 0.05 * nrm(ks[24], (NR, R_WIDTH), f32),
        "rwkv_ln_beta": 0.02 * nrm(ks[25], (NR, R_WIDTH), f32),
        "rwkv_w_out": nrm(ks[26], (NR, R_WIDTH, D_MODEL), f32) * R_WIDTH ** -0.5,
    }


def reference(x_prompt, x_sample, cache_win_k, cache_win_v, state_wkv, state_shift,
              meta_tokens, rel_bias_table, norm_gain, final_gain,
              attn_w_in, attn_sinks, attn_w_out,
              rwkv_mu, rwkv_w_in, rwkv_w0, rwkv_w1, rwkv_w2, rwkv_a0, rwkv_a1, rwkv_a2,
              rwkv_k_k, rwkv_k_a, rwkv_r_k, rwkv_ln_gamma, rwkv_ln_beta, rwkv_w_out):
    p = dict(table=rel_bias_table, norm_gain=norm_gain, final_gain=final_gain,
             attn_w_in=attn_w_in, attn_sinks=attn_sinks, attn_w_out=attn_w_out,
             mu=rwkv_mu, r_w_in=rwkv_w_in, w0=rwkv_w0, w1=rwkv_w1, w2=rwkv_w2,
             a0=rwkv_a0, a1=rwkv_a1, a2=rwkv_a2, k_k=rwkv_k_k, k_a=rwkv_k_a, r_k=rwkv_r_k,
             ln_g=rwkv_ln_gamma, ln_b=rwkv_ln_beta, r_w_out=rwkv_w_out)
    B = x_prompt.shape[0]
    meta = jnp.broadcast_to(meta_tokens[None].astype(x_prompt.dtype), (B, N_META, D_MODEL))
    h_prompt = jnp.concatenate([meta, x_prompt], axis=1)
    wkv_zero = jnp.zeros((N_RWKV_LAYERS, B, R_HEADS, R_HEAD_DIM, R_HEAD_DIM), jnp.float32)
    shift_zero = jnp.zeros((N_RWKV_LAYERS, B, D_MODEL), x_prompt.dtype)
    out_p, new_win_k_prompt, new_win_v_prompt, new_wkv_prompt, new_shift_prompt = run_trunk(
        h_prompt, p, None, None, wkv_zero, shift_zero, True)
    y_prompt = out_p[:, N_META:]
    y_sample, new_win_k_sample, new_win_v_sample, new_wkv_sample, new_shift_sample = run_trunk(
        x_sample, p, cache_win_k, cache_win_v, state_wkv, state_shift, False)
    return (y_prompt, y_sample,
            new_win_k_prompt, new_win_v_prompt, new_wkv_prompt, new_shift_prompt,
            new_win_k_sample, new_win_v_sample, new_wkv_sample, new_shift_sample)
```

```cpp
#include <hip/hip_runtime.h>
#include <cstdio>
#include <cstdint>
namespace pg8 {
#define PG8_LAS __attribute__((address_space(3)))
typedef unsigned short bf16_t;
typedef short bf16x8 __attribute__((ext_vector_type(8)));
typedef float f32x4 __attribute__((ext_vector_type(4)));
typedef unsigned u32x4 __attribute__((ext_vector_type(4)));
constexpr int BM = 256, BK = 64, HALF = 128, HTB = HALF * BK * 2  , STAGE_BYTES = 8 * HTB, NXCD = 8, WGM = 8;

__host__ __device__ __forceinline__ int lds_byte(int r, int c) { const int st = (r >> 4) * 2 + (c >> 5), rr = r & 15, cc = c & 31, ob = rr * 64 + cc * 2; return st * 1024 + (ob ^ (((ob >> 9) & 1) << 5)); }
__host__ __device__ __forceinline__ void stage_rc(int b, int& R, int& C) { const int st = b / 1024, sb = b % 1024, swz = sb ^ (((sb >> 9) & 1) << 5); R = (st >> 1) * 16 + swz / 64; C = (st & 1) * 32 + (swz % 64) / 2; }
__host__ __device__ __forceinline__ int perm32(int rho) { const int n = rho >> 4, i = rho & 15; return 8 * (i >> 2) + 4 * n + (i & 3); }

struct Unit { int pm, pn; };
struct Gemm { const bf16_t* A; const bf16_t* Bt; int M, N, K; int gdiv; size_t a_gstride; };

struct StaticOrder {
    int nM, nN, nwg, G, c;
    __host__ __device__ void init(int M, int N, int G_, int c_) { nM = M / BM; nN = N / BM; nwg = nM * nN; G = G_; c = c_; }
    __host__ __device__ bool next(int i, Unit& u) const {
        const long L = (long)i * G + c; if (L >= nwg) return false;
        int wgid = (int)L; { const int q = nwg / NXCD, r = nwg % NXCD, xcd = wgid % NXCD, off = wgid / NXCD; wgid = (xcd < r ? xcd * (q + 1) : r * (q + 1) + (xcd - r) * q) + off; }
        const int nig = WGM * nN, gid = wgid / nig, fm = gid * WGM, gsz = (nM - fm) < WGM ? (nM - fm) : WGM;
        u.pm = fm + ((wgid % nig) % gsz); u.pn = (wgid % nig) / gsz; return true;
    }
    __device__ __forceinline__ void a_ready(const Unit&) const {}
    __device__ __forceinline__ void done(const Unit&) const {}
};

__device__ __forceinline__ unsigned cvt_pk_bf16(float lo, float hi) { unsigned r; asm volatile("v_cvt_pk_bf16_f32 %0, %1, %2" : "=v"(r) : "v"(lo), "v"(hi)); return r; }
struct EpiBf16G {
    static constexpr bool PERM = true, AFTER_DRAIN = false;
    bf16_t *O0, *O1, *O2, *O3; int ldc, tpg, Mvalid, scale_tiles; float scale0;
    __device__ __forceinline__ void operator()(const f32x4 (&acc)[2][2][4][2], const Unit& u, int wr, int wc, int fr, int fq) const {
        const int grp = u.pn / tpg, colt = (u.pn - grp * tpg) * BM;
        bf16_t* base = grp == 0 ? O0 : grp == 1 ? O1 : grp == 2 ? O2 : O3;
        const float sc = (u.pn < scale_tiles) ? scale0 : 1.f;
        const int row0 = u.pm * BM + wr * 64 + fr, col0 = colt + wc * 32 + 8 * fq;
#pragma unroll
        for (int ai = 0; ai < 2; ++ai)
#pragma unroll
            for (int m = 0; m < 4; ++m) { const int row = row0 + ai * HALF + m * 16; bf16_t* rowp = base + (size_t)row * ldc + col0;
                if (row < Mvalid) {
#pragma unroll
                for (int bj = 0; bj < 2; ++bj) { const f32x4 v0 = acc[ai][bj][m][0] * sc, v1 = acc[ai][bj][m][1] * sc;
                    u32x4 w; w.x = cvt_pk_bf16(v0[0], v0[1]); w.y = cvt_pk_bf16(v0[2], v0[3]); w.z = cvt_pk_bf16(v1[0], v1[1]); w.w = cvt_pk_bf16(v1[2], v1[3]);
                    *(u32x4*)(rowp + bj * HALF) = w; } } }
    }
};
struct EpiRes {
    static constexpr bool PERM = false, AFTER_DRAIN = false;
    const float* base; float* out; const float *meta, *xp, *xs; int Mvalid;
    __device__ __forceinline__ void operator()(const f32x4 (&acc)[2][2][4][2], const Unit& u, int wr, int wc, int fr, int fq) const {
        const int row0 = u.pm * BM + wr * 64 + fr, col0 = u.pn * BM + wc * 32 + 4 * fq;
#pragma unroll
        for (int ai = 0; ai < 2; ++ai)
#pragma unroll
            for (int m = 0; m < 4; ++m) { const int row = row0 + ai * HALF + m * 16;
                if (row < Mvalid) {
                    const float* b;
                    if (base) b = base + (size_t)row * 1024;
                    else if (row < 16448) { const int bb = row / 4112, t = row - bb * 4112; b = t < 16 ? meta + t * 1024 : xp + ((size_t)bb * 4096 + (t - 16)) * 1024; }
                    else b = xs + (size_t)(row - 16448) * 1024;
                    float* o = out + (size_t)row * 1024;
#pragma unroll
                    for (int bj = 0; bj < 2; ++bj)
#pragma unroll
                        for (int n = 0; n < 2; ++n) { const int c = col0 + bj * HALF + n * 16; const f32x4 r = *(const f32x4*)(b + c); *(f32x4*)(o + c) = r + acc[ai][bj][m][n]; } } }
    }
};
template <class Epi, class Sched, bool ALIGN_EPI = false, bool SP2 = false>
__device__ __forceinline__ void gemm_phase(PG8_LAS unsigned char* lds, const Gemm g, const Sched& S, const Epi& E) {
    const int tid = threadIdx.x, wid = __builtin_amdgcn_readfirstlane(tid >> 6), lane = tid & 63, wr = wid >> 2, wc = wid & 3, fr = lane & 15, fq = lane >> 4;
    const int K = g.K, nt = K / BK;
    unsigned voffA[2], voffB[2];
#pragma unroll
    for (int i = 0; i < 2; ++i) { int R, C; stage_rc(tid * 16 + i * 8192, R, C); const int Rb = Epi::PERM ? ((R & ~31) + perm32(R & 31)) : R;
        voffA[i] = (unsigned)(R * K + C) * 2u; voffB[i] = (unsigned)(Rb * K + C) * 2u; }
    const size_t kstep = (size_t)(BK * 2);
    const size_t hstep = (size_t)HALF * K * 2;
    const size_t tstep = 2 * hstep;
    const unsigned ldsw = (unsigned)wid * 1024u;
    const int aoff = lds_byte(wr * 64 + fr, fq * 8), boff = lds_byte(wc * 32 + fr, fq * 8);
#define PG8_SA(b, h) (((b) * 2 + (h)) * HTB)
#define PG8_SB(b, h) ((4 + (b) * 2 + (h)) * HTB)
#define PG8_STAGE(bufoff, gbase, voff) do { _Pragma("unroll") for (int _i = 0; _i < 2; ++_i) \
        __builtin_amdgcn_global_load_lds((const unsigned*)((const char*)(gbase) + (voff)[_i]), (PG8_LAS unsigned*)(lds + (bufoff) + ldsw + _i * 8192), 16, 0, 0); } while (0)
#define PG8_LDA(dst, b, h) do { _Pragma("unroll") for (int m = 0; m < 4; ++m) _Pragma("unroll") for (int k = 0; k < 2; ++k) dst[m][k] = *(const PG8_LAS bf16x8*)(lds + PG8_SA(b, h) + aoff + m * 2048 + k * 1024); } while (0)
#define PG8_LDB(dst, b, h) do { _Pragma("unroll") for (int n = 0; n < 2; ++n) _Pragma("unroll") for (int k = 0; k < 2; ++k) dst[n][k] = *(const PG8_LAS bf16x8*)(lds + PG8_SB(b, h) + boff + n * 2048 + k * 1024); } while (0)
#define PG8_MMA(ai, bj, At, Bt) do { __builtin_amdgcn_s_setprio(1); _Pragma("unroll") for (int m = 0; m < 4; ++m) _Pragma("unroll") for (int n = 0; n < 2; ++n) _Pragma("unroll") for (int k = 0; k < 2; ++k) \
        acc[ai][bj][m][n] = __builtin_amdgcn_mfma_f32_16x16x32_bf16(Bt[n][k], At[m][k], acc[ai][bj][m][n], 0, 0, 0); __builtin_amdgcn_s_setprio(0); } while (0)
#define PG8_WAIT_V(n) asm volatile("s_waitcnt vmcnt(" #n ")" ::: "memory")
#define PG8_WAIT_L(n) asm volatile("s_waitcnt lgkmcnt(" #n ")" ::: "memory")
#define PG8_BAR __builtin_amdgcn_s_barrier()
#define PG8_SCHED __builtin_amdgcn_sched_barrier(0)
    Unit cur, nxt; int ui = 0;
    if (!S.next(0, cur)) return;
    f32x4 acc[2][2][4][2];
#pragma unroll
    for (int a = 0; a < 2; ++a)
#pragma unroll
        for (int b = 0; b < 2; ++b)
#pragma unroll
            for (int m = 0; m < 4; ++m)
#pragma unroll
                for (int n = 0; n < 2; ++n) acc[a][b][m][n] = (f32x4){0.f, 0.f, 0.f, 0.f};
    bf16x8 At[4][2], B0[2][2], B1[2][2];
    const char* cA = (const char*)g.A + (size_t)(cur.pn / g.gdiv) * g.a_gstride + (size_t)cur.pm * tstep; const char* cB = (const char*)g.Bt + (size_t)cur.pn * tstep;
    S.a_ready(cur);
    if constexpr (SP2) {
        PG8_STAGE(PG8_SB(0, 0), cB, voffB); PG8_STAGE(PG8_SB(0, 1), cB + hstep, voffB); PG8_STAGE(PG8_SA(0, 0), cA, voffA); PG8_STAGE(PG8_SA(0, 1), cA + hstep, voffA);
        if (wr == 1) PG8_BAR;
        PG8_WAIT_V(2); PG8_BAR;
        PG8_STAGE(PG8_SB(1, 0), cB + kstep, voffB); PG8_STAGE(PG8_SA(1, 0), cA + kstep, voffA); PG8_STAGE(PG8_SB(1, 1), cB + hstep + kstep, voffB);
        PG8_WAIT_V(6); PG8_BAR;
    } else {
        PG8_STAGE(PG8_SB(0, 0), cB, voffB); PG8_STAGE(PG8_SA(0, 0), cA, voffA); PG8_STAGE(PG8_SB(0, 1), cB + hstep, voffB); PG8_STAGE(PG8_SA(0, 1), cA + hstep, voffA);
        if (wr == 1) PG8_BAR;
        PG8_WAIT_V(4); PG8_BAR;
        PG8_STAGE(PG8_SB(1, 0), cB + kstep, voffB); PG8_STAGE(PG8_SA(1, 0), cA + kstep, voffA); PG8_STAGE(PG8_SB(1, 1), cB + hstep + kstep, voffB);
        PG8_WAIT_V(6); PG8_BAR;
    }
    for (;;) {
        const bool has_next = S.next(ui + 1, nxt);
        const char* nA = has_next ? (const char*)g.A + (size_t)(nxt.pn / g.gdiv) * g.a_gstride + (size_t)nxt.pm * tstep : cA; const char* nB = has_next ? (const char*)g.Bt + (size_t)nxt.pn * tstep : cB;
        for (int t = 0; t < nt; t += 2) {
            const bool last = (t == nt - 2);
            const char* a1 = cA + (size_t)(t + 1) * kstep;
            const char* a2 = last ? nA : cA + (size_t)(t + 2) * kstep; const char* b2 = last ? nB : cB + (size_t)(t + 2) * kstep;
            const char* a3 = a2 + kstep; const char* b3 = b2 + kstep;
            if (last && has_next) S.a_ready(nxt);
            if constexpr (SP2) {
            PG8_LDB(B0, 0, 0); PG8_LDB(B1, 0, 1); PG8_SCHED; PG8_LDA(At, 0, 0); PG8_STAGE(PG8_SA(1, 1), a1 + hstep, voffA);
            PG8_WAIT_V(8); PG8_WAIT_L(0); PG8_BAR; PG8_MMA(0, 0, At, B0); PG8_MMA(0, 1, At, B1); PG8_BAR; PG8_SCHED;
            PG8_LDA(At, 0, 1); PG8_STAGE(PG8_SB(0, 0), b2, voffB); PG8_STAGE(PG8_SB(0, 1), b2 + hstep, voffB); PG8_STAGE(PG8_SA(0, 0), a2, voffA);
            PG8_WAIT_V(8); PG8_WAIT_L(0); PG8_BAR; PG8_MMA(1, 0, At, B0); PG8_MMA(1, 1, At, B1); PG8_BAR; PG8_SCHED;
            PG8_LDB(B0, 1, 0); PG8_LDB(B1, 1, 1); PG8_SCHED; PG8_LDA(At, 1, 0); PG8_STAGE(PG8_SA(0, 1), a2 + hstep, voffA);
            PG8_WAIT_V(8); PG8_WAIT_L(0); PG8_BAR; PG8_MMA(0, 0, At, B0); PG8_MMA(0, 1, At, B1); PG8_BAR; PG8_SCHED;
            PG8_LDA(At, 1, 1); PG8_STAGE(PG8_SB(1, 0), b3, voffB); PG8_STAGE(PG8_SB(1, 1), b3 + hstep, voffB); PG8_STAGE(PG8_SA(1, 0), a3, voffA);
            PG8_WAIT_V(8); PG8_WAIT_L(0); PG8_BAR; PG8_MMA(1, 0, At, B0); PG8_MMA(1, 1, At, B1); PG8_BAR; PG8_SCHED;
            } else {
            PG8_LDB(B0, 0, 0); PG8_SCHED; PG8_LDA(At, 0, 0); PG8_STAGE(PG8_SA(1, 1), a1 + hstep, voffA);
            PG8_WAIT_L(8); PG8_BAR; PG8_WAIT_L(0); PG8_MMA(0, 0, At, B0); PG8_BAR; PG8_SCHED;
            PG8_LDB(B1, 0, 1); PG8_STAGE(PG8_SB(0, 0), b2, voffB);
            PG8_BAR; PG8_WAIT_L(0); PG8_MMA(0, 1, At, B1); PG8_BAR;
            PG8_LDA(At, 0, 1); PG8_STAGE(PG8_SA(0, 0), a2, voffA);
            PG8_BAR; PG8_WAIT_L(0); PG8_MMA(1, 0, At, B0); PG8_BAR; PG8_SCHED;
            PG8_STAGE(PG8_SB(0, 1), b2 + hstep, voffB);
            PG8_WAIT_V(6); PG8_BAR; PG8_MMA(1, 1, At, B1); PG8_BAR;
            PG8_LDB(B0, 1, 0); PG8_SCHED; PG8_LDA(At, 1, 0); PG8_STAGE(PG8_SA(0, 1), a2 + hstep, voffA);
            PG8_WAIT_L(8); PG8_BAR; PG8_WAIT_L(0); PG8_MMA(0, 0, At, B0); PG8_BAR; PG8_SCHED;
            PG8_LDB(B1, 1, 1); PG8_STAGE(PG8_SB(1, 0), b3, voffB);
            PG8_BAR; PG8_WAIT_L(0); PG8_MMA(0, 1, At, B1); PG8_BAR;
            PG8_LDA(At, 1, 1); PG8_STAGE(PG8_SA(1, 0), a3, voffA);
            PG8_BAR; PG8_WAIT_L(0); PG8_MMA(1, 0, At, B0); PG8_BAR; PG8_SCHED;
            PG8_STAGE(PG8_SB(1, 1), b3 + hstep, voffB);
            PG8_WAIT_V(6); PG8_BAR; PG8_MMA(1, 1, At, B1); PG8_BAR;
            }
        }
        if constexpr (ALIGN_EPI) { if (wr == 0) PG8_BAR; }
        if constexpr (!Epi::AFTER_DRAIN) { E(acc, cur, wr, wc, fr, fq); S.done(cur); }
        if (!has_next) break;
#pragma unroll
        for (int a = 0; a < 2; ++a)
#pragma unroll
            for (int b = 0; b < 2; ++b)
#pragma unroll
                for (int m = 0; m < 4; ++m)
#pragma unroll
                    for (int n = 0; n < 2; ++n) acc[a][b][m][n] = (f32x4){0.f, 0.f, 0.f, 0.f};
        cur = nxt; cA = nA; cB = nB; ++ui;
        if constexpr (ALIGN_EPI) { if (wr == 1) PG8_BAR; }
    }
    PG8_WAIT_V(0);
    if constexpr (!ALIGN_EPI) { if (wr == 0) PG8_BAR; }
    PG8_BAR;
    if constexpr (Epi::AFTER_DRAIN) { E.fused(acc, cur, wr, wc, fr, fq, lds, wid, lane); S.done(cur); }
#undef PG8_SA
#undef PG8_SB
#undef PG8_STAGE
#undef PG8_LDA
#undef PG8_LDB
#undef PG8_MMA
#undef PG8_WAIT_V
#undef PG8_WAIT_L
#undef PG8_BAR
#undef PG8_SCHED
}
}
#define GAS __attribute__((address_space(1)))
#define LAS __attribute__((address_space(3)))
typedef unsigned short bf16;
typedef unsigned v4u __attribute__((ext_vector_type(4)));
typedef float f32x4 __attribute__((ext_vector_type(4)));
typedef short bf16x8 __attribute__((ext_vector_type(8)));
typedef GAS unsigned gu32;
typedef GAS unsigned long long gu64;
#define RLX_AGENT __ATOMIC_RELAXED, __HIP_MEMORY_SCOPE_AGENT
#define LDS_WAIT() asm volatile("s_waitcnt lgkmcnt(0)" ::: "memory")
#define VM_WAIT() asm volatile("s_waitcnt vmcnt(0)" ::: "memory")
__device__ __forceinline__ unsigned long long rt() { return __builtin_amdgcn_s_memrealtime(); }
__device__ __forceinline__ unsigned f2bf(float f) { unsigned u = __builtin_bit_cast(unsigned, f); return (u + 0x7fffu + ((u >> 16) & 1u)) >> 16; }
__device__ __forceinline__ unsigned pk2(float lo, float hi) { return f2bf(lo) | (f2bf(hi) << 16); }

#define XB_TMO      128
#define XB_XCNT(j)  (256  + 64 * (j))
#define XB_XSUB(j)  (1280 + 64 * (j))
#define XB_XGEN(j)  (2304 + 64 * (j))
#define XB_TOP      3328
#define XB_TOPGEN   3392
#define XCD_BAR_WORDS 3456
#define XB_SPIN_CAP (1u << 18)

__device__ __forceinline__ unsigned xb_ld(unsigned* p)              { return __hip_atomic_load(p, __ATOMIC_RELAXED, __HIP_MEMORY_SCOPE_AGENT); }
__device__ __forceinline__ unsigned xb_add(unsigned* p, unsigned v) { return __hip_atomic_fetch_add(p, v, __ATOMIC_RELAXED, __HIP_MEMORY_SCOPE_AGENT); }
__device__ __forceinline__ unsigned xb_xcc_id() { return (unsigned)__builtin_amdgcn_s_getreg((3 << 11) | 20) & 0xFu; }
#define XB_SPIN(cond, bar) do { unsigned _sp = 0; while (cond) { __builtin_amdgcn_s_sleep(1); \
    if ((++_sp & 255u) == 0u) { if (xb_ld(&(bar)[XB_TMO])) break; if (_sp > XB_SPIN_CAP) { atomicAdd(&(bar)[XB_TMO], 1u); break; } } } } while (0)

struct XcdBarrier {
    unsigned* bar; unsigned x;
    volatile LAS unsigned* st;
};

__device__ __forceinline__ XcdBarrier xcd_barrier_post(unsigned* bar, volatile LAS unsigned* st) {
    XcdBarrier b; b.bar = bar; b.x = xb_xcc_id(); b.st = st;
    if (threadIdx.x == 0) (void)xb_add(&bar[XB_XCNT(b.x)], 1u);
    return b;
}
__device__ __forceinline__ void xcd_barrier_complete(unsigned* bar, unsigned x, unsigned& nloc, unsigned& nx) {
    const unsigned G = gridDim.x * gridDim.y * gridDim.z;
    unsigned sum, cnt, mine, sp = 0u;
    for (;;) {
        sum = 0u; cnt = 0u; mine = 0u;
#pragma unroll
        for (unsigned j = 0; j < 16; ++j) { const unsigned c = xb_ld(&bar[XB_XCNT(j)]); sum += c; cnt += (c > 0u) ? 1u : 0u; mine = (j == x) ? c : mine; }
        if (sum == G) break;
        __builtin_amdgcn_s_sleep(1);
        if ((++sp & 255u) == 0u) { if (xb_ld(&bar[XB_TMO])) break; if (sp > XB_SPIN_CAP) { atomicAdd(&bar[XB_TMO], 1u); break; } }
    }
    nloc = mine > 0u ? mine : 1u; nx = cnt > 0u ? cnt : 1u;
}

__device__ __forceinline__ void xcd_barrier(const XcdBarrier& b) {
    asm volatile("s_waitcnt vmcnt(0)" ::: "memory");
    __syncthreads();
    if (threadIdx.x == 0) {
        unsigned* bar = b.bar;
        __builtin_amdgcn_s_waitcnt(0);
        unsigned nloc = b.st[0], nx = b.st[1];
        if (nloc == 0u) { xcd_barrier_complete(bar, b.x, nloc, nx); b.st[0] = nloc; b.st[1] = nx; }
        const unsigned old = xb_add(&bar[XB_XSUB(b.x)], 1u);
        const unsigned gen = old / nloc;
        if (old + 1u == (gen + 1u) * nloc) {
            __builtin_amdgcn_fence(__ATOMIC_RELEASE, "agent");
            asm volatile("s_waitcnt vmcnt(0)" ::: "memory");
            const unsigned og = xb_add(&bar[XB_TOP], 1u);
            const unsigned tg = og / nx;
            if (og + 1u == (tg + 1u) * nx) xb_add(&bar[XB_TOPGEN], 1u);
            else XB_SPIN(xb_ld(&bar[XB_TOPGEN]) == tg, bar);
            __builtin_amdgcn_fence(__ATOMIC_ACQUIRE, "agent");
            xb_add(&bar[XB_XGEN(b.x)], 1u);
            asm volatile("s_waitcnt vmcnt(0)" ::: "memory");
        } else {
            XB_SPIN(xb_ld(&bar[XB_XGEN(b.x)]) == gen, bar);
            __builtin_amdgcn_fence(__ATOMIC_ACQUIRE, "agent");
            asm volatile("s_waitcnt vmcnt(0)" ::: "memory");
        }
    }
    __syncthreads();
}
constexpr int NWAVES = 8;
constexpr int DM = 1024, NB = 4, SEQ = 4096, NMETA = 16, LP = 4112, MPR = 16448, DBATCH = 128, DSEQ = 4, MSAMP = 512, MTOK = 16960, MPAD = 17152;
constexpr int NH = 16, HD = 64, NKV = 4, LDQ = 2560, WIN = 128;
constexpr float RMS_EPS = 1e-6f, GN_EPS = 64e-5f, LOG2E = 1.4426950408889634f, QSCALE = 0.125f * 1.4426950408889634f;
constexpr size_t O_YP = 0, O_YS = 16777216, O_WKP = 17301504, O_WVP = 17432576, O_WKVP = 17563648, O_SHP = 17825792, O_WKS = 17829888, O_WVS = 22024192, O_WKVS = 26218496, O_SHS = 34607104, O_END = 34738176;
constexpr size_t MiB = 1u << 20;
constexpr size_t WS_CTL = 0, CTL_ZERO_BYTES = 1 * MiB;
constexpr size_t WS_WAIN = 1 * MiB, WS_WAOUT = 6 * MiB, WS_WRIN = 8 * MiB, WS_WROUT = 16 * MiB, WS_W1A1 = 18 * MiB;
constexpr size_t WS_KVP = 18 * MiB + 512 * 1024, WS_KVS = 19 * MiB, WS_SHP = 19 * MiB + 512 * 1024, WS_WKVP = 20 * MiB, WS_T12 = 21 * MiB;
constexpr size_t WS_XA = 30 * MiB, WS_QKVG = 64 * MiB, WS_H1 = 189 * MiB, WS_MIX = 30 * MiB, MIX_STRIDE = (size_t)MPAD * DM * 2, WS_G = 30 * MiB, WS_OG2 = 64 * MiB, WS_END = 256 * MiB;
constexpr size_t DO_MIX4 = 0, DO_MIX5 = MIX_STRIDE, RKV_STRIDE = (size_t)MTOK * DM * 2;
static_assert(WS_T12 + (size_t)MTOK * 128 * 4 <= WS_XA && WS_XA + MIX_STRIDE <= WS_QKVG && WS_QKVG + (size_t)MPAD * LDQ * 2 <= WS_H1 && WS_MIX + 4 * MIX_STRIDE <= WS_H1 && WS_H1 + (size_t)MPAD * DM * 4 <= WS_END, "ws map");
static_assert(3 * RKV_STRIDE <= O_WKVS * 4 && 2 * MIX_STRIDE <= O_END * 4, "d_out scratch map");
constexpr int CW_TMO = 0, CW_CODE = 1, CW_BAR = 4096;
constexpr int RING_OFF = 0, RING_BYTES = 131072, LDSCTL_OFF = RING_BYTES, MISC_OFF = LDSCTL_OFF + 320, LDS_BYTES = 147456;

typedef short s16x4 __attribute__((ext_vector_type(4)));
typedef float f32x16 __attribute__((ext_vector_type(16)));
struct Frame {
    LAS unsigned char* lds;
    volatile LAS unsigned* MISC;
    gu32* ctl;
    int tid, lane, wave, vcu, G;
    const float *xp, *xs, *cache_k, *cache_v, *state_wkv, *state_shift, *meta, *table, *norm_gain, *final_gain, *a_w_in, *sinks, *a_w_out;
    const float *mu, *r_w_in, *w0, *w1, *w2, *a0, *a1, *a2, *k_k, *k_a, *r_k, *ln_g, *ln_b, *r_w_out;
    float* out; unsigned char* ws; unsigned char* dob;
};
__device__ __forceinline__ float wave_sum(float v) {
#pragma unroll
    for (int o = 1; o < 64; o <<= 1) v += __shfl_xor(v, o);
    return v;
}
__device__ __forceinline__ float bf2f(bf16 b) { return __builtin_bit_cast(float, (unsigned)b << 16); }
__device__ __forceinline__ const float* h0_row(const Frame& F, int m) {
    if (m < MPR) { const int b = m / LP, t = m - b * LP; return t < NMETA ? F.meta + t * DM : F.xp + ((size_t)b * SEQ + (t - NMETA)) * DM; }
    return F.xs + (size_t)(m - MPR) * DM;
}
__device__ __forceinline__ void p0_transpose_item(const float* W, int K, int N, bf16* WT, int row_off, LAS float* scr, int item, int lane) {
    const int nblk = N / 32, kb = item / nblk, nb = item % nblk, k0 = 64 * kb, n0 = 32 * nb;
#pragma unroll 8
    for (int i = 0; i < 32; ++i) { const int kk = 2 * i + (lane >> 5); scr[kk * 33 + (lane & 31)] = W[(size_t)(k0 + kk) * N + n0 + (lane & 31)]; }
    LDS_WAIT(); asm volatile("" ::: "memory");
    const int c = lane & 7;
#pragma unroll
    for (int j = 0; j < 4; ++j) { const int n = (lane >> 3) + 8 * j; const LAS float* s = scr + (8 * c) * 33 + n;
        v4u o; o.x = pk2(s[0 * 33], s[1 * 33]); o.y = pk2(s[2 * 33], s[3 * 33]); o.z = pk2(s[4 * 33], s[5 * 33]); o.w = pk2(s[6 * 33], s[7 * 33]);
        *(GAS v4u*)(WT + (size_t)(row_off + n0 + n) * K + k0 + 8 * c) = o; }
    LDS_WAIT(); asm volatile("" ::: "memory");
}
__device__ __forceinline__ void rms_row(const float* xrow, const float* gain, int lane, f32x4 (&v)[4]) {
    const GAS f32x4* xr = (const GAS f32x4*)xrow + lane; float s = 0.f;
#pragma unroll
    for (int j = 0; j < 4; ++j) { v[j] = xr[64 * j]; s += (v[j].x * v[j].x + v[j].y * v[j].y) + (v[j].z * v[j].z + v[j].w * v[j].w); }
    const float rstd = 1.0f / sqrtf(wave_sum(s) * (1.f / DM) + RMS_EPS);
    const GAS f32x4* gr = (const GAS f32x4*)gain + lane;
#pragma unroll
    for (int j = 0; j < 4; ++j) v[j] = v[j] * rstd * gr[64 * j];
}
__device__ __forceinline__ void store_bf16_row(bf16* orow, int lane, const f32x4 (&v)[4]) {
    GAS unsigned long long* o8 = (GAS unsigned long long*)orow + lane;
#pragma unroll
    for (int j = 0; j < 4; ++j) o8[64 * j] = (unsigned long long)pk2(v[j].x, v[j].y) | ((unsigned long long)pk2(v[j].z, v[j].w) << 32);
}
__device__ __forceinline__ void p0_prologue(Frame& F) {
    LAS float* scr = (LAS float*)(F.lds + RING_OFF + F.wave * 16384);
    const int gw = F.vcu * NWAVES + F.wave, NGW = F.G * NWAVES;
    bf16* wain = (bf16*)(F.ws + WS_WAIN); bf16* waout = (bf16*)(F.ws + WS_WAOUT); bf16* wrin = (bf16*)(F.ws + WS_WRIN); bf16* wrout = (bf16*)(F.ws + WS_WROUT); bf16* w1a1 = (bf16*)(F.ws + WS_W1A1);
    constexpr int I_AIN = 16 * 80, I_SQ = 16 * 32, I_L1 = 16 * 2;
    constexpr int NITEMS = I_AIN + 6 * I_SQ + 2 * I_L1;
    for (int it = gw; it < NITEMS; it += NGW) {
        int r = it;
        if (r < I_AIN) { p0_transpose_item(F.a_w_in, DM, LDQ, wain, 0, scr, r, F.lane); continue; } r -= I_AIN;
        if (r < I_SQ) { p0_transpose_item(F.a_w_out, DM, DM, waout, 0, scr, r, F.lane); continue; } r -= I_SQ;
        if (r < 4 * I_SQ) { const int c = r / I_SQ; p0_transpose_item(F.r_w_in + (size_t)c * DM * DM, DM, DM, wrin, c * DM, scr, r - c * I_SQ, F.lane); continue; } r -= 4 * I_SQ;
        if (r < I_SQ) { p0_transpose_item(F.r_w_out, DM, DM, wrout, 0, scr, r, F.lane); continue; } r -= I_SQ;
        if (r < I_L1) { p0_transpose_item(F.w1, DM, 64, w1a1, 0, scr, r, F.lane); continue; } r -= I_L1;
        p0_transpose_item(F.a1, DM, 64, w1a1, 64, scr, r, F.lane);
    }
    bf16* xa = (bf16*)(F.ws + WS_XA);
    for (int m = gw; m < MPAD; m += NGW) {
        f32x4 v[4];
        if (m < MTOK) rms_row(h0_row(F, m), F.norm_gain, F.lane, v);
        else { for (int j = 0; j < 4; ++j) v[j] = (f32x4){0.f, 0.f, 0.f, 0.f}; }
        store_bf16_row(xa + (size_t)m * DM, F.lane, v);
    }
}

namespace att {
constexpr int KSTR = 72, VSTR = 260;
constexpr int BEXT = 192;
constexpr int K_OFF = 0, V_OFF = 256 * KSTR * 2, B_OFF = V_OFF + 64 * VSTR * 2, ST_OFF = B_OFF + NH * BEXT * 4, END_OFF = ST_OFF + NWAVES * 4096;
static_assert(END_OFF <= RING_BYTES && (B_OFF % 16) == 0 && (ST_OFF % 16) == 0, "attention LDS");
__device__ __forceinline__ int crow(int r, int hi) { return (r & 3) + 8 * (r >> 2) + 4 * hi; }
__device__ __forceinline__ int t5_bucket(int rel) {
    if (rel < 16) return rel;
    int b = 16;
    b += rel >= 19; b += rel >= 21; b += rel >= 24; b += rel >= 27; b += rel >= 31; b += rel >= 35; b += rel >= 40; b += rel >= 46;
    b += rel >= 52; b += rel >= 59; b += rel >= 67; b += rel >= 77; b += rel >= 87; b += rel >= 99; b += rel >= 113;
    return b;
}
__device__ __forceinline__ void attn_wave(LAS unsigned char* lds, const bf16* qkvg, bf16* og, int qrow0, int nq, int jt, int kt_lo, int h, float sink2, int lane, int wave) {
    const int c = lane & 31, hh = lane >> 5;
    const LAS float* bp = (const LAS float*)(lds + B_OFF) + h * BEXT + 5 + c - 4 * hh;
    const int qrow = qrow0 + (c < nq ? c : nq - 1);
    bf16x8 qf[4];
#pragma unroll
    for (int s = 0; s < 4; ++s) qf[s] = *(const GAS bf16x8*)(qkvg + (size_t)qrow * LDQ + h * HD + 16 * s + 8 * hh);
    const LAS unsigned char* kbase = lds + K_OFF + ((32 * jt + c) * KSTR + 8 * hh) * 2;
    const LAS unsigned char* vbase = lds + V_OFF + (c * VSTR + 32 * jt + 4 * hh) * 2;
    f32x16 sc[5];
#pragma unroll
    for (int kt = 0; kt < 5; ++kt) {
        f32x16 a;
#pragma unroll
        for (int r = 0; r < 16; ++r) a[r] = bp[155 - (32 * kt + (r & 3) + 8 * (r >> 2))];
#pragma unroll
        for (int s = 0; s < 4; ++s) { const bf16x8 kf = *(const LAS bf16x8*)(kbase + kt * (32 * KSTR * 2) + 32 * s); a = __builtin_amdgcn_mfma_f32_32x32x16_bf16(kf, qf[s], a, 0, 0, 0); }
        if (kt < kt_lo) {
#pragma unroll
            for (int r = 0; r < 16; ++r) a[r] = -1e30f;
        }
        sc[kt] = a;
    }
    float mx = -1e30f;
#pragma unroll
    for (int kt = 0; kt < 5; ++kt)
#pragma unroll
        for (int r = 0; r < 16; ++r) mx = fmaxf(mx, sc[kt][r]);
    mx = fmaxf(mx, __shfl_xor(mx, 32)); mx = fmaxf(mx, sink2);
    float l = 0.f;
#pragma unroll
    for (int kt = 0; kt < 5; ++kt)
#pragma unroll
        for (int r = 0; r < 16; ++r) { const float p = __builtin_amdgcn_exp2f(sc[kt][r] - mx); sc[kt][r] = p; l += p; }
    l += __shfl_xor(l, 32); l += __builtin_amdgcn_exp2f(sink2 - mx);
    const float linv = 1.0f / l;
    f32x16 o[2]; o[0] = f32x16{}; o[1] = f32x16{};
#pragma unroll
    for (int kt = 0; kt < 5; ++kt) {
#pragma unroll
        for (int s2 = 0; s2 < 2; ++s2) {
            v4u pw; pw.x = pk2(sc[kt][8 * s2 + 0] * linv, sc[kt][8 * s2 + 1] * linv); pw.y = pk2(sc[kt][8 * s2 + 2] * linv, sc[kt][8 * s2 + 3] * linv);
            pw.z = pk2(sc[kt][8 * s2 + 4] * linv, sc[kt][8 * s2 + 5] * linv); pw.w = pk2(sc[kt][8 * s2 + 6] * linv, sc[kt][8 * s2 + 7] * linv);
            const bf16x8 pf = __builtin_bit_cast(bf16x8, pw);
#pragma unroll
            for (int dh = 0; dh < 2; ++dh) {
                const LAS unsigned char* vp = vbase + (32 * dh * VSTR + 32 * kt + 16 * s2) * 2;
                const s16x4 lo = *(const LAS s16x4*)vp, hi = *(const LAS s16x4*)(vp + 16);
                const bf16x8 vf = (bf16x8){lo[0], lo[1], lo[2], lo[3], hi[0], hi[1], hi[2], hi[3]};
                o[dh] = __builtin_amdgcn_mfma_f32_32x32x16_bf16(pf, vf, o[dh], 0, 0, 0);
            }
        }
    }
    LAS float* stg = (LAS float*)(lds + ST_OFF + wave * 4096);
    const int srow = lane >> 1, sc0 = (lane & 1) * 16;
    const size_t grow = (size_t)(qrow0 + srow);
#pragma unroll
    for (int dh = 0; dh < 2; ++dh) {
#pragma unroll
        for (int r = 0; r < 16; ++r) stg[((r & 3) + 8 * (r >> 2) + 4 * hh) * 32 + c] = o[dh][r];
        asm volatile("s_waitcnt lgkmcnt(0)" ::: "memory");
        f32x4 x[4];
#pragma unroll
        for (int i = 0; i < 4; ++i) x[i] = *(const LAS f32x4*)(stg + srow * 32 + sc0 + 4 * i);
        asm volatile("s_waitcnt lgkmcnt(0)" ::: "memory");
        if (srow < nq) {
            const int col = h * HD + 32 * dh + sc0;
            const v4u g0 = *(const GAS v4u*)(qkvg + grow * LDQ + 1536 + col), g1 = *(const GAS v4u*)(qkvg + grow * LDQ + 1536 + col + 8);
            const unsigned gw[8] = {g0.x, g0.y, g0.z, g0.w, g1.x, g1.y, g1.z, g1.w};
            unsigned ow[8];
#pragma unroll
            for (int e = 0; e < 8; ++e) { const float ga = __builtin_bit_cast(float, gw[e] << 16), gb = __builtin_bit_cast(float, gw[e] & 0xffff0000u);
                const float ya = x[e >> 1][(e & 1) * 2] * ga / (1.0f + __expf(-ga)), yb = x[e >> 1][(e & 1) * 2 + 1] * gb / (1.0f + __expf(-gb)); ow[e] = pk2(ya, yb); }
            *(GAS v4u*)(og + grow * DM + col) = (v4u){ow[0], ow[1], ow[2], ow[3]}; *(GAS v4u*)(og + grow * DM + col + 8) = (v4u){ow[4], ow[5], ow[6], ow[7]};
        }
    }
}
constexpr int N_PROMPT_UNITS = NB * NKV * 33, N_SAMPLE_UNITS = DBATCH * NKV, N_COPY_UNITS = 8, N_UNITS = N_PROMPT_UNITS + N_SAMPLE_UNITS + N_COPY_UNITS;
}
__device__ __forceinline__ void p2_attention(Frame& F) {
    using namespace att;
    const bf16* qkvg = (const bf16*)(F.ws + WS_QKVG); bf16* og = (bf16*)(F.ws + WS_XA);
    LAS unsigned char* lds = F.lds + RING_OFF;
    for (int i = F.tid; i < NH * BEXT; i += NWAVES * 64) { const int h = i / BEXT, rel = i % BEXT - 32;
        ((LAS float*)(lds + B_OFF))[i] = (rel >= 0 && rel < 128) ? F.table[t5_bucket(rel) * NH + h] * LOG2E : -1e30f; }
    __syncthreads();
#pragma unroll 1
    for (int u = F.vcu; u < N_UNITS; u += F.G) {
        if (u >= N_PROMPT_UNITS + N_SAMPLE_UNITS) {
            const int cu = u - (N_PROMPT_UNITS + N_SAMPLE_UNITS);
            bf16* kvp = (bf16*)(F.ws + WS_KVP); bf16* kvs = (bf16*)(F.ws + WS_KVS);
            for (int i = cu * 512 + F.tid; i < 1024 * 64; i += N_COPY_UNITS * 512) {
                const int rr = i >> 6, ch = i & 63;
                const int srow = rr < 512 ? (rr >> 7) * LP + (LP - WIN) + (rr & 127) : MPR + (rr - 512);
                const v4u x = *(const GAS v4u*)(qkvg + (size_t)srow * LDQ + 1024 + 8 * ch);
                bf16* dst = rr < 512 ? kvp + (size_t)rr * 512 + 8 * ch : kvs + (size_t)(rr - 512) * 512 + 8 * ch;
                *(GAS v4u*)dst = x;
            }
            continue;
        }
        int kvh, nwu, qbase, q0, kt0;
        const bool is_prompt = u < N_PROMPT_UNITS;
        const int row = F.tid >> 1, half = F.tid & 1;
        if (is_prompt) {
            const int qblk = u % 33, b = u / (33 * NKV); kvh = (u / 33) % NKV;
            q0 = 128 * qblk; nwu = 16; qbase = b * LP + q0; kt0 = qblk == 0 ? 4 : 0;
            int pos = q0 - 128 + row; pos = pos < 0 ? 0 : (pos > LP - 1 ? LP - 1 : pos);
            const bf16* src = qkvg + (size_t)(b * LP + pos) * LDQ + 1024 + kvh * HD + half * 32;
#pragma unroll
            for (int i = 0; i < 4; ++i) { const v4u kv = *(const GAS v4u*)(src + 8 * i); *(LAS v4u*)(lds + K_OFF + (row * KSTR + half * 32 + 8 * i) * 2) = kv; }
#pragma unroll
            for (int i = 0; i < 4; ++i) { const v4u vv = *(const GAS v4u*)(src + 256 + 8 * i); const unsigned w[4] = {vv.x, vv.y, vv.z, vv.w};
#pragma unroll
                for (int e = 0; e < 8; ++e) { const bf16 x = (bf16)((w[e >> 1] >> ((e & 1) * 16)) & 0xffffu); *(LAS bf16*)(lds + V_OFF + ((half * 32 + 8 * i + e) * VSTR + row) * 2) = x; } }
        } else {
            const int su = u - N_PROMPT_UNITS, sb = su / NKV; kvh = su % NKV;
            q0 = LP; nwu = 4; qbase = MPR + sb * DSEQ; kt0 = 0;
            if (row < 160) {
#pragma unroll
                for (int i = 0; i < 4; ++i) {
                    v4u kq = (v4u){0u, 0u, 0u, 0u}, vq = (v4u){0u, 0u, 0u, 0u};
                    if (row < 128) {
                        const float* ck = F.cache_k + (((size_t)sb * WIN + row) * NKV + kvh) * HD + half * 32 + 8 * i; const float* cv = F.cache_v + (((size_t)sb * WIN + row) * NKV + kvh) * HD + half * 32 + 8 * i;
                        const f32x4 a0 = *(const GAS f32x4*)ck, a1 = *(const GAS f32x4*)(ck + 4), b0 = *(const GAS f32x4*)cv, b1 = *(const GAS f32x4*)(cv + 4);
                        kq = (v4u){pk2(a0.x, a0.y), pk2(a0.z, a0.w), pk2(a1.x, a1.y), pk2(a1.z, a1.w)}; vq = (v4u){pk2(b0.x, b0.y), pk2(b0.z, b0.w), pk2(b1.x, b1.y), pk2(b1.z, b1.w)};
                    } else if (row < 132) {
                        const bf16* src = qkvg + (size_t)(MPR + sb * DSEQ + (row - 128)) * LDQ + 1024 + kvh * HD + half * 32 + 8 * i;
                        kq = *(const GAS v4u*)src; vq = *(const GAS v4u*)(src + 256);
                    }
                    *(LAS v4u*)(lds + K_OFF + (row * KSTR + half * 32 + 8 * i) * 2) = kq;
                    const unsigned w[4] = {vq.x, vq.y, vq.z, vq.w};
#pragma unroll
                    for (int e = 0; e < 8; ++e) { const bf16 x = (bf16)((w[e >> 1] >> ((e & 1) * 16)) & 0xffffu); *(LAS bf16*)(lds + V_OFF + ((half * 32 + 8 * i + e) * VSTR + row) * 2) = x; }
                }
            }
        }
        __syncthreads();
#pragma unroll 1
        for (int wu = F.wave; wu < nwu; wu += NWAVES) {
            const int hg = wu & 3, j = wu >> 2, h = kvh * 4 + hg;
            int nq = is_prompt ? LP - (q0 + 32 * j) : DSEQ; nq = nq < 32 ? nq : 32;
            if (nq > 0) attn_wave(lds, qkvg, og, qbase + 32 * j, nq, j, kt0 - j, h, F.sinks[h] * LOG2E, F.lane, F.wave);
        }
        __syncthreads();
    }
}

__device__ __forceinline__ void p4_mix(Frame& F) {
    const int gw = F.vcu * NWAVES + F.wave, NGW = F.G * NWAVES;
    const float* h1 = (const float*)(F.ws + WS_H1); const float* gain = F.norm_gain + DM;
    for (int m = gw; m < MTOK; m += NGW) {
        f32x4 x[4], xp[4];
        rms_row(h1 + (size_t)m * DM, gain, F.lane, x);
        bool first; const float* sh = nullptr;
        if (m < MPR) { first = (m % LP) == 0; } else { first = ((m - MPR) & 3) == 0; sh = F.state_shift + (size_t)((m - MPR) >> 2) * DM; }
        if (!first) rms_row(h1 + (size_t)(m - 1) * DM, gain, F.lane, xp);
        else {
#pragma unroll
            for (int j = 0; j < 4; ++j) xp[j] = sh ? ((const GAS f32x4*)sh)[F.lane + 64 * j] : (f32x4){0.f, 0.f, 0.f, 0.f};
        }
#pragma unroll
        for (int c = 0; c < 6; ++c) {
            bf16* dst = (c < 4 ? (bf16*)(F.ws + WS_MIX + c * MIX_STRIDE) : (bf16*)(F.dob + (c == 4 ? DO_MIX4 : DO_MIX5))) + (size_t)m * DM;
            f32x4 v[4];
#pragma unroll
            for (int j = 0; j < 4; ++j) { const f32x4 mu = ((const GAS f32x4*)(F.mu + c * DM))[F.lane + 64 * j]; v[j] = x[j] + (xp[j] - x[j]) * mu; }
            store_bf16_row(dst, F.lane, v);
        }
        if (m < MPR) { if ((m % LP) == LP - 1) { float* d = (float*)(F.ws + WS_SHP) + (size_t)(m / LP) * DM;
#pragma unroll
                for (int j = 0; j < 4; ++j) ((GAS f32x4*)d)[F.lane + 64 * j] = x[j]; } }
        else if (((m - MPR) & 3) == 3) { float* d = F.out + O_SHS + (size_t)((m - MPR) >> 2) * DM;
#pragma unroll
            for (int j = 0; j < 4; ++j) ((GAS f32x4*)d)[F.lane + 64 * j] = x[j]; }
    }
}

__device__ __forceinline__ void p5a_lora1(Frame& F) {
    const int gw = F.vcu * NWAVES + F.wave, NGW = F.G * NWAVES;
    const bf16* w1a1 = (const bf16*)(F.ws + WS_W1A1); float* t12 = (float*)(F.ws + WS_T12);
    const int c = F.lane & 31, hh = F.lane >> 5;
    constexpr int NRT = MTOK / 32;
    for (int it = gw; it < NRT * 4; it += NGW) {
        const int rt = it >> 2, ct = it & 3;
        const bf16* A = (const bf16*)(F.dob + (ct < 2 ? DO_MIX4 : DO_MIX5)) + (size_t)(rt * 32 + c) * DM + 8 * hh;
        const bf16* B = w1a1 + (size_t)(ct * 32 + c) * DM + 8 * hh;
        f32x16 acc = f32x16{};
#pragma unroll 8
        for (int s = 0; s < DM / 16; ++s) { const bf16x8 af = *(const GAS bf16x8*)(A + 16 * s), bfr = *(const GAS bf16x8*)(B + 16 * s); acc = __builtin_amdgcn_mfma_f32_32x32x16_bf16(af, bfr, acc, 0, 0, 0); }
#pragma unroll
        for (int r = 0; r < 16; ++r) { const int row = rt * 32 + att::crow(r, hh); float v = acc[r]; if (ct < 2) v = tanhf(v); t12[(size_t)row * 128 + ct * 32 + c] = v; }
    }
}

__device__ __forceinline__ void wkv_seq_unit(Frame& F, LAS float* wl, int row0, int T, int h, const float* S0, float* Sout, int lane) {
    const bf16* R = (const bf16*)(F.dob); const bf16* Kb = (const bf16*)(F.dob + RKV_STRIDE); const bf16* Vb = (const bf16*)(F.dob + 2 * RKV_STRIDE);
    const bf16* Gb = (const bf16*)(F.ws + WS_G); const float* t12 = (const float*)(F.ws + WS_T12); bf16* og2 = (bf16*)(F.ws + WS_OG2);
    const int ch = h * HD + lane;
    unsigned w2p[32], a2p[32]; float S[64];
#pragma unroll
    for (int i = 0; i < 32; ++i) { w2p[i] = pk2(F.w2[(2 * i) * DM + ch], F.w2[(2 * i + 1) * DM + ch]); a2p[i] = pk2(F.a2[(2 * i) * DM + ch], F.a2[(2 * i + 1) * DM + ch]); }
    const float w0c = F.w0[ch], a0c = F.a0[ch], kkc = F.k_k[ch], kac = F.k_a[ch], rkc = F.r_k[ch], lng = F.ln_g[ch], lnb = F.ln_b[ch];
    if (S0) {
#pragma unroll
        for (int i = 0; i < 16; ++i) { const f32x4 v = *(const GAS f32x4*)(S0 + (size_t)lane * 64 + 4 * i); S[4 * i] = v.x; S[4 * i + 1] = v.y; S[4 * i + 2] = v.z; S[4 * i + 3] = v.w; }
    } else {
#pragma unroll
        for (int i = 0; i < 64; ++i) S[i] = 0.f;
    }
    for (int t = 0; t < T; ++t) {
        const size_t m = (size_t)(row0 + t);
#pragma unroll
        for (int i = 0; i < 32; ++i) { asm volatile("" : "+v"(w2p[i])); asm volatile("" : "+v"(a2p[i])); }
        const float r = bf2f(R[m * DM + ch]), k = bf2f(Kb[m * DM + ch]), v = bf2f(Vb[m * DM + ch]), g = bf2f(Gb[m * DM + ch]);
        wl[lane] = t12[m * 128 + lane]; wl[64 + lane] = t12[m * 128 + 64 + lane];
        asm volatile("s_waitcnt lgkmcnt(0)" ::: "memory");
        float z = w0c, az = a0c;
#pragma unroll
        for (int i = 0; i < 16; ++i) { const f32x4 x = *(const LAS f32x4*)(wl + 4 * i), y = *(const LAS f32x4*)(wl + 64 + 4 * i);
            z += x.x * __builtin_bit_cast(float, w2p[2 * i] << 16) + x.y * __builtin_bit_cast(float, w2p[2 * i] & 0xffff0000u) + x.z * __builtin_bit_cast(float, w2p[2 * i + 1] << 16) + x.w * __builtin_bit_cast(float, w2p[2 * i + 1] & 0xffff0000u);
            az += y.x * __builtin_bit_cast(float, a2p[2 * i] << 16) + y.y * __builtin_bit_cast(float, a2p[2 * i] & 0xffff0000u) + y.z * __builtin_bit_cast(float, a2p[2 * i + 1] << 16) + y.w * __builtin_bit_cast(float, a2p[2 * i + 1] & 0xffff0000u); }
        const float a = 1.0f / (1.0f + __expf(-az)), sg = 1.0f / (1.0f + __expf(-z)), dec = __expf(-0.6065306597126334f * sg);
        float kk = k * kkc; const float n2 = wave_sum(kk * kk); kk = kk / fmaxf(sqrtf(n2), 1e-12f);
        const float kh = k * (1.0f + (a - 1.0f) * kac);
        const float rk = wave_sum(r * kh * rkc);
        wl[128 + lane] = -kk; wl[192 + lane] = kk * a; wl[256 + lane] = dec; wl[320 + lane] = kh; wl[384 + lane] = r;
        asm volatile("s_waitcnt lgkmcnt(0)" ::: "memory");
        float sa = 0.f;
#pragma unroll
        for (int i = 0; i < 16; ++i) { const f32x4 x = *(const LAS f32x4*)(wl + 128 + 4 * i); sa += S[4 * i] * x.x + S[4 * i + 1] * x.y + S[4 * i + 2] * x.z + S[4 * i + 3] * x.w; }
        float y = 0.f;
#pragma unroll
        for (int i = 0; i < 16; ++i) {
            const f32x4 bq = *(const LAS f32x4*)(wl + 192 + 4 * i), wq = *(const LAS f32x4*)(wl + 256 + 4 * i), kq = *(const LAS f32x4*)(wl + 320 + 4 * i), rq = *(const LAS f32x4*)(wl + 384 + 4 * i);
            S[4 * i] = S[4 * i] * wq.x + sa * bq.x + v * kq.x; S[4 * i + 1] = S[4 * i + 1] * wq.y + sa * bq.y + v * kq.y;
            S[4 * i + 2] = S[4 * i + 2] * wq.z + sa * bq.z + v * kq.z; S[4 * i + 3] = S[4 * i + 3] * wq.w + sa * bq.w + v * kq.w;
            y += S[4 * i] * rq.x + S[4 * i + 1] * rq.y + S[4 * i + 2] * rq.z + S[4 * i + 3] * rq.w; }
        const float mean = wave_sum(y) * (1.f / 64.f), dv = y - mean, var = wave_sum(dv * dv) * (1.f / 64.f);
        const float yn = dv * (1.0f / sqrtf(var + GN_EPS)) * lng + lnb + rk * v;
        og2[m * DM + ch] = (bf16)f2bf(yn * g / (1.0f + __expf(-g)));
        asm volatile("" ::: "memory");
    }
#pragma unroll
    for (int i = 0; i < 16; ++i) *(GAS f32x4*)(Sout + (size_t)lane * 64 + 4 * i) = (f32x4){S[4 * i], S[4 * i + 1], S[4 * i + 2], S[4 * i + 3]};
}
__device__ __forceinline__ void p6_wkv_seq(Frame& F) {
    LAS float* wl = (LAS float*)(F.lds + RING_OFF) + F.wave * 512;
    constexpr int NSU = DBATCH * NH;
    for (int u = F.wave * F.G + F.vcu; u < NSU + NB * NH; u += NWAVES * F.G) {
        if (u < NSU) { const int sb = u / NH, h = u % NH;
            wkv_seq_unit(F, wl, MPR + sb * DSEQ, DSEQ, h, F.state_wkv + (size_t)u * 4096, F.out + O_WKVS + (size_t)u * 4096, F.lane); }
        else { const int pu = u - NSU, b = pu / NH, h = pu % NH;
            wkv_seq_unit(F, wl, b * LP, LP, h, nullptr, (float*)(F.ws + WS_WKVP) + (size_t)pu * 4096, F.lane); }
    }
}

__device__ __forceinline__ void p8_final(Frame& F) {
    const int gw = F.vcu * NWAVES + F.wave, NGW = F.G * NWAVES;
    const float* h2 = (const float*)(F.ws + WS_H1);
    for (int m = gw; m < MTOK; m += NGW) {
        float* dst;
        if (m < MPR) { const int b = m / LP, t = m - b * LP; if (t < NMETA) continue; dst = F.out + O_YP + ((size_t)b * SEQ + (t - NMETA)) * DM; }
        else dst = F.out + O_YS + (size_t)(m - MPR) * DM;
        f32x4 v[4]; rms_row(h2 + (size_t)m * DM, F.final_gain, F.lane, v);
#pragma unroll
        for (int j = 0; j < 4; ++j) ((GAS f32x4*)dst)[F.lane + 64 * j] = v[j];
    }
    const int gt = F.vcu * (NWAVES * 64) + F.tid, NGT = F.G * NWAVES * 64;
    const bf16* kvp = (const bf16*)(F.ws + WS_KVP); const bf16* kvs = (const bf16*)(F.ws + WS_KVS);
    for (int i = gt; i < 2 * NB * WIN * 256; i += NGT) { const int kv = i / (NB * WIN * 256), r = i % (NB * WIN * 256), row = r >> 8, col = r & 255;
        F.out[(kv ? O_WVP : O_WKP) + r] = bf2f(kvp[(size_t)row * 512 + kv * 256 + col]); }
    for (int i = gt; i < NB * NH * 4096; i += NGT) F.out[O_WKVP + i] = ((const float*)(F.ws + WS_WKVP))[i];
    for (int i = gt; i < NB * DM; i += NGT) F.out[O_SHP + i] = ((const float*)(F.ws + WS_SHP))[i];
    for (int i = gt; i < 2 * DBATCH * WIN * 64; i += NGT) {
        const int kv = i / (DBATCH * WIN * 64), r = i % (DBATCH * WIN * 64), sb = r / (WIN * 64), j = (r / 64) % WIN, c4 = r % 64;
        f32x4 v;
        if (j < WIN - DSEQ) v = *(const GAS f32x4*)((kv ? F.cache_v : F.cache_k) + ((size_t)sb * WIN + j + DSEQ) * 256 + 4 * c4);
        else { const bf16* s = kvs + (size_t)(sb * DSEQ + (j - (WIN - DSEQ))) * 512 + kv * 256 + 4 * c4; v = (f32x4){bf2f(s[0]), bf2f(s[1]), bf2f(s[2]), bf2f(s[3])}; }
        *(GAS f32x4*)(F.out + (kv ? O_WVS : O_WKS) + (size_t)r * 4) = v;
    }
}
#ifndef MK_ONE_LAUNCH
#define MK_ONE_LAUNCH 0
#endif
constexpr int N_PHASES = 11;
struct Args { const float* in[27]; float* out; unsigned char* ws; int ph_lo, ph_hi, li, pad; };
__global__ void __launch_bounds__(NWAVES * 64, 2) mega_fwd(Args args) {
    extern __shared__ __attribute__((aligned(16))) unsigned char lds[];
    Frame F;
    F.lds = (LAS unsigned char*)lds;
    F.MISC = (volatile LAS unsigned*)(F.lds + MISC_OFF);
    F.tid = threadIdx.x; F.lane = F.tid & 63; F.wave = __builtin_amdgcn_readfirstlane(F.tid >> 6);
    F.G = gridDim.x; { const int bx = blockIdx.x; F.vcu = (F.G % 8 == 0) ? (bx % 8) * (F.G / 8) + bx / 8 : bx; }
    F.ws = args.ws; F.out = args.out; F.dob = (unsigned char*)args.out;
    F.ctl = (gu32*)(F.ws + WS_CTL);
    F.xp = args.in[0]; F.xs = args.in[1]; F.cache_k = args.in[2]; F.cache_v = args.in[3]; F.state_wkv = args.in[4]; F.state_shift = args.in[5];
    F.meta = args.in[6]; F.table = args.in[7]; F.norm_gain = args.in[8]; F.final_gain = args.in[9]; F.a_w_in = args.in[10]; F.sinks = args.in[11]; F.a_w_out = args.in[12];
    F.mu = args.in[13]; F.r_w_in = args.in[14]; F.w0 = args.in[15]; F.w1 = args.in[16]; F.w2 = args.in[17]; F.a0 = args.in[18]; F.a1 = args.in[19]; F.a2 = args.in[20];
    F.k_k = args.in[21]; F.k_a = args.in[22]; F.r_k = args.in[23]; F.ln_g = args.in[24]; F.ln_b = args.in[25]; F.r_w_out = args.in[26];
    for (int u = F.tid; u < (LDS_BYTES - LDSCTL_OFF) / 4; u += NWAVES * 64) ((LAS unsigned*)(F.lds + LDSCTL_OFF))[u] = 0u;
    __syncthreads();
    XcdBarrier bar; bar.bar = (unsigned*)(F.ctl + CW_BAR); bar.x = 0; bar.st = nullptr;
    const int lo = args.ph_lo, hi = args.ph_hi;
    if (hi - lo > 1) bar = xcd_barrier_post((unsigned*)(F.ctl + CW_BAR), F.MISC + 8);
#define IN(k) (lo <= (k) && (k) < hi)
#define SEAM(k) do { if (IN(k) && IN((k) + 1)) xcd_barrier(bar); } while (0)
    bf16* XA = (bf16*)(F.ws + WS_XA); bf16* QKVG = (bf16*)(F.ws + WS_QKVG); float* H1 = (float*)(F.ws + WS_H1);
    bf16* Rb = (bf16*)(F.dob); bf16* Kb = (bf16*)(F.dob + RKV_STRIDE); bf16* Vb = (bf16*)(F.dob + 2 * RKV_STRIDE); bf16* Gb = (bf16*)(F.ws + WS_G);

    if (IN(0)) { p0_prologue(F); } SEAM(0);
    if (IN(1)) {
        pg8::Gemm g{XA, (const bf16*)(F.ws + WS_WAIN), MPAD, LDQ, DM, 1 << 30, 0}; pg8::StaticOrder S; S.init(MPAD, LDQ, F.G, (int)blockIdx.x);
        pg8::EpiBf16G E{QKVG, QKVG, QKVG, QKVG, LDQ, 64, MPAD, 4, QSCALE};
        pg8::gemm_phase<pg8::EpiBf16G, pg8::StaticOrder, true, true>(F.lds + RING_OFF, g, S, E);
    } SEAM(1);
    if (IN(2)) { p2_attention(F); } SEAM(2);
    if (IN(3)) {
        pg8::Gemm g{XA, (const bf16*)(F.ws + WS_WAOUT), MPAD, DM, DM, 1 << 30, 0}; pg8::StaticOrder S; S.init(MPAD, DM, F.G, (int)blockIdx.x);
        pg8::EpiRes E{nullptr, H1, F.meta, F.xp, F.xs, MTOK};
        pg8::gemm_phase<pg8::EpiRes, pg8::StaticOrder, true, true>(F.lds + RING_OFF, g, S, E);
    } SEAM(3);
    if (IN(4)) { p4_mix(F); } SEAM(4);
    if (IN(5)) { p5a_lora1(F); } SEAM(5);
    if (IN(6)) {
        pg8::Gemm g{(const bf16*)(F.ws + WS_MIX), (const bf16*)(F.ws + WS_WRIN), MPAD, 3 * DM, DM, 4, MIX_STRIDE}; pg8::StaticOrder S; S.init(MPAD, 3 * DM, F.G, (int)blockIdx.x);
        pg8::EpiBf16G E{Rb, Kb, Vb, Vb, DM, 4, MTOK, 0, 1.f};
        pg8::gemm_phase<pg8::EpiBf16G, pg8::StaticOrder, true, true>(F.lds + RING_OFF, g, S, E);
    } SEAM(6);
    if (IN(7)) {
        pg8::Gemm g{(const bf16*)(F.ws + WS_MIX + 3 * MIX_STRIDE), (const bf16*)(F.ws + WS_WRIN) + (size_t)3 * DM * DM, MPAD, DM, DM, 1 << 30, 0}; pg8::StaticOrder S; S.init(MPAD, DM, F.G, (int)blockIdx.x);
        pg8::EpiBf16G E{Gb, Gb, Gb, Gb, DM, 64, MTOK, 0, 1.f};
        pg8::gemm_phase<pg8::EpiBf16G, pg8::StaticOrder, true, true>(F.lds + RING_OFF, g, S, E);
    } SEAM(7);
    if (IN(8)) { p6_wkv_seq(F); } SEAM(8);
    if (IN(9)) {
        pg8::Gemm g{(const bf16*)(F.ws + WS_OG2), (const bf16*)(F.ws + WS_WROUT), MPAD, DM, DM, 1 << 30, 0}; pg8::StaticOrder S; S.init(MPAD, DM, F.G, (int)blockIdx.x);
        pg8::EpiRes E{H1, H1, F.meta, F.xp, F.xs, MTOK};
        pg8::gemm_phase<pg8::EpiRes, pg8::StaticOrder, true, true>(F.lds + RING_OFF, g, S, E);
    } SEAM(9);
    if (IN(10)) { p8_final(F); }
#undef IN
#undef SEAM
}

extern "C" void kernel_launch(void* const* d_in, const int* in_sizes, int n_in, void* d_out, int out_size, void* d_ws, size_t ws_size, hipStream_t stream) {
    static int grid = 0;
    if (grid == 0) {
        if (n_in != 27 || (size_t)out_size != O_END || ws_size < WS_END) { fprintf(stderr, "kernel_launch: unexpected shapes n_in %d out %d ws %zu\n", n_in, out_size, ws_size); grid = -1; return; }
        int dev = 0, cus = 0, per_cu = 0;
        if (hipGetDevice(&dev) != hipSuccess || hipDeviceGetAttribute(&cus, hipDeviceAttributeMultiprocessorCount, dev) != hipSuccess) { grid = -1; return; }
        if (hipFuncSetAttribute((const void*)mega_fwd, hipFuncAttributeMaxDynamicSharedMemorySize, LDS_BYTES) != hipSuccess) { fprintf(stderr, "kernel_launch: hipFuncSetAttribute failed\n"); grid = -1; return; }
        if (hipOccupancyMaxActiveBlocksPerMultiprocessor(&per_cu, (const void*)mega_fwd, NWAVES * 64, LDS_BYTES) != hipSuccess || per_cu < 1) fprintf(stderr, "kernel_launch: occupancy query says %d\n", per_cu);
        (void)hipGetLastError();
        grid = cus;
    }
    if (grid < 0) return;
    if (hipMemsetAsync((char*)d_ws + WS_CTL, 0, CTL_ZERO_BYTES, stream) != hipSuccess) return;
    Args a{};
    for (int i = 0; i < 27; ++i) a.in[i] = (const float*)d_in[i];
    a.out = (float*)d_out; a.ws = (unsigned char*)d_ws;
#if MK_ONE_LAUNCH
    a.ph_lo = 0; a.ph_hi = N_PHASES; a.li = 0;
    hipLaunchKernelGGL(mega_fwd, dim3(grid), dim3(NWAVES * 64), LDS_BYTES, stream, a);
#else
    for (int p = 0; p < N_PHASES; ++p) { a.ph_lo = p; a.ph_hi = p + 1; a.li = p;
        hipLaunchKernelGGL(mega_fwd, dim3(grid), dim3(NWAVES * 64), LDS_BYTES, stream, a); }
#endif
}
```

```cpp
#include <hip/hip_runtime.h>
#include <cstdio>
#include <cstdint>
#define WKV_EXP 0
#define WKV_DUMP_T 4096
#define WKV_VAR 0
#define WKV_SUB 0
#define PROBE_PHASE 0
#define PROBE_REPS 0
#define PROBE_STEP 0
namespace pg8 {
#define PG8_LAS __attribute__((address_space(3)))
typedef unsigned short bf16_t;
typedef short bf16x8 __attribute__((ext_vector_type(8)));
typedef float f32x4 __attribute__((ext_vector_type(4)));
typedef unsigned u32x4 __attribute__((ext_vector_type(4)));
constexpr int BM = 256, BK = 64, HALF = 128, HTB = HALF * BK * 2  , STAGE_BYTES = 8 * HTB, NXCD = 8, WGM = 8;

__host__ __device__ __forceinline__ int lds_byte(int r, int c) { const int st = (r >> 4) * 2 + (c >> 5), rr = r & 15, cc = c & 31, ob = rr * 64 + cc * 2; return st * 1024 + (ob ^ (((ob >> 9) & 1) << 5)); }
__host__ __device__ __forceinline__ void stage_rc(int b, int& R, int& C) { const int st = b / 1024, sb = b % 1024, swz = sb ^ (((sb >> 9) & 1) << 5); R = (st >> 1) * 16 + swz / 64; C = (st & 1) * 32 + (swz % 64) / 2; }
__host__ __device__ __forceinline__ int perm32(int rho) { const int n = rho >> 4, i = rho & 15; return 8 * (i >> 2) + 4 * n + (i & 3); }

struct Unit { int pm, pn; };
struct Gemm { const bf16_t* A; const bf16_t* Bt; int M, N, K; int gdiv; size_t a_gstride; };

struct SplitOrder;
struct StaticOrder {
    int nM, nN, nwg, G, c;
    __host__ __device__ void init(int M, int N, int G_, int c_) { nM = M / BM; nN = N / BM; nwg = nM * nN; G = G_; c = c_; }
    __host__ __device__ bool next(int i, Unit& u) const {
        const long L = (long)i * G + c; if (L >= nwg) return false;
        int wgid = (int)L; { const int q = nwg / NXCD, r = nwg % NXCD, xcd = wgid % NXCD, off = wgid / NXCD; wgid = (xcd < r ? xcd * (q + 1) : r * (q + 1) + (xcd - r) * q) + off; }
        const int nig = WGM * nN, gid = wgid / nig, fm = gid * WGM, gsz = (nM - fm) < WGM ? (nM - fm) : WGM;
        u.pm = fm + ((wgid % nig) % gsz); u.pn = (wgid % nig) / gsz; return true;
    }
    __device__ __forceinline__ void a_ready(const Unit&) const {}
    __device__ __forceinline__ void done(const Unit&) const {}
};
struct SplitOrder {
    StaticOrder a, b; int nMa; unsigned* cnt;
    __device__ void init(int M, int N, int G_, int c_, unsigned* cnt_) { const int nN = N / BM; nMa = G_ / nN; a.init(nMa * BM, N, G_, c_); b.init(M - nMa * BM, N, G_, c_); cnt = cnt_; }
    __device__ bool next(int i, Unit& u) const { if (i == 0) return a.next(0, u); const bool ok = b.next(i - 1, u); u.pm += nMa; return ok; }
    __device__ __forceinline__ void a_ready(const Unit&) const {}
    __device__ __forceinline__ void done(const Unit& u) const {
        __syncthreads();
        if (threadIdx.x < 64) { __builtin_amdgcn_fence(__ATOMIC_RELEASE, "agent");
            if (threadIdx.x == 0) __hip_atomic_fetch_add(cnt + u.pm, 1u, __ATOMIC_RELAXED, __HIP_MEMORY_SCOPE_AGENT); }
    }
};

__device__ __forceinline__ unsigned cvt_pk_bf16(float lo, float hi) { unsigned r; asm volatile("v_cvt_pk_bf16_f32 %0, %1, %2" : "=v"(r) : "v"(lo), "v"(hi)); return r; }
struct EpiBf16G {
    static constexpr bool PERM = true, AFTER_DRAIN = false;
    bf16_t *O0, *O1, *O2, *O3; int ldc, tpg, Mvalid, scale_tiles; float scale0;
    __device__ __forceinline__ void operator()(const f32x4 (&acc)[2][2][4][2], const Unit& u, int wr, int wc, int fr, int fq) const {
        const int grp = u.pn / tpg, colt = (u.pn - grp * tpg) * BM;
        bf16_t* base = grp == 0 ? O0 : grp == 1 ? O1 : grp == 2 ? O2 : O3;
        const float sc = (u.pn < scale_tiles) ? scale0 : 1.f;
        const int row0 = u.pm * BM + wr * 64 + fr, col0 = colt + wc * 32 + 8 * fq;
#pragma unroll
        for (int ai = 0; ai < 2; ++ai)
#pragma unroll
            for (int m = 0; m < 4; ++m) { const int row = row0 + ai * HALF + m * 16; const unsigned roff = (unsigned)(((size_t)row * ldc + col0) * 2);
                if (row < Mvalid) {
#pragma unroll
                for (int bj = 0; bj < 2; ++bj) { const f32x4 v0 = acc[ai][bj][m][0] * sc, v1 = acc[ai][bj][m][1] * sc;
                    u32x4 w; w.x = cvt_pk_bf16(v0[0], v0[1]); w.y = cvt_pk_bf16(v0[2], v0[3]); w.z = cvt_pk_bf16(v1[0], v1[1]); w.w = cvt_pk_bf16(v1[2], v1[3]);
                    *(u32x4*)((char*)base + roff + bj * HALF * 2) = w; } } }
    }
};
struct EpiRes {
    static constexpr bool PERM = false, AFTER_DRAIN = false;
    const float* base; float* out; const float *meta, *xp, *xs; int Mvalid;
    __device__ __forceinline__ void operator()(const f32x4 (&acc)[2][2][4][2], const Unit& u, int wr, int wc, int fr, int fq) const {
        const int row0 = u.pm * BM + wr * 64 + fr, col0 = u.pn * BM + wc * 32 + 4 * fq;
#pragma unroll
        for (int ai = 0; ai < 2; ++ai)
#pragma unroll
            for (int m = 0; m < 4; ++m) { const int row = row0 + ai * HALF + m * 16;
                if (row < Mvalid) {
                    const float* b;
                    if (base) b = base + (size_t)row * 1024;
                    else if (row < 16448) { const int bb = row / 4112, t = row - bb * 4112; b = t < 16 ? meta + t * 1024 : xp + ((size_t)bb * 4096 + (t - 16)) * 1024; }
                    else b = xs + (size_t)(row - 16448) * 1024;
                    float* o = out + (size_t)row * 1024;
#pragma unroll
                    for (int bj = 0; bj < 2; ++bj)
#pragma unroll
                        for (int n = 0; n < 2; ++n) { const int c = col0 + bj * HALF + n * 16; const f32x4 r = *(const f32x4*)(b + c); *(f32x4*)(o + c) = r + acc[ai][bj][m][n]; } } }
    }
};

struct EpiResB {
    static constexpr bool PERM = true, AFTER_DRAIN = false;
    const bf16_t* base; bf16_t* out; const float *meta, *xp, *xs; int Mvalid;
    __device__ __forceinline__ void operator()(const f32x4 (&acc)[2][2][4][2], const Unit& u, int wr, int wc, int fr, int fq) const {
        const int row0 = u.pm * BM + wr * 64 + fr, col0 = u.pn * BM + wc * 32 + 8 * fq;
#pragma unroll
        for (int ai = 0; ai < 2; ++ai)
#pragma unroll
            for (int m = 0; m < 4; ++m) { const int row = row0 + ai * HALF + m * 16;
                if (row < Mvalid) {
                    const unsigned ooff = (unsigned)(((size_t)row * 1024 + col0) * 2);
                    if (base) {
                        const bf16_t* b = base + (size_t)row * 1024 + col0;
#pragma unroll
                        for (int bj = 0; bj < 2; ++bj) { const u32x4 rw = *(const u32x4*)(b + bj * HALF); const f32x4 a0 = acc[ai][bj][m][0], a1 = acc[ai][bj][m][1]; u32x4 w;
                            w.x = cvt_pk_bf16(a0[0] + __builtin_bit_cast(float, rw.x << 16), a0[1] + __builtin_bit_cast(float, rw.x & 0xffff0000u));
                            w.y = cvt_pk_bf16(a0[2] + __builtin_bit_cast(float, rw.y << 16), a0[3] + __builtin_bit_cast(float, rw.y & 0xffff0000u));
                            w.z = cvt_pk_bf16(a1[0] + __builtin_bit_cast(float, rw.z << 16), a1[1] + __builtin_bit_cast(float, rw.z & 0xffff0000u));
                            w.w = cvt_pk_bf16(a1[2] + __builtin_bit_cast(float, rw.w << 16), a1[3] + __builtin_bit_cast(float, rw.w & 0xffff0000u));
                            *(u32x4*)((char*)out + ooff + bj * HALF * 2) = w; }
                    } else {
                        const float* b;
                        if (row < 16448) { const int bb = row / 4112, t = row - bb * 4112; b = t < 16 ? meta + t * 1024 : xp + ((size_t)bb * 4096 + (t - 16)) * 1024; }
                        else b = xs + (size_t)(row - 16448) * 1024;
                        b += col0;
#pragma unroll
                        for (int bj = 0; bj < 2; ++bj) { const f32x4 r0 = *(const f32x4*)(b + bj * HALF), r1 = *(const f32x4*)(b + bj * HALF + 4); const f32x4 v0 = acc[ai][bj][m][0] + r0, v1 = acc[ai][bj][m][1] + r1; u32x4 w;
                            w.x = cvt_pk_bf16(v0[0], v0[1]); w.y = cvt_pk_bf16(v0[2], v0[3]); w.z = cvt_pk_bf16(v1[0], v1[1]); w.w = cvt_pk_bf16(v1[2], v1[3]);
                            *(u32x4*)((char*)out + ooff + bj * HALF * 2) = w; }
                    } } }
    }
};

struct EpiT12 {
    static constexpr bool PERM = false, AFTER_DRAIN = false;
    float* t12; int Mvalid; unsigned char* t12b;
    __device__ __forceinline__ void operator()(const f32x4 (&acc)[2][2][4][2], const Unit& u, int wr, int wc, int fr, int fq) const {
        if (wc >= 2) return;
        const int row0 = u.pm * BM + wr * 64 + fr, col0 = wc * 32 + 4 * fq;
#pragma unroll
        for (int ai = 0; ai < 2; ++ai)
#pragma unroll
            for (int m = 0; m < 4; ++m) { const int row = row0 + ai * HALF + m * 16;
                if (row < Mvalid) {
                    float* o = t12 + (size_t)row * 128 + u.pn * 64 + col0;
                    const int bb = row / 4112, t = row - bb * 4112;
                    unsigned char* ob = t12b + ((size_t)((bb * 129 + (t >> 5)) * 8 + u.pn * 4) * 64 + (t & 31)) * 16;
#pragma unroll
                    for (int n = 0; n < 2; ++n) { f32x4 v = acc[ai][0][m][n];
                        if (u.pn == 0) { v[0] = tanhf(v[0]); v[1] = tanhf(v[1]); v[2] = tanhf(v[2]); v[3] = tanhf(v[3]); }
                        *(f32x4*)(o + n * 16) = v;
                        if (row < 16448) { const int j = col0 + n * 16;
                            *(unsigned long long*)(ob + ((j >> 4) * 64 + 32 * ((j >> 3) & 1)) * 16 + (j & 7) * 2) = (unsigned long long)cvt_pk_bf16(v[0], v[1]) | ((unsigned long long)cvt_pk_bf16(v[2], v[3]) << 32); } } } }
    }
};

struct EpiF32 {
    static constexpr bool PERM = false, AFTER_DRAIN = false;
    float* out; int ldc;
    __device__ __forceinline__ void operator()(const f32x4 (&acc)[2][2][4][2], const Unit& u, int wr, int wc, int fr, int fq) const {
        const int row0 = u.pm * BM + wr * 64 + fr, col0 = u.pn * BM + wc * 32 + 4 * fq;
#pragma unroll
        for (int ai = 0; ai < 2; ++ai)
#pragma unroll
            for (int m = 0; m < 4; ++m) { const int row = row0 + ai * HALF + m * 16; const unsigned ooff = (unsigned)(((size_t)row * ldc + col0) * 4);
#pragma unroll
                for (int bj = 0; bj < 2; ++bj)
#pragma unroll
                    for (int n = 0; n < 2; ++n) *(f32x4*)((char*)out + ooff + (bj * HALF + n * 16) * 4) = acc[ai][bj][m][n]; }
    }
};
template <class Epi, class Sched, bool ALIGN_EPI = false, bool SP2 = false>
__device__ __forceinline__ void gemm_phase(PG8_LAS unsigned char* lds, const Gemm g, const Sched& S, const Epi& E) {
    const int tid = threadIdx.x, wid = __builtin_amdgcn_readfirstlane(tid >> 6), lane = tid & 63, wr = wid >> 2, wc = wid & 3, fr = lane & 15, fq = lane >> 4;
    const int K = g.K, nt = K / BK;
    unsigned voffA[2], voffB[2];
#pragma unroll
    for (int i = 0; i < 2; ++i) { int R, C; stage_rc(tid * 16 + i * 8192, R, C); const int Rb = Epi::PERM ? ((R & ~31) + perm32(R & 31)) : R;
        voffA[i] = (unsigned)(R * K + C) * 2u; voffB[i] = (unsigned)(Rb * K + C) * 2u; }
    const size_t kstep = (size_t)(BK * 2);
    const size_t hstep = (size_t)HALF * K * 2;
    const size_t tstep = 2 * hstep;
    const unsigned ldsw = (unsigned)wid * 1024u;
    const int aoff = lds_byte(wr * 64 + fr, fq * 8), boff = lds_byte(wc * 32 + fr, fq * 8);
#define PG8_SA(b, h) (((b) * 2 + (h)) * HTB)
#define PG8_SB(b, h) ((4 + (b) * 2 + (h)) * HTB)
#define PG8_STAGE(bufoff, gbase, voff) do { _Pragma("unroll") for (int _i = 0; _i < 2; ++_i) \
        __builtin_amdgcn_global_load_lds((const unsigned*)((const char*)(gbase) + (voff)[_i]), (PG8_LAS unsigned*)(lds + (bufoff) + ldsw + _i * 8192), 16, 0, 0); } while (0)
#define PG8_LDA(dst, b, h) do { _Pragma("unroll") for (int m = 0; m < 4; ++m) _Pragma("unroll") for (int k = 0; k < 2; ++k) dst[m][k] = *(const PG8_LAS bf16x8*)(lds + PG8_SA(b, h) + aoff + m * 2048 + k * 1024); } while (0)
#define PG8_LDB(dst, b, h) do { _Pragma("unroll") for (int n = 0; n < 2; ++n) _Pragma("unroll") for (int k = 0; k < 2; ++k) dst[n][k] = *(const PG8_LAS bf16x8*)(lds + PG8_SB(b, h) + boff + n * 2048 + k * 1024); } while (0)
#define PG8_MMA(ai, bj, At, Bt) do { __builtin_amdgcn_s_setprio(1); _Pragma("unroll") for (int m = 0; m < 4; ++m) _Pragma("unroll") for (int n = 0; n < 2; ++n) _Pragma("unroll") for (int k = 0; k < 2; ++k) \
        acc[ai][bj][m][n] = __builtin_amdgcn_mfma_f32_16x16x32_bf16(Bt[n][k], At[m][k], acc[ai][bj][m][n], 0, 0, 0); __builtin_amdgcn_s_setprio(0); } while (0)
#define PG8_WAIT_V(n) asm volatile("s_waitcnt vmcnt(" #n ")" ::: "memory")
#define PG8_WAIT_L(n) asm volatile("s_waitcnt lgkmcnt(" #n ")" ::: "memory")
#define PG8_BAR __builtin_amdgcn_s_barrier()
#define PG8_SCHED __builtin_amdgcn_sched_barrier(0)
    Unit cur, nxt; int ui = 0;
    if (!S.next(0, cur)) return;
    f32x4 acc[2][2][4][2];
#pragma unroll
    for (int a = 0; a < 2; ++a)
#pragma unroll
        for (int b = 0; b < 2; ++b)
#pragma unroll
            for (int m = 0; m < 4; ++m)
#pragma unroll
                for (int n = 0; n < 2; ++n) acc[a][b][m][n] = (f32x4){0.f, 0.f, 0.f, 0.f};
    bf16x8 At[4][2], B0[2][2], B1[2][2];
    const char* cA = (const char*)g.A + (size_t)(cur.pn / g.gdiv) * g.a_gstride + (size_t)cur.pm * tstep; const char* cB = (const char*)g.Bt + (size_t)cur.pn * tstep;
    S.a_ready(cur);
    if constexpr (SP2) {
        PG8_STAGE(PG8_SB(0, 0), cB, voffB); PG8_STAGE(PG8_SB(0, 1), cB + hstep, voffB); PG8_STAGE(PG8_SA(0, 0), cA, voffA); PG8_STAGE(PG8_SA(0, 1), cA + hstep, voffA);
        if (wr == 1) PG8_BAR;
        PG8_WAIT_V(2); PG8_BAR;
        PG8_STAGE(PG8_SB(1, 0), cB + kstep, voffB); PG8_STAGE(PG8_SA(1, 0), cA + kstep, voffA); PG8_STAGE(PG8_SB(1, 1), cB + hstep + kstep, voffB);
        PG8_WAIT_V(6); PG8_BAR;
    } else {
        PG8_STAGE(PG8_SB(0, 0), cB, voffB); PG8_STAGE(PG8_SA(0, 0), cA, voffA); PG8_STAGE(PG8_SB(0, 1), cB + hstep, voffB); PG8_STAGE(PG8_SA(0, 1), cA + hstep, voffA);
        if (wr == 1) PG8_BAR;
        PG8_WAIT_V(4); PG8_BAR;
        PG8_STAGE(PG8_SB(1, 0), cB + kstep, voffB); PG8_STAGE(PG8_SA(1, 0), cA + kstep, voffA); PG8_STAGE(PG8_SB(1, 1), cB + hstep + kstep, voffB);
        PG8_WAIT_V(6); PG8_BAR;
    }
    for (;;) {
        const bool has_next = S.next(ui + 1, nxt);
        const char* nA = has_next ? (const char*)g.A + (size_t)(nxt.pn / g.gdiv) * g.a_gstride + (size_t)nxt.pm * tstep : cA; const char* nB = has_next ? (const char*)g.Bt + (size_t)nxt.pn * tstep : cB;
        for (int t = 0; t < nt; t += 2) {
            const bool last = (t == nt - 2);
            const char* a1 = cA + (size_t)(t + 1) * kstep;
            const char* a2 = last ? nA : cA + (size_t)(t + 2) * kstep; const char* b2 = last ? nB : cB + (size_t)(t + 2) * kstep;
            const char* a3 = a2 + kstep; const char* b3 = b2 + kstep;
            if (last && has_next) S.a_ready(nxt);
            if constexpr (SP2) {
            PG8_LDB(B0, 0, 0); PG8_LDB(B1, 0, 1); PG8_SCHED; PG8_LDA(At, 0, 0); PG8_STAGE(PG8_SA(1, 1), a1 + hstep, voffA);
            PG8_WAIT_V(8); PG8_WAIT_L(0); PG8_BAR; PG8_MMA(0, 0, At, B0); PG8_MMA(0, 1, At, B1); PG8_BAR; PG8_SCHED;
            PG8_LDA(At, 0, 1); PG8_STAGE(PG8_SB(0, 0), b2, voffB); PG8_STAGE(PG8_SB(0, 1), b2 + hstep, voffB); PG8_STAGE(PG8_SA(0, 0), a2, voffA);
            PG8_WAIT_V(8); PG8_WAIT_L(0); PG8_BAR; PG8_MMA(1, 0, At, B0); PG8_MMA(1, 1, At, B1); PG8_BAR; PG8_SCHED;
            PG8_LDB(B0, 1, 0); PG8_LDB(B1, 1, 1); PG8_SCHED; PG8_LDA(At, 1, 0); PG8_STAGE(PG8_SA(0, 1), a2 + hstep, voffA);
            PG8_WAIT_V(8); PG8_WAIT_L(0); PG8_BAR; PG8_MMA(0, 0, At, B0); PG8_MMA(0, 1, At, B1); PG8_BAR; PG8_SCHED;
            PG8_LDA(At, 1, 1); PG8_STAGE(PG8_SB(1, 0), b3, voffB); PG8_STAGE(PG8_SB(1, 1), b3 + hstep, voffB); PG8_STAGE(PG8_SA(1, 0), a3, voffA);
            PG8_WAIT_V(8); PG8_WAIT_L(0); PG8_BAR; PG8_MMA(1, 0, At, B0); PG8_MMA(1, 1, At, B1); PG8_BAR; PG8_SCHED;
            } else {
            PG8_LDB(B0, 0, 0); PG8_SCHED; PG8_LDA(At, 0, 0); PG8_STAGE(PG8_SA(1, 1), a1 + hstep, voffA);
            PG8_WAIT_L(8); PG8_BAR; PG8_WAIT_L(0); PG8_MMA(0, 0, At, B0); PG8_BAR; PG8_SCHED;
            PG8_LDB(B1, 0, 1); PG8_STAGE(PG8_SB(0, 0), b2, voffB);
            PG8_BAR; PG8_WAIT_L(0); PG8_MMA(0, 1, At, B1); PG8_BAR;
            PG8_LDA(At, 0, 1); PG8_STAGE(PG8_SA(0, 0), a2, voffA);
            PG8_BAR; PG8_WAIT_L(0); PG8_MMA(1, 0, At, B0); PG8_BAR; PG8_SCHED;
            PG8_STAGE(PG8_SB(0, 1), b2 + hstep, voffB);
            PG8_WAIT_V(6); PG8_BAR; PG8_MMA(1, 1, At, B1); PG8_BAR;
            PG8_LDB(B0, 1, 0); PG8_SCHED; PG8_LDA(At, 1, 0); PG8_STAGE(PG8_SA(0, 1), a2 + hstep, voffA);
            PG8_WAIT_L(8); PG8_BAR; PG8_WAIT_L(0); PG8_MMA(0, 0, At, B0); PG8_BAR; PG8_SCHED;
            PG8_LDB(B1, 1, 1); PG8_STAGE(PG8_SB(1, 0), b3, voffB);
            PG8_BAR; PG8_WAIT_L(0); PG8_MMA(0, 1, At, B1); PG8_BAR;
            PG8_LDA(At, 1, 1); PG8_STAGE(PG8_SA(1, 0), a3, voffA);
            PG8_BAR; PG8_WAIT_L(0); PG8_MMA(1, 0, At, B0); PG8_BAR; PG8_SCHED;
            PG8_STAGE(PG8_SB(1, 1), b3 + hstep, voffB);
            PG8_WAIT_V(6); PG8_BAR; PG8_MMA(1, 1, At, B1); PG8_BAR;
            }
        }
        if constexpr (ALIGN_EPI) { if (wr == 0) PG8_BAR; }
        if constexpr (!Epi::AFTER_DRAIN) { E(acc, cur, wr, wc, fr, fq); S.done(cur); }
        if (!has_next) break;
#pragma unroll
        for (int a = 0; a < 2; ++a)
#pragma unroll
            for (int b = 0; b < 2; ++b)
#pragma unroll
                for (int m = 0; m < 4; ++m)
#pragma unroll
                    for (int n = 0; n < 2; ++n) acc[a][b][m][n] = (f32x4){0.f, 0.f, 0.f, 0.f};
        cur = nxt; cA = nA; cB = nB; ++ui;
        if constexpr (ALIGN_EPI) { if (wr == 1) PG8_BAR; }
    }
    PG8_WAIT_V(0);
    if constexpr (!ALIGN_EPI) { if (wr == 0) PG8_BAR; }
    PG8_BAR;
    if constexpr (Epi::AFTER_DRAIN) { E.fused(acc, cur, wr, wc, fr, fq, lds, wid, lane); S.done(cur); }
#undef PG8_SA
#undef PG8_SB
#undef PG8_STAGE
#undef PG8_LDA
#undef PG8_LDB
#undef PG8_MMA
#undef PG8_WAIT_V
#undef PG8_WAIT_L
#undef PG8_BAR
#undef PG8_SCHED
}
}
#define GAS __attribute__((address_space(1)))
#define LAS __attribute__((address_space(3)))
typedef unsigned short bf16;
typedef unsigned v4u __attribute__((ext_vector_type(4)));
typedef float f32x4 __attribute__((ext_vector_type(4)));
typedef short bf16x8 __attribute__((ext_vector_type(8)));
typedef GAS unsigned gu32;
typedef GAS unsigned long long gu64;
#define RLX_AGENT __ATOMIC_RELAXED, __HIP_MEMORY_SCOPE_AGENT
#define LDS_WAIT() asm volatile("s_waitcnt lgkmcnt(0)" ::: "memory")
#define VM_WAIT() asm volatile("s_waitcnt vmcnt(0)" ::: "memory")
__device__ __forceinline__ unsigned long long rt() { return __builtin_amdgcn_s_memrealtime(); }
__device__ __forceinline__ unsigned f2bf(float f) { unsigned u = __builtin_bit_cast(unsigned, f); return (u + 0x7fffu + ((u >> 16) & 1u)) >> 16; }
typedef __bf16 pk_bf2_t __attribute__((ext_vector_type(2))); typedef float pk_f2_t __attribute__((ext_vector_type(2)));
__device__ __forceinline__ unsigned pk2(float lo, float hi) { const pk_f2_t v = {lo, hi}; return __builtin_bit_cast(unsigned, __builtin_convertvector(v, pk_bf2_t)); }

#define XB_TMO      128
#define XB_XCNT(j)  (256  + 64 * (j))
#define XB_XSUB(j)  (1280 + 64 * (j))
#define XB_XGEN(j)  (2304 + 64 * (j))
#define XB_TOP      3328
#define XB_TOPGEN   3392
#define XCD_BAR_WORDS 3456
#define XB_SPIN_CAP (1u << 18)

__device__ __forceinline__ unsigned xb_ld(unsigned* p)              { return __hip_atomic_load(p, __ATOMIC_RELAXED, __HIP_MEMORY_SCOPE_AGENT); }
__device__ __forceinline__ unsigned xb_add(unsigned* p, unsigned v) { return __hip_atomic_fetch_add(p, v, __ATOMIC_RELAXED, __HIP_MEMORY_SCOPE_AGENT); }
__device__ __forceinline__ unsigned xb_xcc_id() { return (unsigned)__builtin_amdgcn_s_getreg((3 << 11) | 20) & 0xFu; }
#define XB_SPIN(cond, bar) do { unsigned _sp = 0; while (cond) { __builtin_amdgcn_s_sleep(1); \
    if ((++_sp & 255u) == 0u) { if (xb_ld(&(bar)[XB_TMO])) break; if (_sp > XB_SPIN_CAP) { atomicAdd(&(bar)[XB_TMO], 1u); break; } } } } while (0)

struct XcdBarrier {
    unsigned* bar; unsigned x;
    volatile LAS unsigned* st;
};

__device__ __forceinline__ XcdBarrier xcd_barrier_post(unsigned* bar, volatile LAS unsigned* st) {
    XcdBarrier b; b.bar = bar; b.x = xb_xcc_id(); b.st = st;
    if (threadIdx.x == 0) (void)xb_add(&bar[XB_XCNT(b.x)], 1u);
    return b;
}
__device__ __forceinline__ void xcd_barrier_complete(unsigned* bar, unsigned x, unsigned& nloc, unsigned& nx) {
    const unsigned G = gridDim.x * gridDim.y * gridDim.z;
    unsigned sum, cnt, mine, sp = 0u;
    for (;;) {
        sum = 0u; cnt = 0u; mine = 0u;
#pragma unroll
        for (unsigned j = 0; j < 16; ++j) { const unsigned c = xb_ld(&bar[XB_XCNT(j)]); sum += c; cnt += (c > 0u) ? 1u : 0u; mine = (j == x) ? c : mine; }
        if (sum == G) break;
        __builtin_amdgcn_s_sleep(1);
        if ((++sp & 255u) == 0u) { if (xb_ld(&bar[XB_TMO])) break; if (sp > XB_SPIN_CAP) { atomicAdd(&bar[XB_TMO], 1u); break; } }
    }
    nloc = mine > 0u ? mine : 1u; nx = cnt > 0u ? cnt : 1u;
}

__device__ __forceinline__ void xcd_barrier(const XcdBarrier& b) {
    asm volatile("s_waitcnt vmcnt(0)" ::: "memory");
    __syncthreads();
    if (threadIdx.x == 0) {
        unsigned* bar = b.bar;
        __builtin_amdgcn_s_waitcnt(0);
        unsigned nloc = b.st[0], nx = b.st[1];
        if (nloc == 0u) { xcd_barrier_complete(bar, b.x, nloc, nx); b.st[0] = nloc; b.st[1] = nx; }
        const unsigned old = xb_add(&bar[XB_XSUB(b.x)], 1u);
        const unsigned gen = old / nloc;
        if (old + 1u == (gen + 1u) * nloc) {
            __builtin_amdgcn_fence(__ATOMIC_RELEASE, "agent");
            asm volatile("s_waitcnt vmcnt(0)" ::: "memory");
            const unsigned og = xb_add(&bar[XB_TOP], 1u);
            const unsigned tg = og / nx;
            if (og + 1u == (tg + 1u) * nx) xb_add(&bar[XB_TOPGEN], 1u);
            else XB_SPIN(xb_ld(&bar[XB_TOPGEN]) == tg, bar);
            __builtin_amdgcn_fence(__ATOMIC_ACQUIRE, "agent");
            xb_add(&bar[XB_XGEN(b.x)], 1u);
            asm volatile("s_waitcnt vmcnt(0)" ::: "memory");
        } else {
            XB_SPIN(xb_ld(&bar[XB_XGEN(b.x)]) == gen, bar);
            __builtin_amdgcn_fence(__ATOMIC_ACQUIRE, "agent");
            asm volatile("s_waitcnt vmcnt(0)" ::: "memory");
        }
    }
    __syncthreads();
}
constexpr int NWAVES = 8;
constexpr int DM = 1024, NB = 4, SEQ = 4096, NMETA = 16, LP = 4112, MPR = 16448, DBATCH = 128, DSEQ = 4, MSAMP = 512, MTOK = 16960, MPAD = 17152;
constexpr int NH = 16, HD = 64, NKV = 4, LDQ = 2560, WIN = 128;
constexpr float RMS_EPS = 1e-6f, GN_EPS = 64e-5f, LOG2E = 1.4426950408889634f, QSCALE = 0.125f * 1.4426950408889634f;
constexpr size_t O_YP = 0, O_YS = 16777216, O_WKP = 17301504, O_WVP = 17432576, O_WKVP = 17563648, O_SHP = 17825792, O_WKS = 17829888, O_WVS = 22024192, O_WKVS = 26218496, O_SHS = 34607104, O_END = 34738176;
constexpr size_t MiB = 1u << 20;
constexpr size_t WS_CTL = 0, CTL_ZERO_BYTES = 1 * MiB;
constexpr size_t WS_T12B = 1 * MiB;
constexpr size_t WS_WAIN = 1 * MiB, WS_WAOUT = 6 * MiB, WS_WRIN = 8 * MiB, WS_WROUT = 16 * MiB, WS_W1A1 = 185 * MiB;
constexpr size_t WS_XN1S = 186 * MiB, WS_U = 164 * MiB;
constexpr int U_SROW = 16640;
constexpr size_t WS_KVP = 18 * MiB + 512 * 1024, WS_KVS = 19 * MiB, WS_SHP = 19 * MiB + 512 * 1024, WS_WKVP = 20 * MiB, WS_T12 = 21 * MiB;
constexpr size_t WS_XA = 30 * MiB, WS_QKVG = 64 * MiB, WS_H1 = 189 * MiB, WS_MIX = 30 * MiB, MIX_STRIDE = (size_t)MPAD * DM * 2, WS_G = 222 * MiB + 512 * 1024, WS_OG2 = 64 * MiB, WS_END = 256 * MiB;
constexpr size_t RKV_STRIDE = (size_t)MTOK * DM * 2, DO_XN1 = 3 * RKV_STRIDE,
     DO_OG2 = 2 * RKV_STRIDE;
static_assert(WS_T12 + (size_t)MTOK * 128 * 4 <= WS_XA && WS_XA + MIX_STRIDE <= WS_QKVG && WS_QKVG + (size_t)MPAD * LDQ * 2 <= WS_H1 && WS_MIX + 4 * MIX_STRIDE <= WS_H1 && WS_H1 + (size_t)MPAD * DM * 4 <= WS_END, "ws map");
static_assert(3 * RKV_STRIDE <= O_WKVS * 4 && 2 * MIX_STRIDE <= O_END * 4, "d_out scratch map");
constexpr int CW_TMO = 0, CW_CODE = 1, CW_BAR = 4096, CW_TFLAG = 65536, CW_RC2 = 70000, CW_RC4 = 70128;
constexpr int RING_OFF = 0, RING_BYTES = 131072, LDSCTL_OFF = RING_BYTES, MISC_OFF = LDSCTL_OFF + 320, LDS_BYTES = 147456;

typedef short s16x4 __attribute__((ext_vector_type(4)));
typedef float f32x16 __attribute__((ext_vector_type(16)));
struct Frame {
    LAS unsigned char* lds;
    volatile LAS unsigned* MISC;
    gu32* ctl;
    int tid, lane, wave, vcu, G, skip;
    const float *xp, *xs, *cache_k, *cache_v, *state_wkv, *state_shift, *meta, *table, *norm_gain, *final_gain, *a_w_in, *sinks, *a_w_out;
    const float *mu, *r_w_in, *w0, *w1, *w2, *a0, *a1, *a2, *k_k, *k_a, *r_k, *ln_g, *ln_b, *r_w_out;
    float* out; unsigned char* ws; unsigned char* dob;
};
template <int CTRL> __device__ __forceinline__ float dpp_mov(float v) { return __builtin_bit_cast(float, __builtin_amdgcn_update_dpp(0, __builtin_bit_cast(int, v), CTRL, 0xF, 0xF, true)); }
__device__ __forceinline__ float wave_sum(float v) {
    v += dpp_mov<0xB1>(v);
    v += dpp_mov<0x4E>(v);
    v += dpp_mov<0x141>(v);
    v += dpp_mov<0x140>(v);
    v += __shfl_xor(v, 16);
    { const unsigned u = __builtin_bit_cast(unsigned, v); auto r = __builtin_amdgcn_permlane32_swap(u, u, false, false); v = __builtin_bit_cast(float, (unsigned)r[0]) + __builtin_bit_cast(float, (unsigned)r[1]); }
    return v;
}
__device__ __forceinline__ float bf2f(bf16 b) { return __builtin_bit_cast(float, (unsigned)b << 16); }
__device__ __forceinline__ const float* h0_row(const Frame& F, int m) {
    if (m < MPR) { const int b = m / LP, t = m - b * LP; return t < NMETA ? F.meta + t * DM : F.xp + ((size_t)b * SEQ + (t - NMETA)) * DM; }
    return F.xs + (size_t)(m - MPR) * DM;
}
__device__ __forceinline__ void p0_transpose_item(const float* W, int K, int N, bf16* WT, int row_off, LAS float* scr, int item, int lane, const float* sc = nullptr, bool one_minus = false) {
    const int nblk = N / 32, kb = item / nblk, nb = item % nblk, k0 = 64 * kb, n0 = 32 * nb;
#pragma unroll 8
    for (int i = 0; i < 32; ++i) { const int kk = 2 * i + (lane >> 5); float w = W[(size_t)(k0 + kk) * N + n0 + (lane & 31)]; if (sc) { const float s_ = sc[k0 + kk]; w *= one_minus ? 1.0f - s_ : s_; } scr[kk * 33 + (lane & 31)] = w; }
    LDS_WAIT(); asm volatile("" ::: "memory");
    const int c = lane & 7;
#pragma unroll
    for (int j = 0; j < 4; ++j) { const int n = (lane >> 3) + 8 * j; const LAS float* s = scr + (8 * c) * 33 + n;
        v4u o; o.x = pk2(s[0 * 33], s[1 * 33]); o.y = pk2(s[2 * 33], s[3 * 33]); o.z = pk2(s[4 * 33], s[5 * 33]); o.w = pk2(s[6 * 33], s[7 * 33]);
        *(GAS v4u*)(WT + (size_t)(row_off + n0 + n) * K + k0 + 8 * c) = o; }
    LDS_WAIT(); asm volatile("" ::: "memory");
}
__device__ __forceinline__ void rms_row(const float* xrow, const float* gain, int lane, f32x4 (&v)[4]) {
    const GAS f32x4* xr = (const GAS f32x4*)xrow + lane; float s = 0.f;
#pragma unroll
    for (int j = 0; j < 4; ++j) { v[j] = xr[64 * j]; s += (v[j].x * v[j].x + v[j].y * v[j].y) + (v[j].z * v[j].z + v[j].w * v[j].w); }
    const float rstd = 1.0f / sqrtf(wave_sum(s) * (1.f / DM) + RMS_EPS);
    const GAS f32x4* gr = (const GAS f32x4*)gain + lane;
#pragma unroll
    for (int j = 0; j < 4; ++j) v[j] = v[j] * rstd * gr[64 * j];
}
__device__ __forceinline__ void rms_row_b(const bf16* xrow, const float* gain, int lane, f32x4 (&v)[4]) {
    const GAS unsigned long long* xr = (const GAS unsigned long long*)xrow + lane; float s = 0.f;
#pragma unroll
    for (int j = 0; j < 4; ++j) { const unsigned long long w = xr[64 * j];
        v[j].x = __builtin_bit_cast(float, (unsigned)w << 16); v[j].y = __builtin_bit_cast(float, (unsigned)w & 0xffff0000u); v[j].z = __builtin_bit_cast(float, (unsigned)(w >> 32) << 16); v[j].w = __builtin_bit_cast(float, (unsigned)(w >> 32) & 0xffff0000u);
        s += (v[j].x * v[j].x + v[j].y * v[j].y) + (v[j].z * v[j].z + v[j].w * v[j].w); }
    const float rstd = 1.0f / sqrtf(wave_sum(s) * (1.f / DM) + RMS_EPS);
    const GAS f32x4* gr = (const GAS f32x4*)gain + lane;
#pragma unroll
    for (int j = 0; j < 4; ++j) v[j] = v[j] * rstd * gr[64 * j];
}
__device__ __forceinline__ void store_bf16_row(bf16* orow, int lane, const f32x4 (&v)[4]) {
    GAS unsigned long long* o8 = (GAS unsigned long long*)orow + lane;
#pragma unroll
    for (int j = 0; j < 4; ++j) o8[64 * j] = (unsigned long long)pk2(v[j].x, v[j].y) | ((unsigned long long)pk2(v[j].z, v[j].w) << 32);
}
__device__ __forceinline__ void p0_prologue(Frame& F, int part, int gw, int NGW) {
    LAS float* scr = (LAS float*)(F.lds + RING_OFF + F.wave * 16384);
    bf16* wain = (bf16*)(F.ws + WS_WAIN); bf16* waout = (bf16*)(F.ws + WS_WAOUT); bf16* wrin = (bf16*)(F.ws + WS_WRIN); bf16* wrout = (bf16*)(F.ws + WS_WROUT); bf16* w1a1 = (bf16*)(F.ws + WS_W1A1);
    constexpr int I_AIN = 16 * 80, I_SQ = 16 * 32, I_L1 = 16 * 2;
    constexpr int I_L2 = 32;
    constexpr int NITEMS = I_AIN + 6 * I_SQ + 4 * I_L1 + 2 * I_L2;
    for (int it = (part == 1 ? I_AIN : 0) + gw; it < (part == 0 ? I_AIN : NITEMS); it += NGW) {
        int r = it;
        if (r < I_AIN) { p0_transpose_item(F.a_w_in, DM, LDQ, wain, 0, scr, r, F.lane); continue; } r -= I_AIN;
        if (r < I_SQ) { p0_transpose_item(F.a_w_out, DM, DM, waout, 0, scr, r, F.lane); continue; } r -= I_SQ;
        if (r < 4 * I_SQ) { const int c = r / I_SQ; p0_transpose_item(F.r_w_in + (size_t)c * DM * DM, DM, DM, wrin, c * DM, scr, r - c * I_SQ, F.lane); continue; } r -= 4 * I_SQ;
        if (r < I_SQ) { p0_transpose_item(F.r_w_out, DM, DM, wrout, 0, scr, r, F.lane); continue; } r -= I_SQ;
        if (r < 4 * I_L1) { const int q = r / I_L1; p0_transpose_item(q < 2 ? F.w1 : F.a1, DM, 64, w1a1, 64 * q, scr, r - q * I_L1, F.lane, F.mu + (q < 2 ? 4 : 5) * DM, (q & 1) == 0); continue; } r -= 4 * I_L1;
        if (r < I_L2) { p0_transpose_item(F.w2, 64, DM, (bf16*)(F.ws + 18 * MiB + 256 * 1024), 0, scr, r, F.lane); continue; } r -= I_L2;
        p0_transpose_item(F.a2, 64, DM, (bf16*)(F.ws + 18 * MiB + 384 * 1024), 0, scr, r, F.lane);
    }
    if (part == 1) return;
    bf16* xa = (bf16*)(F.ws + WS_XA);
    for (int m = gw; m < MPAD; m += NGW) {
        f32x4 v[4];
        if (m < MTOK) rms_row(h0_row(F, m), F.norm_gain, F.lane, v);
        else { for (int j = 0; j < 4; ++j) v[j] = (f32x4){0.f, 0.f, 0.f, 0.f}; }
        store_bf16_row(xa + (size_t)m * DM, F.lane, v);
    }
}

namespace att {
constexpr int KSTR = 72, VSTR = 260;
constexpr int BEXT = 192;
constexpr int K_OFF = 0, V_OFF = 256 * KSTR * 2, B_OFF = V_OFF + 64 * VSTR * 2, ST_OFF = B_OFF + NH * BEXT * 4, END_OFF = ST_OFF + NWAVES * 4096;
static_assert(END_OFF <= RING_BYTES && (B_OFF % 16) == 0 && (ST_OFF % 16) == 0, "attention LDS");
__device__ __forceinline__ int crow(int r, int hi) { return (r & 3) + 8 * (r >> 2) + 4 * hi; }
__device__ __forceinline__ int t5_bucket(int rel) {
    if (rel < 16) return rel;
    int b = 16;
    b += rel >= 19; b += rel >= 21; b += rel >= 24; b += rel >= 27; b += rel >= 31; b += rel >= 35; b += rel >= 40; b += rel >= 46;
    b += rel >= 52; b += rel >= 59; b += rel >= 67; b += rel >= 77; b += rel >= 87; b += rel >= 99; b += rel >= 113;
    return b;
}
__device__ __forceinline__ void attn_wave(LAS unsigned char* lds, const bf16* qkvg, bf16* og, int qrow0, int nq, int jt, int kt_lo, int h, float sink2, int lane, int wave) {
    const int c = lane & 31, hh = lane >> 5;
    const LAS float* bp = (const LAS float*)(lds + B_OFF) + h * BEXT + 5 + c - 4 * hh;
    const int qrow = qrow0 + (c < nq ? c : nq - 1);
    bf16x8 qf[4];
#pragma unroll
    for (int s = 0; s < 4; ++s) qf[s] = *(const GAS bf16x8*)(qkvg + (size_t)qrow * LDQ + h * HD + 16 * s + 8 * hh);
    const LAS unsigned char* kbase = lds + K_OFF + ((32 * jt + c) * KSTR + 8 * hh) * 2;
    const LAS unsigned char* vbase = lds + V_OFF + (c * VSTR + 32 * jt + 4 * hh) * 2;
    f32x16 sc[5];
#pragma unroll
    for (int kt = 0; kt < 5; ++kt) {
        f32x16 a;
#pragma unroll
        for (int r = 0; r < 16; ++r) a[r] = bp[155 - (32 * kt + (r & 3) + 8 * (r >> 2))];
#pragma unroll
        for (int s = 0; s < 4; ++s) { const bf16x8 kf = *(const LAS bf16x8*)(kbase + kt * (32 * KSTR * 2) + 32 * s); a = __builtin_amdgcn_mfma_f32_32x32x16_bf16(kf, qf[s], a, 0, 0, 0); }
        if (kt < kt_lo) {
#pragma unroll
            for (int r = 0; r < 16; ++r) a[r] = -1e30f;
        }
        sc[kt] = a;
    }
    float mx = -1e30f;
#pragma unroll
    for (int kt = 0; kt < 5; ++kt)
#pragma unroll
        for (int r = 0; r < 16; ++r) mx = fmaxf(mx, sc[kt][r]);
    mx = fmaxf(mx, __shfl_xor(mx, 32)); mx = fmaxf(mx, sink2);
    float l = 0.f;
#pragma unroll
    for (int kt = 0; kt < 5; ++kt)
#pragma unroll
        for (int r = 0; r < 16; ++r) { const float p = __builtin_amdgcn_exp2f(sc[kt][r] - mx); sc[kt][r] = p; l += p; }
    l += __shfl_xor(l, 32); l += __builtin_amdgcn_exp2f(sink2 - mx);
    const float linv = __builtin_amdgcn_rcpf(l);
    f32x16 o[2]; o[0] = f32x16{}; o[1] = f32x16{};
#pragma unroll
    for (int kt = 0; kt < 5; ++kt) {
#pragma unroll
        for (int s2 = 0; s2 < 2; ++s2) {
            v4u pw; pw.x = pk2(sc[kt][8 * s2 + 0] * linv, sc[kt][8 * s2 + 1] * linv); pw.y = pk2(sc[kt][8 * s2 + 2] * linv, sc[kt][8 * s2 + 3] * linv);
            pw.z = pk2(sc[kt][8 * s2 + 4] * linv, sc[kt][8 * s2 + 5] * linv); pw.w = pk2(sc[kt][8 * s2 + 6] * linv, sc[kt][8 * s2 + 7] * linv);
            const bf16x8 pf = __builtin_bit_cast(bf16x8, pw);
#pragma unroll
            for (int dh = 0; dh < 2; ++dh) {
                const LAS unsigned char* vp = vbase + (32 * dh * VSTR + 32 * kt + 16 * s2) * 2;
                const s16x4 lo = *(const LAS s16x4*)vp, hi = *(const LAS s16x4*)(vp + 16);
                const bf16x8 vf = (bf16x8){lo[0], lo[1], lo[2], lo[3], hi[0], hi[1], hi[2], hi[3]};
                o[dh] = __builtin_amdgcn_mfma_f32_32x32x16_bf16(pf, vf, o[dh], 0, 0, 0);
            }
        }
    }
    LAS float* stg = (LAS float*)(lds + ST_OFF + wave * 4096);
    const int srow = lane >> 1, sc0 = (lane & 1) * 16;
    const size_t grow = (size_t)(qrow0 + srow);
#pragma unroll
    for (int dh = 0; dh < 2; ++dh) {
#pragma unroll
        for (int r = 0; r < 16; ++r) stg[((r & 3) + 8 * (r >> 2) + 4 * hh) * 32 + c] = o[dh][r];
        asm volatile("s_waitcnt lgkmcnt(0)" ::: "memory");
        f32x4 x[4];
#pragma unroll
        for (int i = 0; i < 4; ++i) x[i] = *(const LAS f32x4*)(stg + srow * 32 + sc0 + 4 * i);
        asm volatile("s_waitcnt lgkmcnt(0)" ::: "memory");
        if (srow < nq) {
            const int col = h * HD + 32 * dh + sc0;
            const v4u g0 = *(const GAS v4u*)(qkvg + grow * LDQ + 1536 + col), g1 = *(const GAS v4u*)(qkvg + grow * LDQ + 1536 + col + 8);
            const unsigned gw[8] = {g0.x, g0.y, g0.z, g0.w, g1.x, g1.y, g1.z, g1.w};
            unsigned ow[8];
#pragma unroll
            for (int e = 0; e < 8; ++e) { const float ga = __builtin_bit_cast(float, gw[e] << 16), gb = __builtin_bit_cast(float, gw[e] & 0xffff0000u);
                const float ya = x[e >> 1][(e & 1) * 2] * ga * __builtin_amdgcn_rcpf(1.0f + __builtin_amdgcn_exp2f(-1.4426950408889634f * ga)), yb = x[e >> 1][(e & 1) * 2 + 1] * gb * __builtin_amdgcn_rcpf(1.0f + __builtin_amdgcn_exp2f(-1.4426950408889634f * gb)); ow[e] = pk2(ya, yb); }
            *(GAS v4u*)(og + grow * DM + col) = (v4u){ow[0], ow[1], ow[2], ow[3]}; *(GAS v4u*)(og + grow * DM + col + 8) = (v4u){ow[4], ow[5], ow[6], ow[7]};
        }
    }
}
constexpr int N_PROMPT_UNITS = NB * NKV * 33, N_SAMPLE_UNITS = DBATCH * NKV, N_COPY_UNITS = 8, N_UNITS = N_PROMPT_UNITS + N_SAMPLE_UNITS + N_COPY_UNITS;
}
__device__ __forceinline__ void p2_attention(Frame& F) {
    using namespace att;
    const bf16* qkvg = (const bf16*)(F.ws + WS_QKVG); bf16* og = (bf16*)(F.ws + WS_XA);
    LAS unsigned char* lds = F.lds + RING_OFF;
    for (int i = F.tid; i < NH * BEXT; i += NWAVES * 64) { const int h = i / BEXT, rel = i % BEXT - 32;
        ((LAS float*)(lds + B_OFF))[i] = (rel >= 0 && rel < 128) ? F.table[t5_bucket(rel) * NH + h] * LOG2E : -1e30f; }
    __syncthreads();
#pragma unroll 1
    for (int ui = F.vcu; ui < N_UNITS; ui += F.G) {
        int u;
        if (ui < 512) u = (ui >> 5) * 33 + (ui & 31);
        else if (ui < 528) u = (ui - 512) * 33 + 32;
        else u = ui;
        if (u >= N_PROMPT_UNITS + N_SAMPLE_UNITS) {
            const int cu = u - (N_PROMPT_UNITS + N_SAMPLE_UNITS);
            bf16* kvp = (bf16*)(F.ws + WS_KVP); bf16* kvs = (bf16*)(F.ws + WS_KVS);
            for (int i = cu * 512 + F.tid; i < 1024 * 64; i += N_COPY_UNITS * 512) {
                const int rr = i >> 6, ch = i & 63;
                const int srow = rr < 512 ? (rr >> 7) * LP + (LP - WIN) + (rr & 127) : MPR + (rr - 512);
                const v4u x = *(const GAS v4u*)(qkvg + (size_t)srow * LDQ + 1024 + 8 * ch);
                bf16* dst = rr < 512 ? kvp + (size_t)rr * 512 + 8 * ch : kvs + (size_t)(rr - 512) * 512 + 8 * ch;
                *(GAS v4u*)dst = x;
            }
            continue;
        }
        int kvh, nwu, qbase, q0, kt0;
        const bool is_prompt = u < N_PROMPT_UNITS;
        const int row = F.tid >> 1, half = F.tid & 1;
        if (is_prompt) {
            const int qblk = u % 33, b = u / (33 * NKV); kvh = (u / 33) % NKV;
            q0 = 128 * qblk; nwu = 16; qbase = b * LP + q0; kt0 = qblk == 0 ? 4 : 0;
            int pos = q0 - 128 + row; pos = pos < 0 ? 0 : (pos > LP - 1 ? LP - 1 : pos);
            const bf16* src = qkvg + (size_t)(b * LP + pos) * LDQ + 1024 + kvh * HD + half * 32;
#pragma unroll
            for (int i = 0; i < 4; ++i) { const v4u kv = *(const GAS v4u*)(src + 8 * i); *(LAS v4u*)(lds + K_OFF + (row * KSTR + half * 32 + 8 * i) * 2) = kv; }
#pragma unroll
            for (int i = 0; i < 4; ++i) { const v4u vv = *(const GAS v4u*)(src + 256 + 8 * i); const unsigned w[4] = {vv.x, vv.y, vv.z, vv.w};
#pragma unroll
                for (int e = 0; e < 8; ++e) { const bf16 x = (bf16)((w[e >> 1] >> ((e & 1) * 16)) & 0xffffu); *(LAS bf16*)(lds + V_OFF + ((half * 32 + 8 * i + e) * VSTR + row) * 2) = x; } }
        } else {
            const int su = u - N_PROMPT_UNITS, sb = su / NKV; kvh = su % NKV;
            q0 = LP; nwu = 4; qbase = MPR + sb * DSEQ; kt0 = 0;
            if (row < 160) {
#pragma unroll
                for (int i = 0; i < 4; ++i) {
                    v4u kq = (v4u){0u, 0u, 0u, 0u}, vq = (v4u){0u, 0u, 0u, 0u};
                    if (row < 128) {
                        const float* ck = F.cache_k + (((size_t)sb * WIN + row) * NKV + kvh) * HD + half * 32 + 8 * i; const float* cv = F.cache_v + (((size_t)sb * WIN + row) * NKV + kvh) * HD + half * 32 + 8 * i;
                        const f32x4 a0 = *(const GAS f32x4*)ck, a1 = *(const GAS f32x4*)(ck + 4), b0 = *(const GAS f32x4*)cv, b1 = *(const GAS f32x4*)(cv + 4);
                        kq = (v4u){pk2(a0.x, a0.y), pk2(a0.z, a0.w), pk2(a1.x, a1.y), pk2(a1.z, a1.w)}; vq = (v4u){pk2(b0.x, b0.y), pk2(b0.z, b0.w), pk2(b1.x, b1.y), pk2(b1.z, b1.w)};
                    } else if (row < 132) {
                        const bf16* src = qkvg + (size_t)(MPR + sb * DSEQ + (row - 128)) * LDQ + 1024 + kvh * HD + half * 32 + 8 * i;
                        kq = *(const GAS v4u*)src; vq = *(const GAS v4u*)(src + 256);
                    }
                    *(LAS v4u*)(lds + K_OFF + (row * KSTR + half * 32 + 8 * i) * 2) = kq;
                    const unsigned w[4] = {vq.x, vq.y, vq.z, vq.w};
#pragma unroll
                    for (int e = 0; e < 8; ++e) { const bf16 x = (bf16)((w[e >> 1] >> ((e & 1) * 16)) & 0xffffu); *(LAS bf16*)(lds + V_OFF + ((half * 32 + 8 * i + e) * VSTR + row) * 2) = x; }
                }
            }
        }
        __syncthreads();
#pragma unroll 1
        for (int wu = F.wave; wu < nwu; wu += NWAVES) {
            const int hg = wu & 3, j = wu >> 2, h = kvh * 4 + hg;
            int nq = is_prompt ? LP - (q0 + 32 * j) : DSEQ; nq = nq < 32 ? nq : 32;
            if (nq > 0) attn_wave(lds, qkvg, og, qbase + 32 * j, nq, j, kt0 - j, h, F.sinks[h] * LOG2E, F.lane, F.wave);
        }
        __syncthreads();
    }
}

__device__ __forceinline__ void rms_row8(const bf16* xrow, const float (&g8)[2][8], int lane, float (&x)[2][8]) {
    float s = 0.f;
#pragma unroll
    for (int j = 0; j < 2; ++j) { const v4u w = *(const GAS v4u*)(xrow + 8 * lane + 512 * j); const unsigned ww[4] = {w.x, w.y, w.z, w.w};
#pragma unroll
        for (int i = 0; i < 4; ++i) { x[j][2 * i] = __builtin_bit_cast(float, ww[i] << 16); x[j][2 * i + 1] = __builtin_bit_cast(float, ww[i] & 0xffff0000u); s += x[j][2 * i] * x[j][2 * i] + x[j][2 * i + 1] * x[j][2 * i + 1]; } }
    const float rstd = 1.0f / sqrtf(wave_sum(s) * (1.f / DM) + RMS_EPS);
#pragma unroll
    for (int j = 0; j < 2; ++j)
#pragma unroll
        for (int i = 0; i < 8; ++i) x[j][i] = x[j][i] * rstd * g8[j][i];
}
__device__ __forceinline__ void wait_row_tiles(const unsigned* cnt, int ra, int rb, unsigned full) {
    if (threadIdx.x < 64) {
        for (int pm = (ra < 0 ? 0 : ra) >> 8; pm <= (rb >> 8); ++pm)
            while (__hip_atomic_load(cnt + pm, __ATOMIC_RELAXED, __HIP_MEMORY_SCOPE_AGENT) < full) __builtin_amdgcn_s_sleep(8);
        __builtin_amdgcn_fence(__ATOMIC_ACQUIRE, "agent");
    }
    __syncthreads();
}
__device__ __forceinline__ void flow_range(const Frame& F, int seg, int nlate_wg, int rows_early, int& r0, int& r1, int& g0, int& g1) {
    const int bx = (int)blockIdx.x;
    if (seg == 0) { if (bx < nlate_wg) { r0 = r1 = g0 = g1 = 0; return; } const long wb = (long)(bx - nlate_wg) * NWAVES, w = wb + F.wave, NW = (long)(F.G - nlate_wg) * NWAVES;
        r0 = (int)((w * rows_early) / NW); r1 = (int)(((w + 1) * rows_early) / NW); g0 = (int)((wb * rows_early) / NW); g1 = (int)(((wb + NWAVES) * rows_early) / NW); }
    else { const long wb = (long)bx * NWAVES, w = wb + F.wave, NW = (long)F.G * NWAVES; const int nl = MTOK - rows_early;
        r0 = rows_early + (int)((w * nl) / NW); r1 = rows_early + (int)(((w + 1) * nl) / NW); g0 = rows_early + (int)((wb * nl) / NW); g1 = rows_early + (int)(((wb + NWAVES) * nl) / NW); }
}
__device__ __forceinline__ void p4_mix(Frame& F) {
    const int gw = F.vcu * NWAVES + F.wave, NGW = F.G * NWAVES;
    const bf16* h1 = (const bf16*)(F.ws + WS_H1); const float* gain = F.norm_gain + DM;
    float g8[2][8], mu8[4][2][8];
#pragma unroll
    for (int j = 0; j < 2; ++j) { const f32x4 a = *(const GAS f32x4*)(gain + 8 * F.lane + 512 * j), b = *(const GAS f32x4*)(gain + 8 * F.lane + 512 * j + 4);
        g8[j][0] = a.x; g8[j][1] = a.y; g8[j][2] = a.z; g8[j][3] = a.w; g8[j][4] = b.x; g8[j][5] = b.y; g8[j][6] = b.z; g8[j][7] = b.w;
#pragma unroll
        for (int c = 0; c < 4; ++c) { const f32x4 a2 = *(const GAS f32x4*)(F.mu + c * DM + 8 * F.lane + 512 * j), b2 = *(const GAS f32x4*)(F.mu + c * DM + 8 * F.lane + 512 * j + 4);
            mu8[c][j][0] = a2.x; mu8[c][j][1] = a2.y; mu8[c][j][2] = a2.z; mu8[c][j][3] = a2.w; mu8[c][j][4] = b2.x; mu8[c][j][5] = b2.y; mu8[c][j][6] = b2.z; mu8[c][j][7] = b2.w; } }
    float xp[2][8];
#pragma unroll
    for (int j = 0; j < 2; ++j)
#pragma unroll
        for (int i = 0; i < 8; ++i) xp[j][i] = 0.f;
    const int r0 = (int)(((long)gw * MTOK) / NGW), r1 = (int)(((long)(gw + 1) * MTOK) / NGW);
    bool have_prev = false;
#pragma unroll 1
    for (int m = r0; m < r1; ++m) {
        float x[2][8];
        rms_row8(h1 + (size_t)m * DM, g8, F.lane, x);
        bool first; const float* sh = nullptr;
        if (m < MPR) { first = (m % LP) == 0; } else { first = ((m - MPR) & 3) == 0; sh = F.state_shift + (size_t)((m - MPR) >> 2) * DM; }
        if (first) {
#pragma unroll
            for (int j = 0; j < 2; ++j) { f32x4 a = (f32x4){0.f, 0.f, 0.f, 0.f}, b = a; if (sh) { a = *(const GAS f32x4*)(sh + 8 * F.lane + 512 * j); b = *(const GAS f32x4*)(sh + 8 * F.lane + 512 * j + 4); }
                xp[j][0] = a.x; xp[j][1] = a.y; xp[j][2] = a.z; xp[j][3] = a.w; xp[j][4] = b.x; xp[j][5] = b.y; xp[j][6] = b.z; xp[j][7] = b.w; }
        } else if (!have_prev) rms_row8(h1 + (size_t)(m - 1) * DM, g8, F.lane, xp);
        {
            bf16* xr = m < MPR ? (bf16*)(F.dob + DO_XN1) + (size_t)m * DM : (bf16*)(F.ws + WS_XN1S) + (size_t)(m - MPR) * DM;
#pragma unroll
            for (int j = 0; j < 2; ++j) { v4u o; o.x = pk2(x[j][0], x[j][1]); o.y = pk2(x[j][2], x[j][3]); o.z = pk2(x[j][4], x[j][5]); o.w = pk2(x[j][6], x[j][7]); *(GAS v4u*)(xr + 8 * F.lane + 512 * j) = o; }
            if (first && sh) { bf16* sr = (bf16*)(F.ws + WS_XN1S) + (size_t)(DBATCH * DSEQ + ((m - MPR) >> 2)) * DM;
#pragma unroll
                for (int j = 0; j < 2; ++j) { v4u o; o.x = pk2(xp[j][0], xp[j][1]); o.y = pk2(xp[j][2], xp[j][3]); o.z = pk2(xp[j][4], xp[j][5]); o.w = pk2(xp[j][6], xp[j][7]); *(GAS v4u*)(sr + 8 * F.lane + 512 * j) = o; } }
        }
#pragma unroll
        for (int c = 0; c < 4; ++c) {
            bf16* dst = (bf16*)(F.ws + WS_MIX + c * MIX_STRIDE) + (size_t)m * DM;
#pragma unroll
            for (int j = 0; j < 2; ++j) { float v[8];
#pragma unroll
                for (int i = 0; i < 8; ++i) v[i] = x[j][i] + (xp[j][i] - x[j][i]) * mu8[c][j][i];
                v4u o; o.x = pk2(v[0], v[1]); o.y = pk2(v[2], v[3]); o.z = pk2(v[4], v[5]); o.w = pk2(v[6], v[7]);
                *(GAS v4u*)(dst + 8 * F.lane + 512 * j) = o; }
        }
        float* d = nullptr;
        if (m < MPR) { if ((m % LP) == LP - 1) d = (float*)(F.ws + WS_SHP) + (size_t)(m / LP) * DM; }
        else if (((m - MPR) & 3) == 3) d = F.out + O_SHS + (size_t)((m - MPR) >> 2) * DM;
        if (d) {
#pragma unroll
            for (int j = 0; j < 2; ++j) { *(GAS f32x4*)(d + 8 * F.lane + 512 * j) = (f32x4){x[j][0], x[j][1], x[j][2], x[j][3]}; *(GAS f32x4*)(d + 8 * F.lane + 512 * j + 4) = (f32x4){x[j][4], x[j][5], x[j][6], x[j][7]}; } }
#pragma unroll
        for (int j = 0; j < 2; ++j)
#pragma unroll
            for (int i = 0; i < 8; ++i) xp[j][i] = x[j][i];
        have_prev = true;
    }
}

__device__ __forceinline__ void p5_lora1_combine(Frame& F) {
    const int gw = F.vcu * NWAVES + F.wave, NGW = F.G * NWAVES;
    const float* U = (const float*)(F.ws + WS_U); float* t12 = (float*)(F.ws + WS_T12); unsigned char* t12b = F.ws + WS_T12B;
    const int j = F.lane;
    const int r0 = (int)(((long)gw * MTOK) / NGW), r1 = (int)(((long)(gw + 1) * MTOK) / NGW);
    for (int m = r0; m < r1; ++m) {
        const float* cur; const float* prev = nullptr;
        if (m < MPR) { cur = U + (size_t)m * 256; if ((m % LP) != 0) prev = cur - 256; }
        else { const int i = m - MPR; cur = U + (size_t)(U_SROW + i) * 256; prev = (i & 3) == 0 ? U + (size_t)(U_SROW + DBATCH * DSEQ + (i >> 2)) * 256 : cur - 256; }
        float a = cur[j], b2 = cur[128 + j];
        if (prev) { a += prev[64 + j]; b2 += prev[192 + j]; }
        a = tanhf(a);
        t12[(size_t)m * 128 + j] = a; t12[(size_t)m * 128 + 64 + j] = b2;
        if (m < MPR) { const int bb = m / LP, t = m - bb * LP;
            unsigned char* ob = t12b + ((size_t)((bb * 129 + (t >> 5)) * 8) * 64 + (t & 31)) * 16 + ((j >> 4) * 64 + 32 * ((j >> 3) & 1)) * 16 + (j & 7) * 2;
            *(bf16*)ob = (bf16)f2bf(a); *(bf16*)(ob + 4 * 1024) = (bf16)f2bf(b2); }
    }
}

__device__ __forceinline__ void wkv_seq_unit(Frame& F, LAS float* wl, int row0, int T, int h, const float* S0, float* Sout, int lane, bf16* hout = nullptr) {
    asm volatile("" : "+v"(lane));
    const bf16* R = (const bf16*)(F.dob); const bf16* Kb = (const bf16*)(F.dob + RKV_STRIDE); const bf16* Vb = (const bf16*)(F.dob + 2 * RKV_STRIDE);
    const bf16* Gb = (const bf16*)(F.ws + WS_G); const float* t12 = (const float*)(F.ws + WS_T12); bf16* og2 = (bf16*)(F.dob + DO_OG2);
    const int ch = h * HD + lane;
    unsigned w2p[32], a2p[32]; float S[64];
#pragma unroll
    for (int i = 0; i < 32; ++i) { w2p[i] = pk2(F.w2[(2 * i) * DM + ch], F.w2[(2 * i + 1) * DM + ch]); a2p[i] = pk2(F.a2[(2 * i) * DM + ch], F.a2[(2 * i + 1) * DM + ch]); }
    const float w0c = F.w0[ch], a0c = F.a0[ch], kkc = F.k_k[ch], kac = F.k_a[ch], rkc = F.r_k[ch], lng = F.ln_g[ch], lnb = F.ln_b[ch];
    if (S0) {
#pragma unroll
        for (int i = 0; i < 16; ++i) { const f32x4 v = *(const GAS f32x4*)(S0 + (size_t)lane * 64 + 4 * i); S[4 * i] = v.x; S[4 * i + 1] = v.y; S[4 * i + 2] = v.z; S[4 * i + 3] = v.w; }
    } else {
#pragma unroll
        for (int i = 0; i < 64; ++i) S[i] = 0.f;
    }
    for (int t = 0; t < T; ++t) {
        const size_t m = (size_t)(row0 + t);
#if WKV_EXP >= 30
        if (T == LP && t == WKV_DUMP_T) { float* dp = (float*)(F.ws + 184 * MiB) + (size_t)((row0 / LP) * NH + h) * 4096;
#pragma unroll
            for (int i = 0; i < 16; ++i) *(GAS f32x4*)(dp + (size_t)lane * 64 + 4 * i) = (f32x4){S[4 * i], S[4 * i + 1], S[4 * i + 2], S[4 * i + 3]}; }
#endif
#pragma unroll
        for (int i = 0; i < 32; ++i) { asm volatile("" : "+v"(w2p[i])); asm volatile("" : "+v"(a2p[i])); }
        const float r = bf2f(R[m * DM + ch]), k = bf2f(Kb[m * DM + ch]), v = bf2f(Vb[m * DM + ch]), g = bf2f(Gb[m * DM + ch]);
        wl[lane] = t12[m * 128 + lane]; wl[64 + lane] = t12[m * 128 + 64 + lane];
        asm volatile("s_waitcnt lgkmcnt(0)" ::: "memory");
        float z = w0c, az = a0c;
#pragma unroll
        for (int i = 0; i < 16; ++i) { const f32x4 x = *(const LAS f32x4*)(wl + 4 * i), y = *(const LAS f32x4*)(wl + 64 + 4 * i);
            z += x.x * __builtin_bit_cast(float, w2p[2 * i] << 16) + x.y * __builtin_bit_cast(float, w2p[2 * i] & 0xffff0000u) + x.z * __builtin_bit_cast(float, w2p[2 * i + 1] << 16) + x.w * __builtin_bit_cast(float, w2p[2 * i + 1] & 0xffff0000u);
            az += y.x * __builtin_bit_cast(float, a2p[2 * i] << 16) + y.y * __builtin_bit_cast(float, a2p[2 * i] & 0xffff0000u) + y.z * __builtin_bit_cast(float, a2p[2 * i + 1] << 16) + y.w * __builtin_bit_cast(float, a2p[2 * i + 1] & 0xffff0000u); }
        const float a = 1.0f / (1.0f + __expf(-az)), sg = 1.0f / (1.0f + __expf(-z)), dec = __expf(-0.6065306597126334f * sg);
        float kk = k * kkc; const float n2 = wave_sum(kk * kk); kk = kk / fmaxf(sqrtf(n2), 1e-12f);
        const float kh = k * (1.0f + (a - 1.0f) * kac);
        const float rk = wave_sum(r * kh * rkc);
        wl[128 + lane] = -kk; wl[192 + lane] = kk * a; wl[256 + lane] = dec; wl[320 + lane] = kh; wl[384 + lane] = r;
        asm volatile("s_waitcnt lgkmcnt(0)" ::: "memory");
        float sa = 0.f;
#pragma unroll
        for (int i = 0; i < 16; ++i) { const f32x4 x = *(const LAS f32x4*)(wl + 128 + 4 * i); sa += S[4 * i] * x.x + S[4 * i + 1] * x.y + S[4 * i + 2] * x.z + S[4 * i + 3] * x.w; }
        float y = 0.f;
#pragma unroll
        for (int i = 0; i < 16; ++i) {
            const f32x4 bq = *(const LAS f32x4*)(wl + 192 + 4 * i), wq = *(const LAS f32x4*)(wl + 256 + 4 * i), kq = *(const LAS f32x4*)(wl + 320 + 4 * i), rq = *(const LAS f32x4*)(wl + 384 + 4 * i);
#if WKV_EXP == 45 && WKV_VAR == 2
            if (hout) sa = 0.f;
#endif
            S[4 * i] = S[4 * i] * wq.x + sa * bq.x + v * kq.x; S[4 * i + 1] = S[4 * i + 1] * wq.y + sa * bq.y + v * kq.y;
            S[4 * i + 2] = S[4 * i + 2] * wq.z + sa * bq.z + v * kq.z; S[4 * i + 3] = S[4 * i + 3] * wq.w + sa * bq.w + v * kq.w;
            y += S[4 * i] * rq.x + S[4 * i + 1] * rq.y + S[4 * i + 2] * rq.z + S[4 * i + 3] * rq.w; }
        const float mean = wave_sum(y) * (1.f / 64.f), dv = y - mean, var = wave_sum(dv * dv) * (1.f / 64.f);
        const float yn = dv * (1.0f / sqrtf(var + GN_EPS)) * lng + lnb + rk * v;
        if (!hout) og2[m * DM + ch] = (bf16)f2bf(yn * g / (1.0f + __expf(-g)));
        asm volatile("" ::: "memory");
    }
    if (hout) {
#pragma unroll
        for (int i = 0; i < 16; ++i) *(GAS unsigned long long*)(hout + (size_t)lane * 64 + 4 * i) = (unsigned long long)pk2(S[4 * i], S[4 * i + 1]) | ((unsigned long long)pk2(S[4 * i + 2], S[4 * i + 3]) << 32);
        return;
    }
#pragma unroll
    for (int i = 0; i < 16; ++i) *(GAS f32x4*)(Sout + (size_t)lane * 64 + 4 * i) = (f32x4){S[4 * i], S[4 * i + 1], S[4 * i + 2], S[4 * i + 3]};
}
#define SEQ_FENCE() do { asm volatile("" ::: "memory"); __builtin_amdgcn_sched_barrier(0); } while (0)
__device__ __forceinline__ void wkv_seq4_unit(Frame& F, LAS float* wl, int row0, int h, const float* S0, float* Sout, int lane) {
    asm volatile("" : "+v"(lane));
    const bf16* R = (const bf16*)(F.dob); const bf16* Kb = (const bf16*)(F.dob + RKV_STRIDE); const bf16* Vb = (const bf16*)(F.dob + 2 * RKV_STRIDE);
    const bf16* Gb = (const bf16*)(F.ws + WS_G); const float* t12 = (const float*)(F.ws + WS_T12); bf16* og2 = (bf16*)(F.dob + DO_OG2);
    const int ch = h * HD + lane;
    constexpr float L2E = 1.4426950408889634f;
    {
        float r[4], k[4], v[4], g[4];
#pragma unroll
        for (int t = 0; t < 4; ++t) { const size_t m = (size_t)(row0 + t); r[t] = bf2f(R[m * DM + ch]); k[t] = bf2f(Kb[m * DM + ch]); v[t] = bf2f(Vb[m * DM + ch]); g[t] = bf2f(Gb[m * DM + ch]);
            wl[t * 128 + lane] = t12[m * 128 + lane]; wl[t * 128 + 64 + lane] = t12[m * 128 + 64 + lane]; }
        const float w0c = F.w0[ch], a0c = F.a0[ch], kkc = F.k_k[ch], kac = F.k_a[ch], rkc = F.r_k[ch];
        float z[4], az[4];
#pragma unroll
        for (int t = 0; t < 4; ++t) { z[t] = w0c; az[t] = a0c; }
        asm volatile("s_waitcnt lgkmcnt(0)" ::: "memory");
        SEQ_FENCE();
#pragma unroll
        for (int i = 0; i < 16; ++i) {
            float w4[4], a4[4];
#pragma unroll
            for (int e = 0; e < 4; ++e) { w4[e] = F.w2[(4 * i + e) * DM + ch]; a4[e] = F.a2[(4 * i + e) * DM + ch]; }
#pragma unroll
            for (int t = 0; t < 4; ++t) { const f32x4 x = *(const LAS f32x4*)(wl + t * 128 + 4 * i), y = *(const LAS f32x4*)(wl + t * 128 + 64 + 4 * i);
                z[t] += x.x * w4[0] + x.y * w4[1] + x.z * w4[2] + x.w * w4[3]; az[t] += y.x * a4[0] + y.y * a4[1] + y.z * a4[2] + y.w * a4[3]; }
            if ((i & 3) == 3) SEQ_FENCE(); }
        asm volatile("s_waitcnt lgkmcnt(0)" ::: "memory");
#pragma unroll
        for (int t = 0; t < 4; ++t) {
            const float a = __builtin_amdgcn_rcpf(1.0f + __builtin_amdgcn_exp2f(-az[t] * L2E)), sg = __builtin_amdgcn_rcpf(1.0f + __builtin_amdgcn_exp2f(-z[t] * L2E)), dec = __builtin_amdgcn_exp2f((-0.6065306597126334f * L2E) * sg);
            float kk = k[t] * kkc; const float n2 = wave_sum(kk * kk); kk = kk * __builtin_amdgcn_rsqf(fmaxf(n2, 1e-24f));
            const float kh = k[t] * (1.0f + (a - 1.0f) * kac);
            const float rk = wave_sum(r[t] * kh * rkc);
            LAS float* w = wl + t * 512;
            w[lane] = -kk; w[64 + lane] = kk * a; w[128 + lane] = dec; w[192 + lane] = kh; w[256 + lane] = r[t]; w[320 + lane] = v[t]; w[384 + lane] = g[t]; w[448 + lane] = rk;
        }
    }
    SEQ_FENCE();
    float S[64];
#pragma unroll
    for (int i = 0; i < 16; ++i) { const f32x4 x = *(const GAS f32x4*)(S0 + (size_t)lane * 64 + 4 * i); S[4 * i] = x.x; S[4 * i + 1] = x.y; S[4 * i + 2] = x.z; S[4 * i + 3] = x.w; }
    const float lng = F.ln_g[ch], lnb = F.ln_b[ch];
    asm volatile("s_waitcnt lgkmcnt(0)" ::: "memory");
#pragma unroll 1
    for (int t = 0; t < 4; ++t) {
        const LAS float* w = wl + t * 512;
        float sa = 0.f;
#pragma unroll
        for (int i = 0; i < 16; ++i) { const f32x4 x = *(const LAS f32x4*)(w + 4 * i); sa += S[4 * i] * x.x + S[4 * i + 1] * x.y + S[4 * i + 2] * x.z + S[4 * i + 3] * x.w; }
        const float v = w[320 + lane], g = w[384 + lane], rk = w[448 + lane];
        float y = 0.f;
#pragma unroll
        for (int i = 0; i < 16; ++i) {
            const f32x4 bq = *(const LAS f32x4*)(w + 64 + 4 * i), wq = *(const LAS f32x4*)(w + 128 + 4 * i), kq = *(const LAS f32x4*)(w + 192 + 4 * i), rq = *(const LAS f32x4*)(w + 256 + 4 * i);
            S[4 * i] = S[4 * i] * wq.x + sa * bq.x + v * kq.x; S[4 * i + 1] = S[4 * i + 1] * wq.y + sa * bq.y + v * kq.y;
            S[4 * i + 2] = S[4 * i + 2] * wq.z + sa * bq.z + v * kq.z; S[4 * i + 3] = S[4 * i + 3] * wq.w + sa * bq.w + v * kq.w;
            y += S[4 * i] * rq.x + S[4 * i + 1] * rq.y + S[4 * i + 2] * rq.z + S[4 * i + 3] * rq.w; }
        const float mean = wave_sum(y) * (1.f / 64.f), dv = y - mean, var = wave_sum(dv * dv) * (1.f / 64.f);
        const float yn = dv * __builtin_amdgcn_rsqf(var + GN_EPS) * lng + lnb + rk * v;
        og2[(size_t)(row0 + t) * DM + ch] = (bf16)f2bf(yn * g * __builtin_amdgcn_rcpf(1.0f + __builtin_amdgcn_exp2f(-g * L2E)));
        asm volatile("" ::: "memory");
    }
#pragma unroll
    for (int i = 0; i < 16; ++i) *(GAS f32x4*)(Sout + (size_t)lane * 64 + 4 * i) = (f32x4){S[4 * i], S[4 * i + 1], S[4 * i + 2], S[4 * i + 3]};
    asm volatile("s_waitcnt lgkmcnt(0)" ::: "memory");
}
__device__ __forceinline__ void p6_wkv_seq(Frame& F) {
    LAS float* wl = (LAS float*)(F.lds + RING_OFF) + F.wave * 512;
    constexpr int NSU = DBATCH * NH;
    for (int u = F.wave * F.G + F.vcu; u < NSU + NB * NH; u += NWAVES * F.G) {
        if (u < NSU) { const int sb = u / NH, h = u % NH;
            wkv_seq_unit(F, wl, MPR + sb * DSEQ, DSEQ, h, F.state_wkv + (size_t)u * 4096, F.out + O_WKVS + (size_t)u * 4096, F.lane); }
        else { const int pu = u - NSU, b = pu / NH, h = pu % NH;
            wkv_seq_unit(F, wl, b * LP, LP, h, nullptr, (float*)(F.ws + WS_WKVP) + (size_t)pu * 4096, F.lane); }
    }
}

__device__ __forceinline__ void p8_final(Frame& F) {
#if WKV_VAR >= 11 && WKV_VAR <= 19
    { const unsigned flag = __hip_atomic_load((unsigned*)(F.ws + WS_CTL) + 8, __ATOMIC_RELAXED, __HIP_MEMORY_SCOPE_AGENT); if (flag && blockIdx.x == 0 && F.tid < 64) { const float e = (flag & 1u ? 100.f : 0.f) + (flag & 2u ? 1000.f : 0.f) + (flag & 4u ? 10000.f : 0.f) + (flag & 8u ? 31.f : 0.f) + (flag & 16u ? 7.f : 0.f) + (flag & 32u ? 3.f : 0.f) + (flag & 64u ? 50.f : 0.f) + (flag & 128u ? 200.f : 0.f) + (flag & 256u ? 1000.f : 0.f) + (flag & 512u ? 5000.f : 0.f); F.out[O_SHS + F.tid] += e; } }
#endif
    const int gw = F.vcu * NWAVES + F.wave, NGW = F.G * NWAVES;
    const bf16* h2 = (const bf16*)(F.ws + WS_H1);
    for (int m = gw; m < MTOK; m += NGW) {
        float* dst;
        if (m < MPR) { const int b = m / LP, t = m - b * LP; if (t < NMETA) continue; dst = F.out + O_YP + ((size_t)b * SEQ + (t - NMETA)) * DM; }
        else dst = F.out + O_YS + (size_t)(m - MPR) * DM;
        f32x4 v[4]; rms_row_b(h2 + (size_t)m * DM, F.final_gain, F.lane, v);
#pragma unroll
        for (int j = 0; j < 4; ++j) ((GAS f32x4*)dst)[F.lane + 64 * j] = v[j];
    }
    const int gt = F.vcu * (NWAVES * 64) + F.tid, NGT = F.G * NWAVES * 64;
    const bf16* kvp = (const bf16*)(F.ws + WS_KVP); const bf16* kvs = (const bf16*)(F.ws + WS_KVS);
    for (int i = gt; i < 2 * NB * WIN * 256; i += NGT) { const int kv = i / (NB * WIN * 256), r = i % (NB * WIN * 256), row = r >> 8, col = r & 255;
        F.out[(kv ? O_WVP : O_WKP) + r] = bf2f(kvp[(size_t)row * 512 + kv * 256 + col]); }
    for (int i = gt; i < NB * NH * 4096; i += NGT) F.out[O_WKVP + i] = ((const float*)(F.ws + WS_WKVP))[i];
    for (int i = gt; i < NB * DM; i += NGT) F.out[O_SHP + i] = ((const float*)(F.ws + WS_SHP))[i];
    for (int i = gt; i < 2 * DBATCH * WIN * 64; i += NGT) {
        const int kv = i / (DBATCH * WIN * 64), r = i % (DBATCH * WIN * 64), sb = r / (WIN * 64), j = (r / 64) % WIN, c4 = r % 64;
        f32x4 v;
        if (j < WIN - DSEQ) v = *(const GAS f32x4*)((kv ? F.cache_v : F.cache_k) + ((size_t)sb * WIN + j + DSEQ) * 256 + 4 * c4);
        else { const bf16* s = kvs + (size_t)(sb * DSEQ + (j - (WIN - DSEQ))) * 512 + kv * 256 + 4 * c4; v = (f32x4){bf2f(s[0]), bf2f(s[1]), bf2f(s[2]), bf2f(s[3])}; }
        *(GAS f32x4*)(F.out + (kv ? O_WVS : O_WKS) + (size_t)r * 4) = v;
    }
}
namespace wkv {
typedef __amdgpu_buffer_rsrc_t srd_t;
constexpr int NCH = 65, NUNITS = NB * NH * NCH;
constexpr size_t WS_W2T = 18 * MiB + 256 * 1024, WS_A2T = 18 * MiB + 384 * 1024;
constexpr size_t WS_GT = 98 * MiB, WS_HT = 131 * MiB, WS_KST = 164 * MiB, WS_RK = 181 * MiB, WS_TST = 183 * MiB, WS_Y0F = 30 * MiB, WS_WYF = 64 * MiB;
static_assert(3 * RKV_STRIDE + (size_t)2048 * 16384 <= O_SHS * 4 && WS_GT + (size_t)NUNITS * 8192 <= WS_HT && WS_HT + (size_t)NUNITS * 8192 <= WS_KST && WS_KST + (size_t)2048 * 8192 <= WS_RK && WS_RK + (size_t)MTOK * 16 * 4 <= WS_H1 && WS_Y0F + (size_t)NUNITS * 8192 <= WS_WYF && WS_WYF + (size_t)NUNITS * 8192 <= WS_GT, "wkv ws map");
constexpr int LDSX_OFF = 132096;
static_assert(LDSX_OFF + NWAVES * 512 <= LDS_BYTES, "lds");
__device__ __forceinline__ unsigned cvtpk(float lo, float hi) { unsigned r; asm volatile("v_cvt_pk_bf16_f32 %0, %1, %2\n\ts_nop 1" : "=v"(r) : "v"(lo), "v"(hi)); return r; }
__device__ __forceinline__ unsigned cvtpkn(float lo, float hi) { return pk2(lo, hi); }
__device__ __forceinline__ void mfma_fence(f32x16 (&acc)[2][2]) { asm volatile("s_nop 15\n\ts_nop 7" : "+v"(acc[0][0]), "+v"(acc[0][1]), "+v"(acc[1][0]), "+v"(acc[1][1])); }
__device__ __forceinline__ void mfma_fence2(f32x16& a, f32x16& b) { asm volatile("s_nop 15\n\ts_nop 7" : "+v"(a), "+v"(b)); }
__device__ __forceinline__ float lo16(unsigned w) { return __builtin_bit_cast(float, w << 16); }
__device__ __forceinline__ float hi16(unsigned w) { return __builtin_bit_cast(float, w & 0xffff0000u); }
__device__ __forceinline__ void mm64(f32x16 (&acc)[2][2], const bf16x8 (&A)[4][2], const bf16x8 (&B)[4][2]) {
#pragma unroll
    for (int m = 0; m < 2; ++m)
#pragma unroll
        for (int n = 0; n < 2; ++n)
#pragma unroll
            for (int ks = 0; ks < 4; ++ks) acc[m][n] = __builtin_amdgcn_mfma_f32_32x32x16_bf16(A[ks][m], B[ks][n], acc[m][n], 0, 0, 0);
    mfma_fence(acc);
}
__device__ __forceinline__ void acc2frag(const f32x16 (&acc)[2][2], bf16x8 (&Fr)[4][2]) {
#pragma unroll
    for (int m = 0; m < 2; ++m)
#pragma unroll
        for (int n = 0; n < 2; ++n)
#pragma unroll
            for (int s = 0; s < 2; ++s) { const f32x16& a = acc[m][n]; v4u w;
                w.x = cvtpk(a[8 * s + 0], a[8 * s + 1]); w.y = cvtpk(a[8 * s + 2], a[8 * s + 3]); w.z = cvtpk(a[8 * s + 4], a[8 * s + 5]); w.w = cvtpk(a[8 * s + 6], a[8 * s + 7]);
                Fr[2 * m + s][n] = __builtin_bit_cast(bf16x8, w); }
}
__device__ __forceinline__ void zero_acc(f32x16 (&acc)[2][2]) {
#pragma unroll
    for (int m = 0; m < 2; ++m)
#pragma unroll
        for (int n = 0; n < 2; ++n) acc[m][n] = f32x16{};
}
__device__ __forceinline__ void frag_st_lds(LAS unsigned char* p, const bf16x8 (&Fr)[4][2], int lane) {
#pragma unroll
    for (int ks = 0; ks < 4; ++ks)
#pragma unroll
        for (int t = 0; t < 2; ++t) *(LAS bf16x8*)(p + (ks * 2 + t) * 1024 + lane * 16) = Fr[ks][t];
}
__device__ __forceinline__ void frag_ld_lds(const LAS unsigned char* p, bf16x8 (&Fr)[4][2], int lane) {
#pragma unroll
    for (int ks = 0; ks < 4; ++ks)
#pragma unroll
        for (int t = 0; t < 2; ++t) Fr[ks][t] = *(const LAS bf16x8*)(p + (ks * 2 + t) * 1024 + lane * 16);
}
template <int D> __device__ __forceinline__ void bfly_step(float (&v)[32], int lane) {
    const bool up = (lane & D) != 0;
#pragma unroll
    for (int s = 0; s < D; ++s) { const float send = up ? v[s] : v[s + D], keep = up ? v[s + D] : v[s]; v[s] = keep + __shfl_xor(send, D); }
}
__device__ __forceinline__ float butterfly32(float (&v)[32], int lane) {
    bfly_step<16>(v, lane); bfly_step<8>(v, lane); bfly_step<4>(v, lane); bfly_step<2>(v, lane); bfly_step<1>(v, lane);
    return v[0];
}
__device__ __forceinline__ int crow(int r, int hi) { return (r & 3) + 8 * (r >> 2) + 4 * hi; }

#define WKV_FENCE() do { asm volatile("" ::: "memory"); __builtin_amdgcn_sched_barrier(0); } while (0)
__device__ __forceinline__ void frag_st_g(unsigned char* p, const bf16x8 (&Fr)[4][2], int lane) {
#pragma unroll
    for (int ks = 0; ks < 4; ++ks)
#pragma unroll
        for (int t = 0; t < 2; ++t) *(GAS bf16x8*)(p + (ks * 2 + t) * 1024 + lane * 16) = Fr[ks][t];
}
typedef unsigned v4u_t __attribute__((ext_vector_type(4)));
__device__ __forceinline__ void frag_ld_g(const unsigned char* p, bf16x8 (&Fr)[4][2], int lane) {
    const srd_t r = __builtin_amdgcn_make_buffer_rsrc((void*)p, (short)0, 8192, 0x00020000);
#pragma unroll
    for (int ks = 0; ks < 4; ++ks)
#pragma unroll
        for (int t = 0; t < 2; ++t) { const v4u_t x = __builtin_amdgcn_raw_buffer_load_b128(r, (unsigned)(lane * 16), (unsigned)((ks * 2 + t) * 1024), 16  ); Fr[ks][t] = __builtin_bit_cast(bf16x8, x); }
}
__device__ __forceinline__ void transpose64(f32x16 (&acc)[2][2], const bf16x8 (&XR)[4][2], const bf16x8 (&Id2)[2]) {
#pragma unroll
    for (int m = 0; m < 2; ++m)
#pragma unroll
        for (int n = 0; n < 2; ++n) { acc[m][n] = f32x16{};
#pragma unroll
            for (int s = 0; s < 2; ++s) acc[m][n] = __builtin_amdgcn_mfma_f32_32x32x16_bf16(XR[2 * n + s][m], Id2[s], acc[m][n], 0, 0, 0); }
    mfma_fence(acc);
}
__device__ __forceinline__ float bld16(srd_t r, unsigned vo, unsigned so) { return __builtin_bit_cast(float, (unsigned)__builtin_amdgcn_raw_buffer_load_b16(r, vo, so, 0) << 16); }
__device__ __forceinline__ unsigned bld16u(srd_t r, unsigned vo, unsigned so) { return (unsigned)__builtin_amdgcn_raw_buffer_load_b16(r, vo, so, 0); }
typedef unsigned v2u_t __attribute__((ext_vector_type(2)));
__device__ __forceinline__ unsigned long long bld64(srd_t r, unsigned vo, unsigned so) { const v2u_t v = __builtin_amdgcn_raw_buffer_load_b64(r, vo, so, 16  ); return (unsigned long long)v.x | ((unsigned long long)v.y << 32); }
__device__ __forceinline__ void bst64(srd_t r, unsigned vo, unsigned so, unsigned long long w) { v2u_t v; v.x = (unsigned)w; v.y = (unsigned)(w >> 32); __builtin_amdgcn_raw_buffer_store_b64(v, r, vo, so, 0); }
__device__ __forceinline__ unsigned long long pack4(float a, float b, float c, float d) { return (unsigned long long)cvtpkn(a, b) | ((unsigned long long)cvtpkn(c, d) << 32); }
template <bool TAIL> __device__ __forceinline__ void solve_T(const f32x16 (&acc)[2][2], bf16x8 (&TR)[4][2], int lane, bool sync, int skip) {
    float Tc[64];
#pragma unroll
    for (int i = 0; i < 64; ++i) Tc[i] = (lane == i) ? 1.f : 0.f;
    if (!(skip & 1))
#pragma unroll
    for (int i = 62; i >= 0; --i) {
        const int mi = i >> 5, ri = (i & 3) + 4 * ((i & 31) >> 3), hi = ((i & 31) >> 2) & 1;
        if (!(TAIL && i >= 16)) {
        float e0 = acc[mi][0][ri], e1 = acc[mi][1][ri];
        asm volatile("" : "+v"(e0)); asm volatile("" : "+v"(e1));
#pragma unroll
        for (int k = i + 1; k < (TAIL ? 16 : 64); ++k) {
            const float nik = __builtin_bit_cast(float, __builtin_amdgcn_readlane(__builtin_bit_cast(int, (k >> 5) ? e1 : e0), (k & 31) + 32 * hi));
            Tc[i] = __builtin_fmaf(nik, Tc[k], Tc[i]);
        }
        }
        if ((i & 7) == 0 && sync) __builtin_amdgcn_s_barrier();
        WKV_FENCE();
    }
#pragma unroll
    for (int ks = 0; ks < 4; ++ks) {
        const int b0 = 16 * ks;
        v4u E, O;
        E.x = cvtpk(Tc[b0 + 0], Tc[b0 + 1]); E.y = cvtpk(Tc[b0 + 2], Tc[b0 + 3]); E.z = cvtpk(Tc[b0 + 8], Tc[b0 + 9]); E.w = cvtpk(Tc[b0 + 10], Tc[b0 + 11]);
        O.x = cvtpk(Tc[b0 + 4], Tc[b0 + 5]); O.y = cvtpk(Tc[b0 + 6], Tc[b0 + 7]); O.z = cvtpk(Tc[b0 + 12], Tc[b0 + 13]); O.w = cvtpk(Tc[b0 + 14], Tc[b0 + 15]);
        { auto r = __builtin_amdgcn_permlane32_swap(E.x, O.x, false, false); E.x = r[0]; O.x = r[1]; }
        { auto r = __builtin_amdgcn_permlane32_swap(E.y, O.y, false, false); E.y = r[0]; O.y = r[1]; }
        { auto r = __builtin_amdgcn_permlane32_swap(E.z, O.z, false, false); E.z = r[0]; O.z = r[1]; }
        { auto r = __builtin_amdgcn_permlane32_swap(E.w, O.w, false, false); E.w = r[0]; O.w = r[1]; }
        TR[ks][0] = __builtin_bit_cast(bf16x8, E); TR[ks][1] = __builtin_bit_cast(bf16x8, O);
    }
}
__device__ __forceinline__ void mfma_fence1(f32x16& a) { asm volatile("s_nop 15\n\ts_nop 7" : "+v"(a)); }
__device__ __forceinline__ void make_idn(bf16x8 (&IdN)[2], int c, int hh) {
    asm volatile("" : "+v"(c), "+v"(hh));
#pragma unroll
    for (int s2 = 0; s2 < 2; ++s2) { bf16x8 v;
#pragma unroll
        for (int jj = 0; jj < 8; ++jj) v[jj] = ((16 * s2 + 8 * hh + jj) == c) ? (short)0x3F80 : (short)0;
        IdN[s2] = v; }
}
__device__ __forceinline__ f32x16 tile_from_rows(const bf16x8& a0, const bf16x8& a1, const bf16x8 (&IdN)[2]) {
    f32x16 t = f32x16{};
    t = __builtin_amdgcn_mfma_f32_32x32x16_bf16(a0, IdN[0], t, 0, 0, 0);
    t = __builtin_amdgcn_mfma_f32_32x32x16_bf16(a1, IdN[1], t, 0, 0, 0);
    return t;
}
__device__ __forceinline__ bf16x8 bld128(srd_t r, unsigned vo, unsigned so) { const v4u_t x = __builtin_amdgcn_raw_buffer_load_b128(r, vo, so, 0); return __builtin_bit_cast(bf16x8, x); }
#ifndef WKV_SEQ4
#define WKV_SEQ4 0
#endif
#ifndef WKV_LOCKSTEP
#define WKV_LOCKSTEP 0
#endif
#define WKV_SYNC() do { if (sync) __builtin_amdgcn_s_barrier(); } while (0)
__device__ __forceinline__ void stageA_unit(Frame& F, int uidx, int lane, int wave, bool sync, int lslot) {
    asm volatile("" : "+v"(lane));
    const int c = lane & 31, hh = lane >> 5;
    const int ch = uidx % NCH, bh = uidx / NCH, h = bh % NH, b = bh / NH;
    const int row0 = b * LP + 64 * ch, nvalid = (LP - 64 * ch) < 64 ? (LP - 64 * ch) : 64;
    const float* t12 = (const float*)(F.ws + WS_T12);
    const bf16* w2t = (const bf16*)(F.ws + WS_W2T); const bf16* a2t = (const bf16*)(F.ws + WS_A2T);
    LAS unsigned char* wl = F.lds + RING_OFF + lslot * 16384;
    LAS float* red = (LAS float*)(F.lds + LDSX_OFF + wave * 512);
#if WKV_VAR == 14
    {
        unsigned bad = 0u;
        float x = (float)(lane * 3 + 1); asm volatile("" : "+v"(x));
        f32x16 t; for (int r = 0; r < 16; ++r) t[r] = (float)(lane * 16 + r);
        asm volatile("" : "+v"(t));
#define RLCHK(L) { const float g = __builtin_bit_cast(float, __builtin_amdgcn_readlane(__builtin_bit_cast(int, x), L)); if (g != (float)((L) * 3 + 1)) bad |= 64u; }
        RLCHK(0) RLCHK(5) RLCHK(31) RLCHK(32) RLCHK(40) RLCHK(63)
#undef RLCHK
#define RLCHK2(R, L) { const float g = __builtin_bit_cast(float, __builtin_amdgcn_readlane(__builtin_bit_cast(int, t[R]), L)); if (g != (float)((L) * 16 + (R))) bad |= 128u; }
        RLCHK2(0, 3) RLCHK2(7, 33) RLCHK2(13, 63) RLCHK2(14, 63) RLCHK2(15, 62) RLCHK2(9, 17)
#undef RLCHK2
        f32x16 t2; for (int r = 0; r < 16; ++r) t2[r] = (float)(lane * 16 + r);
#define RLCHK3(R, L) { const float g = __builtin_bit_cast(float, __builtin_amdgcn_readlane(__builtin_bit_cast(int, t2[R]), L)); if (g != (float)((L) * 16 + (R))) bad |= 256u; }
        RLCHK3(0, 3) RLCHK3(7, 33) RLCHK3(13, 63) RLCHK3(14, 63) RLCHK3(15, 62) RLCHK3(9, 17)
#undef RLCHK3
#define RLCHK4(R, L) { float e = t[R]; asm volatile("" : "+v"(e)); const float g = __builtin_bit_cast(float, __builtin_amdgcn_readlane(__builtin_bit_cast(int, e), L)); if (g != (float)((L) * 16 + (R))) bad |= 512u; }
        RLCHK4(0, 3) RLCHK4(7, 33) RLCHK4(13, 63) RLCHK4(14, 63) RLCHK4(15, 62) RLCHK4(9, 17)
#undef RLCHK4
        if (bad) atomicOr((unsigned*)(F.ws + WS_CTL) + 8, bad);
        return;
    }
#endif
#if WKV_VAR == 13
    {
        f32x16 acc[2][2];
#pragma unroll
        for (int m = 0; m < 2; ++m)
#pragma unroll
            for (int n = 0; n < 2; ++n)
#pragma unroll
                for (int r = 0; r < 16; ++r) { const int i_ = 32 * m + crow(r, hh), k_ = 32 * n + c; acc[m][n][r] = (k_ == i_ + 1) ? 0.5f : (k_ == i_ + 2) ? 0.25f : (k_ <= i_) ? 1.0f : 0.f; }
        asm volatile("" : "+v"(acc[0][0]), "+v"(acc[0][1]), "+v"(acc[1][0]), "+v"(acc[1][1]));
        float Tc[64]; unsigned badn = 0u;
#pragma unroll
        for (int i = 0; i < 64; ++i) Tc[i] = (lane == i) ? 1.f : 0.f;
#pragma unroll
        for (int i = 62; i >= 0; --i) {
            const int mi = i >> 5, ri = (i & 3) + 4 * ((i & 31) >> 3), hi = ((i & 31) >> 2) & 1;
#pragma unroll
            for (int k = i + 1; k < 64; ++k) {
                const float nik = __builtin_bit_cast(float, __builtin_amdgcn_readlane(__builtin_bit_cast(int, acc[mi][k >> 5][ri]), (k & 31) + 32 * hi));
                const float exn = (k == i + 1) ? 0.5f : (k == i + 2) ? 0.25f : 0.f;
                if (nik != exn) badn |= 32u;
#if WKV_SUB == 1
                Tc[i] = __builtin_fmaf(nik, Tc[k], Tc[i]);
#else
                asm volatile("v_fmac_f32 %0, %1, %2" : "+v"(Tc[i]) : "s"(nik), "v"(Tc[k]));
#endif
            }
            WKV_FENCE();
        }
        unsigned bad = badn;
#pragma unroll
        for (int i = 0; i < 64; ++i) { const int d = lane - i; float ex = 0.f; if (d >= 0) { float t0 = 1.f, t1 = 0.5f; ex = d == 0 ? 1.f : 0.5f; for (int q = 2; q <= d; ++q) { const float t2 = 0.5f * t1 + 0.25f * t0; t0 = t1; t1 = t2; ex = t2; } }
            if (fabsf(Tc[i] - ex) > 1e-5f * fabsf(ex) + 1e-12f) bad |= 16u; }
        if (bad) atomicOr((unsigned*)(F.ws + WS_CTL) + 8, bad);
        WKV_FENCE();
        return;
    }
#endif
#if WKV_VAR == 12
    {
        f32x16 acc[2][2]; bf16x8 TR[4][2];
#pragma unroll
        for (int m = 0; m < 2; ++m)
#pragma unroll
            for (int n = 0; n < 2; ++n)
#pragma unroll
                for (int r = 0; r < 16; ++r) { const int i_ = 32 * m + crow(r, hh), k_ = 32 * n + c; acc[m][n][r] = (k_ == i_ + 1) ? 0.5f : (k_ == i_ + 2) ? 0.25f : (k_ <= i_) ? 1.0f : 0.f; }
        solve_T<false>(acc, TR, lane, false, 0);
        WKV_FENCE();
        bf16x8 Ir[4][2];
#pragma unroll
        for (int ks = 0; ks < 4; ++ks)
#pragma unroll
            for (int n = 0; n < 2; ++n) { bf16x8 v;
#pragma unroll
                for (int jj = 0; jj < 8; ++jj) v[jj] = ((16 * ks + 8 * (jj >> 2) + 4 * hh + (jj & 3)) == 32 * n + c) ? (short)0x3F80 : (short)0;
                Ir[ks][n] = v; }
        zero_acc(acc); mm64(acc, TR, Ir);
        unsigned bad = 0u;
#pragma unroll
        for (int m = 0; m < 2; ++m)
#pragma unroll
            for (int n = 0; n < 2; ++n)
#pragma unroll
                for (int r = 0; r < 16; ++r) { const int jp = 32 * m + crow(r, hh), j_ = 32 * n + c, d = jp - j_;
                    float ex = 0.f; if (d >= 0) { float t0 = 1.f, t1 = 0.5f; ex = d == 0 ? 1.f : 0.5f; for (int q = 2; q <= d; ++q) { const float t2 = 0.5f * t1 + 0.25f * t0; t0 = t1; t1 = t2; ex = t2; } }
                    const float got = acc[m][n][r]; if (fabsf(got - ex) > 0.01f * fabsf(ex) + 1e-6f) bad |= 8u; }
        if (bad) atomicOr((unsigned*)(F.ws + WS_CTL) + 8, bad);
        WKV_FENCE();
        return;
    }
#endif
#if WKV_VAR == 11
    {
        f32x16 acc[2][2]; bf16x8 IdT[2];
#pragma unroll
        for (int s = 0; s < 2; ++s) { bf16x8 v;
#pragma unroll
            for (int jj = 0; jj < 8; ++jj) v[jj] = ((16 * s + 8 * (jj >> 2) + (jj & 3)) == (c - 4 * hh)) ? (short)0x3F80 : (short)0;
            IdT[s] = v; }
        {
            bf16x8 XA[4][2], XB[4][2];
#pragma unroll
            for (int ks = 0; ks < 4; ++ks)
#pragma unroll
                for (int t = 0; t < 2; ++t) { bf16x8 va, vb;
#pragma unroll
                    for (int jj = 0; jj < 8; ++jj) { const int tk = 16 * ks + 8 * (jj >> 2) + 4 * hh + (jj & 3), chn = 32 * t + c;
                        va[jj] = (short)f2bf((float)(((tk + 2 * chn) & 7) - 3)); vb[jj] = (tk == chn) ? (short)0x3F80 : (short)0; }
                    XA[ks][t] = va; XB[ks][t] = vb; }
            frag_st_lds(wl, XA, lane); frag_st_lds(wl + 8192, XB, lane);
        }
        WKV_FENCE();
        unsigned bad = 0u;
        bf16x8 AC[4][2], BC[4][2];
        { bf16x8 X[4][2]; frag_ld_lds(wl + 8192, X, lane); transpose64(acc, X, IdT);
#pragma unroll
          for (int m = 0; m < 2; ++m)
#pragma unroll
            for (int n = 0; n < 2; ++n)
#pragma unroll
                for (int r = 0; r < 16; ++r) { const int chn = 32 * m + crow(r, hh), tk = 32 * n + c; if (acc[m][n][r] != ((tk == chn) ? 1.f : 0.f)) bad |= 1u; }
          acc2frag(acc, BC); }
        WKV_FENCE();
        { bf16x8 X[4][2]; frag_ld_lds(wl, X, lane); transpose64(acc, X, IdT);
#pragma unroll
          for (int m = 0; m < 2; ++m)
#pragma unroll
            for (int n = 0; n < 2; ++n)
#pragma unroll
                for (int r = 0; r < 16; ++r) { const int chn = 32 * m + crow(r, hh), tk = 32 * n + c; if (acc[m][n][r] != (float)(((tk + 2 * chn) & 7) - 3)) bad |= 2u; }
          acc2frag(acc, AC); }
        WKV_FENCE();
        zero_acc(acc); mm64(acc, BC, AC);
#pragma unroll
        for (int m = 0; m < 2; ++m)
#pragma unroll
            for (int n = 0; n < 2; ++n)
#pragma unroll
                for (int r = 0; r < 16; ++r) { const int i_ = 32 * m + crow(r, hh), j_ = 32 * n + c; if (acc[m][n][r] != (float)(((j_ + 2 * i_) & 7) - 3)) bad |= 4u; }
        if (bad) atomicOr((unsigned*)(F.ws + WS_CTL) + 8, bad);
        WKV_FENCE();
        return;
    }
#endif
#if WKV_VAR == 7
    const int wid = F.vcu * 2 + wave;
#else
    const int wid = F.vcu * NWAVES + wave;
#endif
    unsigned char* gs0 = F.ws + WS_KST + (size_t)wid * 8192;
#if WKV_VAR == 7
    unsigned char* gs1 = F.ws + WS_KST + 4 * MiB + (size_t)wid * 16384;
#else
    unsigned char* gs1 = F.dob + 3 * RKV_STRIDE + (size_t)wid * 16384;
#endif
    if (nvalid < 64) gs1 = F.ws + WS_TST + (size_t)bh * 16384;
    unsigned char* gs2 = gs1 + 8192;
    const size_t rbase = (size_t)row0 * DM + h * HD;
    const bool tail = nvalid < 64;
#define TPAD(m, r) (tail && (32 * (m) + 8 * ((r) >> 2) >= 16))
#define JOK(n) (!tail || ((n) == 0 && c < 16))
    const int dlt = c - 4 * hh;
#define KR(r) (((r) & 3) + 8 * ((r) >> 2))
#define ROW_GT_COL(m, n, r) (((m) > (n)) || ((m) == (n) && KR(r) > dlt))
    const srd_t sD = __builtin_amdgcn_make_buffer_rsrc((void*)F.dob, (short)0, (int)(O_END * 4), 0x00020000);
    const unsigned soR = (unsigned)(rbase * 2), soK = (unsigned)(RKV_STRIDE + rbase * 2), soV = (unsigned)(2 * RKV_STRIDE + rbase * 2);
    const unsigned voE = (unsigned)((4 * hh * DM + c) * 2);
    const unsigned voW = (unsigned)((c * DM + 4 * hh) * 2);
    const unsigned voA = (unsigned)((c * DM + 8 * hh) * 2);
#define CA(m, s) ((unsigned)(((32 * (m)) * DM + 16 * (s)) * 2))
#define CE(m, r, n) ((unsigned)(((32 * (m) + ((r) & 3) + 8 * ((r) >> 2)) * DM + 32 * (n)) * 2))
#define CW(m, q, n) ((unsigned)(((32 * (n)) * DM + 32 * (m) + 8 * (q)) * 2))
    constexpr float L2E = 1.4426950408889634f;
    float kkc[2], kac[2], rkc[2], w0c[2], a0c[2];
#pragma unroll
    for (int n = 0; n < 2; ++n) { const int cc = h * HD + 32 * n + c; kkc[n] = F.k_k[cc]; kac[n] = F.k_a[cc]; rkc[n] = F.r_k[cc]; w0c[n] = F.w0[cc]; a0c[n] = F.a0[cc]; }
    {
        bf16x8 KA[2][4], IdN[2];
#pragma unroll
        for (int m = 0; m < 2; ++m)
#pragma unroll
            for (int s4 = 0; s4 < 4; ++s4) KA[m][s4] = bld128(sD, voA, soK + CA(m, s4));
        make_idn(IdN, c, hh);
        float nv[32];
#pragma unroll
        for (int m = 0; m < 2; ++m) {
            const f32x16 t0 = tile_from_rows(KA[m][0], KA[m][1], IdN), t1 = tile_from_rows(KA[m][2], KA[m][3], IdN);
#pragma unroll
            for (int r = 0; r < 16; ++r) { const float q0 = t0[r] * kkc[0], q1 = t1[r] * kkc[1]; nv[16 * m + r] = TPAD(m, r) ? 0.f : (q0 * q0 + q1 * q1); } }
        const float tot = butterfly32(nv, lane);
        red[32 * (c >> 4) + crow(c & 15, hh)] = __builtin_amdgcn_rsqf(fmaxf(tot, 1e-24f));
        asm volatile("s_waitcnt lgkmcnt(0)" ::: "memory");
    }
    WKV_FENCE();
    WKV_SYNC();
    float gC[2], erk[32];
#pragma unroll
    for (int i = 0; i < 32; ++i) erk[i] = 0.f;
    gC[0] = gC[1] = 1.f;
    if (!(F.skip & 2))
#pragma unroll
    for (int n = 0; n < 2; ++n) {
        f32x16 z[2], az[2];
        {
            bf16x8 wf[4], af[4];
#pragma unroll
            for (int s = 0; s < 4; ++s) { wf[s] = *(const GAS bf16x8*)(w2t + (size_t)(h * HD + 32 * n + c) * 64 + 16 * s + 8 * hh); af[s] = *(const GAS bf16x8*)(a2t + (size_t)(h * HD + 32 * n + c) * 64 + 16 * s + 8 * hh); }
#pragma unroll
            for (int m = 0; m < 2; ++m) { z[m] = f32x16{}; az[m] = f32x16{};
                const unsigned char* tp = F.ws + WS_T12B + (size_t)((b * 129 + 2 * ch + m) * 8) * 1024 + lane * 16;
                if (!(tail && m == 1))
#pragma unroll
                for (int s = 0; s < 4; ++s) {
                    const bf16x8 xa = *(const GAS bf16x8*)(tp + s * 1024), ya = *(const GAS bf16x8*)(tp + (4 + s) * 1024);
                    z[m] = __builtin_amdgcn_mfma_f32_32x32x16_bf16(xa, wf[s], z[m], 0, 0, 0);
                    az[m] = __builtin_amdgcn_mfma_f32_32x32x16_bf16(ya, af[s], az[m], 0, 0, 0); } }
        }
        WKV_FENCE();
        bf16x8 KA2[2][2], RA2[2][2];
#pragma unroll
        for (int m = 0; m < 2; ++m)
#pragma unroll
            for (int s2 = 0; s2 < 2; ++s2) { KA2[m][s2] = bld128(sD, voA, soK + CA(m, 2 * n + s2)); RA2[m][s2] = bld128(sD, voA, soR + CA(m, 2 * n + s2)); }
#pragma unroll
        for (int m = 0; m < 2; ++m)
#pragma unroll
            for (int r = 0; r < 16; ++r) { const int t = 32 * m + crow(r, hh);
                const float sg = __builtin_amdgcn_rcpf(1.0f + __builtin_amdgcn_exp2f(-(z[m][r] + w0c[n]) * L2E)); z[m][r] = TPAD(m, r) ? 0.f : (-0.6065306597126334f * L2E) * sg;
                az[m][r] = __builtin_amdgcn_rcpf(1.0f + __builtin_amdgcn_exp2f(-(az[m][r] + a0c[n]) * L2E)); }
        float gt[8], ot[8], base[8];
#pragma unroll
        for (int g = 0; g < 8; ++g) { const int m = g >> 2, q = g & 3; gt[g] = (z[m][4 * q] + z[m][4 * q + 1]) + (z[m][4 * q + 2] + z[m][4 * q + 3]); ot[g] = __shfl_xor(gt[g], 32); }
        { float run = 0.f;
#pragma unroll
          for (int g = 0; g < 8; ++g) { base[g] = run + (hh ? ot[g] : 0.f); run += gt[g] + ot[g]; }
          gC[n] = __builtin_amdgcn_exp2f(run); }
#pragma unroll
        for (int m = 0; m < 2; ++m) {
            bf16x8 IdN[2]; make_idn(IdN, c, hh);
            const f32x16 ktile = tile_from_rows(KA2[m][0], KA2[m][1], IdN), rtile = tile_from_rows(RA2[m][0], RA2[m][1], IdN);
#pragma unroll
            for (int s = 0; s < 2; ++s) {
                float at[8], bt[8], kt[8], rt[8];
#pragma unroll
                for (int e = 0; e < 8; ++e) { at[e] = 0.f; bt[e] = 0.f; kt[e] = 0.f; rt[e] = 0.f; }
                if (!(tail && (m | s)))
#pragma unroll
                for (int qq = 0; qq < 2; ++qq) { const int q = 2 * s + qq; float acc = base[4 * m + q];
#pragma unroll
                    for (int i = 0; i < 4; ++i) { const int r = 4 * q + i, t = 32 * m + crow(r, hh), e = 4 * qq + i;
                        const float lw = z[m][r]; acc += lw; const float LG = acc;
                        const float eLG = __builtin_amdgcn_exp2f(LG), ieLG = __builtin_amdgcn_exp2f(-LG), eLGp = __builtin_amdgcn_exp2f(LG - lw);
                        float k = ktile[r], rr = rtile[r];
                        if (TPAD(m, r)) { k = 0.f; rr = 0.f; }
                        const float a = az[m][r];
                        const float kkn = k * kkc[n] * red[t];
                        const float kh = k * (1.0f + (a - 1.0f) * kac[n]);
                        at[e] = -kkn * eLGp; bt[e] = kkn * a * ieLG; kt[e] = kh * ieLG; rt[e] = rr * eLG;
                        erk[16 * m + r] += rr * kh * rkc[n]; } }
                const int fo = ((2 * m + s) * 2 + n) * 1024 + lane * 16; v4u w;
                w.x = cvtpkn(at[0], at[1]); w.y = cvtpkn(at[2], at[3]); w.z = cvtpkn(at[4], at[5]); w.w = cvtpkn(at[6], at[7]); *(LAS v4u*)(wl + fo) = w;
                w.x = cvtpkn(bt[0], bt[1]); w.y = cvtpkn(bt[2], bt[3]); w.z = cvtpkn(bt[4], bt[5]); w.w = cvtpkn(bt[6], bt[7]); *(LAS v4u*)(wl + 8192 + fo) = w;
                w.x = cvtpkn(kt[0], kt[1]); w.y = cvtpkn(kt[2], kt[3]); w.z = cvtpkn(kt[4], kt[5]); w.w = cvtpkn(kt[6], kt[7]); *(GAS v4u*)(gs0 + fo) = w;
                w.x = cvtpkn(rt[0], rt[1]); w.y = cvtpkn(rt[2], rt[3]); w.z = cvtpkn(rt[4], rt[5]); w.w = cvtpkn(rt[6], rt[7]); *(GAS v4u*)(gs1 + fo) = w;
                WKV_SYNC();
                WKV_FENCE();
            } }
        WKV_FENCE();
    }
    WKV_SYNC();
    {
        const float tot = butterfly32(erk, lane); const int t = 32 * (c >> 4) + crow(c & 15, hh);
        if (t < nvalid) ((float*)(F.ws + WS_RK))[(size_t)(row0 + t) * 16 + h] = tot;
    }
    WKV_FENCE();
#define MAKE_ID2(Id) do { int dl_ = dlt; asm volatile("" : "+v"(dl_)); _Pragma("unroll") for (int s_ = 0; s_ < 2; ++s_) { bf16x8 v_; \
        _Pragma("unroll") for (int jj = 0; jj < 8; ++jj) v_[jj] = ((16 * s_ + 8 * (jj >> 2) + (jj & 3)) == dl_) ? (short)0x3F80 : (short)0; \
        Id[s_] = v_; } } while (0)
    f32x16 acc[2][2];
    bf16x8 MbrR[4][2], MkaTR[4][2];
    {
        bf16x8 KtC[4][2];
        { bf16x8 X[4][2], Id2[2]; frag_ld_g(gs0, X, lane); MAKE_ID2(Id2); transpose64(acc, X, Id2); acc2frag(acc, KtC); }
        WKV_FENCE();
        {
            bf16x8 RtC[4][2];
            { bf16x8 X[4][2], Id2[2]; frag_ld_g(gs1, X, lane); MAKE_ID2(Id2); transpose64(acc, X, Id2); acc2frag(acc, RtC); }
            WKV_FENCE();
            WKV_SYNC();
            {
                zero_acc(acc); mm64(acc, KtC, RtC);
#pragma unroll
                for (int m = 0; m < 2; ++m)
#pragma unroll
                    for (int n = 0; n < 2; ++n)
#pragma unroll
                        for (int r = 0; r < 16; ++r) { if (ROW_GT_COL(m, n, r)) acc[m][n][r] = 0.f; }
                bf16x8 MkrR[4][2]; acc2frag(acc, MkrR); frag_st_g(gs2, MkrR, lane);
            }
            WKV_FENCE();
            WKV_SYNC();
            bf16x8 BtC[4][2];
            { bf16x8 X[4][2], Id2[2]; frag_ld_lds(wl + 8192, X, lane); MAKE_ID2(Id2); transpose64(acc, X, Id2); acc2frag(acc, BtC); }
            {
                zero_acc(acc); mm64(acc, BtC, RtC);
#pragma unroll
                for (int m = 0; m < 2; ++m)
#pragma unroll
                    for (int n = 0; n < 2; ++n)
#pragma unroll
                        for (int r = 0; r < 16; ++r) { if (ROW_GT_COL(m, n, r)) acc[m][n][r] = 0.f; }
                acc2frag(acc, MbrR);
            }
            WKV_FENCE();
            WKV_SYNC();
            bf16x8 AtC[4][2];
            { bf16x8 X[4][2], Id2[2]; frag_ld_lds(wl, X, lane); MAKE_ID2(Id2); transpose64(acc, X, Id2); acc2frag(acc, AtC); }
            {
                zero_acc(acc); mm64(acc, AtC, KtC);
#pragma unroll
                for (int m = 0; m < 2; ++m)
#pragma unroll
                    for (int n = 0; n < 2; ++n)
#pragma unroll
                        for (int r = 0; r < 16; ++r) { if (!ROW_GT_COL(m, n, r)) acc[m][n][r] = 0.f; }
                acc2frag(acc, MkaTR);
            }
            WKV_FENCE();
            zero_acc(acc); mm64(acc, BtC, AtC);
        }
    }
    WKV_FENCE();
    WKV_SYNC();
    bf16x8 TR[4][2];
    if (tail) solve_T<true>(acc, TR, lane, false, F.skip); else solve_T<false>(acc, TR, lane, sync, F.skip);
    WKV_FENCE();
    WKV_SYNC();
    if (!(F.skip & 4)) {
    unsigned char* gt_out = F.ws + WS_GT + (size_t)uidx * 8192; unsigned char* ht_out = F.ws + WS_HT + (size_t)uidx * 8192;
    unsigned char* wy_out = F.ws + WS_WYF + (size_t)uidx * 8192; unsigned char* y0_out = F.ws + WS_Y0F + (size_t)uidx * 8192;
    bf16x8 BtL[4][2];
    {
        bf16x8 P1R[4][2];
        { bf16x8 X[4][2]; frag_ld_lds(wl, X, lane); zero_acc(acc); mm64(acc, TR, X); acc2frag(acc, P1R); }
        WKV_FENCE();
        { bf16x8 X[4][2], Id2[2]; frag_ld_g(gs1, X, lane); MAKE_ID2(Id2); transpose64(acc, X, Id2); }
        mm64(acc, P1R, MbrR);
        { bf16x8 WyR[4][2]; acc2frag(acc, WyR); frag_st_g(wy_out, WyR, lane); }
        WKV_FENCE();
        frag_ld_lds(wl + 8192, BtL, lane);
        zero_acc(acc); mm64(acc, P1R, BtL);
#pragma unroll
        for (int m = 0; m < 2; ++m)
#pragma unroll
            for (int n = 0; n < 2; ++n)
#pragma unroll
                for (int s = 0; s < 2; ++s) { float v[8];
#pragma unroll
                    for (int i = 0; i < 8; ++i) v[i] = (acc[m][n][8 * s + i] + ((m == n && KR(8 * s + i) == dlt) ? 1.f : 0.f)) * gC[n];
                    v4u w; w.x = cvtpk(v[0], v[1]); w.y = cvtpk(v[2], v[3]); w.z = cvtpk(v[4], v[5]); w.w = cvtpk(v[6], v[7]);
                    *(GAS v4u*)(gt_out + ((2 * m + s) * 2 + n) * 1024 + lane * 16) = w; }
    }
    WKV_FENCE();
    WKV_SYNC();
    bf16x8 NyR[4][2], HkR[4][2];
    {
        bf16x8 P2TR[4][2];
        zero_acc(acc); mm64(acc, TR, MkaTR); acc2frag(acc, P2TR);
        WKV_FENCE();
        zero_acc(acc); mm64(acc, P2TR, MbrR); acc2frag(acc, NyR);
        WKV_FENCE();
        zero_acc(acc); mm64(acc, P2TR, BtL);
#pragma unroll
        for (int m = 0; m < 2; ++m)
#pragma unroll
            for (int n = 0; n < 2; ++n)
#pragma unroll
                for (int s = 0; s < 2; ++s) { const v4u kw = __builtin_amdgcn_raw_buffer_load_b128(__builtin_amdgcn_make_buffer_rsrc((void*)gs0, (short)0, 8192, 0x00020000), (unsigned)(lane * 16), (unsigned)(((2 * m + s) * 2 + n) * 1024), 16); const unsigned kk4[4] = {kw.x, kw.y, kw.z, kw.w}; unsigned ww[4];
#pragma unroll
                    for (int p = 0; p < 4; ++p) ww[p] = cvtpk((acc[m][n][8 * s + 2 * p] + lo16(kk4[p])) * gC[n], (acc[m][n][8 * s + 2 * p + 1] + hi16(kk4[p])) * gC[n]);
                    HkR[2 * m + s][n] = __builtin_bit_cast(bf16x8, (v4u){ww[0], ww[1], ww[2], ww[3]}); }
    }
    WKV_FENCE();
    WKV_SYNC();
    bf16x8 VtR[4][2];
    { bf16x8 VA[2][4], IdN[2];
#pragma unroll
      for (int m = 0; m < 2; ++m)
#pragma unroll
        for (int s4 = 0; s4 < 4; ++s4) VA[m][s4] = bld128(sD, voA, soV + CA(m, s4));
      make_idn(IdN, c, hh);
#pragma unroll
      for (int m = 0; m < 2; ++m)
#pragma unroll
        for (int n = 0; n < 2; ++n) { f32x16 t = tile_from_rows(VA[m][2 * n], VA[m][2 * n + 1], IdN);
#pragma unroll
            for (int r = 0; r < 16; ++r) if (TPAD(m, r)) t[r] = 0.f;
            mfma_fence1(t);
#pragma unroll
            for (int s = 0; s < 2; ++s) { v4u w; w.x = cvtpk(t[8 * s + 0], t[8 * s + 1]); w.y = cvtpk(t[8 * s + 2], t[8 * s + 3]); w.z = cvtpk(t[8 * s + 4], t[8 * s + 5]); w.w = cvtpk(t[8 * s + 6], t[8 * s + 7]); VtR[2 * m + s][n] = __builtin_bit_cast(bf16x8, w); } } }
    zero_acc(acc);
    { bf16x8 MkrR[4][2]; frag_ld_g(gs2, MkrR, lane); mm64(acc, VtR, MkrR); }
    mm64(acc, VtR, NyR);
#pragma unroll
    for (int m = 0; m < 2; ++m)
#pragma unroll
        for (int n = 0; n < 2; ++n)
#pragma unroll
            for (int q = 0; q < 4; ++q) { const f32x16& a = acc[m][n];
                *(GAS unsigned long long*)(y0_out + ((m * 2 + n) * 4 + q) * 512 + lane * 8) = pack4(a[4 * q], a[4 * q + 1], a[4 * q + 2], a[4 * q + 3]); }
    WKV_FENCE();
    zero_acc(acc); mm64(acc, HkR, VtR);
#pragma unroll
    for (int m = 0; m < 2; ++m)
#pragma unroll
        for (int n = 0; n < 2; ++n)
#pragma unroll
            for (int q = 0; q < 4; ++q) { const f32x16& a = acc[m][n];
                *(GAS unsigned long long*)(ht_out + ((n * 2 + m) * 4 + q) * 512 + lane * 8) = pack4(a[4 * q], a[4 * q + 1], a[4 * q + 2], a[4 * q + 3]); }
    WKV_FENCE();
    }
#undef MAKE_ID2
#undef CE
#undef CW
#undef CA
#undef TPAD
#undef JOK
#undef KR
#undef ROW_GT_COL
}

__device__ __forceinline__ void stageB_unit(Frame& F, int ub, int lane, unsigned* tflag) {
    asm volatile("" : "+v"(lane));
    const int c = lane & 31, hh = lane >> 5;
    const int n0 = ub & 1, bh = ub >> 1;
    const bf16* gt = (const bf16*)(F.ws + WS_GT) + (size_t)bh * NCH * 4096; bf16* ht = (bf16*)(F.ws + WS_HT) + (size_t)bh * NCH * 4096;
    const int nu = 32 * n0 + c;
#if WKV_EXP == 45
    {
        const bf16* ha = gt + (size_t)(NCH - 1) * 4096 + (size_t)nu * 64; const bf16* hx = ht + (size_t)(NCH - 1) * 4096 + (size_t)nu * 64;
        float* so = (float*)(F.ws + WS_WKVP) + (size_t)bh * 4096 + (size_t)nu * 64;
        for (int i = hh; i < 64; i += 2) so[i] += bf2f(ha[i]) - bf2f(hx[i]);
        return;
    }
#endif
    f32x16 S[2]; S[0] = f32x16{}; S[1] = f32x16{};
#ifndef WKB_DEPTH
#define WKB_DEPTH 2
#endif
    v4u gqA[2][4], gqB[2][4]; unsigned long long hqA[2][4], hqB[2][4];
#if WKB_DEPTH == 3
    v4u gqC[2][4]; unsigned long long hqC[2][4];
#endif
    const unsigned char* gtb = (const unsigned char*)gt; unsigned char* htb = (unsigned char*)ht;
#define WKB_LOAD(gq, hq, cc) do { const unsigned char* g_ = gtb + (size_t)(cc) * 8192 + lane * 16; const unsigned char* h_ = htb + (size_t)(cc) * 8192 + n0 * 4096 + lane * 8; \
        _Pragma("unroll") for (int m = 0; m < 2; ++m) { \
            _Pragma("unroll") for (int ks = 0; ks < 4; ++ks) gq[m][ks] = *(const GAS v4u*)(g_ + (ks * 2 + m) * 1024); \
            _Pragma("unroll") for (int q = 0; q < 4; ++q) hq[m][q] = *(const GAS unsigned long long*)(h_ + (m * 4 + q) * 512); } } while (0)
#define WKB_STEP(gq, hq, chv) do { const int ch = (chv); \
        bf16x8 SB[4]; \
        _Pragma("unroll") for (int m = 0; m < 2; ++m) \
            _Pragma("unroll") for (int s = 0; s < 2; ++s) { v4u w; w.x = cvtpkn(S[m][8 * s + 0], S[m][8 * s + 1]); w.y = cvtpkn(S[m][8 * s + 2], S[m][8 * s + 3]); w.z = cvtpkn(S[m][8 * s + 4], S[m][8 * s + 5]); w.w = cvtpkn(S[m][8 * s + 6], S[m][8 * s + 7]); SB[2 * m + s] = __builtin_bit_cast(bf16x8, w); } \
        f32x16 N[2]; \
        _Pragma("unroll") for (int m = 0; m < 2; ++m) \
            _Pragma("unroll") for (int q = 0; q < 4; ++q) { const unsigned long long w = hq[m][q]; N[m][4 * q] = lo16((unsigned)w); N[m][4 * q + 1] = hi16((unsigned)w); N[m][4 * q + 2] = lo16((unsigned)(w >> 32)); N[m][4 * q + 3] = hi16((unsigned)(w >> 32)); } \
        _Pragma("unroll") for (int m = 0; m < 2; ++m) \
            _Pragma("unroll") for (int ks = 0; ks < 4; ++ks) N[m] = __builtin_amdgcn_mfma_f32_32x32x16_bf16(__builtin_bit_cast(bf16x8, gq[m][ks]), SB[ks], N[m], 0, 0, 0); \
        if (ch + WKB_DEPTH < NCH) { \
            if (ch + WKB_DEPTH == NCH - 1) {     \
                while (__hip_atomic_load(tflag, __ATOMIC_RELAXED, __HIP_MEMORY_SCOPE_AGENT) == 0u) __builtin_amdgcn_s_sleep(4); \
                __builtin_amdgcn_fence(__ATOMIC_ACQUIRE, "agent"); } \
            WKB_LOAD(gq, hq, ch + WKB_DEPTH); } \
        if (ch > 0) {     \
            unsigned char* sp = htb + (size_t)(ch - 1) * 8192 + n0 * 4096 + lane * 16; \
            _Pragma("unroll") for (int ks = 0; ks < 4; ++ks) *(GAS bf16x8*)(sp + ks * 1024) = SB[ks]; } \
        mfma_fence2(N[0], N[1]); \
        S[0] = N[0]; S[1] = N[1]; } while (0)
#if WKB_DEPTH == 3
    WKB_LOAD(gqA, hqA, 0); WKB_LOAD(gqB, hqB, 1); WKB_LOAD(gqC, hqC, 2);
    static_assert(NCH == 65, "stage B step schedule");
#pragma unroll 1
    for (int ch0 = 0; ch0 < 63; ch0 += 3) { WKB_STEP(gqA, hqA, ch0); WKB_STEP(gqB, hqB, ch0 + 1); WKB_STEP(gqC, hqC, ch0 + 2); }
    WKB_STEP(gqA, hqA, 63); WKB_STEP(gqB, hqB, 64);
#else
    WKB_LOAD(gqA, hqA, 0); WKB_LOAD(gqB, hqB, 1);
    static_assert(NCH == 65, "stage B step schedule");
#pragma unroll 1
    for (int ch0 = 0; ch0 < 64; ch0 += 2) { WKB_STEP(gqA, hqA, ch0); WKB_STEP(gqB, hqB, ch0 + 1); }
    WKB_STEP(gqA, hqA, 64);
#endif
#undef WKB_STEP
#undef WKB_LOAD
#if WKV_EXP == 2 || WKV_EXP == 4 || WKV_EXP == 10
    float* so = (float*)(F.ws + WS_KST) + (size_t)bh * 4096 + (size_t)nu * 64;
#else
    float* so = (float*)(F.ws + WS_WKVP) + (size_t)bh * 4096 + (size_t)nu * 64;
#endif
#pragma unroll
    for (int m = 0; m < 2; ++m)
#pragma unroll
        for (int q = 0; q < 4; ++q) *(GAS f32x4*)(so + 32 * m + 8 * q + 4 * hh) = (f32x4){S[m][4 * q], S[m][4 * q + 1], S[m][4 * q + 2], S[m][4 * q + 3]};
}

__device__ __forceinline__ void stageC_unit(Frame& F, int uidx, int lane) {
    asm volatile("" : "+v"(lane));
    const int c = lane & 31, hh = lane >> 5;
    const int ch = uidx % NCH, bh = uidx / NCH, h = bh % NH, b = bh / NH;
    const int row0 = b * LP + 64 * ch, nvalid = (LP - 64 * ch) < 64 ? (LP - 64 * ch) : 64;
    const bf16* Vb = (const bf16*)(F.dob + 2 * RKV_STRIDE);
    const bf16* Gb = (const bf16*)(F.ws + WS_G); bf16* og2 = (bf16*)(F.dob + DO_OG2);
    const unsigned char* wyf = F.ws + WS_WYF + (size_t)uidx * 8192; const unsigned char* y0f = F.ws + WS_Y0F + (size_t)uidx * 8192;
    const size_t rbase = (size_t)row0 * DM + h * HD;
    unsigned long long vq[2][2][4], gq[2][2][4]; float rkv[2];
#define WKC_PREF(n) do { rkv[n] = ((const GAS float*)(F.ws + WS_RK))[(size_t)(row0 + 32 * (n) + c) * 16 + h]; \
        _Pragma("unroll") for (int m = 0; m < 2; ++m) \
            _Pragma("unroll") for (int q = 0; q < 4; ++q) { const size_t e = (size_t)(row0 + 32 * (n) + c) * DM + h * HD + 32 * m + 8 * q + 4 * hh; vq[n][m][q] = *(const GAS unsigned long long*)(Vb + e); gq[n][m][q] = *(const GAS unsigned long long*)(Gb + e); } } while (0)
    WKC_PREF(0);
    f32x16 acc[2][2];
#pragma unroll
    for (int m = 0; m < 2; ++m)
#pragma unroll
        for (int n = 0; n < 2; ++n)
#pragma unroll
            for (int q = 0; q < 4; ++q) { const unsigned long long w = *(const GAS unsigned long long*)(y0f + ((m * 2 + n) * 4 + q) * 512 + lane * 8);
                acc[m][n][4 * q] = lo16((unsigned)w); acc[m][n][4 * q + 1] = hi16((unsigned)w); acc[m][n][4 * q + 2] = lo16((unsigned)(w >> 32)); acc[m][n][4 * q + 3] = hi16((unsigned)(w >> 32)); }
    if (ch > 0) {
        const unsigned char* sc = F.ws + WS_HT + (size_t)(uidx - 1) * 8192;
        bf16x8 SA[4][2], WB[4][2];
#pragma unroll
        for (int ks = 0; ks < 4; ++ks)
#pragma unroll
            for (int t = 0; t < 2; ++t) { SA[ks][t] = *(const GAS bf16x8*)(sc + t * 4096 + ks * 1024 + lane * 16); WB[ks][t] = *(const GAS bf16x8*)(wyf + (ks * 2 + t) * 1024 + lane * 16); }
        mm64(acc, SA, WB);
    }
    WKV_FENCE();
    WKC_PREF(1);
#undef WKC_PREF
    float s[2], mean[2], rstd[2];
#pragma unroll
    for (int n = 0; n < 2; ++n) { float t = 0.f;
#pragma unroll
        for (int m = 0; m < 2; ++m)
#pragma unroll
            for (int r = 0; r < 16; ++r) t += acc[m][n][r];
        t += __shfl_xor(t, 32); mean[n] = t * (1.f / 64.f); float v = 0.f;
#pragma unroll
        for (int m = 0; m < 2; ++m)
#pragma unroll
            for (int r = 0; r < 16; ++r) { const float d = acc[m][n][r] - mean[n]; v += d * d; }
        v += __shfl_xor(v, 32); rstd[n] = __builtin_amdgcn_rsqf(v * (1.f / 64.f) + GN_EPS); s[n] = 0.f; }
    (void)s;
#pragma unroll
    for (int n = 0; n < 2; ++n) { const int j = 32 * n + c;
        if (j < nvalid) {
            const float rk = rkv[n];
#pragma unroll
            for (int m = 0; m < 2; ++m)
#pragma unroll
                for (int q = 0; q < 4; ++q) { const int nu0 = h * HD + 32 * m + 8 * q + 4 * hh; const size_t e = (size_t)(row0 + j) * DM + nu0;
                    const f32x4 lg = *(const GAS f32x4*)(F.ln_g + nu0), lb = *(const GAS f32x4*)(F.ln_b + nu0);
                    const unsigned long long vw = vq[n][m][q], gw = gq[n][m][q];
                    const float vv[4] = {lo16((unsigned)vw), hi16((unsigned)vw), lo16((unsigned)(vw >> 32)), hi16((unsigned)(vw >> 32))};
                    const float gg[4] = {lo16((unsigned)gw), hi16((unsigned)gw), lo16((unsigned)(gw >> 32)), hi16((unsigned)(gw >> 32))};
                    float o[4];
#pragma unroll
                    for (int i = 0; i < 4; ++i) { const float yn = (acc[m][n][4 * q + i] - mean[n]) * rstd[n] * lg[i] + lb[i] + rk * vv[i]; o[i] = yn * gg[i] * __builtin_amdgcn_rcpf(1.0f + __builtin_amdgcn_exp2f(-1.4426950408889634f * gg[i])); }
                    *(GAS unsigned long long*)(og2 + e) = (unsigned long long)cvtpkn(o[0], o[1]) | ((unsigned long long)cvtpkn(o[2], o[3]) << 32); } } }
}
}
__device__ __forceinline__ void p8a_wkvA(Frame& F) {
#if WKV_VAR == 7
    if (F.wave >= 2) return;
#pragma unroll 1
    for (int u = F.wave * F.G + F.vcu; u < wkv::NUNITS; u += 2 * F.G) wkv::stageA_unit(F, u, F.lane, F.wave, false, F.wave);
#else
    const bool sync = WKV_LOCKSTEP && (NB * NH * (wkv::NCH - 1)) % (NWAVES * F.G) == 0;
#pragma unroll 1
    for (int u = F.wave * F.G + F.vcu; u < NB * NH * (wkv::NCH - 1); u += NWAVES * F.G) wkv::stageA_unit(F, (u >> 6) * wkv::NCH + (u & 63), F.lane, F.wave, sync, F.wave);
#endif
}
__device__ __forceinline__ void p8b_wkvB(Frame& F, int mode, unsigned* tflags) {
    LAS float* wl = (LAS float*)(F.lds + RING_OFF) + F.wave * 2048;
    static_assert(DSEQ == 4, "wkv_seq4_unit");
    const int NBW = 2 * NB * NH, NTW = NB * NH;
    const bool bwave = (F.wave == 1 && F.vcu < NBW), twave = (F.wave == 2 && F.vcu < NTW);
    if ((mode & 1) && bwave) {
        if (!(F.skip & 16)) wkv::stageB_unit(F, F.vcu, F.lane, tflags + (F.vcu >> 1));
        __builtin_amdgcn_fence(__ATOMIC_RELEASE, "agent");
        if (F.lane == 0) __hip_atomic_fetch_add(tflags + 64 + (F.vcu >> 1), 1u, __ATOMIC_RELAXED, __HIP_MEMORY_SCOPE_AGENT);
    }
    if ((mode & 1) && twave) {
        if (!(F.skip & 8)) wkv::stageA_unit(F, F.vcu * wkv::NCH + (wkv::NCH - 1), F.lane, F.wave, false, 4);
        __builtin_amdgcn_fence(__ATOMIC_RELEASE, "agent");
        if (F.lane == 0) __hip_atomic_store(tflags + F.vcu, 1u, __ATOMIC_RELAXED, __HIP_MEMORY_SCOPE_AGENT);
    }
    int sid;
    if (F.wave == 0) sid = F.vcu;
    else if (F.wave == 1) sid = F.G + (F.vcu - NBW);
    else if (F.wave == 2) sid = 2 * F.G - NBW + (F.vcu - NTW);
    else sid = F.wave * F.G - NBW - NTW + F.vcu;
    const int nslots = NWAVES * F.G - NBW - NTW;
    const int u_hi = ((mode & 2) && !bwave && !twave && !(F.skip & 32)) ? DBATCH * NH : 0;
#pragma unroll 1
    for (int u = sid; u < u_hi; u += nslots) {
        const int sb = u / NH, h = u % NH;
#if WKV_SEQ4
        wkv_seq4_unit(F, wl, MPR + sb * DSEQ, h, F.state_wkv + (size_t)u * 4096, F.out + O_WKVS + (size_t)u * 4096, F.lane);
#else
        wkv_seq_unit(F, wl, MPR + sb * DSEQ, DSEQ, h, F.state_wkv + (size_t)u * 4096, F.out + O_WKVS + (size_t)u * 4096, F.lane);
#endif
    }
}
__device__ __forceinline__ void p8c_wkvC(Frame& F, bool tailmode, unsigned* tflags) {
    int u, uend, ustep;
    if (tailmode) {
        const bool twave = (F.wave == 2 && F.vcu < NB * NH);
        u = F.vcu; uend = (twave && !(F.skip & 8)) ? F.vcu + 1 : 0; ustep = 1;
        if (twave) { while (__hip_atomic_load(tflags + 64 + F.vcu, __ATOMIC_RELAXED, __HIP_MEMORY_SCOPE_AGENT) < 2u) __builtin_amdgcn_s_sleep(8);
            __builtin_amdgcn_fence(__ATOMIC_ACQUIRE, "agent"); }
    } else { u = F.wave * F.G + F.vcu; uend = NB * NH * (wkv::NCH - 1); ustep = NWAVES * F.G; }
#pragma unroll 1
    for (; u < uend; u += ustep) wkv::stageC_unit(F, tailmode ? u * wkv::NCH + (wkv::NCH - 1) : (u >> 6) * wkv::NCH + (u & 63), F.lane);
}
#ifndef PROBE_REPS
#define PROBE_REPS 0
#define PROBE_PHASE 0
#endif
#ifndef WKV_FLOW
#define WKV_FLOW 0
#endif
#ifndef PROBE_STEP
#define PROBE_STEP 0
#endif
#ifndef WKV_ZERO_ROWS
#define WKV_ZERO_ROWS 0
#endif
#ifndef WKV_DELAY
#define WKV_DELAY 0
#endif
#ifndef WKV_EXP
#define WKV_EXP 0
#endif
#ifndef MK_ONE_LAUNCH
#define MK_ONE_LAUNCH 1
#endif
constexpr int N_PHASES = 11;
struct Args { const float* in[27]; float* out; unsigned char* ws; int ph_lo, ph_hi, li, pad; };
__device__ __forceinline__ bool in_phase(int lo, int hi, int k) { asm volatile("" : "+s"(lo), "+s"(hi)); return lo <= k && k < hi; }
__global__ void __launch_bounds__(NWAVES * 64, 2) mega_fwd(Args args) {
    extern __shared__ __attribute__((aligned(16))) unsigned char lds[];
    Frame F;
    F.lds = (LAS unsigned char*)lds;
    F.MISC = (volatile LAS unsigned*)(F.lds + MISC_OFF);
    F.tid = threadIdx.x; F.lane = F.tid & 63; F.wave = __builtin_amdgcn_readfirstlane(F.tid >> 6);
    F.G = gridDim.x; { const int bx = blockIdx.x; F.vcu = (F.G % 8 == 0) ? (bx % 8) * (F.G / 8) + bx / 8 : bx; }
    F.ws = args.ws; F.out = args.out; F.dob = (unsigned char*)args.out;
    F.ctl = (gu32*)(F.ws + WS_CTL); F.skip = args.pad >> 8;
    F.xp = args.in[0]; F.xs = args.in[1]; F.cache_k = args.in[2]; F.cache_v = args.in[3]; F.state_wkv = args.in[4]; F.state_shift = args.in[5];
    F.meta = args.in[6]; F.table = args.in[7]; F.norm_gain = args.in[8]; F.final_gain = args.in[9]; F.a_w_in = args.in[10]; F.sinks = args.in[11]; F.a_w_out = args.in[12];
    F.mu = args.in[13]; F.r_w_in = args.in[14]; F.w0 = args.in[15]; F.w1 = args.in[16]; F.w2 = args.in[17]; F.a0 = args.in[18]; F.a1 = args.in[19]; F.a2 = args.in[20];
    F.k_k = args.in[21]; F.k_a = args.in[22]; F.r_k = args.in[23]; F.ln_g = args.in[24]; F.ln_b = args.in[25]; F.r_w_out = args.in[26];
    for (int u = F.tid; u < (LDS_BYTES - LDSCTL_OFF) / 4; u += NWAVES * 64) ((LAS unsigned*)(F.lds + LDSCTL_OFF))[u] = 0u;
    __syncthreads();
    XcdBarrier bar; bar.bar = (unsigned*)(F.ctl + CW_BAR) + args.li * XCD_BAR_WORDS; bar.x = 0; bar.st = nullptr;
    const int lo = args.ph_lo, hi = args.ph_hi;
    if (hi - lo > 1 || lo == 8) bar = xcd_barrier_post((unsigned*)(F.ctl + CW_BAR) + args.li * XCD_BAR_WORDS, F.MISC + 8);
#define flow (WKV_FLOW && (gridDim.x == 256) && (args.ph_hi - args.ph_lo > 1))
#define rc2 ((unsigned*)(args.ws + WS_CTL) + CW_RC2 + args.li * 256)
#define rc4 ((unsigned*)(args.ws + WS_CTL) + CW_RC4 + args.li * 256)
#define IN(k) (lo <= (k) && (k) < hi)
#define SEAM(k) do { if (IN(k) && IN((k) + 1)) xcd_barrier(bar); } while (0)
    bf16* XA = (bf16*)(F.ws + WS_XA); bf16* QKVG = (bf16*)(F.ws + WS_QKVG); bf16* H1 = (bf16*)(F.ws + WS_H1);
    bf16* Rb = (bf16*)(F.dob); bf16* Kb = (bf16*)(F.dob + RKV_STRIDE); bf16* Vb = (bf16*)(F.dob + 2 * RKV_STRIDE); bf16* Gb = (bf16*)(F.ws + WS_G);

    if (IN(0)) { p0_prologue(F, 2, F.vcu * NWAVES + F.wave, F.G * NWAVES); } SEAM(0);
    if (IN(1)) {
        pg8::Gemm g{XA, (const bf16*)(F.ws + WS_WAIN), MPAD, LDQ, DM, 1 << 30, 0}; pg8::StaticOrder S; S.init(MPAD, LDQ, F.G, (int)blockIdx.x);
        pg8::EpiBf16G E{QKVG, QKVG, QKVG, QKVG, LDQ, 64, MPAD, 4, QSCALE};
        pg8::gemm_phase<pg8::EpiBf16G, pg8::StaticOrder, true, true>(F.lds + RING_OFF, g, S, E);
    } SEAM(1);
    if (IN(2)) { p2_attention(F); } SEAM(2);
    if (IN(3)) {
        pg8::Gemm g{XA, (const bf16*)(F.ws + WS_WAOUT), MPAD, DM, DM, 1 << 30, 0};
        pg8::EpiResB E{nullptr, H1, F.meta, F.xp, F.xs, MTOK};
        if (flow) { pg8::SplitOrder S; S.init(MPAD, DM, F.G, (int)blockIdx.x, rc2); pg8::gemm_phase<pg8::EpiResB, pg8::SplitOrder, true, true>(F.lds + RING_OFF, g, S, E); }
        else { pg8::StaticOrder S; S.init(MPAD, DM, F.G, (int)blockIdx.x); pg8::gemm_phase<pg8::EpiResB, pg8::StaticOrder, true, true>(F.lds + RING_OFF, g, S, E); }
    } if (IN(3) && IN(4) && !flow) xcd_barrier(bar);
    if (IN(4)) { p4_mix(F); } if (IN(4) && IN(6)) xcd_barrier(bar);
    if (IN(6)) {
        {
            pg8::Gemm g{(const bf16*)(F.ws + WS_MIX), (const bf16*)(F.ws + WS_WRIN), MPAD, 3 * DM, DM, 4, MIX_STRIDE}; pg8::StaticOrder S; S.init(MPAD, 3 * DM, F.G, (int)blockIdx.x);
            pg8::EpiBf16G E{Rb, Kb, Vb, Vb, DM, 4, MTOK, 0, 1.f};
            pg8::gemm_phase<pg8::EpiBf16G, pg8::StaticOrder, true, true>(F.lds + RING_OFF, g, S, E);
        }
        __syncthreads();
        {
            const int rot = (((MPAD / 256) * (3 * DM / 256)) % F.G + 7) & ~7;
            pg8::Gemm g{(const bf16*)(F.ws + WS_MIX + 3 * MIX_STRIDE), (const bf16*)(F.ws + WS_WRIN) + (size_t)3 * DM * DM, MPAD, DM, DM, 1 << 30, 0}; pg8::StaticOrder S; S.init(MPAD, DM, F.G, ((int)blockIdx.x - rot + 2 * F.G) % F.G);
            pg8::EpiBf16G E{Gb, Gb, Gb, Gb, DM, 64, MTOK, 0, 1.f};
            pg8::gemm_phase<pg8::EpiBf16G, pg8::StaticOrder, true, true>(F.lds + RING_OFF, g, S, E);
        }
        __syncthreads();
        {
            const int rot = ((((MPAD / 256) * (3 * DM / 256)) % F.G + 7) & ~7) + ((((MPAD / 256) * (DM / 256)) % F.G + 7) & ~7);
            const int cid = ((int)blockIdx.x - rot + 4 * F.G) % F.G;
            pg8::Gemm g{(const bf16*)(F.dob + DO_XN1), (const bf16*)(F.ws + WS_W1A1), U_SROW, 256, DM, 1 << 30, 0}; pg8::StaticOrder S; S.init(U_SROW, 256, F.G, cid);
            pg8::EpiF32 E{(float*)(F.ws + WS_U), 256};
            pg8::gemm_phase<pg8::EpiF32, pg8::StaticOrder, true, true>(F.lds + RING_OFF, g, S, E);
            __syncthreads();
            pg8::Gemm g2{(const bf16*)(F.ws + WS_XN1S), (const bf16*)(F.ws + WS_W1A1), 768, 256, DM, 1 << 30, 0}; pg8::StaticOrder S2; S2.init(768, 256, F.G, (cid - 72 + F.G) % F.G);
            pg8::EpiF32 E2{(float*)(F.ws + WS_U) + (size_t)U_SROW * 256, 256};
            pg8::gemm_phase<pg8::EpiF32, pg8::StaticOrder, true, true>(F.lds + RING_OFF, g2, S2, E2);
        }
    } if (IN(6) && IN(7)) xcd_barrier(bar);
    if (IN(7)) { p5_lora1_combine(F); } SEAM(7);
    if (IN(8)) {
#if WKV_EXP == 40 || WKV_EXP == 45
        const int nst = 4; const int prog[4] = {3, 6, 0, 1};
#elif WKV_EXP >= 30
        const int nst = 3; const int prog[4] = {3, 0, 1, 1};
#elif WKV_EXP == 21
        const int nst = 4; const int prog[4] = {0, 1, 2, 4};
#elif WKV_EXP == 0
        const int nst = 3; const int prog[4] = {0, 1, 2, 2};
#elif WKV_EXP == 1
        const int nst = 3; const int prog[4] = {3, 0, 1, 1};
#elif WKV_EXP == 16 || WKV_EXP == 19
        const int nst = 2; const int prog[4] = {3, 1, 1, 1};
#elif WKV_EXP == 10
        const int nst = 4; const int prog[4] = {3, 0, 4, 5};
#elif WKV_EXP == 5 || WKV_EXP == 12
        const int nst = 3; const int prog[4] = {3, 0, 4, 4};
#elif WKV_EXP == 4 || WKV_EXP == 7 || WKV_EXP == 8 || WKV_EXP == 14 || WKV_EXP == 15
        const int nst = 3; const int prog[4] = {3, 0, 1, 1};
#elif WKV_EXP == 2
        const int nst = 4; const int prog[4] = {3, 0, 1, 2};
#else
        const int nst = 2; const int prog[4] = {3, 4, 4, 4};
#endif
#pragma unroll 1
        for (int st = 0; st < nst; ++st) {
            const int kind = st == 0 ? prog[0] : st == 1 ? prog[1] : st == 2 ? prog[2] : prog[3];
            if ((args.pad & 255) && st + 1 != (args.pad & 255)) continue;
            unsigned* tflags = (unsigned*)(F.ctl + CW_TFLAG) + args.li * 128;
            if (kind == 0) p8a_wkvA(F);
            else { if (kind != 2) p8b_wkvB(F, 3, tflags); p8c_wkvC(F, kind != 2, tflags); }
            if (st + 1 < nst && !args.pad) xcd_barrier(bar);
        }
    } SEAM(8);
#if WKV_ZERO_ROWS
    if (blockIdx.x == 0) { bf16* o_ = (bf16*)(F.ws + WS_OG2) + (size_t)16864 * DM; for (int i = F.tid; i < 32 * DM; i += NWAVES * 64) o_[i] = 0; }
    xcd_barrier(bar);
#endif
#if WKV_DELAY
    { const unsigned long long t0_ = __builtin_amdgcn_s_memrealtime(); while (__builtin_amdgcn_s_memrealtime() - t0_ < 20000ull) __builtin_amdgcn_s_sleep(8); }
#endif
    if (IN(9)) {
        pg8::Gemm g{(const bf16*)(F.dob + DO_OG2), (const bf16*)(F.ws + WS_WROUT), MPAD, DM, DM, 1 << 30, 0};
        pg8::EpiResB E{H1, H1, F.meta, F.xp, F.xs, MTOK};
        if (flow) { pg8::SplitOrder S; S.init(MPAD, DM, F.G, (int)blockIdx.x, rc4); pg8::gemm_phase<pg8::EpiResB, pg8::SplitOrder, true, true>(F.lds + RING_OFF, g, S, E); }
        else { pg8::StaticOrder S; S.init(MPAD, DM, F.G, (int)blockIdx.x); pg8::gemm_phase<pg8::EpiResB, pg8::StaticOrder, true, true>(F.lds + RING_OFF, g, S, E); }
    } if (IN(9) && IN(10) && !flow) xcd_barrier(bar);
#ifdef EXTRA_BARRIERS
    if (hi - lo > 1) { for (int e_ = 0; e_ < EXTRA_BARRIERS; ++e_) xcd_barrier(bar); }
#endif
    if (IN(10)) { p8_final(F); }
#undef IN
#undef SEAM
}

extern "C" void kernel_launch(void* const* d_in, const int* in_sizes, int n_in, void* d_out, int out_size, void* d_ws, size_t ws_size, hipStream_t stream) {
    static int grid = 0;
    if (grid == 0) {
        if (n_in != 27 || (size_t)out_size != O_END || ws_size < WS_END) { fprintf(stderr, "kernel_launch: unexpected shapes n_in %d out %d ws %zu\n", n_in, out_size, ws_size); grid = -1; return; }
        int dev = 0, cus = 0, per_cu = 0;
        if (hipGetDevice(&dev) != hipSuccess || hipDeviceGetAttribute(&cus, hipDeviceAttributeMultiprocessorCount, dev) != hipSuccess) { grid = -1; return; }
        if (hipFuncSetAttribute((const void*)mega_fwd, hipFuncAttributeMaxDynamicSharedMemorySize, LDS_BYTES) != hipSuccess) { fprintf(stderr, "kernel_launch: hipFuncSetAttribute failed\n"); grid = -1; return; }
        if (hipOccupancyMaxActiveBlocksPerMultiprocessor(&per_cu, (const void*)mega_fwd, NWAVES * 64, LDS_BYTES) != hipSuccess || per_cu < 1) fprintf(stderr, "kernel_launch: occupancy query says %d\n", per_cu);
        (void)hipGetLastError();
        grid = cus;
    }
    if (grid < 0) return;
    if (hipMemsetAsync((char*)d_ws + WS_CTL, 0, CTL_ZERO_BYTES, stream) != hipSuccess) return;
    Args a{};
    for (int i = 0; i < 27; ++i) a.in[i] = (const float*)d_in[i];
    a.out = (float*)d_out; a.ws = (unsigned char*)d_ws;
#if PROBE_REPS > 0
    for (int r_ = 0; r_ < PROBE_REPS; ++r_) { a.ph_lo = PROBE_PHASE; a.ph_hi = PROBE_PHASE + 1; a.li = 1 + r_; a.pad = PROBE_STEP; hipLaunchKernelGGL(mega_fwd, dim3(grid), dim3(NWAVES * 64), LDS_BYTES, stream, a); }
#endif
#if MK_ONE_LAUNCH
    a.ph_lo = 0; a.ph_hi = N_PHASES; a.li = 0; a.pad = 0;
    hipLaunchKernelGGL(mega_fwd, dim3(grid), dim3(NWAVES * 64), LDS_BYTES, stream, a);
#else
    for (int p = 0; p < N_PHASES; ++p) { a.ph_lo = p; a.ph_hi = p + 1; a.li = p;
        hipLaunchKernelGGL(mega_fwd, dim3(grid), dim3(NWAVES * 64), LDS_BYTES, stream, a); }
#endif
}
```

```cpp
#include <hip/hip_runtime.h>
#include <cstdio>
#include <cstdint>
#define WKV_EXP 0
#define WKV_DUMP_T 4096
#define WKV_VAR 0
#define WKV_SUB 0
#define PROBE_PHASE 0
#define PROBE_REPS 0
#define PROBE_STEP 0
namespace pg8 {
#define PG8_LAS __attribute__((address_space(3)))
typedef unsigned short bf16_t;
typedef short bf16x8 __attribute__((ext_vector_type(8)));
typedef float f32x4 __attribute__((ext_vector_type(4)));
typedef unsigned u32x4 __attribute__((ext_vector_type(4)));
constexpr int BM = 256, BK = 64, HALF = 128, HTB = HALF * BK * 2  , STAGE_BYTES = 8 * HTB, NXCD = 8, WGM = 8;

__host__ __device__ __forceinline__ int lds_byte(int r, int c) { const int st = (r >> 4) * 2 + (c >> 5), rr = r & 15, cc = c & 31, ob = rr * 64 + cc * 2; return st * 1024 + (ob ^ (((ob >> 9) & 1) << 5)); }
__host__ __device__ __forceinline__ void stage_rc(int b, int& R, int& C) { const int st = b / 1024, sb = b % 1024, swz = sb ^ (((sb >> 9) & 1) << 5); R = (st >> 1) * 16 + swz / 64; C = (st & 1) * 32 + (swz % 64) / 2; }
__host__ __device__ __forceinline__ int perm32(int rho) { const int n = rho >> 4, i = rho & 15; return 8 * (i >> 2) + 4 * n + (i & 3); }

struct Unit { int pm, pn; };
struct Gemm { const bf16_t* A; const bf16_t* Bt; int M, N, K; int gdiv; size_t a_gstride; };

struct SplitOrder;
struct StaticOrder {
    int nM, nN, nwg, G, c;
    __host__ __device__ void init(int M, int N, int G_, int c_) { nM = M / BM; nN = N / BM; nwg = nM * nN; G = G_; c = c_; }
    __host__ __device__ bool next(int i, Unit& u) const {
        const long L = (long)i * G + c; if (L >= nwg) return false;
        int wgid = (int)L; { const int q = nwg / NXCD, r = nwg % NXCD, xcd = wgid % NXCD, off = wgid / NXCD; wgid = (xcd < r ? xcd * (q + 1) : r * (q + 1) + (xcd - r) * q) + off; }
        const int nig = WGM * nN, gid = wgid / nig, fm = gid * WGM, gsz = (nM - fm) < WGM ? (nM - fm) : WGM;
        u.pm = fm + ((wgid % nig) % gsz); u.pn = (wgid % nig) / gsz; return true;
    }
    __device__ __forceinline__ void a_ready(const Unit&) const {}
    __device__ __forceinline__ void done(const Unit&) const {}
};
struct SplitOrder {
    StaticOrder a, b; int nMa; unsigned* cnt;
    __device__ void init(int M, int N, int G_, int c_, unsigned* cnt_) { const int nN = N / BM; nMa = G_ / nN; a.init(nMa * BM, N, G_, c_); b.init(M - nMa * BM, N, G_, c_); cnt = cnt_; }
    __device__ bool next(int i, Unit& u) const { if (i == 0) return a.next(0, u); const bool ok = b.next(i - 1, u); u.pm += nMa; return ok; }
    __device__ __forceinline__ void a_ready(const Unit&) const {}
    __device__ __forceinline__ void done(const Unit& u) const {
        __syncthreads();
        if (threadIdx.x < 64) { __builtin_amdgcn_fence(__ATOMIC_RELEASE, "agent");
            if (threadIdx.x == 0) __hip_atomic_fetch_add(cnt + u.pm, 1u, __ATOMIC_RELAXED, __HIP_MEMORY_SCOPE_AGENT); }
    }
};

__device__ __forceinline__ unsigned cvt_pk_bf16(float lo, float hi) { unsigned r; asm volatile("v_cvt_pk_bf16_f32 %0, %1, %2" : "=v"(r) : "v"(lo), "v"(hi)); return r; }
struct EpiBf16G {
    static constexpr bool PERM = true, AFTER_DRAIN = false;
    bf16_t *O0, *O1, *O2, *O3; int ldc, tpg, Mvalid, scale_tiles; float scale0;
    __device__ __forceinline__ void operator()(const f32x4 (&acc)[2][2][4][2], const Unit& u, int wr, int wc, int fr, int fq) const {
        const int grp = u.pn / tpg, colt = (u.pn - grp * tpg) * BM;
        bf16_t* base = grp == 0 ? O0 : grp == 1 ? O1 : grp == 2 ? O2 : O3;
        const float sc = (u.pn < scale_tiles) ? scale0 : 1.f;
        const int row0 = u.pm * BM + wr * 64 + fr, col0 = colt + wc * 32 + 8 * fq;
#pragma unroll
        for (int ai = 0; ai < 2; ++ai)
#pragma unroll
            for (int m = 0; m < 4; ++m) { const int row = row0 + ai * HALF + m * 16; const unsigned roff = (unsigned)(((size_t)row * ldc + col0) * 2);
                if (row < Mvalid) {
#pragma unroll
                for (int bj = 0; bj < 2; ++bj) { const f32x4 v0 = acc[ai][bj][m][0] * sc, v1 = acc[ai][bj][m][1] * sc;
                    u32x4 w; w.x = cvt_pk_bf16(v0[0], v0[1]); w.y = cvt_pk_bf16(v0[2], v0[3]); w.z = cvt_pk_bf16(v1[0], v1[1]); w.w = cvt_pk_bf16(v1[2], v1[3]);
                    *(u32x4*)((char*)base + roff + bj * HALF * 2) = w; } } }
    }
};
struct EpiRes {
    static constexpr bool PERM = false, AFTER_DRAIN = false;
    const float* base; float* out; const float *meta, *xp, *xs; int Mvalid;
    __device__ __forceinline__ void operator()(const f32x4 (&acc)[2][2][4][2], const Unit& u, int wr, int wc, int fr, int fq) const {
        const int row0 = u.pm * BM + wr * 64 + fr, col0 = u.pn * BM + wc * 32 + 4 * fq;
#pragma unroll
        for (int ai = 0; ai < 2; ++ai)
#pragma unroll
            for (int m = 0; m < 4; ++m) { const int row = row0 + ai * HALF + m * 16;
                if (row < Mvalid) {
                    const float* b;
                    if (base) b = base + (size_t)row * 1024;
                    else if (row < 16448) { const int bb = row / 4112, t = row - bb * 4112; b = t < 16 ? meta + t * 1024 : xp + ((size_t)bb * 4096 + (t - 16)) * 1024; }
                    else b = xs + (size_t)(row - 16448) * 1024;
                    float* o = out + (size_t)row * 1024;
#pragma unroll
                    for (int bj = 0; bj < 2; ++bj)
#pragma unroll
                        for (int n = 0; n < 2; ++n) { const int c = col0 + bj * HALF + n * 16; const f32x4 r = *(const f32x4*)(b + c); *(f32x4*)(o + c) = r + acc[ai][bj][m][n]; } } }
    }
};

struct EpiResB {
    static constexpr bool PERM = true, AFTER_DRAIN = false;
    const bf16_t* base; bf16_t* out; const float *meta, *xp, *xs; int Mvalid;
    __device__ __forceinline__ void operator()(const f32x4 (&acc)[2][2][4][2], const Unit& u, int wr, int wc, int fr, int fq) const {
        const int row0 = u.pm * BM + wr * 64 + fr, col0 = u.pn * BM + wc * 32 + 8 * fq;
#pragma unroll
        for (int ai = 0; ai < 2; ++ai)
#pragma unroll
            for (int m = 0; m < 4; ++m) { const int row = row0 + ai * HALF + m * 16;
                if (row < Mvalid) {
                    const unsigned ooff = (unsigned)(((size_t)row * 1024 + col0) * 2);
                    if (base) {
                        const bf16_t* b = base + (size_t)row * 1024 + col0;
#pragma unroll
                        for (int bj = 0; bj < 2; ++bj) { const u32x4 rw = *(const u32x4*)(b + bj * HALF); const f32x4 a0 = acc[ai][bj][m][0], a1 = acc[ai][bj][m][1]; u32x4 w;
                            w.x = cvt_pk_bf16(a0[0] + __builtin_bit_cast(float, rw.x << 16), a0[1] + __builtin_bit_cast(float, rw.x & 0xffff0000u));
                            w.y = cvt_pk_bf16(a0[2] + __builtin_bit_cast(float, rw.y << 16), a0[3] + __builtin_bit_cast(float, rw.y & 0xffff0000u));
                            w.z = cvt_pk_bf16(a1[0] + __builtin_bit_cast(float, rw.z << 16), a1[1] + __builtin_bit_cast(float, rw.z & 0xffff0000u));
                            w.w = cvt_pk_bf16(a1[2] + __builtin_bit_cast(float, rw.w << 16), a1[3] + __builtin_bit_cast(float, rw.w & 0xffff0000u));
                            *(u32x4*)((char*)out + ooff + bj * HALF * 2) = w; }
                    } else {
                        const float* b;
                        if (row < 16448) { const int bb = row / 4112, t = row - bb * 4112; b = t < 16 ? meta + t * 1024 : xp + ((size_t)bb * 4096 + (t - 16)) * 1024; }
                        else b = xs + (size_t)(row - 16448) * 1024;
                        b += col0;
#pragma unroll
                        for (int bj = 0; bj < 2; ++bj) { const f32x4 r0 = *(const f32x4*)(b + bj * HALF), r1 = *(const f32x4*)(b + bj * HALF + 4); const f32x4 v0 = acc[ai][bj][m][0] + r0, v1 = acc[ai][bj][m][1] + r1; u32x4 w;
                            w.x = cvt_pk_bf16(v0[0], v0[1]); w.y = cvt_pk_bf16(v0[2], v0[3]); w.z = cvt_pk_bf16(v1[0], v1[1]); w.w = cvt_pk_bf16(v1[2], v1[3]);
                            *(u32x4*)((char*)out + ooff + bj * HALF * 2) = w; }
                    } } }
    }
};

struct EpiT12 {
    static constexpr bool PERM = false, AFTER_DRAIN = false;
    float* t12; int Mvalid; unsigned char* t12b;
    __device__ __forceinline__ void operator()(const f32x4 (&acc)[2][2][4][2], const Unit& u, int wr, int wc, int fr, int fq) const {
        if (wc >= 2) return;
        const int row0 = u.pm * BM + wr * 64 + fr, col0 = wc * 32 + 4 * fq;
#pragma unroll
        for (int ai = 0; ai < 2; ++ai)
#pragma unroll
            for (int m = 0; m < 4; ++m) { const int row = row0 + ai * HALF + m * 16;
                if (row < Mvalid) {
                    float* o = t12 + (size_t)row * 128 + u.pn * 64 + col0;
                    const int bb = row / 4112, t = row - bb * 4112;
                    unsigned char* ob = t12b + ((size_t)((bb * 129 + (t >> 5)) * 8 + u.pn * 4) * 64 + (t & 31)) * 16;
#pragma unroll
                    for (int n = 0; n < 2; ++n) { f32x4 v = acc[ai][0][m][n];
                        if (u.pn == 0) { v[0] = tanhf(v[0]); v[1] = tanhf(v[1]); v[2] = tanhf(v[2]); v[3] = tanhf(v[3]); }
                        *(f32x4*)(o + n * 16) = v;
                        if (row < 16448) { const int j = col0 + n * 16;
                            *(unsigned long long*)(ob + ((j >> 4) * 64 + 32 * ((j >> 3) & 1)) * 16 + (j & 7) * 2) = (unsigned long long)cvt_pk_bf16(v[0], v[1]) | ((unsigned long long)cvt_pk_bf16(v[2], v[3]) << 32); } } } }
    }
};

struct EpiF32 {
    static constexpr bool PERM = false, AFTER_DRAIN = false;
    float* out; int ldc;
    __device__ __forceinline__ void operator()(const f32x4 (&acc)[2][2][4][2], const Unit& u, int wr, int wc, int fr, int fq) const {
        const int row0 = u.pm * BM + wr * 64 + fr, col0 = u.pn * BM + wc * 32 + 4 * fq;
#pragma unroll
        for (int ai = 0; ai < 2; ++ai)
#pragma unroll
            for (int m = 0; m < 4; ++m) { const int row = row0 + ai * HALF + m * 16; const unsigned ooff = (unsigned)(((size_t)row * ldc + col0) * 4);
#pragma unroll
                for (int bj = 0; bj < 2; ++bj)
#pragma unroll
                    for (int n = 0; n < 2; ++n) *(f32x4*)((char*)out + ooff + (bj * HALF + n * 16) * 4) = acc[ai][bj][m][n]; }
    }
};
template <class Epi, class Sched, bool ALIGN_EPI = false, bool SP2 = false>
__device__ __forceinline__ void gemm_phase(PG8_LAS unsigned char* lds, const Gemm g, const Sched& S, const Epi& E) {
    const int tid = threadIdx.x, wid = __builtin_amdgcn_readfirstlane(tid >> 6), lane = tid & 63, wr = wid >> 2, wc = wid & 3, fr = lane & 15, fq = lane >> 4;
    const int K = g.K, nt = K / BK;
    unsigned voffA[2], voffB[2];
#pragma unroll
    for (int i = 0; i < 2; ++i) { int R, C; stage_rc(tid * 16 + i * 8192, R, C); const int Rb = Epi::PERM ? ((R & ~31) + perm32(R & 31)) : R;
        voffA[i] = (unsigned)(R * K + C) * 2u; voffB[i] = (unsigned)(Rb * K + C) * 2u; }
    const size_t kstep = (size_t)(BK * 2);
    const size_t hstep = (size_t)HALF * K * 2;
    const size_t tstep = 2 * hstep;
    const unsigned ldsw = (unsigned)wid * 1024u;
    const int aoff = lds_byte(wr * 64 + fr, fq * 8), boff = lds_byte(wc * 32 + fr, fq * 8);
#define PG8_SA(b, h) (((b) * 2 + (h)) * HTB)
#define PG8_SB(b, h) ((4 + (b) * 2 + (h)) * HTB)
#define PG8_STAGE(bufoff, gbase, voff) do { _Pragma("unroll") for (int _i = 0; _i < 2; ++_i) \
        __builtin_amdgcn_global_load_lds((const unsigned*)((const char*)(gbase) + (voff)[_i]), (PG8_LAS unsigned*)(lds + (bufoff) + ldsw + _i * 8192), 16, 0, 0); } while (0)
#define PG8_LDA(dst, b, h) do { _Pragma("unroll") for (int m = 0; m < 4; ++m) _Pragma("unroll") for (int k = 0; k < 2; ++k) dst[m][k] = *(const PG8_LAS bf16x8*)(lds + PG8_SA(b, h) + aoff + m * 2048 + k * 1024); } while (0)
#define PG8_LDB(dst, b, h) do { _Pragma("unroll") for (int n = 0; n < 2; ++n) _Pragma("unroll") for (int k = 0; k < 2; ++k) dst[n][k] = *(const PG8_LAS bf16x8*)(lds + PG8_SB(b, h) + boff + n * 2048 + k * 1024); } while (0)
#define PG8_MMA(ai, bj, At, Bt) do { __builtin_amdgcn_s_setprio(1); _Pragma("unroll") for (int m = 0; m < 4; ++m) _Pragma("unroll") for (int n = 0; n < 2; ++n) _Pragma("unroll") for (int k = 0; k < 2; ++k) \
        acc[ai][bj][m][n] = __builtin_amdgcn_mfma_f32_16x16x32_bf16(Bt[n][k], At[m][k], acc[ai][bj][m][n], 0, 0, 0); __builtin_amdgcn_s_setprio(0); } while (0)
#define PG8_WAIT_V(n) asm volatile("s_waitcnt vmcnt(" #n ")" ::: "memory")
#define PG8_WAIT_L(n) asm volatile("s_waitcnt lgkmcnt(" #n ")" ::: "memory")
#define PG8_BAR __builtin_amdgcn_s_barrier()
#define PG8_SCHED __builtin_amdgcn_sched_barrier(0)
    Unit cur, nxt; int ui = 0;
    if (!S.next(0, cur)) return;
    f32x4 acc[2][2][4][2];
#pragma unroll
    for (int a = 0; a < 2; ++a)
#pragma unroll
        for (int b = 0; b < 2; ++b)
#pragma unroll
            for (int m = 0; m < 4; ++m)
#pragma unroll
                for (int n = 0; n < 2; ++n) acc[a][b][m][n] = (f32x4){0.f, 0.f, 0.f, 0.f};
    bf16x8 At[4][2], B0[2][2], B1[2][2];
    const char* cA = (const char*)g.A + (size_t)(cur.pn / g.gdiv) * g.a_gstride + (size_t)cur.pm * tstep; const char* cB = (const char*)g.Bt + (size_t)cur.pn * tstep;
    S.a_ready(cur);
    if constexpr (SP2) {
        PG8_STAGE(PG8_SB(0, 0), cB, voffB); PG8_STAGE(PG8_SB(0, 1), cB + hstep, voffB); PG8_STAGE(PG8_SA(0, 0), cA, voffA); PG8_STAGE(PG8_SA(0, 1), cA + hstep, voffA);
        if (wr == 1) PG8_BAR;
        PG8_WAIT_V(2); PG8_BAR;
        PG8_STAGE(PG8_SB(1, 0), cB + kstep, voffB); PG8_STAGE(PG8_SA(1, 0), cA + kstep, voffA); PG8_STAGE(PG8_SB(1, 1), cB + hstep + kstep, voffB);
        PG8_WAIT_V(6); PG8_BAR;
    } else {
        PG8_STAGE(PG8_SB(0, 0), cB, voffB); PG8_STAGE(PG8_SA(0, 0), cA, voffA); PG8_STAGE(PG8_SB(0, 1), cB + hstep, voffB); PG8_STAGE(PG8_SA(0, 1), cA + hstep, voffA);
        if (wr == 1) PG8_BAR;
        PG8_WAIT_V(4); PG8_BAR;
        PG8_STAGE(PG8_SB(1, 0), cB + kstep, voffB); PG8_STAGE(PG8_SA(1, 0), cA + kstep, voffA); PG8_STAGE(PG8_SB(1, 1), cB + hstep + kstep, voffB);
        PG8_WAIT_V(6); PG8_BAR;
    }
    for (;;) {
        const bool has_next = S.next(ui + 1, nxt);
        const char* nA = has_next ? (const char*)g.A + (size_t)(nxt.pn / g.gdiv) * g.a_gstride + (size_t)nxt.pm * tstep : cA; const char* nB = has_next ? (const char*)g.Bt + (size_t)nxt.pn * tstep : cB;
        for (int t = 0; t < nt; t += 2) {
            const bool last = (t == nt - 2);
            const char* a1 = cA + (size_t)(t + 1) * kstep;
            const char* a2 = last ? nA : cA + (size_t)(t + 2) * kstep; const char* b2 = last ? nB : cB + (size_t)(t + 2) * kstep;
            const char* a3 = a2 + kstep; const char* b3 = b2 + kstep;
            if (last && has_next) S.a_ready(nxt);
            if constexpr (SP2) {
            PG8_LDB(B0, 0, 0); PG8_LDB(B1, 0, 1); PG8_SCHED; PG8_LDA(At, 0, 0); PG8_STAGE(PG8_SA(1, 1), a1 + hstep, voffA);
            PG8_WAIT_V(8); PG8_WAIT_L(0); PG8_BAR; PG8_MMA(0, 0, At, B0); PG8_MMA(0, 1, At, B1); PG8_BAR; PG8_SCHED;
            PG8_LDA(At, 0, 1); PG8_STAGE(PG8_SB(0, 0), b2, voffB); PG8_STAGE(PG8_SB(0, 1), b2 + hstep, voffB); PG8_STAGE(PG8_SA(0, 0), a2, voffA);
            PG8_WAIT_V(8); PG8_WAIT_L(0); PG8_BAR; PG8_MMA(1, 0, At, B0); PG8_MMA(1, 1, At, B1); PG8_BAR; PG8_SCHED;
            PG8_LDB(B0, 1, 0); PG8_LDB(B1, 1, 1); PG8_SCHED; PG8_LDA(At, 1, 0); PG8_STAGE(PG8_SA(0, 1), a2 + hstep, voffA);
            PG8_WAIT_V(8); PG8_WAIT_L(0); PG8_BAR; PG8_MMA(0, 0, At, B0); PG8_MMA(0, 1, At, B1); PG8_BAR; PG8_SCHED;
            PG8_LDA(At, 1, 1); PG8_STAGE(PG8_SB(1, 0), b3, voffB); PG8_STAGE(PG8_SB(1, 1), b3 + hstep, voffB); PG8_STAGE(PG8_SA(1, 0), a3, voffA);
            PG8_WAIT_V(8); PG8_WAIT_L(0); PG8_BAR; PG8_MMA(1, 0, At, B0); PG8_MMA(1, 1, At, B1); PG8_BAR; PG8_SCHED;
            } else {
            PG8_LDB(B0, 0, 0); PG8_SCHED; PG8_LDA(At, 0, 0); PG8_STAGE(PG8_SA(1, 1), a1 + hstep, voffA);
            PG8_WAIT_L(8); PG8_BAR; PG8_WAIT_L(0); PG8_MMA(0, 0, At, B0); PG8_BAR; PG8_SCHED;
            PG8_LDB(B1, 0, 1); PG8_STAGE(PG8_SB(0, 0), b2, voffB);
            PG8_BAR; PG8_WAIT_L(0); PG8_MMA(0, 1, At, B1); PG8_BAR;
            PG8_LDA(At, 0, 1); PG8_STAGE(PG8_SA(0, 0), a2, voffA);
            PG8_BAR; PG8_WAIT_L(0); PG8_MMA(1, 0, At, B0); PG8_BAR; PG8_SCHED;
            PG8_STAGE(PG8_SB(0, 1), b2 + hstep, voffB);
            PG8_WAIT_V(6); PG8_BAR; PG8_MMA(1, 1, At, B1); PG8_BAR;
            PG8_LDB(B0, 1, 0); PG8_SCHED; PG8_LDA(At, 1, 0); PG8_STAGE(PG8_SA(0, 1), a2 + hstep, voffA);
            PG8_WAIT_L(8); PG8_BAR; PG8_WAIT_L(0); PG8_MMA(0, 0, At, B0); PG8_BAR; PG8_SCHED;
            PG8_LDB(B1, 1, 1); PG8_STAGE(PG8_SB(1, 0), b3, voffB);
            PG8_BAR; PG8_WAIT_L(0); PG8_MMA(0, 1, At, B1); PG8_BAR;
            PG8_LDA(At, 1, 1); PG8_STAGE(PG8_SA(1, 0), a3, voffA);
            PG8_BAR; PG8_WAIT_L(0); PG8_MMA(1, 0, At, B0); PG8_BAR; PG8_SCHED;
            PG8_STAGE(PG8_SB(1, 1), b3 + hstep, voffB);
            PG8_WAIT_V(6); PG8_BAR; PG8_MMA(1, 1, At, B1); PG8_BAR;
            }
        }
        if constexpr (ALIGN_EPI) { if (wr == 0) PG8_BAR; }
        if constexpr (!Epi::AFTER_DRAIN) { E(acc, cur, wr, wc, fr, fq); S.done(cur); }
        if (!has_next) break;
#pragma unroll
        for (int a = 0; a < 2; ++a)
#pragma unroll
            for (int b = 0; b < 2; ++b)
#pragma unroll
                for (int m = 0; m < 4; ++m)
#pragma unroll
                    for (int n = 0; n < 2; ++n) acc[a][b][m][n] = (f32x4){0.f, 0.f, 0.f, 0.f};
        cur = nxt; cA = nA; cB = nB; ++ui;
        if constexpr (ALIGN_EPI) { if (wr == 1) PG8_BAR; }
    }
    PG8_WAIT_V(0);
    if constexpr (!ALIGN_EPI) { if (wr == 0) PG8_BAR; }
    PG8_BAR;
    if constexpr (Epi::AFTER_DRAIN) { E.fused(acc, cur, wr, wc, fr, fq, lds, wid, lane); S.done(cur); }
#undef PG8_SA
#undef PG8_SB
#undef PG8_STAGE
#undef PG8_LDA
#undef PG8_LDB
#undef PG8_MMA
#undef PG8_WAIT_V
#undef PG8_WAIT_L
#undef PG8_BAR
#undef PG8_SCHED
}
}
#define GAS __attribute__((address_space(1)))
#define LAS __attribute__((address_space(3)))
typedef unsigned short bf16;
typedef unsigned v4u __attribute__((ext_vector_type(4)));
typedef float f32x4 __attribute__((ext_vector_type(4)));
typedef short bf16x8 __attribute__((ext_vector_type(8)));
typedef GAS unsigned gu32;
typedef GAS unsigned long long gu64;
#define RLX_AGENT __ATOMIC_RELAXED, __HIP_MEMORY_SCOPE_AGENT
#define LDS_WAIT() asm volatile("s_waitcnt lgkmcnt(0)" ::: "memory")
#define VM_WAIT() asm volatile("s_waitcnt vmcnt(0)" ::: "memory")
__device__ __forceinline__ unsigned long long rt() { return __builtin_amdgcn_s_memrealtime(); }
__device__ __forceinline__ unsigned f2bf(float f) { unsigned u = __builtin_bit_cast(unsigned, f); return (u + 0x7fffu + ((u >> 16) & 1u)) >> 16; }
typedef __bf16 pk_bf2_t __attribute__((ext_vector_type(2))); typedef float pk_f2_t __attribute__((ext_vector_type(2)));
__device__ __forceinline__ unsigned pk2(float lo, float hi) { const pk_f2_t v = {lo, hi}; return __builtin_bit_cast(unsigned, __builtin_convertvector(v, pk_bf2_t)); }

#define XB_TMO      128
#define XB_XCNT(j)  (256  + 64 * (j))
#define XB_XSUB(j)  (1280 + 64 * (j))
#define XB_XGEN(j)  (2304 + 64 * (j))
#define XB_TOP      3328
#define XB_TOPGEN   3392
#define XCD_BAR_WORDS 3456
#define XB_SPIN_CAP (1u << 18)

__device__ __forceinline__ unsigned xb_ld(unsigned* p)              { return __hip_atomic_load(p, __ATOMIC_RELAXED, __HIP_MEMORY_SCOPE_AGENT); }
__device__ __forceinline__ unsigned xb_add(unsigned* p, unsigned v) { return __hip_atomic_fetch_add(p, v, __ATOMIC_RELAXED, __HIP_MEMORY_SCOPE_AGENT); }
__device__ __forceinline__ unsigned xb_xcc_id() { return (unsigned)__builtin_amdgcn_s_getreg((3 << 11) | 20) & 0xFu; }
#define XB_SPIN(cond, bar) do { unsigned _sp = 0; while (cond) { __builtin_amdgcn_s_sleep(1); \
    if ((++_sp & 255u) == 0u) { if (xb_ld(&(bar)[XB_TMO])) break; if (_sp > XB_SPIN_CAP) { atomicAdd(&(bar)[XB_TMO], 1u); break; } } } } while (0)

struct XcdBarrier {
    unsigned* bar; unsigned x;
    volatile LAS unsigned* st;
};

__device__ __forceinline__ XcdBarrier xcd_barrier_post(unsigned* bar, volatile LAS unsigned* st) {
    XcdBarrier b; b.bar = bar; b.x = xb_xcc_id(); b.st = st;
    if (threadIdx.x == 0) (void)xb_add(&bar[XB_XCNT(b.x)], 1u);
    return b;
}
__device__ __forceinline__ void xcd_barrier_complete(unsigned* bar, unsigned x, unsigned& nloc, unsigned& nx) {
    const unsigned G = gridDim.x * gridDim.y * gridDim.z;
    unsigned sum, cnt, mine, sp = 0u;
    for (;;) {
        sum = 0u; cnt = 0u; mine = 0u;
#pragma unroll
        for (unsigned j = 0; j < 16; ++j) { const unsigned c = xb_ld(&bar[XB_XCNT(j)]); sum += c; cnt += (c > 0u) ? 1u : 0u; mine = (j == x) ? c : mine; }
        if (sum == G) break;
        __builtin_amdgcn_s_sleep(1);
        if ((++sp & 255u) == 0u) { if (xb_ld(&bar[XB_TMO])) break; if (sp > XB_SPIN_CAP) { atomicAdd(&bar[XB_TMO], 1u); break; } }
    }
    nloc = mine > 0u ? mine : 1u; nx = cnt > 0u ? cnt : 1u;
}

__device__ __forceinline__ void xcd_barrier(const XcdBarrier& b) {
    asm volatile("s_waitcnt vmcnt(0)" ::: "memory");
    __syncthreads();
    if (threadIdx.x == 0) {
        unsigned* bar = b.bar;
        __builtin_amdgcn_s_waitcnt(0);
        unsigned nloc = b.st[0], nx = b.st[1];
        if (nloc == 0u) { xcd_barrier_complete(bar, b.x, nloc, nx); b.st[0] = nloc; b.st[1] = nx; }
        const unsigned old = xb_add(&bar[XB_XSUB(b.x)], 1u);
        const unsigned gen = old / nloc;
        if (old + 1u == (gen + 1u) * nloc) {
            __builtin_amdgcn_fence(__ATOMIC_RELEASE, "agent");
            asm volatile("s_waitcnt vmcnt(0)" ::: "memory");
            const unsigned og = xb_add(&bar[XB_TOP], 1u);
            const unsigned tg = og / nx;
            if (og + 1u == (tg + 1u) * nx) xb_add(&bar[XB_TOPGEN], 1u);
            else XB_SPIN(xb_ld(&bar[XB_TOPGEN]) == tg, bar);
            __builtin_amdgcn_fence(__ATOMIC_ACQUIRE, "agent");
            xb_add(&bar[XB_XGEN(b.x)], 1u);
            asm volatile("s_waitcnt vmcnt(0)" ::: "memory");
        } else {
            XB_SPIN(xb_ld(&bar[XB_XGEN(b.x)]) == gen, bar);
            __builtin_amdgcn_fence(__ATOMIC_ACQUIRE, "agent");
            asm volatile("s_waitcnt vmcnt(0)" ::: "memory");
        }
    }
    __syncthreads();
}
constexpr int NWAVES = 8;
constexpr int DM = 1024, NB = 4, SEQ = 4096, NMETA = 16, LP = 4112, MPR = 16448, DBATCH = 128, DSEQ = 4, MSAMP = 512, MTOK = 16960, MPAD = 17152;
constexpr int NH = 16, HD = 64, NKV = 4, LDQ = 2560, WIN = 128;
constexpr float RMS_EPS = 1e-6f, GN_EPS = 64e-5f, LOG2E = 1.4426950408889634f, QSCALE = 0.125f * 1.4426950408889634f;
constexpr size_t O_YP = 0, O_YS = 16777216, O_WKP = 17301504, O_WVP = 17432576, O_WKVP = 17563648, O_SHP = 17825792, O_WKS = 17829888, O_WVS = 22024192, O_WKVS = 26218496, O_SHS = 34607104, O_END = 34738176;
constexpr size_t MiB = 1u << 20;
constexpr size_t WS_CTL = 0, CTL_ZERO_BYTES = 1 * MiB;
constexpr size_t WS_T12B = 1 * MiB;
constexpr size_t WS_WAIN = 1 * MiB, WS_WAOUT = 6 * MiB, WS_WRIN = 8 * MiB, WS_WROUT = 16 * MiB, WS_W1A1 = 185 * MiB;
constexpr size_t WS_XN1S = 186 * MiB, WS_U = 164 * MiB;
constexpr int U_SROW = 16640;
constexpr size_t WS_KVP = 18 * MiB + 512 * 1024, WS_KVS = 19 * MiB, WS_SHP = 19 * MiB + 512 * 1024, WS_WKVP = 20 * MiB, WS_T12 = 21 * MiB;
constexpr size_t WS_XA = 30 * MiB, WS_QKVG = 64 * MiB, WS_H1 = 189 * MiB, WS_MIX = 30 * MiB, MIX_STRIDE = (size_t)MPAD * DM * 2, WS_G = 222 * MiB + 512 * 1024, WS_OG2 = 64 * MiB, WS_END = 256 * MiB;
constexpr size_t RKV_STRIDE = (size_t)MTOK * DM * 2, DO_XN1 = 3 * RKV_STRIDE,
     DO_OG2 = 2 * RKV_STRIDE;
static_assert(WS_T12 + (size_t)MTOK * 128 * 4 <= WS_XA && WS_XA + MIX_STRIDE <= WS_QKVG && WS_QKVG + (size_t)MPAD * LDQ * 2 <= WS_H1 && WS_MIX + 4 * MIX_STRIDE <= WS_H1 && WS_H1 + (size_t)MPAD * DM * 4 <= WS_END, "ws map");
static_assert(3 * RKV_STRIDE <= O_WKVS * 4 && 2 * MIX_STRIDE <= O_END * 4, "d_out scratch map");
constexpr int CW_TMO = 0, CW_CODE = 1, CW_BAR = 4096, CW_TFLAG = 65536, CW_RC2 = 70000, CW_RC4 = 70128;
constexpr int RING_OFF = 0, RING_BYTES = 131072, LDSCTL_OFF = RING_BYTES, MISC_OFF = LDSCTL_OFF + 320, LDS_BYTES = 147456;

typedef short s16x4 __attribute__((ext_vector_type(4)));
typedef float f32x16 __attribute__((ext_vector_type(16)));
struct Frame {
    LAS unsigned char* lds;
    volatile LAS unsigned* MISC;
    gu32* ctl;
    int tid, lane, wave, vcu, G, skip;
    const float *xp, *xs, *cache_k, *cache_v, *state_wkv, *state_shift, *meta, *table, *norm_gain, *final_gain, *a_w_in, *sinks, *a_w_out;
    const float *mu, *r_w_in, *w0, *w1, *w2, *a0, *a1, *a2, *k_k, *k_a, *r_k, *ln_g, *ln_b, *r_w_out;
    float* out; unsigned char* ws; unsigned char* dob;
};
template <int CTRL> __device__ __forceinline__ float dpp_mov(float v) { return __builtin_bit_cast(float, __builtin_amdgcn_update_dpp(0, __builtin_bit_cast(int, v), CTRL, 0xF, 0xF, true)); }
__device__ __forceinline__ float wave_sum(float v) {
    v += dpp_mov<0xB1>(v);
    v += dpp_mov<0x4E>(v);
    v += dpp_mov<0x141>(v);
    v += dpp_mov<0x140>(v);
    v += __shfl_xor(v, 16);
    { const unsigned u = __builtin_bit_cast(unsigned, v); auto r = __builtin_amdgcn_permlane32_swap(u, u, false, false); v = __builtin_bit_cast(float, (unsigned)r[0]) + __builtin_bit_cast(float, (unsigned)r[1]); }
    return v;
}
__device__ __forceinline__ float bf2f(bf16 b) { return __builtin_bit_cast(float, (unsigned)b << 16); }
__device__ __forceinline__ const float* h0_row(const Frame& F, int m) {
    if (m < MPR) { const int b = m / LP, t = m - b * LP; return t < NMETA ? F.meta + t * DM : F.xp + ((size_t)b * SEQ + (t - NMETA)) * DM; }
    return F.xs + (size_t)(m - MPR) * DM;
}
__device__ __forceinline__ void p0_transpose_item(const float* W, int K, int N, bf16* WT, int row_off, LAS float* scr, int item, int lane, const float* sc = nullptr, bool one_minus = false) {
    const int nblk = N / 32, kb = item / nblk, nb = item % nblk, k0 = 64 * kb, n0 = 32 * nb;
#pragma unroll 8
    for (int i = 0; i < 32; ++i) { const int kk = 2 * i + (lane >> 5); float w = W[(size_t)(k0 + kk) * N + n0 + (lane & 31)]; if (sc) { const float s_ = sc[k0 + kk]; w *= one_minus ? 1.0f - s_ : s_; } scr[kk * 33 + (lane & 31)] = w; }
    LDS_WAIT(); asm volatile("" ::: "memory");
    const int c = lane & 7;
#pragma unroll
    for (int j = 0; j < 4; ++j) { const int n = (lane >> 3) + 8 * j; const LAS float* s = scr + (8 * c) * 33 + n;
        v4u o; o.x = pk2(s[0 * 33], s[1 * 33]); o.y = pk2(s[2 * 33], s[3 * 33]); o.z = pk2(s[4 * 33], s[5 * 33]); o.w = pk2(s[6 * 33], s[7 * 33]);
        *(GAS v4u*)(WT + (size_t)(row_off + n0 + n) * K + k0 + 8 * c) = o; }
    LDS_WAIT(); asm volatile("" ::: "memory");
}
__device__ __forceinline__ void rms_row(const float* xrow, const float* gain, int lane, f32x4 (&v)[4]) {
    const GAS f32x4* xr = (const GAS f32x4*)xrow + lane; float s = 0.f;
#pragma unroll
    for (int j = 0; j < 4; ++j) { v[j] = xr[64 * j]; s += (v[j].x * v[j].x + v[j].y * v[j].y) + (v[j].z * v[j].z + v[j].w * v[j].w); }
    const float rstd = 1.0f / sqrtf(wave_sum(s) * (1.f / DM) + RMS_EPS);
    const GAS f32x4* gr = (const GAS f32x4*)gain + lane;
#pragma unroll
    for (int j = 0; j < 4; ++j) v[j] = v[j] * rstd * gr[64 * j];
}
__device__ __forceinline__ void rms_row_b(const bf16* xrow, const float* gain, int lane, f32x4 (&v)[4]) {
    const GAS unsigned long long* xr = (const GAS unsigned long long*)xrow + lane; float s = 0.f;
#pragma unroll
    for (int j = 0; j < 4; ++j) { const unsigned long long w = xr[64 * j];
        v[j].x = __builtin_bit_cast(float, (unsigned)w << 16); v[j].y = __builtin_bit_cast(float, (unsigned)w & 0xffff0000u); v[j].z = __builtin_bit_cast(float, (unsigned)(w >> 32) << 16); v[j].w = __builtin_bit_cast(float, (unsigned)(w >> 32) & 0xffff0000u);
        s += (v[j].x * v[j].x + v[j].y * v[j].y) + (v[j].z * v[j].z + v[j].w * v[j].w); }
    const float rstd = 1.0f / sqrtf(wave_sum(s) * (1.f / DM) + RMS_EPS);
    const GAS f32x4* gr = (const GAS f32x4*)gain + lane;
#pragma unroll
    for (int j = 0; j < 4; ++j) v[j] = v[j] * rstd * gr[64 * j];
}
__device__ __forceinline__ void store_bf16_row(bf16* orow, int lane, const f32x4 (&v)[4]) {
    GAS unsigned long long* o8 = (GAS unsigned long long*)orow + lane;
#pragma unroll
    for (int j = 0; j < 4; ++j) o8[64 * j] = (unsigned long long)pk2(v[j].x, v[j].y) | ((unsigned long long)pk2(v[j].z, v[j].w) << 32);
}
__device__ __forceinline__ void p0_prologue(Frame& F, int part, int gw, int NGW) {
    LAS float* scr = (LAS float*)(F.lds + RING_OFF + F.wave * 16384);
    bf16* wain = (bf16*)(F.ws + WS_WAIN); bf16* waout = (bf16*)(F.ws + WS_WAOUT); bf16* wrin = (bf16*)(F.ws + WS_WRIN); bf16* wrout = (bf16*)(F.ws + WS_WROUT); bf16* w1a1 = (bf16*)(F.ws + WS_W1A1);
    constexpr int I_AIN = 16 * 80, I_SQ = 16 * 32, I_L1 = 16 * 2;
    constexpr int I_L2 = 32;
    constexpr int NITEMS = I_AIN + 6 * I_SQ + 4 * I_L1 + 2 * I_L2;
    for (int it = (part == 1 ? I_AIN : 0) + gw; it < (part == 0 ? I_AIN : NITEMS); it += NGW) {
        int r = it;
        if (r < I_AIN) { p0_transpose_item(F.a_w_in, DM, LDQ, wain, 0, scr, r, F.lane); continue; } r -= I_AIN;
        if (r < I_SQ) { p0_transpose_item(F.a_w_out, DM, DM, waout, 0, scr, r, F.lane); continue; } r -= I_SQ;
        if (r < 4 * I_SQ) { const int c = r / I_SQ; p0_transpose_item(F.r_w_in + (size_t)c * DM * DM, DM, DM, wrin, c * DM, scr, r - c * I_SQ, F.lane); continue; } r -= 4 * I_SQ;
        if (r < I_SQ) { p0_transpose_item(F.r_w_out, DM, DM, wrout, 0, scr, r, F.lane); continue; } r -= I_SQ;
        if (r < 4 * I_L1) { const int q = r / I_L1; p0_transpose_item(q < 2 ? F.w1 : F.a1, DM, 64, w1a1, 64 * q, scr, r - q * I_L1, F.lane, F.mu + (q < 2 ? 4 : 5) * DM, (q & 1) == 0); continue; } r -= 4 * I_L1;
        if (r < I_L2) { p0_transpose_item(F.w2, 64, DM, (bf16*)(F.ws + 18 * MiB + 256 * 1024), 0, scr, r, F.lane); continue; } r -= I_L2;
        p0_transpose_item(F.a2, 64, DM, (bf16*)(F.ws + 18 * MiB + 384 * 1024), 0, scr, r, F.lane);
    }
    if (part == 1) return;
    bf16* xa = (bf16*)(F.ws + WS_XA);
    for (int m = gw; m < MPAD; m += NGW) {
        f32x4 v[4];
        if (m < MTOK) rms_row(h0_row(F, m), F.norm_gain, F.lane, v);
        else { for (int j = 0; j < 4; ++j) v[j] = (f32x4){0.f, 0.f, 0.f, 0.f}; }
        store_bf16_row(xa + (size_t)m * DM, F.lane, v);
    }
}

namespace att {
constexpr int KSTR = 72, VSTR = 260;
constexpr int BEXT = 192;
constexpr int K_OFF = 0, V_OFF = 256 * KSTR * 2, B_OFF = V_OFF + 64 * VSTR * 2, ST_OFF = B_OFF + NH * BEXT * 4, END_OFF = ST_OFF + NWAVES * 4096;
static_assert(END_OFF <= RING_BYTES && (B_OFF % 16) == 0 && (ST_OFF % 16) == 0, "attention LDS");
__device__ __forceinline__ int crow(int r, int hi) { return (r & 3) + 8 * (r >> 2) + 4 * hi; }
__device__ __forceinline__ int t5_bucket(int rel) {
    if (rel < 16) return rel;
    int b = 16;
    b += rel >= 19; b += rel >= 21; b += rel >= 24; b += rel >= 27; b += rel >= 31; b += rel >= 35; b += rel >= 40; b += rel >= 46;
    b += rel >= 52; b += rel >= 59; b += rel >= 67; b += rel >= 77; b += rel >= 87; b += rel >= 99; b += rel >= 113;
    return b;
}
__device__ __forceinline__ void attn_wave(LAS unsigned char* lds, const bf16* qkvg, bf16* og, int qrow0, int nq, int jt, int kt_lo, int h, float sink2, int lane, int wave) {
    const int c = lane & 31, hh = lane >> 5;
    const LAS float* bp = (const LAS float*)(lds + B_OFF) + h * BEXT + 5 + c - 4 * hh;
    const int qrow = qrow0 + (c < nq ? c : nq - 1);
    bf16x8 qf[4];
#pragma unroll
    for (int s = 0; s < 4; ++s) qf[s] = *(const GAS bf16x8*)(qkvg + (size_t)qrow * LDQ + h * HD + 16 * s + 8 * hh);
    const LAS unsigned char* kbase = lds + K_OFF + ((32 * jt + c) * KSTR + 8 * hh) * 2;
    const LAS unsigned char* vbase = lds + V_OFF + (c * VSTR + 32 * jt + 4 * hh) * 2;
    f32x16 sc[5];
#pragma unroll
    for (int kt = 0; kt < 5; ++kt) {
        f32x16 a;
#pragma unroll
        for (int r = 0; r < 16; ++r) a[r] = bp[155 - (32 * kt + (r & 3) + 8 * (r >> 2))];
#pragma unroll
        for (int s = 0; s < 4; ++s) { const bf16x8 kf = *(const LAS bf16x8*)(kbase + kt * (32 * KSTR * 2) + 32 * s); a = __builtin_amdgcn_mfma_f32_32x32x16_bf16(kf, qf[s], a, 0, 0, 0); }
        if (kt < kt_lo) {
#pragma unroll
            for (int r = 0; r < 16; ++r) a[r] = -1e30f;
        }
        sc[kt] = a;
    }
    float mx = -1e30f;
#pragma unroll
    for (int kt = 0; kt < 5; ++kt)
#pragma unroll
        for (int r = 0; r < 16; ++r) mx = fmaxf(mx, sc[kt][r]);
    mx = fmaxf(mx, __shfl_xor(mx, 32)); mx = fmaxf(mx, sink2);
    float l = 0.f;
#pragma unroll
    for (int kt = 0; kt < 5; ++kt)
#pragma unroll
        for (int r = 0; r < 16; ++r) { const float p = __builtin_amdgcn_exp2f(sc[kt][r] - mx); sc[kt][r] = p; l += p; }
    l += __shfl_xor(l, 32); l += __builtin_amdgcn_exp2f(sink2 - mx);
    const float linv = __builtin_amdgcn_rcpf(l);
    f32x16 o[2]; o[0] = f32x16{}; o[1] = f32x16{};
#pragma unroll
    for (int kt = 0; kt < 5; ++kt) {
#pragma unroll
        for (int s2 = 0; s2 < 2; ++s2) {
            v4u pw; pw.x = pk2(sc[kt][8 * s2 + 0] * linv, sc[kt][8 * s2 + 1] * linv); pw.y = pk2(sc[kt][8 * s2 + 2] * linv, sc[kt][8 * s2 + 3] * linv);
            pw.z = pk2(sc[kt][8 * s2 + 4] * linv, sc[kt][8 * s2 + 5] * linv); pw.w = pk2(sc[kt][8 * s2 + 6] * linv, sc[kt][8 * s2 + 7] * linv);
            const bf16x8 pf = __builtin_bit_cast(bf16x8, pw);
#pragma unroll
            for (int dh = 0; dh < 2; ++dh) {
                const LAS unsigned char* vp = vbase + (32 * dh * VSTR + 32 * kt + 16 * s2) * 2;
                const s16x4 lo = *(const LAS s16x4*)vp, hi = *(const LAS s16x4*)(vp + 16);
                const bf16x8 vf = (bf16x8){lo[0], lo[1], lo[2], lo[3], hi[0], hi[1], hi[2], hi[3]};
                o[dh] = __builtin_amdgcn_mfma_f32_32x32x16_bf16(pf, vf, o[dh], 0, 0, 0);
            }
        }
    }
    LAS float* stg = (LAS float*)(lds + ST_OFF + wave * 4096);
    const int srow = lane >> 1, sc0 = (lane & 1) * 16;
    const size_t grow = (size_t)(qrow0 + srow);
#pragma unroll
    for (int dh = 0; dh < 2; ++dh) {
#pragma unroll
        for (int r = 0; r < 16; ++r) stg[((r & 3) + 8 * (r >> 2) + 4 * hh) * 32 + c] = o[dh][r];
        asm volatile("s_waitcnt lgkmcnt(0)" ::: "memory");
        f32x4 x[4];
#pragma unroll
        for (int i = 0; i < 4; ++i) x[i] = *(const LAS f32x4*)(stg + srow * 32 + sc0 + 4 * i);
        asm volatile("s_waitcnt lgkmcnt(0)" ::: "memory");
        if (srow < nq) {
            const int col = h * HD + 32 * dh + sc0;
            const v4u g0 = *(const GAS v4u*)(qkvg + grow * LDQ + 1536 + col), g1 = *(const GAS v4u*)(qkvg + grow * LDQ + 1536 + col + 8);
            const unsigned gw[8] = {g0.x, g0.y, g0.z, g0.w, g1.x, g1.y, g1.z, g1.w};
            unsigned ow[8];
#pragma unroll
            for (int e = 0; e < 8; ++e) { const float ga = __builtin_bit_cast(float, gw[e] << 16), gb = __builtin_bit_cast(float, gw[e] & 0xffff0000u);
                const float ya = x[e >> 1][(e & 1) * 2] * ga * __builtin_amdgcn_rcpf(1.0f + __builtin_amdgcn_exp2f(-1.4426950408889634f * ga)), yb = x[e >> 1][(e & 1) * 2 + 1] * gb * __builtin_amdgcn_rcpf(1.0f + __builtin_amdgcn_exp2f(-1.4426950408889634f * gb)); ow[e] = pk2(ya, yb); }
            *(GAS v4u*)(og + grow * DM + col) = (v4u){ow[0], ow[1], ow[2], ow[3]}; *(GAS v4u*)(og + grow * DM + col + 8) = (v4u){ow[4], ow[5], ow[6], ow[7]};
        }
    }
}
constexpr int N_PROMPT_UNITS = NB * NKV * 33, N_SAMPLE_UNITS = DBATCH * NKV, N_COPY_UNITS = 8, N_UNITS = N_PROMPT_UNITS + N_SAMPLE_UNITS + N_COPY_UNITS;
}
__device__ __forceinline__ void p2_attention(Frame& F) {
    using namespace att;
    const bf16* qkvg = (const bf16*)(F.ws + WS_QKVG); bf16* og = (bf16*)(F.ws + WS_XA);
    LAS unsigned char* lds = F.lds + RING_OFF;
    for (int i = F.tid; i < NH * BEXT; i += NWAVES * 64) { const int h = i / BEXT, rel = i % BEXT - 32;
        ((LAS float*)(lds + B_OFF))[i] = (rel >= 0 && rel < 128) ? F.table[t5_bucket(rel) * NH + h] * LOG2E : -1e30f; }
    __syncthreads();
#pragma unroll 1
    for (int ui = F.vcu; ui < N_UNITS; ui += F.G) {
        int u;
        if (ui < 512) u = (ui >> 5) * 33 + (ui & 31);
        else if (ui < 528) u = (ui - 512) * 33 + 32;
        else u = ui;
        if (u >= N_PROMPT_UNITS + N_SAMPLE_UNITS) {
            const int cu = u - (N_PROMPT_UNITS + N_SAMPLE_UNITS);
            bf16* kvp = (bf16*)(F.ws + WS_KVP); bf16* kvs = (bf16*)(F.ws + WS_KVS);
            for (int i = cu * 512 + F.tid; i < 1024 * 64; i += N_COPY_UNITS * 512) {
                const int rr = i >> 6, ch = i & 63;
                const int srow = rr < 512 ? (rr >> 7) * LP + (LP - WIN) + (rr & 127) : MPR + (rr - 512);
                const v4u x = *(const GAS v4u*)(qkvg + (size_t)srow * LDQ + 1024 + 8 * ch);
                bf16* dst = rr < 512 ? kvp + (size_t)rr * 512 + 8 * ch : kvs + (size_t)(rr - 512) * 512 + 8 * ch;
                *(GAS v4u*)dst = x;
            }
            continue;
        }
        int kvh, nwu, qbase, q0, kt0;
        const bool is_prompt = u < N_PROMPT_UNITS;
        const int row = F.tid >> 1, half = F.tid & 1;
        if (is_prompt) {
            const int qblk = u % 33, b = u / (33 * NKV); kvh = (u / 33) % NKV;
            q0 = 128 * qblk; nwu = 16; qbase = b * LP + q0; kt0 = qblk == 0 ? 4 : 0;
            int pos = q0 - 128 + row; pos = pos < 0 ? 0 : (pos > LP - 1 ? LP - 1 : pos);
            const bf16* src = qkvg + (size_t)(b * LP + pos) * LDQ + 1024 + kvh * HD + half * 32;
#pragma unroll
            for (int i = 0; i < 4; ++i) { const v4u kv = *(const GAS v4u*)(src + 8 * i); *(LAS v4u*)(lds + K_OFF + (row * KSTR + half * 32 + 8 * i) * 2) = kv; }
#pragma unroll
            for (int i = 0; i < 4; ++i) { const v4u vv = *(const GAS v4u*)(src + 256 + 8 * i); const unsigned w[4] = {vv.x, vv.y, vv.z, vv.w};
#pragma unroll
                for (int e = 0; e < 8; ++e) { const bf16 x = (bf16)((w[e >> 1] >> ((e & 1) * 16)) & 0xffffu); *(LAS bf16*)(lds + V_OFF + ((half * 32 + 8 * i + e) * VSTR + row) * 2) = x; } }
        } else {
            const int su = u - N_PROMPT_UNITS, sb = su / NKV; kvh = su % NKV;
            q0 = LP; nwu = 4; qbase = MPR + sb * DSEQ; kt0 = 0;
            if (row < 160) {
#pragma unroll
                for (int i = 0; i < 4; ++i) {
                    v4u kq = (v4u){0u, 0u, 0u, 0u}, vq = (v4u){0u, 0u, 0u, 0u};
                    if (row < 128) {
                        const float* ck = F.cache_k + (((size_t)sb * WIN + row) * NKV + kvh) * HD + half * 32 + 8 * i; const float* cv = F.cache_v + (((size_t)sb * WIN + row) * NKV + kvh) * HD + half * 32 + 8 * i;
                        const f32x4 a0 = *(const GAS f32x4*)ck, a1 = *(const GAS f32x4*)(ck + 4), b0 = *(const GAS f32x4*)cv, b1 = *(const GAS f32x4*)(cv + 4);
                        kq = (v4u){pk2(a0.x, a0.y), pk2(a0.z, a0.w), pk2(a1.x, a1.y), pk2(a1.z, a1.w)}; vq = (v4u){pk2(b0.x, b0.y), pk2(b0.z, b0.w), pk2(b1.x, b1.y), pk2(b1.z, b1.w)};
                    } else if (row < 132) {
                        const bf16* src = qkvg + (size_t)(MPR + sb * DSEQ + (row - 128)) * LDQ + 1024 + kvh * HD + half * 32 + 8 * i;
                        kq = *(const GAS v4u*)src; vq = *(const GAS v4u*)(src + 256);
                    }
                    *(LAS v4u*)(lds + K_OFF + (row * KSTR + half * 32 + 8 * i) * 2) = kq;
                    const unsigned w[4] = {vq.x, vq.y, vq.z, vq.w};
#pragma unroll
                    for (int e = 0; e < 8; ++e) { const bf16 x = (bf16)((w[e >> 1] >> ((e & 1) * 16)) & 0xffffu); *(LAS bf16*)(lds + V_OFF + ((half * 32 + 8 * i + e) * VSTR + row) * 2) = x; }
                }
            }
        }
        __syncthreads();
#pragma unroll 1
        for (int wu = F.wave; wu < nwu; wu += NWAVES) {
            const int hg = wu & 3, j = wu >> 2, h = kvh * 4 + hg;
            int nq = is_prompt ? LP - (q0 + 32 * j) : DSEQ; nq = nq < 32 ? nq : 32;
            if (nq > 0) attn_wave(lds, qkvg, og, qbase + 32 * j, nq, j, kt0 - j, h, F.sinks[h] * LOG2E, F.lane, F.wave);
        }
        __syncthreads();
    }
}

__device__ __forceinline__ void rms_row8(const bf16* xrow, const float (&g8)[2][8], int lane, float (&x)[2][8]) {
    float s = 0.f;
#pragma unroll
    for (int j = 0; j < 2; ++j) { const v4u w = *(const GAS v4u*)(xrow + 8 * lane + 512 * j); const unsigned ww[4] = {w.x, w.y, w.z, w.w};
#pragma unroll
        for (int i = 0; i < 4; ++i) { x[j][2 * i] = __builtin_bit_cast(float, ww[i] << 16); x[j][2 * i + 1] = __builtin_bit_cast(float, ww[i] & 0xffff0000u); s += x[j][2 * i] * x[j][2 * i] + x[j][2 * i + 1] * x[j][2 * i + 1]; } }
    const float rstd = 1.0f / sqrtf(wave_sum(s) * (1.f / DM) + RMS_EPS);
#pragma unroll
    for (int j = 0; j < 2; ++j)
#pragma unroll
        for (int i = 0; i < 8; ++i) x[j][i] = x[j][i] * rstd * g8[j][i];
}
__device__ __forceinline__ void wait_row_tiles(const unsigned* cnt, int ra, int rb, unsigned full) {
    if (threadIdx.x < 64) {
        for (int pm = (ra < 0 ? 0 : ra) >> 8; pm <= (rb >> 8); ++pm)
            while (__hip_atomic_load(cnt + pm, __ATOMIC_RELAXED, __HIP_MEMORY_SCOPE_AGENT) < full) __builtin_amdgcn_s_sleep(8);
        __builtin_amdgcn_fence(__ATOMIC_ACQUIRE, "agent");
    }
    __syncthreads();
}
__device__ __forceinline__ void flow_range(const Frame& F, int seg, int nlate_wg, int rows_early, int& r0, int& r1, int& g0, int& g1) {
    const int bx = (int)blockIdx.x;
    if (seg == 0) { if (bx < nlate_wg) { r0 = r1 = g0 = g1 = 0; return; } const long wb = (long)(bx - nlate_wg) * NWAVES, w = wb + F.wave, NW = (long)(F.G - nlate_wg) * NWAVES;
        r0 = (int)((w * rows_early) / NW); r1 = (int)(((w + 1) * rows_early) / NW); g0 = (int)((wb * rows_early) / NW); g1 = (int)(((wb + NWAVES) * rows_early) / NW); }
    else { const long wb = (long)bx * NWAVES, w = wb + F.wave, NW = (long)F.G * NWAVES; const int nl = MTOK - rows_early;
        r0 = rows_early + (int)((w * nl) / NW); r1 = rows_early + (int)(((w + 1) * nl) / NW); g0 = rows_early + (int)((wb * nl) / NW); g1 = rows_early + (int)(((wb + NWAVES) * nl) / NW); }
}
__device__ __forceinline__ void p4_mix(Frame& F) {
    const int gw = F.vcu * NWAVES + F.wave, NGW = F.G * NWAVES;
    const bf16* h1 = (const bf16*)(F.ws + WS_H1); const float* gain = F.norm_gain + DM;
    float g8[2][8], mu8[4][2][8];
#pragma unroll
    for (int j = 0; j < 2; ++j) { const f32x4 a = *(const GAS f32x4*)(gain + 8 * F.lane + 512 * j), b = *(const GAS f32x4*)(gain + 8 * F.lane + 512 * j + 4);
        g8[j][0] = a.x; g8[j][1] = a.y; g8[j][2] = a.z; g8[j][3] = a.w; g8[j][4] = b.x; g8[j][5] = b.y; g8[j][6] = b.z; g8[j][7] = b.w;
#pragma unroll
        for (int c = 0; c < 4; ++c) { const f32x4 a2 = *(const GAS f32x4*)(F.mu + c * DM + 8 * F.lane + 512 * j), b2 = *(const GAS f32x4*)(F.mu + c * DM + 8 * F.lane + 512 * j + 4);
            mu8[c][j][0] = a2.x; mu8[c][j][1] = a2.y; mu8[c][j][2] = a2.z; mu8[c][j][3] = a2.w; mu8[c][j][4] = b2.x; mu8[c][j][5] = b2.y; mu8[c][j][6] = b2.z; mu8[c][j][7] = b2.w; } }
    float xp[2][8];
#pragma unroll
    for (int j = 0; j < 2; ++j)
#pragma unroll
        for (int i = 0; i < 8; ++i) xp[j][i] = 0.f;
    const int r0 = (int)(((long)gw * MTOK) / NGW), r1 = (int)(((long)(gw + 1) * MTOK) / NGW);
    bool have_prev = false;
#pragma unroll 1
    for (int m = r0; m < r1; ++m) {
        float x[2][8];
        rms_row8(h1 + (size_t)m * DM, g8, F.lane, x);
        bool first; const float* sh = nullptr;
        if (m < MPR) { first = (m % LP) == 0; } else { first = ((m - MPR) & 3) == 0; sh = F.state_shift + (size_t)((m - MPR) >> 2) * DM; }
        if (first) {
#pragma unroll
            for (int j = 0; j < 2; ++j) { f32x4 a = (f32x4){0.f, 0.f, 0.f, 0.f}, b = a; if (sh) { a = *(const GAS f32x4*)(sh + 8 * F.lane + 512 * j); b = *(const GAS f32x4*)(sh + 8 * F.lane + 512 * j + 4); }
                xp[j][0] = a.x; xp[j][1] = a.y; xp[j][2] = a.z; xp[j][3] = a.w; xp[j][4] = b.x; xp[j][5] = b.y; xp[j][6] = b.z; xp[j][7] = b.w; }
        } else if (!have_prev) rms_row8(h1 + (size_t)(m - 1) * DM, g8, F.lane, xp);
        {
            bf16* xr = m < MPR ? (bf16*)(F.dob + DO_XN1) + (size_t)m * DM : (bf16*)(F.ws + WS_XN1S) + (size_t)(m - MPR) * DM;
#pragma unroll
            for (int j = 0; j < 2; ++j) { v4u o; o.x = pk2(x[j][0], x[j][1]); o.y = pk2(x[j][2], x[j][3]); o.z = pk2(x[j][4], x[j][5]); o.w = pk2(x[j][6], x[j][7]); *(GAS v4u*)(xr + 8 * F.lane + 512 * j) = o; }
            if (first && sh) { bf16* sr = (bf16*)(F.ws + WS_XN1S) + (size_t)(DBATCH * DSEQ + ((m - MPR) >> 2)) * DM;
#pragma unroll
                for (int j = 0; j < 2; ++j) { v4u o; o.x = pk2(xp[j][0], xp[j][1]); o.y = pk2(xp[j][2], xp[j][3]); o.z = pk2(xp[j][4], xp[j][5]); o.w = pk2(xp[j][6], xp[j][7]); *(GAS v4u*)(sr + 8 * F.lane + 512 * j) = o; } }
        }
#pragma unroll
        for (int c = 0; c < 4; ++c) {
            bf16* dst = (bf16*)(F.ws + WS_MIX + c * MIX_STRIDE) + (size_t)m * DM;
#pragma unroll
            for (int j = 0; j < 2; ++j) { float v[8];
#pragma unroll
                for (int i = 0; i < 8; ++i) v[i] = x[j][i] + (xp[j][i] - x[j][i]) * mu8[c][j][i];
                v4u o; o.x = pk2(v[0], v[1]); o.y = pk2(v[2], v[3]); o.z = pk2(v[4], v[5]); o.w = pk2(v[6], v[7]);
                *(GAS v4u*)(dst + 8 * F.lane + 512 * j) = o; }
        }
        float* d = nullptr;
        if (m < MPR) { if ((m % LP) == LP - 1) d = (float*)(F.ws + WS_SHP) + (size_t)(m / LP) * DM; }
        else if (((m - MPR) & 3) == 3) d = F.out + O_SHS + (size_t)((m - MPR) >> 2) * DM;
        if (d) {
#pragma unroll
            for (int j = 0; j < 2; ++j) { *(GAS f32x4*)(d + 8 * F.lane + 512 * j) = (f32x4){x[j][0], x[j][1], x[j][2], x[j][3]}; *(GAS f32x4*)(d + 8 * F.lane + 512 * j + 4) = (f32x4){x[j][4], x[j][5], x[j][6], x[j][7]}; } }
#pragma unroll
        for (int j = 0; j < 2; ++j)
#pragma unroll
            for (int i = 0; i < 8; ++i) xp[j][i] = x[j][i];
        have_prev = true;
    }
}

__device__ __forceinline__ void p5_lora1_combine(Frame& F) {
    const int gw = F.vcu * NWAVES + F.wave, NGW = F.G * NWAVES;
    const float* U = (const float*)(F.ws + WS_U); float* t12 = (float*)(F.ws + WS_T12); unsigned char* t12b = F.ws + WS_T12B;
    const int j = F.lane;
    const int r0 = (int)(((long)gw * MTOK) / NGW), r1 = (int)(((long)(gw + 1) * MTOK) / NGW);
    for (int m = r0; m < r1; ++m) {
        const float* cur; const float* prev = nullptr;
        if (m < MPR) { cur = U + (size_t)m * 256; if ((m % LP) != 0) prev = cur - 256; }
        else { const int i = m - MPR; cur = U + (size_t)(U_SROW + i) * 256; prev = (i & 3) == 0 ? U + (size_t)(U_SROW + DBATCH * DSEQ + (i >> 2)) * 256 : cur - 256; }
        float a = cur[j], b2 = cur[128 + j];
        if (prev) { a += prev[64 + j]; b2 += prev[192 + j]; }
        a = tanhf(a);
        t12[(size_t)m * 128 + j] = a; t12[(size_t)m * 128 + 64 + j] = b2;
        if (m < MPR) { const int bb = m / LP, t = m - bb * LP;
            unsigned char* ob = t12b + ((size_t)((bb * 129 + (t >> 5)) * 8) * 64 + (t & 31)) * 16 + ((j >> 4) * 64 + 32 * ((j >> 3) & 1)) * 16 + (j & 7) * 2;
            *(bf16*)ob = (bf16)f2bf(a); *(bf16*)(ob + 4 * 1024) = (bf16)f2bf(b2); }
    }
}

__device__ __forceinline__ void wkv_seq_unit(Frame& F, LAS float* wl, int row0, int T, int h, const float* S0, float* Sout, int lane, bf16* hout = nullptr) {
    asm volatile("" : "+v"(lane));
    const bf16* R = (const bf16*)(F.dob); const bf16* Kb = (const bf16*)(F.dob + RKV_STRIDE); const bf16* Vb = (const bf16*)(F.dob + 2 * RKV_STRIDE);
    const bf16* Gb = (const bf16*)(F.ws + WS_G); const float* t12 = (const float*)(F.ws + WS_T12); bf16* og2 = (bf16*)(F.dob + DO_OG2);
    const int ch = h * HD + lane;
    unsigned w2p[32], a2p[32]; float S[64];
#pragma unroll
    for (int i = 0; i < 32; ++i) { w2p[i] = pk2(F.w2[(2 * i) * DM + ch], F.w2[(2 * i + 1) * DM + ch]); a2p[i] = pk2(F.a2[(2 * i) * DM + ch], F.a2[(2 * i + 1) * DM + ch]); }
    const float w0c = F.w0[ch], a0c = F.a0[ch], kkc = F.k_k[ch], kac = F.k_a[ch], rkc = F.r_k[ch], lng = F.ln_g[ch], lnb = F.ln_b[ch];
    if (S0) {
#pragma unroll
        for (int i = 0; i < 16; ++i) { const f32x4 v = *(const GAS f32x4*)(S0 + (size_t)lane * 64 + 4 * i); S[4 * i] = v.x; S[4 * i + 1] = v.y; S[4 * i + 2] = v.z; S[4 * i + 3] = v.w; }
    } else {
#pragma unroll
        for (int i = 0; i < 64; ++i) S[i] = 0.f;
    }
    for (int t = 0; t < T; ++t) {
        const size_t m = (size_t)(row0 + t);
#if WKV_EXP >= 30
        if (T == LP && t == WKV_DUMP_T) { float* dp = (float*)(F.ws + 184 * MiB) + (size_t)((row0 / LP) * NH + h) * 4096;
#pragma unroll
            for (int i = 0; i < 16; ++i) *(GAS f32x4*)(dp + (size_t)lane * 64 + 4 * i) = (f32x4){S[4 * i], S[4 * i + 1], S[4 * i + 2], S[4 * i + 3]}; }
#endif
#pragma unroll
        for (int i = 0; i < 32; ++i) { asm volatile("" : "+v"(w2p[i])); asm volatile("" : "+v"(a2p[i])); }
        const float r = bf2f(R[m * DM + ch]), k = bf2f(Kb[m * DM + ch]), v = bf2f(Vb[m * DM + ch]), g = bf2f(Gb[m * DM + ch]);
        wl[lane] = t12[m * 128 + lane]; wl[64 + lane] = t12[m * 128 + 64 + lane];
        asm volatile("s_waitcnt lgkmcnt(0)" ::: "memory");
        float z = w0c, az = a0c;
#pragma unroll
        for (int i = 0; i < 16; ++i) { const f32x4 x = *(const LAS f32x4*)(wl + 4 * i), y = *(const LAS f32x4*)(wl + 64 + 4 * i);
            z += x.x * __builtin_bit_cast(float, w2p[2 * i] << 16) + x.y * __builtin_bit_cast(float, w2p[2 * i] & 0xffff0000u) + x.z * __builtin_bit_cast(float, w2p[2 * i + 1] << 16) + x.w * __builtin_bit_cast(float, w2p[2 * i + 1] & 0xffff0000u);
            az += y.x * __builtin_bit_cast(float, a2p[2 * i] << 16) + y.y * __builtin_bit_cast(float, a2p[2 * i] & 0xffff0000u) + y.z * __builtin_bit_cast(float, a2p[2 * i + 1] << 16) + y.w * __builtin_bit_cast(float, a2p[2 * i + 1] & 0xffff0000u); }
        const float a = 1.0f / (1.0f + __expf(-az)), sg = 1.0f / (1.0f + __expf(-z)), dec = __expf(-0.6065306597126334f * sg);
        float kk = k * kkc; const float n2 = wave_sum(kk * kk); kk = kk / fmaxf(sqrtf(n2), 1e-12f);
        const float kh = k * (1.0f + (a - 1.0f) * kac);
        const float rk = wave_sum(r * kh * rkc);
        wl[128 + lane] = -kk; wl[192 + lane] = kk * a; wl[256 + lane] = dec; wl[320 + lane] = kh; wl[384 + lane] = r;
        asm volatile("s_waitcnt lgkmcnt(0)" ::: "memory");
        float sa = 0.f;
#pragma unroll
        for (int i = 0; i < 16; ++i) { const f32x4 x = *(const LAS f32x4*)(wl + 128 + 4 * i); sa += S[4 * i] * x.x + S[4 * i + 1] * x.y + S[4 * i + 2] * x.z + S[4 * i + 3] * x.w; }
        float y = 0.f;
#pragma unroll
        for (int i = 0; i < 16; ++i) {
            const f32x4 bq = *(const LAS f32x4*)(wl + 192 + 4 * i), wq = *(const LAS f32x4*)(wl + 256 + 4 * i), kq = *(const LAS f32x4*)(wl + 320 + 4 * i), rq = *(const LAS f32x4*)(wl + 384 + 4 * i);
#if WKV_EXP == 45 && WKV_VAR == 2
            if (hout) sa = 0.f;
#endif
            S[4 * i] = S[4 * i] * wq.x + sa * bq.x + v * kq.x; S[4 * i + 1] = S[4 * i + 1] * wq.y + sa * bq.y + v * kq.y;
            S[4 * i + 2] = S[4 * i + 2] * wq.z + sa * bq.z + v * kq.z; S[4 * i + 3] = S[4 * i + 3] * wq.w + sa * bq.w + v * kq.w;
            y += S[4 * i] * rq.x + S[4 * i + 1] * rq.y + S[4 * i + 2] * rq.z + S[4 * i + 3] * rq.w; }
        const float mean = wave_sum(y) * (1.f / 64.f), dv = y - mean, var = wave_sum(dv * dv) * (1.f / 64.f);
        const float yn = dv * (1.0f / sqrtf(var + GN_EPS)) * lng + lnb + rk * v;
        if (!hout) og2[m * DM + ch] = (bf16)f2bf(yn * g / (1.0f + __expf(-g)));
        asm volatile("" ::: "memory");
    }
    if (hout) {
#pragma unroll
        for (int i = 0; i < 16; ++i) *(GAS unsigned long long*)(hout + (size_t)lane * 64 + 4 * i) = (unsigned long long)pk2(S[4 * i], S[4 * i + 1]) | ((unsigned long long)pk2(S[4 * i + 2], S[4 * i + 3]) << 32);
        return;
    }
#pragma unroll
    for (int i = 0; i < 16; ++i) *(GAS f32x4*)(Sout + (size_t)lane * 64 + 4 * i) = (f32x4){S[4 * i], S[4 * i + 1], S[4 * i + 2], S[4 * i + 3]};
}
#define SEQ_FENCE() do { asm volatile("" ::: "memory"); __builtin_amdgcn_sched_barrier(0); } while (0)
__device__ __forceinline__ void wkv_seq4_unit(Frame& F, LAS float* wl, int row0, int h, const float* S0, float* Sout, int lane) {
    asm volatile("" : "+v"(lane));
    const bf16* R = (const bf16*)(F.dob); const bf16* Kb = (const bf16*)(F.dob + RKV_STRIDE); const bf16* Vb = (const bf16*)(F.dob + 2 * RKV_STRIDE);
    const bf16* Gb = (const bf16*)(F.ws + WS_G); const float* t12 = (const float*)(F.ws + WS_T12); bf16* og2 = (bf16*)(F.dob + DO_OG2);
    const int ch = h * HD + lane;
    constexpr float L2E = 1.4426950408889634f;
    {
        float r[4], k[4], v[4], g[4];
#pragma unroll
        for (int t = 0; t < 4; ++t) { const size_t m = (size_t)(row0 + t); r[t] = bf2f(R[m * DM + ch]); k[t] = bf2f(Kb[m * DM + ch]); v[t] = bf2f(Vb[m * DM + ch]); g[t] = bf2f(Gb[m * DM + ch]);
            wl[t * 128 + lane] = t12[m * 128 + lane]; wl[t * 128 + 64 + lane] = t12[m * 128 + 64 + lane]; }
        const float w0c = F.w0[ch], a0c = F.a0[ch], kkc = F.k_k[ch], kac = F.k_a[ch], rkc = F.r_k[ch];
        float z[4], az[4];
#pragma unroll
        for (int t = 0; t < 4; ++t) { z[t] = w0c; az[t] = a0c; }
        asm volatile("s_waitcnt lgkmcnt(0)" ::: "memory");
        SEQ_FENCE();
#pragma unroll
        for (int i = 0; i < 16; ++i) {
            float w4[4], a4[4];
#pragma unroll
            for (int e = 0; e < 4; ++e) { w4[e] = F.w2[(4 * i + e) * DM + ch]; a4[e] = F.a2[(4 * i + e) * DM + ch]; }
#pragma unroll
            for (int t = 0; t < 4; ++t) { const f32x4 x = *(const LAS f32x4*)(wl + t * 128 + 4 * i), y = *(const LAS f32x4*)(wl + t * 128 + 64 + 4 * i);
                z[t] += x.x * w4[0] + x.y * w4[1] + x.z * w4[2] + x.w * w4[3]; az[t] += y.x * a4[0] + y.y * a4[1] + y.z * a4[2] + y.w * a4[3]; }
            if ((i & 3) == 3) SEQ_FENCE(); }
        asm volatile("s_waitcnt lgkmcnt(0)" ::: "memory");
#pragma unroll
        for (int t = 0; t < 4; ++t) {
            const float a = __builtin_amdgcn_rcpf(1.0f + __builtin_amdgcn_exp2f(-az[t] * L2E)), sg = __builtin_amdgcn_rcpf(1.0f + __builtin_amdgcn_exp2f(-z[t] * L2E)), dec = __builtin_amdgcn_exp2f((-0.6065306597126334f * L2E) * sg);
            float kk = k[t] * kkc; const float n2 = wave_sum(kk * kk); kk = kk * __builtin_amdgcn_rsqf(fmaxf(n2, 1e-24f));
            const float kh = k[t] * (1.0f + (a - 1.0f) * kac);
            const float rk = wave_sum(r[t] * kh * rkc);
            LAS float* w = wl + t * 512;
            w[lane] = -kk; w[64 + lane] = kk * a; w[128 + lane] = dec; w[192 + lane] = kh; w[256 + lane] = r[t]; w[320 + lane] = v[t]; w[384 + lane] = g[t]; w[448 + lane] = rk;
        }
    }
    SEQ_FENCE();
    float S[64];
#pragma unroll
    for (int i = 0; i < 16; ++i) { const f32x4 x = *(const GAS f32x4*)(S0 + (size_t)lane * 64 + 4 * i); S[4 * i] = x.x; S[4 * i + 1] = x.y; S[4 * i + 2] = x.z; S[4 * i + 3] = x.w; }
    const float lng = F.ln_g[ch], lnb = F.ln_b[ch];
    asm volatile("s_waitcnt lgkmcnt(0)" ::: "memory");
#pragma unroll 1
    for (int t = 0; t < 4; ++t) {
        const LAS float* w = wl + t * 512;
        float sa = 0.f;
#pragma unroll
        for (int i = 0; i < 16; ++i) { const f32x4 x = *(const LAS f32x4*)(w + 4 * i); sa += S[4 * i] * x.x + S[4 * i + 1] * x.y + S[4 * i + 2] * x.z + S[4 * i + 3] * x.w; }
        const float v = w[320 + lane], g = w[384 + lane], rk = w[448 + lane];
        float y = 0.f;
#pragma unroll
        for (int i = 0; i < 16; ++i) {
            const f32x4 bq = *(const LAS f32x4*)(w + 64 + 4 * i), wq = *(const LAS f32x4*)(w + 128 + 4 * i), kq = *(const LAS f32x4*)(w + 192 + 4 * i), rq = *(const LAS f32x4*)(w + 256 + 4 * i);
            S[4 * i] = S[4 * i] * wq.x + sa * bq.x + v * kq.x; S[4 * i + 1] = S[4 * i + 1] * wq.y + sa * bq.y + v * kq.y;
            S[4 * i + 2] = S[4 * i + 2] * wq.z + sa * bq.z + v * kq.z; S[4 * i + 3] = S[4 * i + 3] * wq.w + sa * bq.w + v * kq.w;
            y += S[4 * i] * rq.x + S[4 * i + 1] * rq.y + S[4 * i + 2] * rq.z + S[4 * i + 3] * rq.w; }
        const float mean = wave_sum(y) * (1.f / 64.f), dv = y - mean, var = wave_sum(dv * dv) * (1.f / 64.f);
        const float yn = dv * __builtin_amdgcn_rsqf(var + GN_EPS) * lng + lnb + rk * v;
        og2[(size_t)(row0 + t) * DM + ch] = (bf16)f2bf(yn * g * __builtin_amdgcn_rcpf(1.0f + __builtin_amdgcn_exp2f(-g * L2E)));
        asm volatile("" ::: "memory");
    }
#pragma unroll
    for (int i = 0; i < 16; ++i) *(GAS f32x4*)(Sout + (size_t)lane * 64 + 4 * i) = (f32x4){S[4 * i], S[4 * i + 1], S[4 * i + 2], S[4 * i + 3]};
    asm volatile("s_waitcnt lgkmcnt(0)" ::: "memory");
}
__device__ __forceinline__ void p6_wkv_seq(Frame& F) {
    LAS float* wl = (LAS float*)(F.lds + RING_OFF) + F.wave * 512;
    constexpr int NSU = DBATCH * NH;
    for (int u = F.wave * F.G + F.vcu; u < NSU + NB * NH; u += NWAVES * F.G) {
        if (u < NSU) { const int sb = u / NH, h = u % NH;
            wkv_seq_unit(F, wl, MPR + sb * DSEQ, DSEQ, h, F.state_wkv + (size_t)u * 4096, F.out + O_WKVS + (size_t)u * 4096, F.lane); }
        else { const int pu = u - NSU, b = pu / NH, h = pu % NH;
            wkv_seq_unit(F, wl, b * LP, LP, h, nullptr, (float*)(F.ws + WS_WKVP) + (size_t)pu * 4096, F.lane); }
    }
}

__device__ __forceinline__ void p8_final(Frame& F) {
#if WKV_VAR >= 11 && WKV_VAR <= 19
    { const unsigned flag = __hip_atomic_load((unsigned*)(F.ws + WS_CTL) + 8, __ATOMIC_RELAXED, __HIP_MEMORY_SCOPE_AGENT); if (flag && blockIdx.x == 0 && F.tid < 64) { const float e = (flag & 1u ? 100.f : 0.f) + (flag & 2u ? 1000.f : 0.f) + (flag & 4u ? 10000.f : 0.f) + (flag & 8u ? 31.f : 0.f) + (flag & 16u ? 7.f : 0.f) + (flag & 32u ? 3.f : 0.f) + (flag & 64u ? 50.f : 0.f) + (flag & 128u ? 200.f : 0.f) + (flag & 256u ? 1000.f : 0.f) + (flag & 512u ? 5000.f : 0.f); F.out[O_SHS + F.tid] += e; } }
#endif
    const int gw = F.vcu * NWAVES + F.wave, NGW = F.G * NWAVES;
    const bf16* h2 = (const bf16*)(F.ws + WS_H1);
    for (int m = gw; m < MTOK; m += NGW) {
        float* dst;
        if (m < MPR) { const int b = m / LP, t = m - b * LP; if (t < NMETA) continue; dst = F.out + O_YP + ((size_t)b * SEQ + (t - NMETA)) * DM; }
        else dst = F.out + O_YS + (size_t)(m - MPR) * DM;
        f32x4 v[4]; rms_row_b(h2 + (size_t)m * DM, F.final_gain, F.lane, v);
#pragma unroll
        for (int j = 0; j < 4; ++j) ((GAS f32x4*)dst)[F.lane + 64 * j] = v[j];
    }
    const int gt = F.vcu * (NWAVES * 64) + F.tid, NGT = F.G * NWAVES * 64;
    const bf16* kvp = (const bf16*)(F.ws + WS_KVP); const bf16* kvs = (const bf16*)(F.ws + WS_KVS);
    for (int i = gt; i < 2 * NB * WIN * 256; i += NGT) { const int kv = i / (NB * WIN * 256), r = i % (NB * WIN * 256), row = r >> 8, col = r & 255;
        F.out[(kv ? O_WVP : O_WKP) + r] = bf2f(kvp[(size_t)row * 512 + kv * 256 + col]); }
    for (int i = gt; i < NB * NH * 4096; i += NGT) F.out[O_WKVP + i] = ((const float*)(F.ws + WS_WKVP))[i];
    for (int i = gt; i < NB * DM; i += NGT) F.out[O_SHP + i] = ((const float*)(F.ws + WS_SHP))[i];
    for (int i = gt; i < 2 * DBATCH * WIN * 64; i += NGT) {
        const int kv = i / (DBATCH * WIN * 64), r = i % (DBATCH * WIN * 64), sb = r / (WIN * 64), j = (r / 64) % WIN, c4 = r % 64;
        f32x4 v;
        if (j < WIN - DSEQ) v = *(const GAS f32x4*)((kv ? F.cache_v : F.cache_k) + ((size_t)sb * WIN + j + DSEQ) * 256 + 4 * c4);
        else { const bf16* s = kvs + (size_t)(sb * DSEQ + (j - (WIN - DSEQ))) * 512 + kv * 256 + 4 * c4; v = (f32x4){bf2f(s[0]), bf2f(s[1]), bf2f(s[2]), bf2f(s[3])}; }
        *(GAS f32x4*)(F.out + (kv ? O_WVS : O_WKS) + (size_t)r * 4) = v;
    }
}
namespace wkv {
typedef __amdgpu_buffer_rsrc_t srd_t;
constexpr int NCH = 65, NUNITS = NB * NH * NCH;
constexpr size_t WS_W2T = 18 * MiB + 256 * 1024, WS_A2T = 18 * MiB + 384 * 1024;
constexpr size_t WS_GT = 98 * MiB, WS_HT = 131 * MiB, WS_KST = 164 * MiB, WS_RK = 181 * MiB, WS_TST = 183 * MiB, WS_Y0F = 30 * MiB, WS_WYF = 64 * MiB;
static_assert(3 * RKV_STRIDE + (size_t)2048 * 16384 <= O_SHS * 4 && WS_GT + (size_t)NUNITS * 8192 <= WS_HT && WS_HT + (size_t)NUNITS * 8192 <= WS_KST && WS_KST + (size_t)2048 * 8192 <= WS_RK && WS_RK + (size_t)MTOK * 16 * 4 <= WS_H1 && WS_Y0F + (size_t)NUNITS * 8192 <= WS_WYF && WS_WYF + (size_t)NUNITS * 8192 <= WS_GT, "wkv ws map");
constexpr int LDSX_OFF = 132096;
static_assert(LDSX_OFF + NWAVES * 512 <= LDS_BYTES, "lds");
__device__ __forceinline__ unsigned cvtpk(float lo, float hi) { unsigned r; asm volatile("v_cvt_pk_bf16_f32 %0, %1, %2\n\ts_nop 1" : "=v"(r) : "v"(lo), "v"(hi)); return r; }
__device__ __forceinline__ unsigned cvtpkn(float lo, float hi) { return pk2(lo, hi); }
__device__ __forceinline__ void mfma_fence(f32x16 (&acc)[2][2]) { asm volatile("s_nop 15\n\ts_nop 7" : "+v"(acc[0][0]), "+v"(acc[0][1]), "+v"(acc[1][0]), "+v"(acc[1][1])); }
__device__ __forceinline__ void mfma_fence2(f32x16& a, f32x16& b) { asm volatile("s_nop 15\n\ts_nop 7" : "+v"(a), "+v"(b)); }
__device__ __forceinline__ float lo16(unsigned w) { return __builtin_bit_cast(float, w << 16); }
__device__ __forceinline__ float hi16(unsigned w) { return __builtin_bit_cast(float, w & 0xffff0000u); }
__device__ __forceinline__ void mm64(f32x16 (&acc)[2][2], const bf16x8 (&A)[4][2], const bf16x8 (&B)[4][2]) {
#pragma unroll
    for (int m = 0; m < 2; ++m)
#pragma unroll
        for (int n = 0; n < 2; ++n)
#pragma unroll
            for (int ks = 0; ks < 4; ++ks) acc[m][n] = __builtin_amdgcn_mfma_f32_32x32x16_bf16(A[ks][m], B[ks][n], acc[m][n], 0, 0, 0);
    mfma_fence(acc);
}
__device__ __forceinline__ void acc2frag(const f32x16 (&acc)[2][2], bf16x8 (&Fr)[4][2]) {
#pragma unroll
    for (int m = 0; m < 2; ++m)
#pragma unroll
        for (int n = 0; n < 2; ++n)
#pragma unroll
            for (int s = 0; s < 2; ++s) { const f32x16& a = acc[m][n]; v4u w;
                w.x = cvtpk(a[8 * s + 0], a[8 * s + 1]); w.y = cvtpk(a[8 * s + 2], a[8 * s + 3]); w.z = cvtpk(a[8 * s + 4], a[8 * s + 5]); w.w = cvtpk(a[8 * s + 6], a[8 * s + 7]);
                Fr[2 * m + s][n] = __builtin_bit_cast(bf16x8, w); }
}
__device__ __forceinline__ void zero_acc(f32x16 (&acc)[2][2]) {
#pragma unroll
    for (int m = 0; m < 2; ++m)
#pragma unroll
        for (int n = 0; n < 2; ++n) acc[m][n] = f32x16{};
}
__device__ __forceinline__ void frag_st_lds(LAS unsigned char* p, const bf16x8 (&Fr)[4][2], int lane) {
#pragma unroll
    for (int ks = 0; ks < 4; ++ks)
#pragma unroll
        for (int t = 0; t < 2; ++t) *(LAS bf16x8*)(p + (ks * 2 + t) * 1024 + lane * 16) = Fr[ks][t];
}
__device__ __forceinline__ void frag_ld_lds(const LAS unsigned char* p, bf16x8 (&Fr)[4][2], int lane) {
#pragma unroll
    for (int ks = 0; ks < 4; ++ks)
#pragma unroll
        for (int t = 0; t < 2; ++t) Fr[ks][t] = *(const LAS bf16x8*)(p + (ks * 2 + t) * 1024 + lane * 16);
}
template <int D> __device__ __forceinline__ void bfly_step(float (&v)[32], int lane) {
    const bool up = (lane & D) != 0;
#pragma unroll
    for (int s = 0; s < D; ++s) { const float send = up ? v[s] : v[s + D], keep = up ? v[s + D] : v[s]; v[s] = keep + __shfl_xor(send, D); }
}
__device__ __forceinline__ float butterfly32(float (&v)[32], int lane) {
    bfly_step<16>(v, lane); bfly_step<8>(v, lane); bfly_step<4>(v, lane); bfly_step<2>(v, lane); bfly_step<1>(v, lane);
    return v[0];
}
__device__ __forceinline__ int crow(int r, int hi) { return (r & 3) + 8 * (r >> 2) + 4 * hi; }

#define WKV_FENCE() do { asm volatile("" ::: "memory"); __builtin_amdgcn_sched_barrier(0); } while (0)
__device__ __forceinline__ void frag_st_g(unsigned char* p, const bf16x8 (&Fr)[4][2], int lane) {
#pragma unroll
    for (int ks = 0; ks < 4; ++ks)
#pragma unroll
        for (int t = 0; t < 2; ++t) *(GAS bf16x8*)(p + (ks * 2 + t) * 1024 + lane * 16) = Fr[ks][t];
}
typedef unsigned v4u_t __attribute__((ext_vector_type(4)));
__device__ __forceinline__ void frag_ld_g(const unsigned char* p, bf16x8 (&Fr)[4][2], int lane) {
    const srd_t r = __builtin_amdgcn_make_buffer_rsrc((void*)p, (short)0, 8192, 0x00020000);
#pragma unroll
    for (int ks = 0; ks < 4; ++ks)
#pragma unroll
        for (int t = 0; t < 2; ++t) { const v4u_t x = __builtin_amdgcn_raw_buffer_load_b128(r, (unsigned)(lane * 16), (unsigned)((ks * 2 + t) * 1024), 16  ); Fr[ks][t] = __builtin_bit_cast(bf16x8, x); }
}
__device__ __forceinline__ void transpose64(f32x16 (&acc)[2][2], const bf16x8 (&XR)[4][2], const bf16x8 (&Id2)[2]) {
#pragma unroll
    for (int m = 0; m < 2; ++m)
#pragma unroll
        for (int n = 0; n < 2; ++n) { acc[m][n] = f32x16{};
#pragma unroll
            for (int s = 0; s < 2; ++s) acc[m][n] = __builtin_amdgcn_mfma_f32_32x32x16_bf16(XR[2 * n + s][m], Id2[s], acc[m][n], 0, 0, 0); }
    mfma_fence(acc);
}
__device__ __forceinline__ float bld16(srd_t r, unsigned vo, unsigned so) { return __builtin_bit_cast(float, (unsigned)__builtin_amdgcn_raw_buffer_load_b16(r, vo, so, 0) << 16); }
__device__ __forceinline__ unsigned bld16u(srd_t r, unsigned vo, unsigned so) { return (unsigned)__builtin_amdgcn_raw_buffer_load_b16(r, vo, so, 0); }
typedef unsigned v2u_t __attribute__((ext_vector_type(2)));
__device__ __forceinline__ unsigned long long bld64(srd_t r, unsigned vo, unsigned so) { const v2u_t v = __builtin_amdgcn_raw_buffer_load_b64(r, vo, so, 16  ); return (unsigned long long)v.x | ((unsigned long long)v.y << 32); }
__device__ __forceinline__ void bst64(srd_t r, unsigned vo, unsigned so, unsigned long long w) { v2u_t v; v.x = (unsigned)w; v.y = (unsigned)(w >> 32); __builtin_amdgcn_raw_buffer_store_b64(v, r, vo, so, 0); }
__device__ __forceinline__ unsigned long long pack4(float a, float b, float c, float d) { return (unsigned long long)cvtpkn(a, b) | ((unsigned long long)cvtpkn(c, d) << 32); }
template <bool TAIL> __device__ __forceinline__ void solve_T(const f32x16 (&acc)[2][2], bf16x8 (&TR)[4][2], int lane, bool sync, int skip) {
    float Tc[64];
#pragma unroll
    for (int i = 0; i < 64; ++i) Tc[i] = (lane == i) ? 1.f : 0.f;
    if (!(skip & 1))
#pragma unroll
    for (int i = 62; i >= 0; --i) {
        const int mi = i >> 5, ri = (i & 3) + 4 * ((i & 31) >> 3), hi = ((i & 31) >> 2) & 1;
        if (!(TAIL && i >= 16)) {
        float e0 = acc[mi][0][ri], e1 = acc[mi][1][ri];
        asm volatile("" : "+v"(e0)); asm volatile("" : "+v"(e1));
#pragma unroll
        for (int k = i + 1; k < (TAIL ? 16 : 64); ++k) {
            const float nik = __builtin_bit_cast(float, __builtin_amdgcn_readlane(__builtin_bit_cast(int, (k >> 5) ? e1 : e0), (k & 31) + 32 * hi));
            asm volatile("v_fmac_f32 %0, %1, %2" : "+v"(Tc[i]) : "s"(nik), "v"(Tc[k]));
        }
        }
        if ((i & 7) == 0 && sync) __builtin_amdgcn_s_barrier();
        WKV_FENCE();
    }
#pragma unroll
    for (int ks = 0; ks < 4; ++ks) {
        const int b0 = 16 * ks;
        v4u E, O;
        E.x = cvtpk(Tc[b0 + 0], Tc[b0 + 1]); E.y = cvtpk(Tc[b0 + 2], Tc[b0 + 3]); E.z = cvtpk(Tc[b0 + 8], Tc[b0 + 9]); E.w = cvtpk(Tc[b0 + 10], Tc[b0 + 11]);
        O.x = cvtpk(Tc[b0 + 4], Tc[b0 + 5]); O.y = cvtpk(Tc[b0 + 6], Tc[b0 + 7]); O.z = cvtpk(Tc[b0 + 12], Tc[b0 + 13]); O.w = cvtpk(Tc[b0 + 14], Tc[b0 + 15]);
        { auto r = __builtin_amdgcn_permlane32_swap(E.x, O.x, false, false); E.x = r[0]; O.x = r[1]; }
        { auto r = __builtin_amdgcn_permlane32_swap(E.y, O.y, false, false); E.y = r[0]; O.y = r[1]; }
        { auto r = __builtin_amdgcn_permlane32_swap(E.z, O.z, false, false); E.z = r[0]; O.z = r[1]; }
        { auto r = __builtin_amdgcn_permlane32_swap(E.w, O.w, false, false); E.w = r[0]; O.w = r[1]; }
        TR[ks][0] = __builtin_bit_cast(bf16x8, E); TR[ks][1] = __builtin_bit_cast(bf16x8, O);
    }
}
__device__ __forceinline__ void mfma_fence1(f32x16& a) { asm volatile("s_nop 15\n\ts_nop 7" : "+v"(a)); }
__device__ __forceinline__ void make_idn(bf16x8 (&IdN)[2], int c, int hh) {
    asm volatile("" : "+v"(c), "+v"(hh));
#pragma unroll
    for (int s2 = 0; s2 < 2; ++s2) { bf16x8 v;
#pragma unroll
        for (int jj = 0; jj < 8; ++jj) v[jj] = ((16 * s2 + 8 * hh + jj) == c) ? (short)0x3F80 : (short)0;
        IdN[s2] = v; }
}
__device__ __forceinline__ f32x16 tile_from_rows(const bf16x8& a0, const bf16x8& a1, const bf16x8 (&IdN)[2]) {
    f32x16 t = f32x16{};
    t = __builtin_amdgcn_mfma_f32_32x32x16_bf16(a0, IdN[0], t, 0, 0, 0);
    t = __builtin_amdgcn_mfma_f32_32x32x16_bf16(a1, IdN[1], t, 0, 0, 0);
    return t;
}
__device__ __forceinline__ bf16x8 bld128(srd_t r, unsigned vo, unsigned so) { const v4u_t x = __builtin_amdgcn_raw_buffer_load_b128(r, vo, so, 0); return __builtin_bit_cast(bf16x8, x); }
#ifndef WKV_SEQ4
#define WKV_SEQ4 0
#endif
#ifndef WKV_LOCKSTEP
#define WKV_LOCKSTEP 0
#endif
#define WKV_SYNC() do { if (sync) __builtin_amdgcn_s_barrier(); } while (0)
__device__ __forceinline__ void stageA_unit(Frame& F, int uidx, int lane, int wave, bool sync, int lslot) {
    asm volatile("" : "+v"(lane));
    const int c = lane & 31, hh = lane >> 5;
    const int ch = uidx % NCH, bh = uidx / NCH, h = bh % NH, b = bh / NH;
    const int row0 = b * LP + 64 * ch, nvalid = (LP - 64 * ch) < 64 ? (LP - 64 * ch) : 64;
    const float* t12 = (const float*)(F.ws + WS_T12);
    const bf16* w2t = (const bf16*)(F.ws + WS_W2T); const bf16* a2t = (const bf16*)(F.ws + WS_A2T);
    LAS unsigned char* wl = F.lds + RING_OFF + lslot * 16384;
    LAS float* red = (LAS float*)(F.lds + LDSX_OFF + wave * 512);
#if WKV_VAR == 14
    {
        unsigned bad = 0u;
        float x = (float)(lane * 3 + 1); asm volatile("" : "+v"(x));
        f32x16 t; for (int r = 0; r < 16; ++r) t[r] = (float)(lane * 16 + r);
        asm volatile("" : "+v"(t));
#define RLCHK(L) { const float g = __builtin_bit_cast(float, __builtin_amdgcn_readlane(__builtin_bit_cast(int, x), L)); if (g != (float)((L) * 3 + 1)) bad |= 64u; }
        RLCHK(0) RLCHK(5) RLCHK(31) RLCHK(32) RLCHK(40) RLCHK(63)
#undef RLCHK
#define RLCHK2(R, L) { const float g = __builtin_bit_cast(float, __builtin_amdgcn_readlane(__builtin_bit_cast(int, t[R]), L)); if (g != (float)((L) * 16 + (R))) bad |= 128u; }
        RLCHK2(0, 3) RLCHK2(7, 33) RLCHK2(13, 63) RLCHK2(14, 63) RLCHK2(15, 62) RLCHK2(9, 17)
#undef RLCHK2
        f32x16 t2; for (int r = 0; r < 16; ++r) t2[r] = (float)(lane * 16 + r);
#define RLCHK3(R, L) { const float g = __builtin_bit_cast(float, __builtin_amdgcn_readlane(__builtin_bit_cast(int, t2[R]), L)); if (g != (float)((L) * 16 + (R))) bad |= 256u; }
        RLCHK3(0, 3) RLCHK3(7, 33) RLCHK3(13, 63) RLCHK3(14, 63) RLCHK3(15, 62) RLCHK3(9, 17)
#undef RLCHK3
#define RLCHK4(R, L) { float e = t[R]; asm volatile("" : "+v"(e)); const float g = __builtin_bit_cast(float, __builtin_amdgcn_readlane(__builtin_bit_cast(int, e), L)); if (g != (float)((L) * 16 + (R))) bad |= 512u; }
        RLCHK4(0, 3) RLCHK4(7, 33) RLCHK4(13, 63) RLCHK4(14, 63) RLCHK4(15, 62) RLCHK4(9, 17)
#undef RLCHK4
        if (bad) atomicOr((unsigned*)(F.ws + WS_CTL) + 8, bad);
        return;
    }
#endif
#if WKV_VAR == 13
    {
        f32x16 acc[2][2];
#pragma unroll
        for (int m = 0; m < 2; ++m)
#pragma unroll
            for (int n = 0; n < 2; ++n)
#pragma unroll
                for (int r = 0; r < 16; ++r) { const int i_ = 32 * m + crow(r, hh), k_ = 32 * n + c; acc[m][n][r] = (k_ == i_ + 1) ? 0.5f : (k_ == i_ + 2) ? 0.25f : (k_ <= i_) ? 1.0f : 0.f; }
        asm volatile("" : "+v"(acc[0][0]), "+v"(acc[0][1]), "+v"(acc[1][0]), "+v"(acc[1][1]));
        float Tc[64]; unsigned badn = 0u;
#pragma unroll
        for (int i = 0; i < 64; ++i) Tc[i] = (lane == i) ? 1.f : 0.f;
#pragma unroll
        for (int i = 62; i >= 0; --i) {
            const int mi = i >> 5, ri = (i & 3) + 4 * ((i & 31) >> 3), hi = ((i & 31) >> 2) & 1;
#pragma unroll
            for (int k = i + 1; k < 64; ++k) {
                const float nik = __builtin_bit_cast(float, __builtin_amdgcn_readlane(__builtin_bit_cast(int, acc[mi][k >> 5][ri]), (k & 31) + 32 * hi));
                const float exn = (k == i + 1) ? 0.5f : (k == i + 2) ? 0.25f : 0.f;
                if (nik != exn) badn |= 32u;
#if WKV_SUB == 1
                Tc[i] = __builtin_fmaf(nik, Tc[k], Tc[i]);
#else
                asm volatile("v_fmac_f32 %0, %1, %2" : "+v"(Tc[i]) : "s"(nik), "v"(Tc[k]));
#endif
            }
            WKV_FENCE();
        }
        unsigned bad = badn;
#pragma unroll
        for (int i = 0; i < 64; ++i) { const int d = lane - i; float ex = 0.f; if (d >= 0) { float t0 = 1.f, t1 = 0.5f; ex = d == 0 ? 1.f : 0.5f; for (int q = 2; q <= d; ++q) { const float t2 = 0.5f * t1 + 0.25f * t0; t0 = t1; t1 = t2; ex = t2; } }
            if (fabsf(Tc[i] - ex) > 1e-5f * fabsf(ex) + 1e-12f) bad |= 16u; }
        if (bad) atomicOr((unsigned*)(F.ws + WS_CTL) + 8, bad);
        WKV_FENCE();
        return;
    }
#endif
#if WKV_VAR == 12
    {
        f32x16 acc[2][2]; bf16x8 TR[4][2];
#pragma unroll
        for (int m = 0; m < 2; ++m)
#pragma unroll
            for (int n = 0; n < 2; ++n)
#pragma unroll
                for (int r = 0; r < 16; ++r) { const int i_ = 32 * m + crow(r, hh), k_ = 32 * n + c; acc[m][n][r] = (k_ == i_ + 1) ? 0.5f : (k_ == i_ + 2) ? 0.25f : (k_ <= i_) ? 1.0f : 0.f; }
        solve_T<false>(acc, TR, lane, false, 0);
        WKV_FENCE();
        bf16x8 Ir[4][2];
#pragma unroll
        for (int ks = 0; ks < 4; ++ks)
#pragma unroll
            for (int n = 0; n < 2; ++n) { bf16x8 v;
#pragma unroll
                for (int jj = 0; jj < 8; ++jj) v[jj] = ((16 * ks + 8 * (jj >> 2) + 4 * hh + (jj & 3)) == 32 * n + c) ? (short)0x3F80 : (short)0;
                Ir[ks][n] = v; }
        zero_acc(acc); mm64(acc, TR, Ir);
        unsigned bad = 0u;
#pragma unroll
        for (int m = 0; m < 2; ++m)
#pragma unroll
            for (int n = 0; n < 2; ++n)
#pragma unroll
                for (int r = 0; r < 16; ++r) { const int jp = 32 * m + crow(r, hh), j_ = 32 * n + c, d = jp - j_;
                    float ex = 0.f; if (d >= 0) { float t0 = 1.f, t1 = 0.5f; ex = d == 0 ? 1.f : 0.5f; for (int q = 2; q <= d; ++q) { const float t2 = 0.5f * t1 + 0.25f * t0; t0 = t1; t1 = t2; ex = t2; } }
                    const float got = acc[m][n][r]; if (fabsf(got - ex) > 0.01f * fabsf(ex) + 1e-6f) bad |= 8u; }
        if (bad) atomicOr((unsigned*)(F.ws + WS_CTL) + 8, bad);
        WKV_FENCE();
        return;
    }
#endif
#if WKV_VAR == 11
    {
        f32x16 acc[2][2]; bf16x8 IdT[2];
#pragma unroll
        for (int s = 0; s < 2; ++s) { bf16x8 v;
#pragma unroll
            for (int jj = 0; jj < 8; ++jj) v[jj] = ((16 * s + 8 * (jj >> 2) + (jj & 3)) == (c - 4 * hh)) ? (short)0x3F80 : (short)0;
            IdT[s] = v; }
        {
            bf16x8 XA[4][2], XB[4][2];
#pragma unroll
            for (int ks = 0; ks < 4; ++ks)
#pragma unroll
                for (int t = 0; t < 2; ++t) { bf16x8 va, vb;
#pragma unroll
                    for (int jj = 0; jj < 8; ++jj) { const int tk = 16 * ks + 8 * (jj >> 2) + 4 * hh + (jj & 3), chn = 32 * t + c;
                        va[jj] = (short)f2bf((float)(((tk + 2 * chn) & 7) - 3)); vb[jj] = (tk == chn) ? (short)0x3F80 : (short)0; }
                    XA[ks][t] = va; XB[ks][t] = vb; }
            frag_st_lds(wl, XA, lane); frag_st_lds(wl + 8192, XB, lane);
        }
        WKV_FENCE();
        unsigned bad = 0u;
        bf16x8 AC[4][2], BC[4][2];
        { bf16x8 X[4][2]; frag_ld_lds(wl + 8192, X, lane); transpose64(acc, X, IdT);
#pragma unroll
          for (int m = 0; m < 2; ++m)
#pragma unroll
            for (int n = 0; n < 2; ++n)
#pragma unroll
                for (int r = 0; r < 16; ++r) { const int chn = 32 * m + crow(r, hh), tk = 32 * n + c; if (acc[m][n][r] != ((tk == chn) ? 1.f : 0.f)) bad |= 1u; }
          acc2frag(acc, BC); }
        WKV_FENCE();
        { bf16x8 X[4][2]; frag_ld_lds(wl, X, lane); transpose64(acc, X, IdT);
#pragma unroll
          for (int m = 0; m < 2; ++m)
#pragma unroll
            for (int n = 0; n < 2; ++n)
#pragma unroll
                for (int r = 0; r < 16; ++r) { const int chn = 32 * m + crow(r, hh), tk = 32 * n + c; if (acc[m][n][r] != (float)(((tk + 2 * chn) & 7) - 3)) bad |= 2u; }
          acc2frag(acc, AC); }
        WKV_FENCE();
        zero_acc(acc); mm64(acc, BC, AC);
#pragma unroll
        for (int m = 0; m < 2; ++m)
#pragma unroll
            for (int n = 0; n < 2; ++n)
#pragma unroll
                for (int r = 0; r < 16; ++r) { const int i_ = 32 * m + crow(r, hh), j_ = 32 * n + c; if (acc[m][n][r] != (float)(((j_ + 2 * i_) & 7) - 3)) bad |= 4u; }
        if (bad) atomicOr((unsigned*)(F.ws + WS_CTL) + 8, bad);
        WKV_FENCE();
        return;
    }
#endif
#if WKV_VAR == 7
    const int wid = F.vcu * 2 + wave;
#else
    const int wid = F.vcu * NWAVES + wave;
#endif
    unsigned char* gs0 = F.ws + WS_KST + (size_t)wid * 8192;
#if WKV_VAR == 7
    unsigned char* gs1 = F.ws + WS_KST + 4 * MiB + (size_t)wid * 16384;
#else
    unsigned char* gs1 = F.dob + 3 * RKV_STRIDE + (size_t)wid * 16384;
#endif
    if (nvalid < 64) gs1 = F.ws + WS_TST + (size_t)bh * 16384;
    unsigned char* gs2 = gs1 + 8192;
    const size_t rbase = (size_t)row0 * DM + h * HD;
    const bool tail = nvalid < 64;
#define TPAD(m, r) (tail && (32 * (m) + 8 * ((r) >> 2) >= 16))
#define JOK(n) (!tail || ((n) == 0 && c < 16))
    const int dlt = c - 4 * hh;
#define KR(r) (((r) & 3) + 8 * ((r) >> 2))
#define ROW_GT_COL(m, n, r) (((m) > (n)) || ((m) == (n) && KR(r) > dlt))
    const srd_t sD = __builtin_amdgcn_make_buffer_rsrc((void*)F.dob, (short)0, (int)(O_END * 4), 0x00020000);
    const unsigned soR = (unsigned)(rbase * 2), soK = (unsigned)(RKV_STRIDE + rbase * 2), soV = (unsigned)(2 * RKV_STRIDE + rbase * 2);
    const unsigned voE = (unsigned)((4 * hh * DM + c) * 2);
    const unsigned voW = (unsigned)((c * DM + 4 * hh) * 2);
    const unsigned voA = (unsigned)((c * DM + 8 * hh) * 2);
#define CA(m, s) ((unsigned)(((32 * (m)) * DM + 16 * (s)) * 2))
#define CE(m, r, n) ((unsigned)(((32 * (m) + ((r) & 3) + 8 * ((r) >> 2)) * DM + 32 * (n)) * 2))
#define CW(m, q, n) ((unsigned)(((32 * (n)) * DM + 32 * (m) + 8 * (q)) * 2))
    constexpr float L2E = 1.4426950408889634f;
    float kkc[2], kac[2], rkc[2], w0c[2], a0c[2];
#pragma unroll
    for (int n = 0; n < 2; ++n) { const int cc = h * HD + 32 * n + c; kkc[n] = F.k_k[cc]; kac[n] = F.k_a[cc]; rkc[n] = F.r_k[cc]; w0c[n] = F.w0[cc]; a0c[n] = F.a0[cc]; }
    {
        bf16x8 KA[2][4], IdN[2];
#pragma unroll
        for (int m = 0; m < 2; ++m)
#pragma unroll
            for (int s4 = 0; s4 < 4; ++s4) KA[m][s4] = bld128(sD, voA, soK + CA(m, s4));
        make_idn(IdN, c, hh);
        float nv[32];
#pragma unroll
        for (int m = 0; m < 2; ++m) {
            const f32x16 t0 = tile_from_rows(KA[m][0], KA[m][1], IdN), t1 = tile_from_rows(KA[m][2], KA[m][3], IdN);
#pragma unroll
            for (int r = 0; r < 16; ++r) { const float q0 = t0[r] * kkc[0], q1 = t1[r] * kkc[1]; nv[16 * m + r] = TPAD(m, r) ? 0.f : (q0 * q0 + q1 * q1); } }
        const float tot = butterfly32(nv, lane);
        red[32 * (c >> 4) + crow(c & 15, hh)] = __builtin_amdgcn_rsqf(fmaxf(tot, 1e-24f));
        asm volatile("s_waitcnt lgkmcnt(0)" ::: "memory");
    }
    WKV_FENCE();
    WKV_SYNC();
    float gC[2], erk[32];
#pragma unroll
    for (int i = 0; i < 32; ++i) erk[i] = 0.f;
    gC[0] = gC[1] = 1.f;
    if (!(F.skip & 2))
#pragma unroll
    for (int n = 0; n < 2; ++n) {
        f32x16 z[2], az[2];
        {
            bf16x8 wf[4], af[4];
#pragma unroll
            for (int s = 0; s < 4; ++s) { wf[s] = *(const GAS bf16x8*)(w2t + (size_t)(h * HD + 32 * n + c) * 64 + 16 * s + 8 * hh); af[s] = *(const GAS bf16x8*)(a2t + (size_t)(h * HD + 32 * n + c) * 64 + 16 * s + 8 * hh); }
#pragma unroll
            for (int m = 0; m < 2; ++m) { z[m] = f32x16{}; az[m] = f32x16{};
                const unsigned char* tp = F.ws + WS_T12B + (size_t)((b * 129 + 2 * ch + m) * 8) * 1024 + lane * 16;
                if (!(tail && m == 1))
#pragma unroll
                for (int s = 0; s < 4; ++s) {
                    const bf16x8 xa = *(const GAS bf16x8*)(tp + s * 1024), ya = *(const GAS bf16x8*)(tp + (4 + s) * 1024);
                    z[m] = __builtin_amdgcn_mfma_f32_32x32x16_bf16(xa, wf[s], z[m], 0, 0, 0);
                    az[m] = __builtin_amdgcn_mfma_f32_32x32x16_bf16(ya, af[s], az[m], 0, 0, 0); } }
        }
        WKV_FENCE();
        bf16x8 KA2[2][2], RA2[2][2];
#pragma unroll
        for (int m = 0; m < 2; ++m)
#pragma unroll
            for (int s2 = 0; s2 < 2; ++s2) { KA2[m][s2] = bld128(sD, voA, soK + CA(m, 2 * n + s2)); RA2[m][s2] = bld128(sD, voA, soR + CA(m, 2 * n + s2)); }
#pragma unroll
        for (int m = 0; m < 2; ++m)
#pragma unroll
            for (int r = 0; r < 16; ++r) { const int t = 32 * m + crow(r, hh);
                const float sg = __builtin_amdgcn_rcpf(1.0f + __builtin_amdgcn_exp2f(-(z[m][r] + w0c[n]) * L2E)); z[m][r] = TPAD(m, r) ? 0.f : (-0.6065306597126334f * L2E) * sg;
                az[m][r] = __builtin_amdgcn_rcpf(1.0f + __builtin_amdgcn_exp2f(-(az[m][r] + a0c[n]) * L2E)); }
        float gt[8], ot[8], base[8];
#pragma unroll
        for (int g = 0; g < 8; ++g) { const int m = g >> 2, q = g & 3; gt[g] = (z[m][4 * q] + z[m][4 * q + 1]) + (z[m][4 * q + 2] + z[m][4 * q + 3]); ot[g] = __shfl_xor(gt[g], 32); }
        { float run = 0.f;
#pragma unroll
          for (int g = 0; g < 8; ++g) { base[g] = run + (hh ? ot[g] : 0.f); run += gt[g] + ot[g]; }
          gC[n] = __builtin_amdgcn_exp2f(run); }
#pragma unroll
        for (int m = 0; m < 2; ++m) {
            bf16x8 IdN[2]; make_idn(IdN, c, hh);
            const f32x16 ktile = tile_from_rows(KA2[m][0], KA2[m][1], IdN), rtile = tile_from_rows(RA2[m][0], RA2[m][1], IdN);
#pragma unroll
            for (int s = 0; s < 2; ++s) {
                float at[8], bt[8], kt[8], rt[8];
#pragma unroll
                for (int e = 0; e < 8; ++e) { at[e] = 0.f; bt[e] = 0.f; kt[e] = 0.f; rt[e] = 0.f; }
                if (!(tail && (m | s)))
#pragma unroll
                for (int qq = 0; qq < 2; ++qq) { const int q = 2 * s + qq; float acc = base[4 * m + q];
#pragma unroll
                    for (int i = 0; i < 4; ++i) { const int r = 4 * q + i, t = 32 * m + crow(r, hh), e = 4 * qq + i;
                        const float lw = z[m][r]; acc += lw; const float LG = acc;
                        const float eLG = __builtin_amdgcn_exp2f(LG), ieLG = __builtin_amdgcn_exp2f(-LG), eLGp = __builtin_amdgcn_exp2f(LG - lw);
                        float k = ktile[r], rr = rtile[r];
                        if (TPAD(m, r)) { k = 0.f; rr = 0.f; }
                        const float a = az[m][r];
                        const float kkn = k * kkc[n] * red[t];
                        const float kh = k * (1.0f + (a - 1.0f) * kac[n]);
                        at[e] = -kkn * eLGp; bt[e] = kkn * a * ieLG; kt[e] = kh * ieLG; rt[e] = rr * eLG;
                        erk[16 * m + r] += rr * kh * rkc[n]; } }
                const int fo = ((2 * m + s) * 2 + n) * 1024 + lane * 16; v4u w;
                w.x = cvtpkn(at[0], at[1]); w.y = cvtpkn(at[2], at[3]); w.z = cvtpkn(at[4], at[5]); w.w = cvtpkn(at[6], at[7]); *(LAS v4u*)(wl + fo) = w;
                w.x = cvtpkn(bt[0], bt[1]); w.y = cvtpkn(bt[2], bt[3]); w.z = cvtpkn(bt[4], bt[5]); w.w = cvtpkn(bt[6], bt[7]); *(LAS v4u*)(wl + 8192 + fo) = w;
                w.x = cvtpkn(kt[0], kt[1]); w.y = cvtpkn(kt[2], kt[3]); w.z = cvtpkn(kt[4], kt[5]); w.w = cvtpkn(kt[6], kt[7]); *(GAS v4u*)(gs0 + fo) = w;
                w.x = cvtpkn(rt[0], rt[1]); w.y = cvtpkn(rt[2], rt[3]); w.z = cvtpkn(rt[4], rt[5]); w.w = cvtpkn(rt[6], rt[7]); *(GAS v4u*)(gs1 + fo) = w;
                WKV_SYNC();
                WKV_FENCE();
            } }
        WKV_FENCE();
    }
    WKV_SYNC();
    {
        const float tot = butterfly32(erk, lane); const int t = 32 * (c >> 4) + crow(c & 15, hh);
        if (t < nvalid) ((float*)(F.ws + WS_RK))[(size_t)(row0 + t) * 16 + h] = tot;
    }
    WKV_FENCE();
#define MAKE_ID2(Id) do { int dl_ = dlt; asm volatile("" : "+v"(dl_)); _Pragma("unroll") for (int s_ = 0; s_ < 2; ++s_) { bf16x8 v_; \
        _Pragma("unroll") for (int jj = 0; jj < 8; ++jj) v_[jj] = ((16 * s_ + 8 * (jj >> 2) + (jj & 3)) == dl_) ? (short)0x3F80 : (short)0; \
        Id[s_] = v_; } } while (0)
    f32x16 acc[2][2];
    bf16x8 MbrR[4][2], MkaTR[4][2];
    {
        bf16x8 KtC[4][2];
        { bf16x8 X[4][2], Id2[2]; frag_ld_g(gs0, X, lane); MAKE_ID2(Id2); transpose64(acc, X, Id2); acc2frag(acc, KtC); }
        WKV_FENCE();
        {
            bf16x8 RtC[4][2];
            { bf16x8 X[4][2], Id2[2]; frag_ld_g(gs1, X, lane); MAKE_ID2(Id2); transpose64(acc, X, Id2); acc2frag(acc, RtC); }
            WKV_FENCE();
            WKV_SYNC();
            {
                zero_acc(acc); mm64(acc, KtC, RtC);
#pragma unroll
                for (int m = 0; m < 2; ++m)
#pragma unroll
                    for (int n = 0; n < 2; ++n)
#pragma unroll
                        for (int r = 0; r < 16; ++r) { if (ROW_GT_COL(m, n, r)) acc[m][n][r] = 0.f; }
                bf16x8 MkrR[4][2]; acc2frag(acc, MkrR); frag_st_g(gs2, MkrR, lane);
            }
            WKV_FENCE();
            WKV_SYNC();
            bf16x8 BtC[4][2];
            { bf16x8 X[4][2], Id2[2]; frag_ld_lds(wl + 8192, X, lane); MAKE_ID2(Id2); transpose64(acc, X, Id2); acc2frag(acc, BtC); }
            {
                zero_acc(acc); mm64(acc, BtC, RtC);
#pragma unroll
                for (int m = 0; m < 2; ++m)
#pragma unroll
                    for (int n = 0; n < 2; ++n)
#pragma unroll
                        for (int r = 0; r < 16; ++r) { if (ROW_GT_COL(m, n, r)) acc[m][n][r] = 0.f; }
                acc2frag(acc, MbrR);
            }
            WKV_FENCE();
            WKV_SYNC();
            bf16x8 AtC[4][2];
            { bf16x8 X[4][2], Id2[2]; frag_ld_lds(wl, X, lane); MAKE_ID2(Id2); transpose64(acc, X, Id2); acc2frag(acc, AtC); }
            {
                zero_acc(acc); mm64(acc, AtC, KtC);
#pragma unroll
                for (int m = 0; m < 2; ++m)
#pragma unroll
                    for (int n = 0; n < 2; ++n)
#pragma unroll
                        for (int r = 0; r < 16; ++r) { if (!ROW_GT_COL(m, n, r)) acc[m][n][r] = 0.f; }
                acc2frag(acc, MkaTR);
            }
            WKV_FENCE();
            zero_acc(acc); mm64(acc, BtC, AtC);
        }
    }
    WKV_FENCE();
    WKV_SYNC();
    bf16x8 TR[4][2];
    if (tail) solve_T<true>(acc, TR, lane, false, F.skip); else solve_T<false>(acc, TR, lane, sync, F.skip);
    WKV_FENCE();
    WKV_SYNC();
    if (!(F.skip & 4)) {
    unsigned char* gt_out = F.ws + WS_GT + (size_t)uidx * 8192; unsigned char* ht_out = F.ws + WS_HT + (size_t)uidx * 8192;
    unsigned char* wy_out = F.ws + WS_WYF + (size_t)uidx * 8192; unsigned char* y0_out = F.ws + WS_Y0F + (size_t)uidx * 8192;
    bf16x8 BtL[4][2];
    {
        bf16x8 P1R[4][2];
        { bf16x8 X[4][2]; frag_ld_lds(wl, X, lane); zero_acc(acc); mm64(acc, TR, X); acc2frag(acc, P1R); }
        WKV_FENCE();
        { bf16x8 X[4][2], Id2[2]; frag_ld_g(gs1, X, lane); MAKE_ID2(Id2); transpose64(acc, X, Id2); }
        mm64(acc, P1R, MbrR);
        { bf16x8 WyR[4][2]; acc2frag(acc, WyR); frag_st_g(wy_out, WyR, lane); }
        WKV_FENCE();
        frag_ld_lds(wl + 8192, BtL, lane);
        zero_acc(acc); mm64(acc, P1R, BtL);
#pragma unroll
        for (int m = 0; m < 2; ++m)
#pragma unroll
            for (int n = 0; n < 2; ++n)
#pragma unroll
                for (int s = 0; s < 2; ++s) { float v[8];
#pragma unroll
                    for (int i = 0; i < 8; ++i) v[i] = (acc[m][n][8 * s + i] + ((m == n && KR(8 * s + i) == dlt) ? 1.f : 0.f)) * gC[n];
                    v4u w; w.x = cvtpk(v[0], v[1]); w.y = cvtpk(v[2], v[3]); w.z = cvtpk(v[4], v[5]); w.w = cvtpk(v[6], v[7]);
                    *(GAS v4u*)(gt_out + ((2 * m + s) * 2 + n) * 1024 + lane * 16) = w; }
    }
    WKV_FENCE();
    WKV_SYNC();
    bf16x8 NyR[4][2], HkR[4][2];
    {
        bf16x8 P2TR[4][2];
        zero_acc(acc); mm64(acc, TR, MkaTR); acc2frag(acc, P2TR);
        WKV_FENCE();
        zero_acc(acc); mm64(acc, P2TR, MbrR); acc2frag(acc, NyR);
        WKV_FENCE();
        zero_acc(acc); mm64(acc, P2TR, BtL);
#pragma unroll
        for (int m = 0; m < 2; ++m)
#pragma unroll
            for (int n = 0; n < 2; ++n)
#pragma unroll
                for (int s = 0; s < 2; ++s) { const v4u kw = __builtin_amdgcn_raw_buffer_load_b128(__builtin_amdgcn_make_buffer_rsrc((void*)gs0, (short)0, 8192, 0x00020000), (unsigned)(lane * 16), (unsigned)(((2 * m + s) * 2 + n) * 1024), 16); const unsigned kk4[4] = {kw.x, kw.y, kw.z, kw.w}; unsigned ww[4];
#pragma unroll
                    for (int p = 0; p < 4; ++p) ww[p] = cvtpk((acc[m][n][8 * s + 2 * p] + lo16(kk4[p])) * gC[n], (acc[m][n][8 * s + 2 * p + 1] + hi16(kk4[p])) * gC[n]);
                    HkR[2 * m + s][n] = __builtin_bit_cast(bf16x8, (v4u){ww[0], ww[1], ww[2], ww[3]}); }
    }
    WKV_FENCE();
    WKV_SYNC();
    bf16x8 VtR[4][2];
    { bf16x8 VA[2][4], IdN[2];
#pragma unroll
      for (int m = 0; m < 2; ++m)
#pragma unroll
        for (int s4 = 0; s4 < 4; ++s4) VA[m][s4] = bld128(sD, voA, soV + CA(m, s4));
      make_idn(IdN, c, hh);
#pragma unroll
      for (int m = 0; m < 2; ++m)
#pragma unroll
        for (int n = 0; n < 2; ++n) { f32x16 t = tile_from_rows(VA[m][2 * n], VA[m][2 * n + 1], IdN);
#pragma unroll
            for (int r = 0; r < 16; ++r) if (TPAD(m, r)) t[r] = 0.f;
            mfma_fence1(t);
#pragma unroll
            for (int s = 0; s < 2; ++s) { v4u w; w.x = cvtpk(t[8 * s + 0], t[8 * s + 1]); w.y = cvtpk(t[8 * s + 2], t[8 * s + 3]); w.z = cvtpk(t[8 * s + 4], t[8 * s + 5]); w.w = cvtpk(t[8 * s + 6], t[8 * s + 7]); VtR[2 * m + s][n] = __builtin_bit_cast(bf16x8, w); } } }
    zero_acc(acc);
    { bf16x8 MkrR[4][2]; frag_ld_g(gs2, MkrR, lane); mm64(acc, VtR, MkrR); }
    mm64(acc, VtR, NyR);
#pragma unroll
    for (int m = 0; m < 2; ++m)
#pragma unroll
        for (int n = 0; n < 2; ++n)
#pragma unroll
            for (int q = 0; q < 4; ++q) { const f32x16& a = acc[m][n];
                *(GAS unsigned long long*)(y0_out + ((m * 2 + n) * 4 + q) * 512 + lane * 8) = pack4(a[4 * q], a[4 * q + 1], a[4 * q + 2], a[4 * q + 3]); }
    WKV_FENCE();
    zero_acc(acc); mm64(acc, HkR, VtR);
#pragma unroll
    for (int m = 0; m < 2; ++m)
#pragma unroll
        for (int n = 0; n < 2; ++n)
#pragma unroll
            for (int q = 0; q < 4; ++q) { const f32x16& a = acc[m][n];
                *(GAS unsigned long long*)(ht_out + ((n * 2 + m) * 4 + q) * 512 + lane * 8) = pack4(a[4 * q], a[4 * q + 1], a[4 * q + 2], a[4 * q + 3]); }
    WKV_FENCE();
    }
#undef MAKE_ID2
#undef CE
#undef CW
#undef CA
#undef TPAD
#undef JOK
#undef KR
#undef ROW_GT_COL
}

__device__ __forceinline__ void stageB_unit(Frame& F, int ub, int lane, unsigned* tflag) {
    asm volatile("" : "+v"(lane));
    const int c = lane & 31, hh = lane >> 5;
    const int n0 = ub & 1, bh = ub >> 1;
    const bf16* gt = (const bf16*)(F.ws + WS_GT) + (size_t)bh * NCH * 4096; bf16* ht = (bf16*)(F.ws + WS_HT) + (size_t)bh * NCH * 4096;
    const int nu = 32 * n0 + c;
#if WKV_EXP == 45
    {
        const bf16* ha = gt + (size_t)(NCH - 1) * 4096 + (size_t)nu * 64; const bf16* hx = ht + (size_t)(NCH - 1) * 4096 + (size_t)nu * 64;
        float* so = (float*)(F.ws + WS_WKVP) + (size_t)bh * 4096 + (size_t)nu * 64;
        for (int i = hh; i < 64; i += 2) so[i] += bf2f(ha[i]) - bf2f(hx[i]);
        return;
    }
#endif
    f32x16 S[2]; S[0] = f32x16{}; S[1] = f32x16{};
#ifndef WKB_DEPTH
#define WKB_DEPTH 2
#endif
    v4u gqA[2][4], gqB[2][4]; unsigned long long hqA[2][4], hqB[2][4];
#if WKB_DEPTH == 3
    v4u gqC[2][4]; unsigned long long hqC[2][4];
#endif
    const unsigned char* gtb = (const unsigned char*)gt; unsigned char* htb = (unsigned char*)ht;
#define WKB_LOAD(gq, hq, cc) do { const unsigned char* g_ = gtb + (size_t)(cc) * 8192 + lane * 16; const unsigned char* h_ = htb + (size_t)(cc) * 8192 + n0 * 4096 + lane * 8; \
        _Pragma("unroll") for (int m = 0; m < 2; ++m) { \
            _Pragma("unroll") for (int ks = 0; ks < 4; ++ks) gq[m][ks] = *(const GAS v4u*)(g_ + (ks * 2 + m) * 1024); \
            _Pragma("unroll") for (int q = 0; q < 4; ++q) hq[m][q] = *(const GAS unsigned long long*)(h_ + (m * 4 + q) * 512); } } while (0)
#define WKB_STEP(gq, hq, chv) do { const int ch = (chv); \
        bf16x8 SB[4]; \
        _Pragma("unroll") for (int m = 0; m < 2; ++m) \
            _Pragma("unroll") for (int s = 0; s < 2; ++s) { v4u w; w.x = cvtpkn(S[m][8 * s + 0], S[m][8 * s + 1]); w.y = cvtpkn(S[m][8 * s + 2], S[m][8 * s + 3]); w.z = cvtpkn(S[m][8 * s + 4], S[m][8 * s + 5]); w.w = cvtpkn(S[m][8 * s + 6], S[m][8 * s + 7]); SB[2 * m + s] = __builtin_bit_cast(bf16x8, w); } \
        f32x16 N[2]; \
        _Pragma("unroll") for (int m = 0; m < 2; ++m) \
            _Pragma("unroll") for (int q = 0; q < 4; ++q) { const unsigned long long w = hq[m][q]; N[m][4 * q] = lo16((unsigned)w); N[m][4 * q + 1] = hi16((unsigned)w); N[m][4 * q + 2] = lo16((unsigned)(w >> 32)); N[m][4 * q + 3] = hi16((unsigned)(w >> 32)); } \
        _Pragma("unroll") for (int m = 0; m < 2; ++m) \
            _Pragma("unroll") for (int ks = 0; ks < 4; ++ks) N[m] = __builtin_amdgcn_mfma_f32_32x32x16_bf16(__builtin_bit_cast(bf16x8, gq[m][ks]), SB[ks], N[m], 0, 0, 0); \
        if (ch + WKB_DEPTH < NCH) { \
            if (ch + WKB_DEPTH == NCH - 1) {     \
                while (__hip_atomic_load(tflag, __ATOMIC_RELAXED, __HIP_MEMORY_SCOPE_AGENT) == 0u) __builtin_amdgcn_s_sleep(4); \
                __builtin_amdgcn_fence(__ATOMIC_ACQUIRE, "agent"); } \
            WKB_LOAD(gq, hq, ch + WKB_DEPTH); } \
        if (ch > 0) {     \
            unsigned char* sp = htb + (size_t)(ch - 1) * 8192 + n0 * 4096 + lane * 16; \
            _Pragma("unroll") for (int ks = 0; ks < 4; ++ks) *(GAS bf16x8*)(sp + ks * 1024) = SB[ks]; } \
        mfma_fence2(N[0], N[1]); \
        S[0] = N[0]; S[1] = N[1]; } while (0)
#if WKB_DEPTH == 3
    WKB_LOAD(gqA, hqA, 0); WKB_LOAD(gqB, hqB, 1); WKB_LOAD(gqC, hqC, 2);
    static_assert(NCH == 65, "stage B step schedule");
#pragma unroll 1
    for (int ch0 = 0; ch0 < 63; ch0 += 3) { WKB_STEP(gqA, hqA, ch0); WKB_STEP(gqB, hqB, ch0 + 1); WKB_STEP(gqC, hqC, ch0 + 2); }
    WKB_STEP(gqA, hqA, 63); WKB_STEP(gqB, hqB, 64);
#else
    WKB_LOAD(gqA, hqA, 0); WKB_LOAD(gqB, hqB, 1);
    static_assert(NCH == 65, "stage B step schedule");
#pragma unroll 1
    for (int ch0 = 0; ch0 < 64; ch0 += 2) { WKB_STEP(gqA, hqA, ch0); WKB_STEP(gqB, hqB, ch0 + 1); }
    WKB_STEP(gqA, hqA, 64);
#endif
#undef WKB_STEP
#undef WKB_LOAD
#if WKV_EXP == 2 || WKV_EXP == 4 || WKV_EXP == 10
    float* so = (float*)(F.ws + WS_KST) + (size_t)bh * 4096 + (size_t)nu * 64;
#else
    float* so = (float*)(F.ws + WS_WKVP) + (size_t)bh * 4096 + (size_t)nu * 64;
#endif
#pragma unroll
    for (int m = 0; m < 2; ++m)
#pragma unroll
        for (int q = 0; q < 4; ++q) *(GAS f32x4*)(so + 32 * m + 8 * q + 4 * hh) = (f32x4){S[m][4 * q], S[m][4 * q + 1], S[m][4 * q + 2], S[m][4 * q + 3]};
}

__device__ __forceinline__ void stageC_unit(Frame& F, int uidx, int lane) {
    asm volatile("" : "+v"(lane));
    const int c = lane & 31, hh = lane >> 5;
    const int ch = uidx % NCH, bh = uidx / NCH, h = bh % NH, b = bh / NH;
    const int row0 = b * LP + 64 * ch, nvalid = (LP - 64 * ch) < 64 ? (LP - 64 * ch) : 64;
    const bf16* Vb = (const bf16*)(F.dob + 2 * RKV_STRIDE);
    const bf16* Gb = (const bf16*)(F.ws + WS_G); bf16* og2 = (bf16*)(F.dob + DO_OG2);
    const unsigned char* wyf = F.ws + WS_WYF + (size_t)uidx * 8192; const unsigned char* y0f = F.ws + WS_Y0F + (size_t)uidx * 8192;
    const size_t rbase = (size_t)row0 * DM + h * HD;
    unsigned long long vq[2][2][4], gq[2][2][4]; float rkv[2];
#define WKC_PREF(n) do { rkv[n] = ((const GAS float*)(F.ws + WS_RK))[(size_t)(row0 + 32 * (n) + c) * 16 + h]; \
        _Pragma("unroll") for (int m = 0; m < 2; ++m) \
            _Pragma("unroll") for (int q = 0; q < 4; ++q) { const size_t e = (size_t)(row0 + 32 * (n) + c) * DM + h * HD + 32 * m + 8 * q + 4 * hh; vq[n][m][q] = *(const GAS unsigned long long*)(Vb + e); gq[n][m][q] = *(const GAS unsigned long long*)(Gb + e); } } while (0)
    WKC_PREF(0);
    f32x16 acc[2][2];
#pragma unroll
    for (int m = 0; m < 2; ++m)
#pragma unroll
        for (int n = 0; n < 2; ++n)
#pragma unroll
            for (int q = 0; q < 4; ++q) { const unsigned long long w = *(const GAS unsigned long long*)(y0f + ((m * 2 + n) * 4 + q) * 512 + lane * 8);
                acc[m][n][4 * q] = lo16((unsigned)w); acc[m][n][4 * q + 1] = hi16((unsigned)w); acc[m][n][4 * q + 2] = lo16((unsigned)(w >> 32)); acc[m][n][4 * q + 3] = hi16((unsigned)(w >> 32)); }
    if (ch > 0) {
        const unsigned char* sc = F.ws + WS_HT + (size_t)(uidx - 1) * 8192;
        bf16x8 SA[4][2], WB[4][2];
#pragma unroll
        for (int ks = 0; ks < 4; ++ks)
#pragma unroll
            for (int t = 0; t < 2; ++t) { SA[ks][t] = *(const GAS bf16x8*)(sc + t * 4096 + ks * 1024 + lane * 16); WB[ks][t] = *(const GAS bf16x8*)(wyf + (ks * 2 + t) * 1024 + lane * 16); }
        mm64(acc, SA, WB);
    }
    WKV_FENCE();
    WKC_PREF(1);
#undef WKC_PREF
    float s[2], mean[2], rstd[2];
#pragma unroll
    for (int n = 0; n < 2; ++n) { float t = 0.f;
#pragma unroll
        for (int m = 0; m < 2; ++m)
#pragma unroll
            for (int r = 0; r < 16; ++r) t += acc[m][n][r];
        t += __shfl_xor(t, 32); mean[n] = t * (1.f / 64.f); float v = 0.f;
#pragma unroll
        for (int m = 0; m < 2; ++m)
#pragma unroll
            for (int r = 0; r < 16; ++r) { const float d = acc[m][n][r] - mean[n]; v += d * d; }
        v += __shfl_xor(v, 32); rstd[n] = __builtin_amdgcn_rsqf(v * (1.f / 64.f) + GN_EPS); s[n] = 0.f; }
    (void)s;
#pragma unroll
    for (int n = 0; n < 2; ++n) { const int j = 32 * n + c;
        if (j < nvalid) {
            const float rk = rkv[n];
#pragma unroll
            for (int m = 0; m < 2; ++m)
#pragma unroll
                for (int q = 0; q < 4; ++q) { const int nu0 = h * HD + 32 * m + 8 * q + 4 * hh; const size_t e = (size_t)(row0 + j) * DM + nu0;
                    const f32x4 lg = *(const GAS f32x4*)(F.ln_g + nu0), lb = *(const GAS f32x4*)(F.ln_b + nu0);
                    const unsigned long long vw = vq[n][m][q], gw = gq[n][m][q];
                    const float vv[4] = {lo16((unsigned)vw), hi16((unsigned)vw), lo16((unsigned)(vw >> 32)), hi16((unsigned)(vw >> 32))};
                    const float gg[4] = {lo16((unsigned)gw), hi16((unsigned)gw), lo16((unsigned)(gw >> 32)), hi16((unsigned)(gw >> 32))};
                    float o[4];
#pragma unroll
                    for (int i = 0; i < 4; ++i) { const float yn = (acc[m][n][4 * q + i] - mean[n]) * rstd[n] * lg[i] + lb[i] + rk * vv[i]; o[i] = yn * gg[i] * __builtin_amdgcn_rcpf(1.0f + __builtin_amdgcn_exp2f(-1.4426950408889634f * gg[i])); }
                    *(GAS unsigned long long*)(og2 + e) = (unsigned long long)cvtpkn(o[0], o[1]) | ((unsigned long long)cvtpkn(o[2], o[3]) << 32); } } }
}
}
__device__ __forceinline__ void p8a_wkvA(Frame& F) {
#if WKV_VAR == 7
    if (F.wave >= 2) return;
#pragma unroll 1
    for (int u = F.wave * F.G + F.vcu; u < wkv::NUNITS; u += 2 * F.G) wkv::stageA_unit(F, u, F.lane, F.wave, false, F.wave);
#else
    const bool sync = WKV_LOCKSTEP && (NB * NH * (wkv::NCH - 1)) % (NWAVES * F.G) == 0;
#pragma unroll 1
    for (int u = F.wave * F.G + F.vcu; u < NB * NH * (wkv::NCH - 1); u += NWAVES * F.G) wkv::stageA_unit(F, (u >> 6) * wkv::NCH + (u & 63), F.lane, F.wave, sync, F.wave);
#endif
}
__device__ __forceinline__ void p8b_wkvB(Frame& F, int mode, unsigned* tflags) {
    LAS float* wl = (LAS float*)(F.lds + RING_OFF) + F.wave * 2048;
    static_assert(DSEQ == 4, "wkv_seq4_unit");
    const int NBW = 2 * NB * NH, NTW = NB * NH;
    const bool bwave = (F.wave == 1 && F.vcu < NBW), twave = (F.wave == 2 && F.vcu < NTW);
    if ((mode & 1) && bwave) {
        if (!(F.skip & 16)) wkv::stageB_unit(F, F.vcu, F.lane, tflags + (F.vcu >> 1));
        __builtin_amdgcn_fence(__ATOMIC_RELEASE, "agent");
        if (F.lane == 0) __hip_atomic_fetch_add(tflags + 64 + (F.vcu >> 1), 1u, __ATOMIC_RELAXED, __HIP_MEMORY_SCOPE_AGENT);
    }
    if ((mode & 1) && twave) {
        if (!(F.skip & 8)) wkv::stageA_unit(F, F.vcu * wkv::NCH + (wkv::NCH - 1), F.lane, F.wave, false, 4);
        __builtin_amdgcn_fence(__ATOMIC_RELEASE, "agent");
        if (F.lane == 0) __hip_atomic_store(tflags + F.vcu, 1u, __ATOMIC_RELAXED, __HIP_MEMORY_SCOPE_AGENT);
    }
    int sid;
    if (F.wave == 0) sid = F.vcu;
    else if (F.wave == 1) sid = F.G + (F.vcu - NBW);
    else if (F.wave == 2) sid = 2 * F.G - NBW + (F.vcu - NTW);
    else sid = F.wave * F.G - NBW - NTW + F.vcu;
    const int nslots = NWAVES * F.G - NBW - NTW;
    const int u_hi = ((mode & 2) && !bwave && !twave && !(F.skip & 32)) ? DBATCH * NH : 0;
#pragma unroll 1
    for (int u = sid; u < u_hi; u += nslots) {
        const int sb = u / NH, h = u % NH;
#if WKV_SEQ4
        wkv_seq4_unit(F, wl, MPR + sb * DSEQ, h, F.state_wkv + (size_t)u * 4096, F.out + O_WKVS + (size_t)u * 4096, F.lane);
#else
        wkv_seq_unit(F, wl, MPR + sb * DSEQ, DSEQ, h, F.state_wkv + (size_t)u * 4096, F.out + O_WKVS + (size_t)u * 4096, F.lane);
#endif
    }
}
__device__ __forceinline__ void p8c_wkvC(Frame& F, bool tailmode, unsigned* tflags) {
    int u, uend, ustep;
    if (tailmode) {
        const bool twave = (F.wave == 2 && F.vcu < NB * NH);
        u = F.vcu; uend = (twave && !(F.skip & 8)) ? F.vcu + 1 : 0; ustep = 1;
        if (twave) { while (__hip_atomic_load(tflags + 64 + F.vcu, __ATOMIC_RELAXED, __HIP_MEMORY_SCOPE_AGENT) < 2u) __builtin_amdgcn_s_sleep(8);
            __builtin_amdgcn_fence(__ATOMIC_ACQUIRE, "agent"); }
    } else { u = F.wave * F.G + F.vcu; uend = NB * NH * (wkv::NCH - 1); ustep = NWAVES * F.G; }
#pragma unroll 1
    for (; u < uend; u += ustep) wkv::stageC_unit(F, tailmode ? u * wkv::NCH + (wkv::NCH - 1) : (u >> 6) * wkv::NCH + (u & 63), F.lane);
}
#ifndef PROBE_REPS
#define PROBE_REPS 0
#define PROBE_PHASE 0
#endif
#ifndef WKV_FLOW
#define WKV_FLOW 0
#endif
#ifndef PROBE_STEP
#define PROBE_STEP 0
#endif
#ifndef WKV_ZERO_ROWS
#define WKV_ZERO_ROWS 0
#endif
#ifndef WKV_DELAY
#define WKV_DELAY 0
#endif
#ifndef WKV_EXP
#define WKV_EXP 0
#endif
#ifndef MK_ONE_LAUNCH
#define MK_ONE_LAUNCH 1
#endif
constexpr int N_PHASES = 11;
struct Args { const float* in[27]; float* out; unsigned char* ws; int ph_lo, ph_hi, li, pad; };
__device__ __forceinline__ bool in_phase(int lo, int hi, int k) { asm volatile("" : "+s"(lo), "+s"(hi)); return lo <= k && k < hi; }
__global__ void __launch_bounds__(NWAVES * 64, 2) mega_fwd(Args args) {
    extern __shared__ __attribute__((aligned(16))) unsigned char lds[];
    Frame F;
    F.lds = (LAS unsigned char*)lds;
    F.MISC = (volatile LAS unsigned*)(F.lds + MISC_OFF);
    F.tid = threadIdx.x; F.lane = F.tid & 63; F.wave = __builtin_amdgcn_readfirstlane(F.tid >> 6);
    F.G = gridDim.x; { const int bx = blockIdx.x; F.vcu = (F.G % 8 == 0) ? (bx % 8) * (F.G / 8) + bx / 8 : bx; }
    F.ws = args.ws; F.out = args.out; F.dob = (unsigned char*)args.out;
    F.ctl = (gu32*)(F.ws + WS_CTL); F.skip = args.pad >> 8;
    F.xp = args.in[0]; F.xs = args.in[1]; F.cache_k = args.in[2]; F.cache_v = args.in[3]; F.state_wkv = args.in[4]; F.state_shift = args.in[5];
    F.meta = args.in[6]; F.table = args.in[7]; F.norm_gain = args.in[8]; F.final_gain = args.in[9]; F.a_w_in = args.in[10]; F.sinks = args.in[11]; F.a_w_out = args.in[12];
    F.mu = args.in[13]; F.r_w_in = args.in[14]; F.w0 = args.in[15]; F.w1 = args.in[16]; F.w2 = args.in[17]; F.a0 = args.in[18]; F.a1 = args.in[19]; F.a2 = args.in[20];
    F.k_k = args.in[21]; F.k_a = args.in[22]; F.r_k = args.in[23]; F.ln_g = args.in[24]; F.ln_b = args.in[25]; F.r_w_out = args.in[26];
    for (int u = F.tid; u < (LDS_BYTES - LDSCTL_OFF) / 4; u += NWAVES * 64) ((LAS unsigned*)(F.lds + LDSCTL_OFF))[u] = 0u;
    __syncthreads();
    XcdBarrier bar; bar.bar = (unsigned*)(F.ctl + CW_BAR) + args.li * XCD_BAR_WORDS; bar.x = 0; bar.st = nullptr;
    const int lo = args.ph_lo, hi = args.ph_hi;
    if (hi - lo > 1 || lo == 8) bar = xcd_barrier_post((unsigned*)(F.ctl + CW_BAR) + args.li * XCD_BAR_WORDS, F.MISC + 8);
#define flow (WKV_FLOW && (gridDim.x == 256) && (args.ph_hi - args.ph_lo > 1))
#define rc2 ((unsigned*)(args.ws + WS_CTL) + CW_RC2 + args.li * 256)
#define rc4 ((unsigned*)(args.ws + WS_CTL) + CW_RC4 + args.li * 256)
#define IN(k) (lo <= (k) && (k) < hi)
#define SEAM(k) do { if (IN(k) && IN((k) + 1)) xcd_barrier(bar); } while (0)
    bf16* XA = (bf16*)(F.ws + WS_XA); bf16* QKVG = (bf16*)(F.ws + WS_QKVG); bf16* H1 = (bf16*)(F.ws + WS_H1);
    bf16* Rb = (bf16*)(F.dob); bf16* Kb = (bf16*)(F.dob + RKV_STRIDE); bf16* Vb = (bf16*)(F.dob + 2 * RKV_STRIDE); bf16* Gb = (bf16*)(F.ws + WS_G);

    if (IN(0)) { p0_prologue(F, 2, F.vcu * NWAVES + F.wave, F.G * NWAVES); } SEAM(0);
    if (IN(1)) {
        pg8::Gemm g{XA, (const bf16*)(F.ws + WS_WAIN), MPAD, LDQ, DM, 1 << 30, 0}; pg8::StaticOrder S; S.init(MPAD, LDQ, F.G, (int)blockIdx.x);
        pg8::EpiBf16G E{QKVG, QKVG, QKVG, QKVG, LDQ, 64, MPAD, 4, QSCALE};
        pg8::gemm_phase<pg8::EpiBf16G, pg8::StaticOrder, true, true>(F.lds + RING_OFF, g, S, E);
    } SEAM(1);
    if (IN(2)) { p2_attention(F); } SEAM(2);
    if (IN(3)) {
        pg8::Gemm g{XA, (const bf16*)(F.ws + WS_WAOUT), MPAD, DM, DM, 1 << 30, 0};
        pg8::EpiResB E{nullptr, H1, F.meta, F.xp, F.xs, MTOK};
        if (flow) { pg8::SplitOrder S; S.init(MPAD, DM, F.G, (int)blockIdx.x, rc2); pg8::gemm_phase<pg8::EpiResB, pg8::SplitOrder, true, true>(F.lds + RING_OFF, g, S, E); }
        else { pg8::StaticOrder S; S.init(MPAD, DM, F.G, (int)blockIdx.x); pg8::gemm_phase<pg8::EpiResB, pg8::StaticOrder, true, true>(F.lds + RING_OFF, g, S, E); }
    } if (IN(3) && IN(4) && !flow) xcd_barrier(bar);
    if (IN(4)) { p4_mix(F); } if (IN(4) && IN(6)) xcd_barrier(bar);
    if (IN(6)) {
        {
            pg8::Gemm g{(const bf16*)(F.ws + WS_MIX), (const bf16*)(F.ws + WS_WRIN), MPAD, 4 * DM, DM, 4, MIX_STRIDE}; pg8::StaticOrder S; S.init(MPAD, 4 * DM, F.G, (int)blockIdx.x);
            pg8::EpiBf16G E{Rb, Kb, Vb, Gb, DM, 4, MTOK, 0, 1.f};
            pg8::gemm_phase<pg8::EpiBf16G, pg8::StaticOrder, true, true>(F.lds + RING_OFF, g, S, E);
        }
        __syncthreads();
        {
            const int rot = (((MPAD / 256) * (4 * DM / 256)) % F.G + 7) & ~7;
            const int cid = ((int)blockIdx.x - rot + 4 * F.G) % F.G;
            pg8::Gemm g{(const bf16*)(F.dob + DO_XN1), (const bf16*)(F.ws + WS_W1A1), U_SROW, 256, DM, 1 << 30, 0}; pg8::StaticOrder S; S.init(U_SROW, 256, F.G, cid);
            pg8::EpiF32 E{(float*)(F.ws + WS_U), 256};
            pg8::gemm_phase<pg8::EpiF32, pg8::StaticOrder, true, true>(F.lds + RING_OFF, g, S, E);
            __syncthreads();
            pg8::Gemm g2{(const bf16*)(F.ws + WS_XN1S), (const bf16*)(F.ws + WS_W1A1), 768, 256, DM, 1 << 30, 0}; pg8::StaticOrder S2; S2.init(768, 256, F.G, (cid - 72 + F.G) % F.G);
            pg8::EpiF32 E2{(float*)(F.ws + WS_U) + (size_t)U_SROW * 256, 256};
            pg8::gemm_phase<pg8::EpiF32, pg8::StaticOrder, true, true>(F.lds + RING_OFF, g2, S2, E2);
        }
    } if (IN(6) && IN(7)) xcd_barrier(bar);
    if (IN(7)) { p5_lora1_combine(F); } SEAM(7);
    if (IN(8)) {
#if WKV_EXP == 40 || WKV_EXP == 45
        const int nst = 4; const int prog[4] = {3, 6, 0, 1};
#elif WKV_EXP >= 30
        const int nst = 3; const int prog[4] = {3, 0, 1, 1};
#elif WKV_EXP == 21
        const int nst = 4; const int prog[4] = {0, 1, 2, 4};
#elif WKV_EXP == 0
        const int nst = 3; const int prog[4] = {0, 1, 2, 2};
#elif WKV_EXP == 1
        const int nst = 3; const int prog[4] = {3, 0, 1, 1};
#elif WKV_EXP == 16 || WKV_EXP == 19
        const int nst = 2; const int prog[4] = {3, 1, 1, 1};
#elif WKV_EXP == 10
        const int nst = 4; const int prog[4] = {3, 0, 4, 5};
#elif WKV_EXP == 5 || WKV_EXP == 12
        const int nst = 3; const int prog[4] = {3, 0, 4, 4};
#elif WKV_EXP == 4 || WKV_EXP == 7 || WKV_EXP == 8 || WKV_EXP == 14 || WKV_EXP == 15
        const int nst = 3; const int prog[4] = {3, 0, 1, 1};
#elif WKV_EXP == 2
        const int nst = 4; const int prog[4] = {3, 0, 1, 2};
#else
        const int nst = 2; const int prog[4] = {3, 4, 4, 4};
#endif
#pragma unroll 1
        for (int st = 0; st < nst; ++st) {
            const int kind = st == 0 ? prog[0] : st == 1 ? prog[1] : st == 2 ? prog[2] : prog[3];
            if ((args.pad & 255) && st + 1 != (args.pad & 255)) continue;
            unsigned* tflags = (unsigned*)(F.ctl + CW_TFLAG) + args.li * 128;
            if (kind == 0) p8a_wkvA(F);
            else { if (kind != 2) p8b_wkvB(F, 3, tflags); p8c_wkvC(F, kind != 2, tflags); }
            if (st + 1 < nst && !args.pad) xcd_barrier(bar);
        }
    } SEAM(8);
#if WKV_ZERO_ROWS
    if (blockIdx.x == 0) { bf16* o_ = (bf16*)(F.ws + WS_OG2) + (size_t)16864 * DM; for (int i = F.tid; i < 32 * DM; i += NWAVES * 64) o_[i] = 0; }
    xcd_barrier(bar);
#endif
#if WKV_DELAY
    { const unsigned long long t0_ = __builtin_amdgcn_s_memrealtime(); while (__builtin_amdgcn_s_memrealtime() - t0_ < 20000ull) __builtin_amdgcn_s_sleep(8); }
#endif
    if (IN(9)) {
        pg8::Gemm g{(const bf16*)(F.dob + DO_OG2), (const bf16*)(F.ws + WS_WROUT), MPAD, DM, DM, 1 << 30, 0};
        pg8::EpiResB E{H1, H1, F.meta, F.xp, F.xs, MTOK};
        if (flow) { pg8::SplitOrder S; S.init(MPAD, DM, F.G, (int)blockIdx.x, rc4); pg8::gemm_phase<pg8::EpiResB, pg8::SplitOrder, true, true>(F.lds + RING_OFF, g, S, E); }
        else { pg8::StaticOrder S; S.init(MPAD, DM, F.G, (int)blockIdx.x); pg8::gemm_phase<pg8::EpiResB, pg8::StaticOrder, true, true>(F.lds + RING_OFF, g, S, E); }
    } if (IN(9) && IN(10) && !flow) xcd_barrier(bar);
#ifdef EXTRA_BARRIERS
    if (hi - lo > 1) { for (int e_ = 0; e_ < EXTRA_BARRIERS; ++e_) xcd_barrier(bar); }
#endif
    if (IN(10)) { p8_final(F); }
#undef IN
#undef SEAM
}

extern "C" void kernel_launch(void* const* d_in, const int* in_sizes, int n_in, void* d_out, int out_size, void* d_ws, size_t ws_size, hipStream_t stream) {
    static int grid = 0;
    if (grid == 0) {
        if (n_in != 27 || (size_t)out_size != O_END || ws_size < WS_END) { fprintf(stderr, "kernel_launch: unexpected shapes n_in %d out %d ws %zu\n", n_in, out_size, ws_size); grid = -1; return; }
        int dev = 0, cus = 0, per_cu = 0;
        if (hipGetDevice(&dev) != hipSuccess || hipDeviceGetAttribute(&cus, hipDeviceAttributeMultiprocessorCount, dev) != hipSuccess) { grid = -1; return; }
        if (hipFuncSetAttribute((const void*)mega_fwd, hipFuncAttributeMaxDynamicSharedMemorySize, LDS_BYTES) != hipSuccess) { fprintf(stderr, "kernel_launch: hipFuncSetAttribute failed\n"); grid = -1; return; }
        if (hipOccupancyMaxActiveBlocksPerMultiprocessor(&per_cu, (const void*)mega_fwd, NWAVES * 64, LDS_BYTES) != hipSuccess || per_cu < 1) fprintf(stderr, "kernel_launch: occupancy query says %d\n", per_cu);
        (void)hipGetLastError();
        grid = cus;
    }
    if (grid < 0) return;
    if (hipMemsetAsync((char*)d_ws + WS_CTL, 0, CTL_ZERO_BYTES, stream) != hipSuccess) return;
    Args a{};
    for (int i = 0; i < 27; ++i) a.in[i] = (const float*)d_in[i];
    a.out = (float*)d_out; a.ws = (unsigned char*)d_ws;
#if PROBE_REPS > 0
    for (int r_ = 0; r_ < PROBE_REPS; ++r_) { a.ph_lo = PROBE_PHASE; a.ph_hi = PROBE_PHASE + 1; a.li = 1 + r_; a.pad = PROBE_STEP; hipLaunchKernelGGL(mega_fwd, dim3(grid), dim3(NWAVES * 64), LDS_BYTES, stream, a); }
#endif
#if MK_ONE_LAUNCH
    a.ph_lo = 0; a.ph_hi = N_PHASES; a.li = 0; a.pad = 0;
    hipLaunchKernelGGL(mega_fwd, dim3(grid), dim3(NWAVES * 64), LDS_BYTES, stream, a);
#else
    for (int p = 0; p < N_PHASES; ++p) { a.ph_lo = p; a.ph_hi = p + 1; a.li = p;
        hipLaunchKernelGGL(mega_fwd, dim3(grid), dim3(NWAVES * 64), LDS_BYTES, stream, a); }
#endif
}
```

```cpp
#include <hip/hip_runtime.h>
#include <cstdio>
#include <cstdint>
#define WKV_EXP 0
#define WKV_DUMP_T 4096
#define WKV_VAR 0
#define WKV_SUB 0
#define PROBE_PHASE 0
#define PROBE_REPS 0
#define PROBE_STEP 0
namespace pg8 {
#define PG8_LAS __attribute__((address_space(3)))
typedef unsigned short bf16_t;
typedef short bf16x8 __attribute__((ext_vector_type(8)));
typedef float f32x4 __attribute__((ext_vector_type(4)));
typedef unsigned u32x4 __attribute__((ext_vector_type(4)));
constexpr int BM = 256, BK = 64, HALF = 128, HTB = HALF * BK * 2  , STAGE_BYTES = 8 * HTB, NXCD = 8, WGM = 8;

__host__ __device__ __forceinline__ int lds_byte(int r, int c) { const int st = (r >> 4) * 2 + (c >> 5), rr = r & 15, cc = c & 31, ob = rr * 64 + cc * 2; return st * 1024 + (ob ^ (((ob >> 9) & 1) << 5)); }
__host__ __device__ __forceinline__ void stage_rc(int b, int& R, int& C) { const int st = b / 1024, sb = b % 1024, swz = sb ^ (((sb >> 9) & 1) << 5); R = (st >> 1) * 16 + swz / 64; C = (st & 1) * 32 + (swz % 64) / 2; }
__host__ __device__ __forceinline__ int perm32(int rho) { const int n = rho >> 4, i = rho & 15; return 8 * (i >> 2) + 4 * n + (i & 3); }

struct Unit { int pm, pn; };
struct Gemm { const bf16_t* A; const bf16_t* Bt; int M, N, K; int gdiv; size_t a_gstride; };

struct SplitOrder;
struct StaticOrder {
    int nM, nN, nwg, G, c;
    __host__ __device__ void init(int M, int N, int G_, int c_) { nM = M / BM; nN = N / BM; nwg = nM * nN; G = G_; c = c_; }
    __host__ __device__ bool next(int i, Unit& u) const {
        const long L = (long)i * G + c; if (L >= nwg) return false;
        int wgid = (int)L; { const int q = nwg / NXCD, r = nwg % NXCD, xcd = wgid % NXCD, off = wgid / NXCD; wgid = (xcd < r ? xcd * (q + 1) : r * (q + 1) + (xcd - r) * q) + off; }
        const int nig = WGM * nN, gid = wgid / nig, fm = gid * WGM, gsz = (nM - fm) < WGM ? (nM - fm) : WGM;
        u.pm = fm + ((wgid % nig) % gsz); u.pn = (wgid % nig) / gsz; return true;
    }
    __device__ __forceinline__ void a_ready(const Unit&) const {}
    __device__ __forceinline__ void done(const Unit&) const {}
};
struct SplitOrder {
    StaticOrder a, b; int nMa; unsigned* cnt;
    __device__ void init(int M, int N, int G_, int c_, unsigned* cnt_) { const int nN = N / BM; nMa = G_ / nN; a.init(nMa * BM, N, G_, c_); b.init(M - nMa * BM, N, G_, c_); cnt = cnt_; }
    __device__ bool next(int i, Unit& u) const { if (i == 0) return a.next(0, u); const bool ok = b.next(i - 1, u); u.pm += nMa; return ok; }
    __device__ __forceinline__ void a_ready(const Unit&) const {}
    __device__ __forceinline__ void done(const Unit& u) const {
        __syncthreads();
        if (threadIdx.x < 64) { __builtin_amdgcn_fence(__ATOMIC_RELEASE, "agent");
            if (threadIdx.x == 0) __hip_atomic_fetch_add(cnt + u.pm, 1u, __ATOMIC_RELAXED, __HIP_MEMORY_SCOPE_AGENT); }
    }
};

__device__ __forceinline__ unsigned cvt_pk_bf16(float lo, float hi) { unsigned r; asm volatile("v_cvt_pk_bf16_f32 %0, %1, %2" : "=v"(r) : "v"(lo), "v"(hi)); return r; }
struct EpiBf16G {
    static constexpr bool PERM = true, AFTER_DRAIN = false;
    bf16_t *O0, *O1, *O2, *O3; int ldc, tpg, Mvalid, scale_tiles; float scale0;
    __device__ __forceinline__ void operator()(const f32x4 (&acc)[2][2][4][2], const Unit& u, int wr, int wc, int fr, int fq) const {
        const int grp = u.pn / tpg, colt = (u.pn - grp * tpg) * BM;
        bf16_t* base = grp == 0 ? O0 : grp == 1 ? O1 : grp == 2 ? O2 : O3;
        const float sc = (u.pn < scale_tiles) ? scale0 : 1.f;
        const int row0 = u.pm * BM + wr * 64 + fr, col0 = colt + wc * 32 + 8 * fq;
#pragma unroll
        for (int ai = 0; ai < 2; ++ai)
#pragma unroll
            for (int m = 0; m < 4; ++m) { const int row = row0 + ai * HALF + m * 16; const unsigned roff = (unsigned)(((size_t)row * ldc + col0) * 2);
                if (row < Mvalid) {
#pragma unroll
                for (int bj = 0; bj < 2; ++bj) { const f32x4 v0 = acc[ai][bj][m][0] * sc, v1 = acc[ai][bj][m][1] * sc;
                    u32x4 w; w.x = cvt_pk_bf16(v0[0], v0[1]); w.y = cvt_pk_bf16(v0[2], v0[3]); w.z = cvt_pk_bf16(v1[0], v1[1]); w.w = cvt_pk_bf16(v1[2], v1[3]);
                    *(u32x4*)((char*)base + roff + bj * HALF * 2) = w; } } }
    }
};
struct EpiRes {
    static constexpr bool PERM = false, AFTER_DRAIN = false;
    const float* base; float* out; const float *meta, *xp, *xs; int Mvalid;
    __device__ __forceinline__ void operator()(const f32x4 (&acc)[2][2][4][2], const Unit& u, int wr, int wc, int fr, int fq) const {
        const int row0 = u.pm * BM + wr * 64 + fr, col0 = u.pn * BM + wc * 32 + 4 * fq;
#pragma unroll
        for (int ai = 0; ai < 2; ++ai)
#pragma unroll
            for (int m = 0; m < 4; ++m) { const int row = row0 + ai * HALF + m * 16;
                if (row < Mvalid) {
                    const float* b;
                    if (base) b = base + (size_t)row * 1024;
                    else if (row < 16448) { const int bb = row / 4112, t = row - bb * 4112; b = t < 16 ? meta + t * 1024 : xp + ((size_t)bb * 4096 + (t - 16)) * 1024; }
                    else b = xs + (size_t)(row - 16448) * 1024;
                    float* o = out + (size_t)row * 1024;
#pragma unroll
                    for (int bj = 0; bj < 2; ++bj)
#pragma unroll
                        for (int n = 0; n < 2; ++n) { const int c = col0 + bj * HALF + n * 16; const f32x4 r = *(const f32x4*)(b + c); *(f32x4*)(o + c) = r + acc[ai][bj][m][n]; } } }
    }
};

struct EpiResB {
    static constexpr bool PERM = true, AFTER_DRAIN = false;
    const bf16_t* base; bf16_t* out; const float *meta, *xp, *xs; int Mvalid;
    __device__ __forceinline__ void operator()(const f32x4 (&acc)[2][2][4][2], const Unit& u, int wr, int wc, int fr, int fq) const {
        const int row0 = u.pm * BM + wr * 64 + fr, col0 = u.pn * BM + wc * 32 + 8 * fq;
#pragma unroll
        for (int ai = 0; ai < 2; ++ai)
#pragma unroll
            for (int m = 0; m < 4; ++m) { const int row = row0 + ai * HALF + m * 16;
                if (row < Mvalid) {
                    const unsigned ooff = (unsigned)(((size_t)row * 1024 + col0) * 2);
                    if (base) {
                        const bf16_t* b = base + (size_t)row * 1024 + col0;
#pragma unroll
                        for (int bj = 0; bj < 2; ++bj) { const u32x4 rw = *(const u32x4*)(b + bj * HALF); const f32x4 a0 = acc[ai][bj][m][0], a1 = acc[ai][bj][m][1]; u32x4 w;
                            w.x = cvt_pk_bf16(a0[0] + __builtin_bit_cast(float, rw.x << 16), a0[1] + __builtin_bit_cast(float, rw.x & 0xffff0000u));
                            w.y = cvt_pk_bf16(a0[2] + __builtin_bit_cast(float, rw.y << 16), a0[3] + __builtin_bit_cast(float, rw.y & 0xffff0000u));
                            w.z = cvt_pk_bf16(a1[0] + __builtin_bit_cast(float, rw.z << 16), a1[1] + __builtin_bit_cast(float, rw.z & 0xffff0000u));
                            w.w = cvt_pk_bf16(a1[2] + __builtin_bit_cast(float, rw.w << 16), a1[3] + __builtin_bit_cast(float, rw.w & 0xffff0000u));
                            *(u32x4*)((char*)out + ooff + bj * HALF * 2) = w; }
                    } else {
                        const float* b;
                        if (row < 16448) { const int bb = row / 4112, t = row - bb * 4112; b = t < 16 ? meta + t * 1024 : xp + ((size_t)bb * 4096 + (t - 16)) * 1024; }
                        else b = xs + (size_t)(row - 16448) * 1024;
                        b += col0;
#pragma unroll
                        for (int bj = 0; bj < 2; ++bj) { const f32x4 r0 = *(const f32x4*)(b + bj * HALF), r1 = *(const f32x4*)(b + bj * HALF + 4); const f32x4 v0 = acc[ai][bj][m][0] + r0, v1 = acc[ai][bj][m][1] + r1; u32x4 w;
                            w.x = cvt_pk_bf16(v0[0], v0[1]); w.y = cvt_pk_bf16(v0[2], v0[3]); w.z = cvt_pk_bf16(v1[0], v1[1]); w.w = cvt_pk_bf16(v1[2], v1[3]);
                            *(u32x4*)((char*)out + ooff + bj * HALF * 2) = w; }
                    } } }
    }
};

struct EpiT12 {
    static constexpr bool PERM = false, AFTER_DRAIN = false;
    float* t12; int Mvalid; unsigned char* t12b;
    __device__ __forceinline__ void operator()(const f32x4 (&acc)[2][2][4][2], const Unit& u, int wr, int wc, int fr, int fq) const {
        if (wc >= 2) return;
        const int row0 = u.pm * BM + wr * 64 + fr, col0 = wc * 32 + 4 * fq;
#pragma unroll
        for (int ai = 0; ai < 2; ++ai)
#pragma unroll
            for (int m = 0; m < 4; ++m) { const int row = row0 + ai * HALF + m * 16;
                if (row < Mvalid) {
                    float* o = t12 + (size_t)row * 128 + u.pn * 64 + col0;
                    const int bb = row / 4112, t = row - bb * 4112;
                    unsigned char* ob = t12b + ((size_t)((bb * 129 + (t >> 5)) * 8 + u.pn * 4) * 64 + (t & 31)) * 16;
#pragma unroll
                    for (int n = 0; n < 2; ++n) { f32x4 v = acc[ai][0][m][n];
                        if (u.pn == 0) { v[0] = tanhf(v[0]); v[1] = tanhf(v[1]); v[2] = tanhf(v[2]); v[3] = tanhf(v[3]); }
                        *(f32x4*)(o + n * 16) = v;
                        if (row < 16448) { const int j = col0 + n * 16;
                            *(unsigned long long*)(ob + ((j >> 4) * 64 + 32 * ((j >> 3) & 1)) * 16 + (j & 7) * 2) = (unsigned long long)cvt_pk_bf16(v[0], v[1]) | ((unsigned long long)cvt_pk_bf16(v[2], v[3]) << 32); } } } }
    }
};

struct EpiF32 {
    static constexpr bool PERM = false, AFTER_DRAIN = false;
    float* out; int ldc;
    __device__ __forceinline__ void operator()(const f32x4 (&acc)[2][2][4][2], const Unit& u, int wr, int wc, int fr, int fq) const {
        const int row0 = u.pm * BM + wr * 64 + fr, col0 = u.pn * BM + wc * 32 + 4 * fq;
#pragma unroll
        for (int ai = 0; ai < 2; ++ai)
#pragma unroll
            for (int m = 0; m < 4; ++m) { const int row = row0 + ai * HALF + m * 16; const unsigned ooff = (unsigned)(((size_t)row * ldc + col0) * 4);
#pragma unroll
                for (int bj = 0; bj < 2; ++bj)
#pragma unroll
                    for (int n = 0; n < 2; ++n) *(f32x4*)((char*)out + ooff + (bj * HALF + n * 16) * 4) = acc[ai][bj][m][n]; }
    }
};
template <class Epi, class Sched, bool ALIGN_EPI = false, bool SP2 = false>
__device__ __forceinline__ void gemm_phase(PG8_LAS unsigned char* lds, const Gemm g, const Sched& S, const Epi& E) {
    const int tid = threadIdx.x, wid = __builtin_amdgcn_readfirstlane(tid >> 6), lane = tid & 63, wr = wid >> 2, wc = wid & 3, fr = lane & 15, fq = lane >> 4;
    const int K = g.K, nt = K / BK;
    unsigned voffA[2], voffB[2];
#pragma unroll
    for (int i = 0; i < 2; ++i) { int R, C; stage_rc(tid * 16 + i * 8192, R, C); const int Rb = Epi::PERM ? ((R & ~31) + perm32(R & 31)) : R;
        voffA[i] = (unsigned)(R * K + C) * 2u; voffB[i] = (unsigned)(Rb * K + C) * 2u; }
    const size_t kstep = (size_t)(BK * 2);
    const size_t hstep = (size_t)HALF * K * 2;
    const size_t tstep = 2 * hstep;
    const unsigned ldsw = (unsigned)wid * 1024u;
    const int aoff = lds_byte(wr * 64 + fr, fq * 8), boff = lds_byte(wc * 32 + fr, fq * 8);
#define PG8_SA(b, h) (((b) * 2 + (h)) * HTB)
#define PG8_SB(b, h) ((4 + (b) * 2 + (h)) * HTB)
#define PG8_STAGE(bufoff, gbase, voff) do { _Pragma("unroll") for (int _i = 0; _i < 2; ++_i) \
        __builtin_amdgcn_global_load_lds((const unsigned*)((const char*)(gbase) + (voff)[_i]), (PG8_LAS unsigned*)(lds + (bufoff) + ldsw + _i * 8192), 16, 0, 0); } while (0)
#define PG8_LDA(dst, b, h) do { _Pragma("unroll") for (int m = 0; m < 4; ++m) _Pragma("unroll") for (int k = 0; k < 2; ++k) dst[m][k] = *(const PG8_LAS bf16x8*)(lds + PG8_SA(b, h) + aoff + m * 2048 + k * 1024); } while (0)
#define PG8_LDB(dst, b, h) do { _Pragma("unroll") for (int n = 0; n < 2; ++n) _Pragma("unroll") for (int k = 0; k < 2; ++k) dst[n][k] = *(const PG8_LAS bf16x8*)(lds + PG8_SB(b, h) + boff + n * 2048 + k * 1024); } while (0)
#define PG8_MMA(ai, bj, At, Bt) do { __builtin_amdgcn_s_setprio(1); _Pragma("unroll") for (int m = 0; m < 4; ++m) _Pragma("unroll") for (int n = 0; n < 2; ++n) _Pragma("unroll") for (int k = 0; k < 2; ++k) \
        acc[ai][bj][m][n] = __builtin_amdgcn_mfma_f32_16x16x32_bf16(Bt[n][k], At[m][k], acc[ai][bj][m][n], 0, 0, 0); __builtin_amdgcn_s_setprio(0); } while (0)
#define PG8_WAIT_V(n) asm volatile("s_waitcnt vmcnt(" #n ")" ::: "memory")
#define PG8_WAIT_L(n) asm volatile("s_waitcnt lgkmcnt(" #n ")" ::: "memory")
#define PG8_BAR __builtin_amdgcn_s_barrier()
#define PG8_SCHED __builtin_amdgcn_sched_barrier(0)
    Unit cur, nxt; int ui = 0;
    if (!S.next(0, cur)) return;
    f32x4 acc[2][2][4][2];
#pragma unroll
    for (int a = 0; a < 2; ++a)
#pragma unroll
        for (int b = 0; b < 2; ++b)
#pragma unroll
            for (int m = 0; m < 4; ++m)
#pragma unroll
                for (int n = 0; n < 2; ++n) acc[a][b][m][n] = (f32x4){0.f, 0.f, 0.f, 0.f};
    bf16x8 At[4][2], B0[2][2], B1[2][2];
    const char* cA = (const char*)g.A + (size_t)(cur.pn / g.gdiv) * g.a_gstride + (size_t)cur.pm * tstep; const char* cB = (const char*)g.Bt + (size_t)cur.pn * tstep;
    S.a_ready(cur);
    if constexpr (SP2) {
        PG8_STAGE(PG8_SB(0, 0), cB, voffB); PG8_STAGE(PG8_SB(0, 1), cB + hstep, voffB); PG8_STAGE(PG8_SA(0, 0), cA, voffA); PG8_STAGE(PG8_SA(0, 1), cA + hstep, voffA);
        if (wr == 1) PG8_BAR;
        PG8_WAIT_V(2); PG8_BAR;
        PG8_STAGE(PG8_SB(1, 0), cB + kstep, voffB); PG8_STAGE(PG8_SA(1, 0), cA + kstep, voffA); PG8_STAGE(PG8_SB(1, 1), cB + hstep + kstep, voffB);
        PG8_WAIT_V(6); PG8_BAR;
    } else {
        PG8_STAGE(PG8_SB(0, 0), cB, voffB); PG8_STAGE(PG8_SA(0, 0), cA, voffA); PG8_STAGE(PG8_SB(0, 1), cB + hstep, voffB); PG8_STAGE(PG8_SA(0, 1), cA + hstep, voffA);
        if (wr == 1) PG8_BAR;
        PG8_WAIT_V(4); PG8_BAR;
        PG8_STAGE(PG8_SB(1, 0), cB + kstep, voffB); PG8_STAGE(PG8_SA(1, 0), cA + kstep, voffA); PG8_STAGE(PG8_SB(1, 1), cB + hstep + kstep, voffB);
        PG8_WAIT_V(6); PG8_BAR;
    }
    for (;;) {
        const bool has_next = S.next(ui + 1, nxt);
        const char* nA = has_next ? (const char*)g.A + (size_t)(nxt.pn / g.gdiv) * g.a_gstride + (size_t)nxt.pm * tstep : cA; const char* nB = has_next ? (const char*)g.Bt + (size_t)nxt.pn * tstep : cB;
        for (int t = 0; t < nt; t += 2) {
            const bool last = (t == nt - 2);
            const char* a1 = cA + (size_t)(t + 1) * kstep;
            const char* a2 = last ? nA : cA + (size_t)(t + 2) * kstep; const char* b2 = last ? nB : cB + (size_t)(t + 2) * kstep;
            const char* a3 = a2 + kstep; const char* b3 = b2 + kstep;
            if (last && has_next) S.a_ready(nxt);
            if constexpr (SP2) {
            PG8_LDB(B0, 0, 0); PG8_LDB(B1, 0, 1); PG8_SCHED; PG8_LDA(At, 0, 0); PG8_STAGE(PG8_SA(1, 1), a1 + hstep, voffA);
            PG8_WAIT_V(8); PG8_WAIT_L(0); PG8_BAR; PG8_MMA(0, 0, At, B0); PG8_MMA(0, 1, At, B1); PG8_BAR; PG8_SCHED;
            PG8_LDA(At, 0, 1); PG8_STAGE(PG8_SB(0, 0), b2, voffB); PG8_STAGE(PG8_SB(0, 1), b2 + hstep, voffB); PG8_STAGE(PG8_SA(0, 0), a2, voffA);
            PG8_WAIT_V(8); PG8_WAIT_L(0); PG8_BAR; PG8_MMA(1, 0, At, B0); PG8_MMA(1, 1, At, B1); PG8_BAR; PG8_SCHED;
            PG8_LDB(B0, 1, 0); PG8_LDB(B1, 1, 1); PG8_SCHED; PG8_LDA(At, 1, 0); PG8_STAGE(PG8_SA(0, 1), a2 + hstep, voffA);
            PG8_WAIT_V(8); PG8_WAIT_L(0); PG8_BAR; PG8_MMA(0, 0, At, B0); PG8_MMA(0, 1, At, B1); PG8_BAR; PG8_SCHED;
            PG8_LDA(At, 1, 1); PG8_STAGE(PG8_SB(1, 0), b3, voffB); PG8_STAGE(PG8_SB(1, 1), b3 + hstep, voffB); PG8_STAGE(PG8_SA(1, 0), a3, voffA);
            PG8_WAIT_V(8); PG8_WAIT_L(0); PG8_BAR; PG8_MMA(1, 0, At, B0); PG8_MMA(1, 1, At, B1); PG8_BAR; PG8_SCHED;
            } else {
            PG8_LDB(B0, 0, 0); PG8_SCHED; PG8_LDA(At, 0, 0); PG8_STAGE(PG8_SA(1, 1), a1 + hstep, voffA);
            PG8_WAIT_L(8); PG8_BAR; PG8_WAIT_L(0); PG8_MMA(0, 0, At, B0); PG8_BAR; PG8_SCHED;
            PG8_LDB(B1, 0, 1); PG8_STAGE(PG8_SB(0, 0), b2, voffB);
            PG8_BAR; PG8_WAIT_L(0); PG8_MMA(0, 1, At, B1); PG8_BAR;
            PG8_LDA(At, 0, 1); PG8_STAGE(PG8_SA(0, 0), a2, voffA);
            PG8_BAR; PG8_WAIT_L(0); PG8_MMA(1, 0, At, B0); PG8_BAR; PG8_SCHED;
            PG8_STAGE(PG8_SB(0, 1), b2 + hstep, voffB);
            PG8_WAIT_V(6); PG8_BAR; PG8_MMA(1, 1, At, B1); PG8_BAR;
            PG8_LDB(B0, 1, 0); PG8_SCHED; PG8_LDA(At, 1, 0); PG8_STAGE(PG8_SA(0, 1), a2 + hstep, voffA);
            PG8_WAIT_L(8); PG8_BAR; PG8_WAIT_L(0); PG8_MMA(0, 0, At, B0); PG8_BAR; PG8_SCHED;
            PG8_LDB(B1, 1, 1); PG8_STAGE(PG8_SB(1, 0), b3, voffB);
            PG8_BAR; PG8_WAIT_L(0); PG8_MMA(0, 1, At, B1); PG8_BAR;
            PG8_LDA(At, 1, 1); PG8_STAGE(PG8_SA(1, 0), a3, voffA);
            PG8_BAR; PG8_WAIT_L(0); PG8_MMA(1, 0, At, B0); PG8_BAR; PG8_SCHED;
            PG8_STAGE(PG8_SB(1, 1), b3 + hstep, voffB);
            PG8_WAIT_V(6); PG8_BAR; PG8_MMA(1, 1, At, B1); PG8_BAR;
            }
        }
        if constexpr (ALIGN_EPI) { if (wr == 0) PG8_BAR; }
        if constexpr (!Epi::AFTER_DRAIN) { E(acc, cur, wr, wc, fr, fq); S.done(cur); }
        if (!has_next) break;
#pragma unroll
        for (int a = 0; a < 2; ++a)
#pragma unroll
            for (int b = 0; b < 2; ++b)
#pragma unroll
                for (int m = 0; m < 4; ++m)
#pragma unroll
                    for (int n = 0; n < 2; ++n) acc[a][b][m][n] = (f32x4){0.f, 0.f, 0.f, 0.f};
        cur = nxt; cA = nA; cB = nB; ++ui;
        if constexpr (ALIGN_EPI) { if (wr == 1) PG8_BAR; }
    }
    PG8_WAIT_V(0);
    if constexpr (!ALIGN_EPI) { if (wr == 0) PG8_BAR; }
    PG8_BAR;
    if constexpr (Epi::AFTER_DRAIN) { E.fused(acc, cur, wr, wc, fr, fq, lds, wid, lane); S.done(cur); }
#undef PG8_SA
#undef PG8_SB
#undef PG8_STAGE
#undef PG8_LDA
#undef PG8_LDB
#undef PG8_MMA
#undef PG8_WAIT_V
#undef PG8_WAIT_L
#undef PG8_BAR
#undef PG8_SCHED
}
}
#define GAS __attribute__((address_space(1)))
#define LAS __attribute__((address_space(3)))
typedef unsigned short bf16;
typedef unsigned v4u __attribute__((ext_vector_type(4)));
typedef float f32x4 __attribute__((ext_vector_type(4)));
typedef short bf16x8 __attribute__((ext_vector_type(8)));
typedef GAS unsigned gu32;
typedef GAS unsigned long long gu64;
#define RLX_AGENT __ATOMIC_RELAXED, __HIP_MEMORY_SCOPE_AGENT
#define LDS_WAIT() asm volatile("s_waitcnt lgkmcnt(0)" ::: "memory")
#define VM_WAIT() asm volatile("s_waitcnt vmcnt(0)" ::: "memory")
__device__ __forceinline__ unsigned long long rt() { return __builtin_amdgcn_s_memrealtime(); }
__device__ __forceinline__ unsigned f2bf(float f) { unsigned u = __builtin_bit_cast(unsigned, f); return (u + 0x7fffu + ((u >> 16) & 1u)) >> 16; }
typedef __bf16 pk_bf2_t __attribute__((ext_vector_type(2))); typedef float pk_f2_t __attribute__((ext_vector_type(2)));
__device__ __forceinline__ unsigned pk2(float lo, float hi) { const pk_f2_t v = {lo, hi}; return __builtin_bit_cast(unsigned, __builtin_convertvector(v, pk_bf2_t)); }

#define XB_TMO      128
#define XB_XCNT(j)  (256  + 64 * (j))
#define XB_XSUB(j)  (1280 + 64 * (j))
#define XB_XGEN(j)  (2304 + 64 * (j))
#define XB_TOP      3328
#define XB_TOPGEN   3392
#define XCD_BAR_WORDS 3456
#define XB_SPIN_CAP (1u << 18)

__device__ __forceinline__ unsigned xb_ld(unsigned* p)              { return __hip_atomic_load(p, __ATOMIC_RELAXED, __HIP_MEMORY_SCOPE_AGENT); }
__device__ __forceinline__ unsigned xb_add(unsigned* p, unsigned v) { return __hip_atomic_fetch_add(p, v, __ATOMIC_RELAXED, __HIP_MEMORY_SCOPE_AGENT); }
__device__ __forceinline__ unsigned xb_xcc_id() { return (unsigned)__builtin_amdgcn_s_getreg((3 << 11) | 20) & 0xFu; }
#define XB_SPIN(cond, bar) do { unsigned _sp = 0; while (cond) { __builtin_amdgcn_s_sleep(1); \
    if ((++_sp & 255u) == 0u) { if (xb_ld(&(bar)[XB_TMO])) break; if (_sp > XB_SPIN_CAP) { atomicAdd(&(bar)[XB_TMO], 1u); break; } } } } while (0)

struct XcdBarrier {
    unsigned* bar; unsigned x;
    volatile LAS unsigned* st;
};

__device__ __forceinline__ XcdBarrier xcd_barrier_post(unsigned* bar, volatile LAS unsigned* st) {
    XcdBarrier b; b.bar = bar; b.x = xb_xcc_id(); b.st = st;
    if (threadIdx.x == 0) (void)xb_add(&bar[XB_XCNT(b.x)], 1u);
    return b;
}
__device__ __forceinline__ void xcd_barrier_complete(unsigned* bar, unsigned x, unsigned& nloc, unsigned& nx) {
    const unsigned G = gridDim.x * gridDim.y * gridDim.z;
    unsigned sum, cnt, mine, sp = 0u;
    for (;;) {
        sum = 0u; cnt = 0u; mine = 0u;
#pragma unroll
        for (unsigned j = 0; j < 16; ++j) { const unsigned c = xb_ld(&bar[XB_XCNT(j)]); sum += c; cnt += (c > 0u) ? 1u : 0u; mine = (j == x) ? c : mine; }
        if (sum == G) break;
        __builtin_amdgcn_s_sleep(1);
        if ((++sp & 255u) == 0u) { if (xb_ld(&bar[XB_TMO])) break; if (sp > XB_SPIN_CAP) { atomicAdd(&bar[XB_TMO], 1u); break; } }
    }
    nloc = mine > 0u ? mine : 1u; nx = cnt > 0u ? cnt : 1u;
}

__device__ __forceinline__ void xcd_barrier(const XcdBarrier& b) {
    asm volatile("s_waitcnt vmcnt(0)" ::: "memory");
    __syncthreads();
    if (threadIdx.x == 0) {
        unsigned* bar = b.bar;
        __builtin_amdgcn_s_waitcnt(0);
        unsigned nloc = b.st[0], nx = b.st[1];
        if (nloc == 0u) { xcd_barrier_complete(bar, b.x, nloc, nx); b.st[0] = nloc; b.st[1] = nx; }
        const unsigned old = xb_add(&bar[XB_XSUB(b.x)], 1u);
        const unsigned gen = old / nloc;
        if (old + 1u == (gen + 1u) * nloc) {
            __builtin_amdgcn_fence(__ATOMIC_RELEASE, "agent");
            asm volatile("s_waitcnt vmcnt(0)" ::: "memory");
            const unsigned og = xb_add(&bar[XB_TOP], 1u);
            const unsigned tg = og / nx;
            if (og + 1u == (tg + 1u) * nx) xb_add(&bar[XB_TOPGEN], 1u);
            else XB_SPIN(xb_ld(&bar[XB_TOPGEN]) == tg, bar);
            __builtin_amdgcn_fence(__ATOMIC_ACQUIRE, "agent");
            xb_add(&bar[XB_XGEN(b.x)], 1u);
            asm volatile("s_waitcnt vmcnt(0)" ::: "memory");
        } else {
            XB_SPIN(xb_ld(&bar[XB_XGEN(b.x)]) == gen, bar);
            __builtin_amdgcn_fence(__ATOMIC_ACQUIRE, "agent");
            asm volatile("s_waitcnt vmcnt(0)" ::: "memory");
        }
    }
    __syncthreads();
}
constexpr int NWAVES = 8;
constexpr int DM = 1024, NB = 4, SEQ = 4096, NMETA = 16, LP = 4112, MPR = 16448, DBATCH = 128, DSEQ = 4, MSAMP = 512, MTOK = 16960, MPAD = 17152;
constexpr int NH = 16, HD = 64, NKV = 4, LDQ = 2560, WIN = 128;
constexpr float RMS_EPS = 1e-6f, GN_EPS = 64e-5f, LOG2E = 1.4426950408889634f, QSCALE = 0.125f * 1.4426950408889634f;
constexpr size_t O_YP = 0, O_YS = 16777216, O_WKP = 17301504, O_WVP = 17432576, O_WKVP = 17563648, O_SHP = 17825792, O_WKS = 17829888, O_WVS = 22024192, O_WKVS = 26218496, O_SHS = 34607104, O_END = 34738176;
constexpr size_t MiB = 1u << 20;
constexpr size_t WS_CTL = 0, CTL_ZERO_BYTES = 1 * MiB;
constexpr size_t WS_T12B = 1 * MiB;
constexpr size_t WS_WAIN = 1 * MiB, WS_WAOUT = 6 * MiB, WS_WRIN = 8 * MiB, WS_WROUT = 16 * MiB, WS_W1A1 = 185 * MiB;
constexpr size_t WS_XN1S = 186 * MiB, WS_U = 164 * MiB;
constexpr int U_SROW = 16640;
constexpr size_t WS_KVP = 18 * MiB + 512 * 1024, WS_KVS = 19 * MiB, WS_SHP = 19 * MiB + 512 * 1024, WS_WKVP = 20 * MiB, WS_T12 = 21 * MiB;
constexpr size_t WS_XA = 30 * MiB, WS_QKVG = 64 * MiB, WS_H1 = 189 * MiB, WS_MIX = 30 * MiB, MIX_STRIDE = (size_t)MPAD * DM * 2, WS_G = 222 * MiB + 512 * 1024, WS_OG2 = 64 * MiB, WS_END = 256 * MiB;
constexpr size_t RKV_STRIDE = (size_t)MTOK * DM * 2, DO_XN1 = 3 * RKV_STRIDE,
     DO_OG2 = 2 * RKV_STRIDE;
static_assert(WS_T12 + (size_t)MTOK * 128 * 4 <= WS_XA && WS_XA + MIX_STRIDE <= WS_QKVG && WS_QKVG + (size_t)MPAD * LDQ * 2 <= WS_H1 && WS_MIX + 4 * MIX_STRIDE <= WS_H1 && WS_H1 + (size_t)MPAD * DM * 4 <= WS_END, "ws map");
static_assert(3 * RKV_STRIDE <= O_WKVS * 4 && 2 * MIX_STRIDE <= O_END * 4, "d_out scratch map");
constexpr int CW_TMO = 0, CW_CODE = 1, CW_BAR = 4096, CW_TFLAG = 65536, CW_RC2 = 70000, CW_RC4 = 70128;
constexpr int RING_OFF = 0, RING_BYTES = 131072, LDSCTL_OFF = RING_BYTES, MISC_OFF = LDSCTL_OFF + 320, LDS_BYTES = 147456;

typedef short s16x4 __attribute__((ext_vector_type(4)));
typedef float f32x16 __attribute__((ext_vector_type(16)));
struct Frame {
    LAS unsigned char* lds;
    volatile LAS unsigned* MISC;
    gu32* ctl;
    int tid, lane, wave, vcu, G, skip;
    const float *xp, *xs, *cache_k, *cache_v, *state_wkv, *state_shift, *meta, *table, *norm_gain, *final_gain, *a_w_in, *sinks, *a_w_out;
    const float *mu, *r_w_in, *w0, *w1, *w2, *a0, *a1, *a2, *k_k, *k_a, *r_k, *ln_g, *ln_b, *r_w_out;
    float* out; unsigned char* ws; unsigned char* dob;
};
template <int CTRL> __device__ __forceinline__ float dpp_mov(float v) { return __builtin_bit_cast(float, __builtin_amdgcn_update_dpp(0, __builtin_bit_cast(int, v), CTRL, 0xF, 0xF, true)); }
__device__ __forceinline__ float wave_sum(float v) {
    v += dpp_mov<0xB1>(v);
    v += dpp_mov<0x4E>(v);
    v += dpp_mov<0x141>(v);
    v += dpp_mov<0x140>(v);
    v += __shfl_xor(v, 16);
    { const unsigned u = __builtin_bit_cast(unsigned, v); auto r = __builtin_amdgcn_permlane32_swap(u, u, false, false); v = __builtin_bit_cast(float, (unsigned)r[0]) + __builtin_bit_cast(float, (unsigned)r[1]); }
    return v;
}
__device__ __forceinline__ float bf2f(bf16 b) { return __builtin_bit_cast(float, (unsigned)b << 16); }
__device__ __forceinline__ const float* h0_row(const Frame& F, int m) {
    if (m < MPR) { const int b = m / LP, t = m - b * LP; return t < NMETA ? F.meta + t * DM : F.xp + ((size_t)b * SEQ + (t - NMETA)) * DM; }
    return F.xs + (size_t)(m - MPR) * DM;
}
__device__ __forceinline__ void p0_transpose_item(const float* W, int K, int N, bf16* WT, int row_off, LAS float* scr, int item, int lane, const float* sc = nullptr, bool one_minus = false) {
    const int nblk = N / 32, kb = item / nblk, nb = item % nblk, k0 = 64 * kb, n0 = 32 * nb;
#pragma unroll 8
    for (int i = 0; i < 32; ++i) { const int kk = 2 * i + (lane >> 5); float w = W[(size_t)(k0 + kk) * N + n0 + (lane & 31)]; if (sc) { const float s_ = sc[k0 + kk]; w *= one_minus ? 1.0f - s_ : s_; } scr[kk * 33 + (lane & 31)] = w; }
    LDS_WAIT(); asm volatile("" ::: "memory");
    const int c = lane & 7;
#pragma unroll
    for (int j = 0; j < 4; ++j) { const int n = (lane >> 3) + 8 * j; const LAS float* s = scr + (8 * c) * 33 + n;
        v4u o; o.x = pk2(s[0 * 33], s[1 * 33]); o.y = pk2(s[2 * 33], s[3 * 33]); o.z = pk2(s[4 * 33], s[5 * 33]); o.w = pk2(s[6 * 33], s[7 * 33]);
        *(GAS v4u*)(WT + (size_t)(row_off + n0 + n) * K + k0 + 8 * c) = o; }
    LDS_WAIT(); asm volatile("" ::: "memory");
}
__device__ __forceinline__ void rms_row(const float* xrow, const float* gain, int lane, f32x4 (&v)[4]) {
    const GAS f32x4* xr = (const GAS f32x4*)xrow + lane; float s = 0.f;
#pragma unroll
    for (int j = 0; j < 4; ++j) { v[j] = xr[64 * j]; s += (v[j].x * v[j].x + v[j].y * v[j].y) + (v[j].z * v[j].z + v[j].w * v[j].w); }
    const float rstd = 1.0f / sqrtf(wave_sum(s) * (1.f / DM) + RMS_EPS);
    const GAS f32x4* gr = (const GAS f32x4*)gain + lane;
#pragma unroll
    for (int j = 0; j < 4; ++j) v[j] = v[j] * rstd * gr[64 * j];
}
__device__ __forceinline__ void rms_row_b(const bf16* xrow, const float* gain, int lane, f32x4 (&v)[4]) {
    const GAS unsigned long long* xr = (const GAS unsigned long long*)xrow + lane; float s = 0.f;
#pragma unroll
    for (int j = 0; j < 4; ++j) { const unsigned long long w = xr[64 * j];
        v[j].x = __builtin_bit_cast(float, (unsigned)w << 16); v[j].y = __builtin_bit_cast(float, (unsigned)w & 0xffff0000u); v[j].z = __builtin_bit_cast(float, (unsigned)(w >> 32) << 16); v[j].w = __builtin_bit_cast(float, (unsigned)(w >> 32) & 0xffff0000u);
        s += (v[j].x * v[j].x + v[j].y * v[j].y) + (v[j].z * v[j].z + v[j].w * v[j].w); }
    const float rstd = 1.0f / sqrtf(wave_sum(s) * (1.f / DM) + RMS_EPS);
    const GAS f32x4* gr = (const GAS f32x4*)gain + lane;
#pragma unroll
    for (int j = 0; j < 4; ++j) v[j] = v[j] * rstd * gr[64 * j];
}
__device__ __forceinline__ void store_bf16_row(bf16* orow, int lane, const f32x4 (&v)[4]) {
    GAS unsigned long long* o8 = (GAS unsigned long long*)orow + lane;
#pragma unroll
    for (int j = 0; j < 4; ++j) o8[64 * j] = (unsigned long long)pk2(v[j].x, v[j].y) | ((unsigned long long)pk2(v[j].z, v[j].w) << 32);
}
__device__ __forceinline__ void p0_prologue(Frame& F, int part, int gw, int NGW) {
    LAS float* scr = (LAS float*)(F.lds + RING_OFF + F.wave * 16384);
    bf16* wain = (bf16*)(F.ws + WS_WAIN); bf16* waout = (bf16*)(F.ws + WS_WAOUT); bf16* wrin = (bf16*)(F.ws + WS_WRIN); bf16* wrout = (bf16*)(F.ws + WS_WROUT); bf16* w1a1 = (bf16*)(F.ws + WS_W1A1);
    constexpr int I_AIN = 16 * 80, I_SQ = 16 * 32, I_L1 = 16 * 2;
    constexpr int I_L2 = 32;
    constexpr int NITEMS = I_AIN + 6 * I_SQ + 4 * I_L1 + 2 * I_L2;
    for (int it = (part == 1 ? I_AIN : 0) + gw; it < (part == 0 ? I_AIN : NITEMS); it += NGW) {
        int r = it;
        if (r < I_AIN) { p0_transpose_item(F.a_w_in, DM, LDQ, wain, 0, scr, r, F.lane); continue; } r -= I_AIN;
        if (r < I_SQ) { p0_transpose_item(F.a_w_out, DM, DM, waout, 0, scr, r, F.lane); continue; } r -= I_SQ;
        if (r < 4 * I_SQ) { const int c = r / I_SQ; p0_transpose_item(F.r_w_in + (size_t)c * DM * DM, DM, DM, wrin, c * DM, scr, r - c * I_SQ, F.lane); continue; } r -= 4 * I_SQ;
        if (r < I_SQ) { p0_transpose_item(F.r_w_out, DM, DM, wrout, 0, scr, r, F.lane); continue; } r -= I_SQ;
        if (r < 4 * I_L1) { const int q = r / I_L1; p0_transpose_item(q < 2 ? F.w1 : F.a1, DM, 64, w1a1, 64 * q, scr, r - q * I_L1, F.lane, F.mu + (q < 2 ? 4 : 5) * DM, (q & 1) == 0); continue; } r -= 4 * I_L1;
        if (r < I_L2) { p0_transpose_item(F.w2, 64, DM, (bf16*)(F.ws + 18 * MiB + 256 * 1024), 0, scr, r, F.lane); continue; } r -= I_L2;
        p0_transpose_item(F.a2, 64, DM, (bf16*)(F.ws + 18 * MiB + 384 * 1024), 0, scr, r, F.lane);
    }
    if (part == 1) return;
    bf16* xa = (bf16*)(F.ws + WS_XA);
    for (int m = gw; m < MPAD; m += NGW) {
        f32x4 v[4];
        if (m < MTOK) rms_row(h0_row(F, m), F.norm_gain, F.lane, v);
        else { for (int j = 0; j < 4; ++j) v[j] = (f32x4){0.f, 0.f, 0.f, 0.f}; }
        store_bf16_row(xa + (size_t)m * DM, F.lane, v);
    }
}

namespace att {
constexpr int KSTR = 72, VSTR = 260;
constexpr int BEXT = 192;
constexpr int K_OFF = 0, V_OFF = 256 * KSTR * 2, B_OFF = V_OFF + 64 * VSTR * 2, ST_OFF = B_OFF + NH * BEXT * 4, END_OFF = ST_OFF + NWAVES * 4096;
static_assert(END_OFF <= RING_BYTES && (B_OFF % 16) == 0 && (ST_OFF % 16) == 0, "attention LDS");
__device__ __forceinline__ int crow(int r, int hi) { return (r & 3) + 8 * (r >> 2) + 4 * hi; }
__device__ __forceinline__ int t5_bucket(int rel) {
    if (rel < 16) return rel;
    int b = 16;
    b += rel >= 19; b += rel >= 21; b += rel >= 24; b += rel >= 27; b += rel >= 31; b += rel >= 35; b += rel >= 40; b += rel >= 46;
    b += rel >= 52; b += rel >= 59; b += rel >= 67; b += rel >= 77; b += rel >= 87; b += rel >= 99; b += rel >= 113;
    return b;
}
__device__ __forceinline__ void attn_wave(LAS unsigned char* lds, const bf16* qkvg, bf16* og, int qrow0, int nq, int jt, int kt_lo, int h, float sink2, int lane, int wave) {
    const int c = lane & 31, hh = lane >> 5;
    const LAS float* bp = (const LAS float*)(lds + B_OFF) + h * BEXT + 5 + c - 4 * hh;
    const int qrow = qrow0 + (c < nq ? c : nq - 1);
    bf16x8 qf[4];
#pragma unroll
    for (int s = 0; s < 4; ++s) qf[s] = *(const GAS bf16x8*)(qkvg + (size_t)qrow * LDQ + h * HD + 16 * s + 8 * hh);
    const LAS unsigned char* kbase = lds + K_OFF + ((32 * jt + c) * KSTR + 8 * hh) * 2;
    const LAS unsigned char* vbase = lds + V_OFF + (c * VSTR + 32 * jt + 4 * hh) * 2;
    f32x16 sc[5];
#pragma unroll
    for (int kt = 0; kt < 5; ++kt) {
        f32x16 a;
#pragma unroll
        for (int r = 0; r < 16; ++r) a[r] = bp[155 - (32 * kt + (r & 3) + 8 * (r >> 2))];
#pragma unroll
        for (int s = 0; s < 4; ++s) { const bf16x8 kf = *(const LAS bf16x8*)(kbase + kt * (32 * KSTR * 2) + 32 * s); a = __builtin_amdgcn_mfma_f32_32x32x16_bf16(kf, qf[s], a, 0, 0, 0); }
        if (kt < kt_lo) {
#pragma unroll
            for (int r = 0; r < 16; ++r) a[r] = -1e30f;
        }
        sc[kt] = a;
    }
    float mx = -1e30f;
#pragma unroll
    for (int kt = 0; kt < 5; ++kt)
#pragma unroll
        for (int r = 0; r < 16; ++r) mx = fmaxf(mx, sc[kt][r]);
    mx = fmaxf(mx, __shfl_xor(mx, 32)); mx = fmaxf(mx, sink2);
    float l = 0.f;
#pragma unroll
    for (int kt = 0; kt < 5; ++kt)
#pragma unroll
        for (int r = 0; r < 16; ++r) { const float p = __builtin_amdgcn_exp2f(sc[kt][r] - mx); sc[kt][r] = p; l += p; }
    l += __shfl_xor(l, 32); l += __builtin_amdgcn_exp2f(sink2 - mx);
    const float linv = __builtin_amdgcn_rcpf(l);
    f32x16 o[2]; o[0] = f32x16{}; o[1] = f32x16{};
#pragma unroll
    for (int kt = 0; kt < 5; ++kt) {
#pragma unroll
        for (int s2 = 0; s2 < 2; ++s2) {
            v4u pw; pw.x = pk2(sc[kt][8 * s2 + 0] * linv, sc[kt][8 * s2 + 1] * linv); pw.y = pk2(sc[kt][8 * s2 + 2] * linv, sc[kt][8 * s2 + 3] * linv);
            pw.z = pk2(sc[kt][8 * s2 + 4] * linv, sc[kt][8 * s2 + 5] * linv); pw.w = pk2(sc[kt][8 * s2 + 6] * linv, sc[kt][8 * s2 + 7] * linv);
            const bf16x8 pf = __builtin_bit_cast(bf16x8, pw);
#pragma unroll
            for (int dh = 0; dh < 2; ++dh) {
                const LAS unsigned char* vp = vbase + (32 * dh * VSTR + 32 * kt + 16 * s2) * 2;
                const s16x4 lo = *(const LAS s16x4*)vp, hi = *(const LAS s16x4*)(vp + 16);
                const bf16x8 vf = (bf16x8){lo[0], lo[1], lo[2], lo[3], hi[0], hi[1], hi[2], hi[3]};
                o[dh] = __builtin_amdgcn_mfma_f32_32x32x16_bf16(pf, vf, o[dh], 0, 0, 0);
            }
        }
    }
    LAS float* stg = (LAS float*)(lds + ST_OFF + wave * 4096);
    const int srow = lane >> 1, sc0 = (lane & 1) * 16;
    const size_t grow = (size_t)(qrow0 + srow);
#pragma unroll
    for (int dh = 0; dh < 2; ++dh) {
#pragma unroll
        for (int r = 0; r < 16; ++r) stg[((r & 3) + 8 * (r >> 2) + 4 * hh) * 32 + c] = o[dh][r];
        asm volatile("s_waitcnt lgkmcnt(0)" ::: "memory");
        f32x4 x[4];
#pragma unroll
        for (int i = 0; i < 4; ++i) x[i] = *(const LAS f32x4*)(stg + srow * 32 + sc0 + 4 * i);
        asm volatile("s_waitcnt lgkmcnt(0)" ::: "memory");
        if (srow < nq) {
            const int col = h * HD + 32 * dh + sc0;
            const v4u g0 = *(const GAS v4u*)(qkvg + grow * LDQ + 1536 + col), g1 = *(const GAS v4u*)(qkvg + grow * LDQ + 1536 + col + 8);
            const unsigned gw[8] = {g0.x, g0.y, g0.z, g0.w, g1.x, g1.y, g1.z, g1.w};
            unsigned ow[8];
#pragma unroll
            for (int e = 0; e < 8; ++e) { const float ga = __builtin_bit_cast(float, gw[e] << 16), gb = __builtin_bit_cast(float, gw[e] & 0xffff0000u);
                const float ya = x[e >> 1][(e & 1) * 2] * ga * __builtin_amdgcn_rcpf(1.0f + __builtin_amdgcn_exp2f(-1.4426950408889634f * ga)), yb = x[e >> 1][(e & 1) * 2 + 1] * gb * __builtin_amdgcn_rcpf(1.0f + __builtin_amdgcn_exp2f(-1.4426950408889634f * gb)); ow[e] = pk2(ya, yb); }
            *(GAS v4u*)(og + grow * DM + col) = (v4u){ow[0], ow[1], ow[2], ow[3]}; *(GAS v4u*)(og + grow * DM + col + 8) = (v4u){ow[4], ow[5], ow[6], ow[7]};
        }
    }
}
constexpr int N_PROMPT_UNITS = NB * NKV * 33, N_SAMPLE_UNITS = DBATCH * NKV, N_COPY_UNITS = 8, N_UNITS = N_PROMPT_UNITS + N_SAMPLE_UNITS + N_COPY_UNITS;
}
__device__ __forceinline__ void p2_attention(Frame& F) {
    using namespace att;
    const bf16* qkvg = (const bf16*)(F.ws + WS_QKVG); bf16* og = (bf16*)(F.ws + WS_XA);
    LAS unsigned char* lds = F.lds + RING_OFF;
    for (int i = F.tid; i < NH * BEXT; i += NWAVES * 64) { const int h = i / BEXT, rel = i % BEXT - 32;
        ((LAS float*)(lds + B_OFF))[i] = (rel >= 0 && rel < 128) ? F.table[t5_bucket(rel) * NH + h] * LOG2E : -1e30f; }
    __syncthreads();
#pragma unroll 1
    for (int ui = F.vcu; ui < N_UNITS; ui += F.G) {
        int u;
        if (ui < 512) u = (ui >> 5) * 33 + (ui & 31);
        else if (ui < 528) u = (ui - 512) * 33 + 32;
        else u = ui;
        if (u >= N_PROMPT_UNITS + N_SAMPLE_UNITS) {
            const int cu = u - (N_PROMPT_UNITS + N_SAMPLE_UNITS);
            bf16* kvp = (bf16*)(F.ws + WS_KVP); bf16* kvs = (bf16*)(F.ws + WS_KVS);
            for (int i = cu * 512 + F.tid; i < 1024 * 64; i += N_COPY_UNITS * 512) {
                const int rr = i >> 6, ch = i & 63;
                const int srow = rr < 512 ? (rr >> 7) * LP + (LP - WIN) + (rr & 127) : MPR + (rr - 512);
                const v4u x = *(const GAS v4u*)(qkvg + (size_t)srow * LDQ + 1024 + 8 * ch);
                bf16* dst = rr < 512 ? kvp + (size_t)rr * 512 + 8 * ch : kvs + (size_t)(rr - 512) * 512 + 8 * ch;
                *(GAS v4u*)dst = x;
            }
            continue;
        }
        int kvh, nwu, qbase, q0, kt0;
        const bool is_prompt = u < N_PROMPT_UNITS;
        const int row = F.tid >> 1, half = F.tid & 1;
        if (is_prompt) {
            const int qblk = u % 33, b = u / (33 * NKV); kvh = (u / 33) % NKV;
            q0 = 128 * qblk; nwu = 16; qbase = b * LP + q0; kt0 = qblk == 0 ? 4 : 0;
            int pos = q0 - 128 + row; pos = pos < 0 ? 0 : (pos > LP - 1 ? LP - 1 : pos);
            const bf16* src = qkvg + (size_t)(b * LP + pos) * LDQ + 1024 + kvh * HD + half * 32;
#pragma unroll
            for (int i = 0; i < 4; ++i) { const v4u kv = *(const GAS v4u*)(src + 8 * i); *(LAS v4u*)(lds + K_OFF + (row * KSTR + half * 32 + 8 * i) * 2) = kv; }
#pragma unroll
            for (int i = 0; i < 4; ++i) { const v4u vv = *(const GAS v4u*)(src + 256 + 8 * i); const unsigned w[4] = {vv.x, vv.y, vv.z, vv.w};
#pragma unroll
                for (int e = 0; e < 8; ++e) { const bf16 x = (bf16)((w[e >> 1] >> ((e & 1) * 16)) & 0xffffu); *(LAS bf16*)(lds + V_OFF + ((half * 32 + 8 * i + e) * VSTR + row) * 2) = x; } }
        } else {
            const int su = u - N_PROMPT_UNITS, sb = su / NKV; kvh = su % NKV;
            q0 = LP; nwu = 4; qbase = MPR + sb * DSEQ; kt0 = 0;
            if (row < 160) {
#pragma unroll
                for (int i = 0; i < 4; ++i) {
                    v4u kq = (v4u){0u, 0u, 0u, 0u}, vq = (v4u){0u, 0u, 0u, 0u};
                    if (row < 128) {
                        const float* ck = F.cache_k + (((size_t)sb * WIN + row) * NKV + kvh) * HD + half * 32 + 8 * i; const float* cv = F.cache_v + (((size_t)sb * WIN + row) * NKV + kvh) * HD + half * 32 + 8 * i;
                        const f32x4 a0 = *(const GAS f32x4*)ck, a1 = *(const GAS f32x4*)(ck + 4), b0 = *(const GAS f32x4*)cv, b1 = *(const GAS f32x4*)(cv + 4);
                        kq = (v4u){pk2(a0.x, a0.y), pk2(a0.z, a0.w), pk2(a1.x, a1.y), pk2(a1.z, a1.w)}; vq = (v4u){pk2(b0.x, b0.y), pk2(b0.z, b0.w), pk2(b1.x, b1.y), pk2(b1.z, b1.w)};
                    } else if (row < 132) {
                        const bf16* src = qkvg + (size_t)(MPR + sb * DSEQ + (row - 128)) * LDQ + 1024 + kvh * HD + half * 32 + 8 * i;
                        kq = *(const GAS v4u*)src; vq = *(const GAS v4u*)(src + 256);
                    }
                    *(LAS v4u*)(lds + K_OFF + (row * KSTR + half * 32 + 8 * i) * 2) = kq;
                    const unsigned w[4] = {vq.x, vq.y, vq.z, vq.w};
#pragma unroll
                    for (int e = 0; e < 8; ++e) { const bf16 x = (bf16)((w[e >> 1] >> ((e & 1) * 16)) & 0xffffu); *(LAS bf16*)(lds + V_OFF + ((half * 32 + 8 * i + e) * VSTR + row) * 2) = x; }
                }
            }
        }
        __syncthreads();
#pragma unroll 1
        for (int wu = F.wave; wu < nwu; wu += NWAVES) {
            const int hg = wu & 3, j = wu >> 2, h = kvh * 4 + hg;
            int nq = is_prompt ? LP - (q0 + 32 * j) : DSEQ; nq = nq < 32 ? nq : 32;
            if (nq > 0) attn_wave(lds, qkvg, og, qbase + 32 * j, nq, j, kt0 - j, h, F.sinks[h] * LOG2E, F.lane, F.wave);
        }
        __syncthreads();
    }
}

__device__ __forceinline__ void rms_row8(const bf16* xrow, const float (&g8)[2][8], int lane, float (&x)[2][8]) {
    float s = 0.f;
#pragma unroll
    for (int j = 0; j < 2; ++j) { const v4u w = *(const GAS v4u*)(xrow + 8 * lane + 512 * j); const unsigned ww[4] = {w.x, w.y, w.z, w.w};
#pragma unroll
        for (int i = 0; i < 4; ++i) { x[j][2 * i] = __builtin_bit_cast(float, ww[i] << 16); x[j][2 * i + 1] = __builtin_bit_cast(float, ww[i] & 0xffff0000u); s += x[j][2 * i] * x[j][2 * i] + x[j][2 * i + 1] * x[j][2 * i + 1]; } }
    const float rstd = 1.0f / sqrtf(wave_sum(s) * (1.f / DM) + RMS_EPS);
#pragma unroll
    for (int j = 0; j < 2; ++j)
#pragma unroll
        for (int i = 0; i < 8; ++i) x[j][i] = x[j][i] * rstd * g8[j][i];
}
__device__ __forceinline__ void wait_row_tiles(const unsigned* cnt, int ra, int rb, unsigned full) {
    if (threadIdx.x < 64) {
        for (int pm = (ra < 0 ? 0 : ra) >> 8; pm <= (rb >> 8); ++pm)
            while (__hip_atomic_load(cnt + pm, __ATOMIC_RELAXED, __HIP_MEMORY_SCOPE_AGENT) < full) __builtin_amdgcn_s_sleep(8);
        __builtin_amdgcn_fence(__ATOMIC_ACQUIRE, "agent");
    }
    __syncthreads();
}
__device__ __forceinline__ void flow_range(const Frame& F, int seg, int nlate_wg, int rows_early, int& r0, int& r1, int& g0, int& g1) {
    const int bx = (int)blockIdx.x;
    if (seg == 0) { if (bx < nlate_wg) { r0 = r1 = g0 = g1 = 0; return; } const long wb = (long)(bx - nlate_wg) * NWAVES, w = wb + F.wave, NW = (long)(F.G - nlate_wg) * NWAVES;
        r0 = (int)((w * rows_early) / NW); r1 = (int)(((w + 1) * rows_early) / NW); g0 = (int)((wb * rows_early) / NW); g1 = (int)(((wb + NWAVES) * rows_early) / NW); }
    else { const long wb = (long)bx * NWAVES, w = wb + F.wave, NW = (long)F.G * NWAVES; const int nl = MTOK - rows_early;
        r0 = rows_early + (int)((w * nl) / NW); r1 = rows_early + (int)(((w + 1) * nl) / NW); g0 = rows_early + (int)((wb * nl) / NW); g1 = rows_early + (int)(((wb + NWAVES) * nl) / NW); }
}
__device__ __forceinline__ void p4_mix(Frame& F) {
    const int gw = F.vcu * NWAVES + F.wave, NGW = F.G * NWAVES;
    const bf16* h1 = (const bf16*)(F.ws + WS_H1); const float* gain = F.norm_gain + DM;
    float g8[2][8], mu8[4][2][8];
#pragma unroll
    for (int j = 0; j < 2; ++j) { const f32x4 a = *(const GAS f32x4*)(gain + 8 * F.lane + 512 * j), b = *(const GAS f32x4*)(gain + 8 * F.lane + 512 * j + 4);
        g8[j][0] = a.x; g8[j][1] = a.y; g8[j][2] = a.z; g8[j][3] = a.w; g8[j][4] = b.x; g8[j][5] = b.y; g8[j][6] = b.z; g8[j][7] = b.w;
#pragma unroll
        for (int c = 0; c < 4; ++c) { const f32x4 a2 = *(const GAS f32x4*)(F.mu + c * DM + 8 * F.lane + 512 * j), b2 = *(const GAS f32x4*)(F.mu + c * DM + 8 * F.lane + 512 * j + 4);
            mu8[c][j][0] = a2.x; mu8[c][j][1] = a2.y; mu8[c][j][2] = a2.z; mu8[c][j][3] = a2.w; mu8[c][j][4] = b2.x; mu8[c][j][5] = b2.y; mu8[c][j][6] = b2.z; mu8[c][j][7] = b2.w; } }
    float xp[2][8];
#pragma unroll
    for (int j = 0; j < 2; ++j)
#pragma unroll
        for (int i = 0; i < 8; ++i) xp[j][i] = 0.f;
    const int r0 = (int)(((long)gw * MTOK) / NGW), r1 = (int)(((long)(gw + 1) * MTOK) / NGW);
    bool have_prev = false;
#pragma unroll 1
    for (int m = r0; m < r1; ++m) {
        float x[2][8];
        rms_row8(h1 + (size_t)m * DM, g8, F.lane, x);
        bool first; const float* sh = nullptr;
        if (m < MPR) { first = (m % LP) == 0; } else { first = ((m - MPR) & 3) == 0; sh = F.state_shift + (size_t)((m - MPR) >> 2) * DM; }
        if (first) {
#pragma unroll
            for (int j = 0; j < 2; ++j) { f32x4 a = (f32x4){0.f, 0.f, 0.f, 0.f}, b = a; if (sh) { a = *(const GAS f32x4*)(sh + 8 * F.lane + 512 * j); b = *(const GAS f32x4*)(sh + 8 * F.lane + 512 * j + 4); }
                xp[j][0] = a.x; xp[j][1] = a.y; xp[j][2] = a.z; xp[j][3] = a.w; xp[j][4] = b.x; xp[j][5] = b.y; xp[j][6] = b.z; xp[j][7] = b.w; }
        } else if (!have_prev) rms_row8(h1 + (size_t)(m - 1) * DM, g8, F.lane, xp);
        {
            bf16* xr = m < MPR ? (bf16*)(F.dob + DO_XN1) + (size_t)m * DM : (bf16*)(F.ws + WS_XN1S) + (size_t)(m - MPR) * DM;
#pragma unroll
            for (int j = 0; j < 2; ++j) { v4u o; o.x = pk2(x[j][0], x[j][1]); o.y = pk2(x[j][2], x[j][3]); o.z = pk2(x[j][4], x[j][5]); o.w = pk2(x[j][6], x[j][7]); *(GAS v4u*)(xr + 8 * F.lane + 512 * j) = o; }
            if (first && sh) { bf16* sr = (bf16*)(F.ws + WS_XN1S) + (size_t)(DBATCH * DSEQ + ((m - MPR) >> 2)) * DM;
#pragma unroll
                for (int j = 0; j < 2; ++j) { v4u o; o.x = pk2(xp[j][0], xp[j][1]); o.y = pk2(xp[j][2], xp[j][3]); o.z = pk2(xp[j][4], xp[j][5]); o.w = pk2(xp[j][6], xp[j][7]); *(GAS v4u*)(sr + 8 * F.lane + 512 * j) = o; } }
        }
#pragma unroll
        for (int c = 0; c < 4; ++c) {
            bf16* dst = (bf16*)(F.ws + WS_MIX + c * MIX_STRIDE) + (size_t)m * DM;
#pragma unroll
            for (int j = 0; j < 2; ++j) { float v[8];
#pragma unroll
                for (int i = 0; i < 8; ++i) v[i] = x[j][i] + (xp[j][i] - x[j][i]) * mu8[c][j][i];
                v4u o; o.x = pk2(v[0], v[1]); o.y = pk2(v[2], v[3]); o.z = pk2(v[4], v[5]); o.w = pk2(v[6], v[7]);
                *(GAS v4u*)(dst + 8 * F.lane + 512 * j) = o; }
        }
        float* d = nullptr;
        if (m < MPR) { if ((m % LP) == LP - 1) d = (float*)(F.ws + WS_SHP) + (size_t)(m / LP) * DM; }
        else if (((m - MPR) & 3) == 3) d = F.out + O_SHS + (size_t)((m - MPR) >> 2) * DM;
        if (d) {
#pragma unroll
            for (int j = 0; j < 2; ++j) { *(GAS f32x4*)(d + 8 * F.lane + 512 * j) = (f32x4){x[j][0], x[j][1], x[j][2], x[j][3]}; *(GAS f32x4*)(d + 8 * F.lane + 512 * j + 4) = (f32x4){x[j][4], x[j][5], x[j][6], x[j][7]}; } }
#pragma unroll
        for (int j = 0; j < 2; ++j)
#pragma unroll
            for (int i = 0; i < 8; ++i) xp[j][i] = x[j][i];
        have_prev = true;
    }
}

__device__ __forceinline__ void p5_lora1_combine(Frame& F) {
    const int gw = F.vcu * NWAVES + F.wave, NGW = F.G * NWAVES;
    const float* U = (const float*)(F.ws + WS_U); float* t12 = (float*)(F.ws + WS_T12); unsigned char* t12b = F.ws + WS_T12B;
    const int j = F.lane;
    const int r0 = (int)(((long)gw * MTOK) / NGW), r1 = (int)(((long)(gw + 1) * MTOK) / NGW);
    for (int m = r0; m < r1; ++m) {
        const float* cur; const float* prev = nullptr;
        if (m < MPR) { cur = U + (size_t)m * 256; if ((m % LP) != 0) prev = cur - 256; }
        else { const int i = m - MPR; cur = U + (size_t)(U_SROW + i) * 256; prev = (i & 3) == 0 ? U + (size_t)(U_SROW + DBATCH * DSEQ + (i >> 2)) * 256 : cur - 256; }
        float a = cur[j], b2 = cur[128 + j];
        if (prev) { a += prev[64 + j]; b2 += prev[192 + j]; }
        a = tanhf(a);
        t12[(size_t)m * 128 + j] = a; t12[(size_t)m * 128 + 64 + j] = b2;
        if (m < MPR) { const int bb = m / LP, t = m - bb * LP;
            unsigned char* ob = t12b + ((size_t)((bb * 129 + (t >> 5)) * 8) * 64 + (t & 31)) * 16 + ((j >> 4) * 64 + 32 * ((j >> 3) & 1)) * 16 + (j & 7) * 2;
            *(bf16*)ob = (bf16)f2bf(a); *(bf16*)(ob + 4 * 1024) = (bf16)f2bf(b2); }
    }
}

__device__ __forceinline__ void wkv_seq_unit(Frame& F, LAS float* wl, int row0, int T, int h, const float* S0, float* Sout, int lane, bf16* hout = nullptr) {
    asm volatile("" : "+v"(lane));
    const bf16* R = (const bf16*)(F.dob); const bf16* Kb = (const bf16*)(F.dob + RKV_STRIDE); const bf16* Vb = (const bf16*)(F.dob + 2 * RKV_STRIDE);
    const bf16* Gb = (const bf16*)(F.ws + WS_G); const float* t12 = (const float*)(F.ws + WS_T12); bf16* og2 = (bf16*)(F.dob + DO_OG2);
    const int ch = h * HD + lane;
    unsigned w2p[32], a2p[32]; float S[64];
#pragma unroll
    for (int i = 0; i < 32; ++i) { w2p[i] = pk2(F.w2[(2 * i) * DM + ch], F.w2[(2 * i + 1) * DM + ch]); a2p[i] = pk2(F.a2[(2 * i) * DM + ch], F.a2[(2 * i + 1) * DM + ch]); }
    const float w0c = F.w0[ch], a0c = F.a0[ch], kkc = F.k_k[ch], kac = F.k_a[ch], rkc = F.r_k[ch], lng = F.ln_g[ch], lnb = F.ln_b[ch];
    if (S0) {
#pragma unroll
        for (int i = 0; i < 16; ++i) { const f32x4 v = *(const GAS f32x4*)(S0 + (size_t)lane * 64 + 4 * i); S[4 * i] = v.x; S[4 * i + 1] = v.y; S[4 * i + 2] = v.z; S[4 * i + 3] = v.w; }
    } else {
#pragma unroll
        for (int i = 0; i < 64; ++i) S[i] = 0.f;
    }
    for (int t = 0; t < T; ++t) {
        const size_t m = (size_t)(row0 + t);
#if WKV_EXP >= 30
        if (T == LP && t == WKV_DUMP_T) { float* dp = (float*)(F.ws + 184 * MiB) + (size_t)((row0 / LP) * NH + h) * 4096;
#pragma unroll
            for (int i = 0; i < 16; ++i) *(GAS f32x4*)(dp + (size_t)lane * 64 + 4 * i) = (f32x4){S[4 * i], S[4 * i + 1], S[4 * i + 2], S[4 * i + 3]}; }
#endif
#pragma unroll
        for (int i = 0; i < 32; ++i) { asm volatile("" : "+v"(w2p[i])); asm volatile("" : "+v"(a2p[i])); }
        const float r = bf2f(R[m * DM + ch]), k = bf2f(Kb[m * DM + ch]), v = bf2f(Vb[m * DM + ch]), g = bf2f(Gb[m * DM + ch]);
        wl[lane] = t12[m * 128 + lane]; wl[64 + lane] = t12[m * 128 + 64 + lane];
        asm volatile("s_waitcnt lgkmcnt(0)" ::: "memory");
        float z = w0c, az = a0c;
#pragma unroll
        for (int i = 0; i < 16; ++i) { const f32x4 x = *(const LAS f32x4*)(wl + 4 * i), y = *(const LAS f32x4*)(wl + 64 + 4 * i);
            z += x.x * __builtin_bit_cast(float, w2p[2 * i] << 16) + x.y * __builtin_bit_cast(float, w2p[2 * i] & 0xffff0000u) + x.z * __builtin_bit_cast(float, w2p[2 * i + 1] << 16) + x.w * __builtin_bit_cast(float, w2p[2 * i + 1] & 0xffff0000u);
            az += y.x * __builtin_bit_cast(float, a2p[2 * i] << 16) + y.y * __builtin_bit_cast(float, a2p[2 * i] & 0xffff0000u) + y.z * __builtin_bit_cast(float, a2p[2 * i + 1] << 16) + y.w * __builtin_bit_cast(float, a2p[2 * i + 1] & 0xffff0000u); }
        const float a = 1.0f / (1.0f + __expf(-az)), sg = 1.0f / (1.0f + __expf(-z)), dec = __expf(-0.6065306597126334f * sg);
        float kk = k * kkc; const float n2 = wave_sum(kk * kk); kk = kk / fmaxf(sqrtf(n2), 1e-12f);
        const float kh = k * (1.0f + (a - 1.0f) * kac);
        const float rk = wave_sum(r * kh * rkc);
        wl[128 + lane] = -kk; wl[192 + lane] = kk * a; wl[256 + lane] = dec; wl[320 + lane] = kh; wl[384 + lane] = r;
        asm volatile("s_waitcnt lgkmcnt(0)" ::: "memory");
        float sa = 0.f;
#pragma unroll
        for (int i = 0; i < 16; ++i) { const f32x4 x = *(const LAS f32x4*)(wl + 128 + 4 * i); sa += S[4 * i] * x.x + S[4 * i + 1] * x.y + S[4 * i + 2] * x.z + S[4 * i + 3] * x.w; }
        float y = 0.f;
#pragma unroll
        for (int i = 0; i < 16; ++i) {
            const f32x4 bq = *(const LAS f32x4*)(wl + 192 + 4 * i), wq = *(const LAS f32x4*)(wl + 256 + 4 * i), kq = *(const LAS f32x4*)(wl + 320 + 4 * i), rq = *(const LAS f32x4*)(wl + 384 + 4 * i);
#if WKV_EXP == 45 && WKV_VAR == 2
            if (hout) sa = 0.f;
#endif
            S[4 * i] = S[4 * i] * wq.x + sa * bq.x + v * kq.x; S[4 * i + 1] = S[4 * i + 1] * wq.y + sa * bq.y + v * kq.y;
            S[4 * i + 2] = S[4 * i + 2] * wq.z + sa * bq.z + v * kq.z; S[4 * i + 3] = S[4 * i + 3] * wq.w + sa * bq.w + v * kq.w;
            y += S[4 * i] * rq.x + S[4 * i + 1] * rq.y + S[4 * i + 2] * rq.z + S[4 * i + 3] * rq.w; }
        const float mean = wave_sum(y) * (1.f / 64.f), dv = y - mean, var = wave_sum(dv * dv) * (1.f / 64.f);
        const float yn = dv * (1.0f / sqrtf(var + GN_EPS)) * lng + lnb + rk * v;
        if (!hout) og2[m * DM + ch] = (bf16)f2bf(yn * g / (1.0f + __expf(-g)));
        asm volatile("" ::: "memory");
    }
    if (hout) {
#pragma unroll
        for (int i = 0; i < 16; ++i) *(GAS unsigned long long*)(hout + (size_t)lane * 64 + 4 * i) = (unsigned long long)pk2(S[4 * i], S[4 * i + 1]) | ((unsigned long long)pk2(S[4 * i + 2], S[4 * i + 3]) << 32);
        return;
    }
#pragma unroll
    for (int i = 0; i < 16; ++i) *(GAS f32x4*)(Sout + (size_t)lane * 64 + 4 * i) = (f32x4){S[4 * i], S[4 * i + 1], S[4 * i + 2], S[4 * i + 3]};
}
#define SEQ_FENCE() do { asm volatile("" ::: "memory"); __builtin_amdgcn_sched_barrier(0); } while (0)
__device__ __forceinline__ void wkv_seq4_unit(Frame& F, LAS float* wl, int row0, int h, const float* S0, float* Sout, int lane) {
    asm volatile("" : "+v"(lane));
    const bf16* R = (const bf16*)(F.dob); const bf16* Kb = (const bf16*)(F.dob + RKV_STRIDE); const bf16* Vb = (const bf16*)(F.dob + 2 * RKV_STRIDE);
    const bf16* Gb = (const bf16*)(F.ws + WS_G); const float* t12 = (const float*)(F.ws + WS_T12); bf16* og2 = (bf16*)(F.dob + DO_OG2);
    const int ch = h * HD + lane;
    constexpr float L2E = 1.4426950408889634f;
    {
        float r[4], k[4], v[4], g[4];
#pragma unroll
        for (int t = 0; t < 4; ++t) { const size_t m = (size_t)(row0 + t); r[t] = bf2f(R[m * DM + ch]); k[t] = bf2f(Kb[m * DM + ch]); v[t] = bf2f(Vb[m * DM + ch]); g[t] = bf2f(Gb[m * DM + ch]);
            wl[t * 128 + lane] = t12[m * 128 + lane]; wl[t * 128 + 64 + lane] = t12[m * 128 + 64 + lane]; }
        const float w0c = F.w0[ch], a0c = F.a0[ch], kkc = F.k_k[ch], kac = F.k_a[ch], rkc = F.r_k[ch];
        float z[4], az[4];
#pragma unroll
        for (int t = 0; t < 4; ++t) { z[t] = w0c; az[t] = a0c; }
        asm volatile("s_waitcnt lgkmcnt(0)" ::: "memory");
        SEQ_FENCE();
#pragma unroll
        for (int i = 0; i < 16; ++i) {
            float w4[4], a4[4];
#pragma unroll
            for (int e = 0; e < 4; ++e) { w4[e] = F.w2[(4 * i + e) * DM + ch]; a4[e] = F.a2[(4 * i + e) * DM + ch]; }
#pragma unroll
            for (int t = 0; t < 4; ++t) { const f32x4 x = *(const LAS f32x4*)(wl + t * 128 + 4 * i), y = *(const LAS f32x4*)(wl + t * 128 + 64 + 4 * i);
                z[t] += x.x * w4[0] + x.y * w4[1] + x.z * w4[2] + x.w * w4[3]; az[t] += y.x * a4[0] + y.y * a4[1] + y.z * a4[2] + y.w * a4[3]; }
            if ((i & 3) == 3) SEQ_FENCE(); }
        asm volatile("s_waitcnt lgkmcnt(0)" ::: "memory");
#pragma unroll
        for (int t = 0; t < 4; ++t) {
            const float a = __builtin_amdgcn_rcpf(1.0f + __builtin_amdgcn_exp2f(-az[t] * L2E)), sg = __builtin_amdgcn_rcpf(1.0f + __builtin_amdgcn_exp2f(-z[t] * L2E)), dec = __builtin_amdgcn_exp2f((-0.6065306597126334f * L2E) * sg);
            float kk = k[t] * kkc; const float n2 = wave_sum(kk * kk); kk = kk * __builtin_amdgcn_rsqf(fmaxf(n2, 1e-24f));
            const float kh = k[t] * (1.0f + (a - 1.0f) * kac);
            const float rk = wave_sum(r[t] * kh * rkc);
            LAS float* w = wl + t * 512;
            w[lane] = -kk; w[64 + lane] = kk * a; w[128 + lane] = dec; w[192 + lane] = kh; w[256 + lane] = r[t]; w[320 + lane] = v[t]; w[384 + lane] = g[t]; w[448 + lane] = rk;
        }
    }
    SEQ_FENCE();
    float S[64];
#pragma unroll
    for (int i = 0; i < 16; ++i) { const f32x4 x = *(const GAS f32x4*)(S0 + (size_t)lane * 64 + 4 * i); S[4 * i] = x.x; S[4 * i + 1] = x.y; S[4 * i + 2] = x.z; S[4 * i + 3] = x.w; }
    const float lng = F.ln_g[ch], lnb = F.ln_b[ch];
    asm volatile("s_waitcnt lgkmcnt(0)" ::: "memory");
#pragma unroll 1
    for (int t = 0; t < 4; ++t) {
        const LAS float* w = wl + t * 512;
        float sa = 0.f;
#pragma unroll
        for (int i = 0; i < 16; ++i) { const f32x4 x = *(const LAS f32x4*)(w + 4 * i); sa += S[4 * i] * x.x + S[4 * i + 1] * x.y + S[4 * i + 2] * x.z + S[4 * i + 3] * x.w; }
        const float v = w[320 + lane], g = w[384 + lane], rk = w[448 + lane];
        float y = 0.f;
#pragma unroll
        for (int i = 0; i < 16; ++i) {
            const f32x4 bq = *(const LAS f32x4*)(w + 64 + 4 * i), wq = *(const LAS f32x4*)(w + 128 + 4 * i), kq = *(const LAS f32x4*)(w + 192 + 4 * i), rq = *(const LAS f32x4*)(w + 256 + 4 * i);
            S[4 * i] = S[4 * i] * wq.x + sa * bq.x + v * kq.x; S[4 * i + 1] = S[4 * i + 1] * wq.y + sa * bq.y + v * kq.y;
            S[4 * i + 2] = S[4 * i + 2] * wq.z + sa * bq.z + v * kq.z; S[4 * i + 3] = S[4 * i + 3] * wq.w + sa * bq.w + v * kq.w;
            y += S[4 * i] * rq.x + S[4 * i + 1] * rq.y + S[4 * i + 2] * rq.z + S[4 * i + 3] * rq.w; }
        const float mean = wave_sum(y) * (1.f / 64.f), dv = y - mean, var = wave_sum(dv * dv) * (1.f / 64.f);
        const float yn = dv * __builtin_amdgcn_rsqf(var + GN_EPS) * lng + lnb + rk * v;
        og2[(size_t)(row0 + t) * DM + ch] = (bf16)f2bf(yn * g * __builtin_amdgcn_rcpf(1.0f + __builtin_amdgcn_exp2f(-g * L2E)));
        asm volatile("" ::: "memory");
    }
#pragma unroll
    for (int i = 0; i < 16; ++i) *(GAS f32x4*)(Sout + (size_t)lane * 64 + 4 * i) = (f32x4){S[4 * i], S[4 * i + 1], S[4 * i + 2], S[4 * i + 3]};
    asm volatile("s_waitcnt lgkmcnt(0)" ::: "memory");
}
__device__ __forceinline__ void p6_wkv_seq(Frame& F) {
    LAS float* wl = (LAS float*)(F.lds + RING_OFF) + F.wave * 512;
    constexpr int NSU = DBATCH * NH;
    for (int u = F.wave * F.G + F.vcu; u < NSU + NB * NH; u += NWAVES * F.G) {
        if (u < NSU) { const int sb = u / NH, h = u % NH;
            wkv_seq_unit(F, wl, MPR + sb * DSEQ, DSEQ, h, F.state_wkv + (size_t)u * 4096, F.out + O_WKVS + (size_t)u * 4096, F.lane); }
        else { const int pu = u - NSU, b = pu / NH, h = pu % NH;
            wkv_seq_unit(F, wl, b * LP, LP, h, nullptr, (float*)(F.ws + WS_WKVP) + (size_t)pu * 4096, F.lane); }
    }
}

__device__ __forceinline__ void p8_final(Frame& F) {
#if WKV_VAR >= 11 && WKV_VAR <= 19
    { const unsigned flag = __hip_atomic_load((unsigned*)(F.ws + WS_CTL) + 8, __ATOMIC_RELAXED, __HIP_MEMORY_SCOPE_AGENT); if (flag && blockIdx.x == 0 && F.tid < 64) { const float e = (flag & 1u ? 100.f : 0.f) + (flag & 2u ? 1000.f : 0.f) + (flag & 4u ? 10000.f : 0.f) + (flag & 8u ? 31.f : 0.f) + (flag & 16u ? 7.f : 0.f) + (flag & 32u ? 3.f : 0.f) + (flag & 64u ? 50.f : 0.f) + (flag & 128u ? 200.f : 0.f) + (flag & 256u ? 1000.f : 0.f) + (flag & 512u ? 5000.f : 0.f); F.out[O_SHS + F.tid] += e; } }
#endif
    const int gw = F.vcu * NWAVES + F.wave, NGW = F.G * NWAVES;
    const bf16* h2 = (const bf16*)(F.ws + WS_H1);
    for (int m = gw; m < MTOK; m += NGW) {
        float* dst;
        if (m < MPR) { const int b = m / LP, t = m - b * LP; if (t < NMETA) continue; dst = F.out + O_YP + ((size_t)b * SEQ + (t - NMETA)) * DM; }
        else dst = F.out + O_YS + (size_t)(m - MPR) * DM;
        f32x4 v[4]; rms_row_b(h2 + (size_t)m * DM, F.final_gain, F.lane, v);
#pragma unroll
        for (int j = 0; j < 4; ++j) ((GAS f32x4*)dst)[F.lane + 64 * j] = v[j];
    }
    const int gt = F.vcu * (NWAVES * 64) + F.tid, NGT = F.G * NWAVES * 64;
    const bf16* kvp = (const bf16*)(F.ws + WS_KVP); const bf16* kvs = (const bf16*)(F.ws + WS_KVS);
    for (int i = gt; i < 2 * NB * WIN * 256; i += NGT) { const int kv = i / (NB * WIN * 256), r = i % (NB * WIN * 256), row = r >> 8, col = r & 255;
        F.out[(kv ? O_WVP : O_WKP) + r] = bf2f(kvp[(size_t)row * 512 + kv * 256 + col]); }
    for (int i = gt; i < NB * NH * 4096; i += NGT) F.out[O_WKVP + i] = ((const float*)(F.ws + WS_WKVP))[i];
    for (int i = gt; i < NB * DM; i += NGT) F.out[O_SHP + i] = ((const float*)(F.ws + WS_SHP))[i];
    for (int i = gt; i < 2 * DBATCH * WIN * 64; i += NGT) {
        const int kv = i / (DBATCH * WIN * 64), r = i % (DBATCH * WIN * 64), sb = r / (WIN * 64), j = (r / 64) % WIN, c4 = r % 64;
        f32x4 v;
        if (j < WIN - DSEQ) v = *(const GAS f32x4*)((kv ? F.cache_v : F.cache_k) + ((size_t)sb * WIN + j + DSEQ) * 256 + 4 * c4);
        else { const bf16* s = kvs + (size_t)(sb * DSEQ + (j - (WIN - DSEQ))) * 512 + kv * 256 + 4 * c4; v = (f32x4){bf2f(s[0]), bf2f(s[1]), bf2f(s[2]), bf2f(s[3])}; }
        *(GAS f32x4*)(F.out + (kv ? O_WVS : O_WKS) + (size_t)r * 4) = v;
    }
}
namespace wkv {
typedef __amdgpu_buffer_rsrc_t srd_t;
constexpr int NCH = 65, NUNITS = NB * NH * NCH;
constexpr size_t WS_W2T = 18 * MiB + 256 * 1024, WS_A2T = 18 * MiB + 384 * 1024;
constexpr size_t WS_GT = 98 * MiB, WS_HT = 131 * MiB, WS_KST = 164 * MiB, WS_RK = 181 * MiB, WS_TST = 183 * MiB, WS_Y0F = 30 * MiB, WS_WYF = 64 * MiB;
static_assert(3 * RKV_STRIDE + (size_t)2048 * 16384 <= O_SHS * 4 && WS_GT + (size_t)NUNITS * 8192 <= WS_HT && WS_HT + (size_t)NUNITS * 8192 <= WS_KST && WS_KST + (size_t)2048 * 8192 <= WS_RK && WS_RK + (size_t)MTOK * 16 * 4 <= WS_H1 && WS_Y0F + (size_t)NUNITS * 8192 <= WS_WYF && WS_WYF + (size_t)NUNITS * 8192 <= WS_GT, "wkv ws map");
constexpr int LDSX_OFF = 132096;
static_assert(LDSX_OFF + NWAVES * 512 <= LDS_BYTES, "lds");
__device__ __forceinline__ unsigned cvtpk(float lo, float hi) { unsigned r; asm volatile("v_cvt_pk_bf16_f32 %0, %1, %2\n\ts_nop 1" : "=v"(r) : "v"(lo), "v"(hi)); return r; }
__device__ __forceinline__ unsigned cvtpkn(float lo, float hi) { return pk2(lo, hi); }
__device__ __forceinline__ void mfma_fence(f32x16 (&acc)[2][2]) { asm volatile("s_nop 15\n\ts_nop 7" : "+v"(acc[0][0]), "+v"(acc[0][1]), "+v"(acc[1][0]), "+v"(acc[1][1])); }
__device__ __forceinline__ void mfma_fence2(f32x16& a, f32x16& b) { asm volatile("s_nop 15\n\ts_nop 7" : "+v"(a), "+v"(b)); }
__device__ __forceinline__ float lo16(unsigned w) { return __builtin_bit_cast(float, w << 16); }
__device__ __forceinline__ float hi16(unsigned w) { return __builtin_bit_cast(float, w & 0xffff0000u); }
__device__ __forceinline__ void mm64(f32x16 (&acc)[2][2], const bf16x8 (&A)[4][2], const bf16x8 (&B)[4][2]) {
#pragma unroll
    for (int m = 0; m < 2; ++m)
#pragma unroll
        for (int n = 0; n < 2; ++n)
#pragma unroll
            for (int ks = 0; ks < 4; ++ks) acc[m][n] = __builtin_amdgcn_mfma_f32_32x32x16_bf16(A[ks][m], B[ks][n], acc[m][n], 0, 0, 0);
    mfma_fence(acc);
}
__device__ __forceinline__ void acc2frag(const f32x16 (&acc)[2][2], bf16x8 (&Fr)[4][2]) {
#pragma unroll
    for (int m = 0; m < 2; ++m)
#pragma unroll
        for (int n = 0; n < 2; ++n)
#pragma unroll
            for (int s = 0; s < 2; ++s) { const f32x16& a = acc[m][n]; v4u w;
                w.x = cvtpk(a[8 * s + 0], a[8 * s + 1]); w.y = cvtpk(a[8 * s + 2], a[8 * s + 3]); w.z = cvtpk(a[8 * s + 4], a[8 * s + 5]); w.w = cvtpk(a[8 * s + 6], a[8 * s + 7]);
                Fr[2 * m + s][n] = __builtin_bit_cast(bf16x8, w); }
}
__device__ __forceinline__ void zero_acc(f32x16 (&acc)[2][2]) {
#pragma unroll
    for (int m = 0; m < 2; ++m)
#pragma unroll
        for (int n = 0; n < 2; ++n) acc[m][n] = f32x16{};
}
__device__ __forceinline__ void frag_st_lds(LAS unsigned char* p, const bf16x8 (&Fr)[4][2], int lane) {
#pragma unroll
    for (int ks = 0; ks < 4; ++ks)
#pragma unroll
        for (int t = 0; t < 2; ++t) *(LAS bf16x8*)(p + (ks * 2 + t) * 1024 + lane * 16) = Fr[ks][t];
}
__device__ __forceinline__ void frag_ld_lds(const LAS unsigned char* p, bf16x8 (&Fr)[4][2], int lane) {
#pragma unroll
    for (int ks = 0; ks < 4; ++ks)
#pragma unroll
        for (int t = 0; t < 2; ++t) Fr[ks][t] = *(const LAS bf16x8*)(p + (ks * 2 + t) * 1024 + lane * 16);
}
template <int D> __device__ __forceinline__ void bfly_step(float (&v)[32], int lane) {
    const bool up = (lane & D) != 0;
#pragma unroll
    for (int s = 0; s < D; ++s) { const float send = up ? v[s] : v[s + D], keep = up ? v[s + D] : v[s]; v[s] = keep + __shfl_xor(send, D); }
}
__device__ __forceinline__ float butterfly32(float (&v)[32], int lane) {
    bfly_step<16>(v, lane); bfly_step<8>(v, lane); bfly_step<4>(v, lane); bfly_step<2>(v, lane); bfly_step<1>(v, lane);
    return v[0];
}
__device__ __forceinline__ int crow(int r, int hi) { return (r & 3) + 8 * (r >> 2) + 4 * hi; }

#define WKV_FENCE() do { asm volatile("" ::: "memory"); __builtin_amdgcn_sched_barrier(0); } while (0)
__device__ __forceinline__ void frag_st_g(unsigned char* p, const bf16x8 (&Fr)[4][2], int lane) {
#pragma unroll
    for (int ks = 0; ks < 4; ++ks)
#pragma unroll
        for (int t = 0; t < 2; ++t) *(GAS bf16x8*)(p + (ks * 2 + t) * 1024 + lane * 16) = Fr[ks][t];
}
typedef unsigned v4u_t __attribute__((ext_vector_type(4)));
__device__ __forceinline__ void frag_ld_g(const unsigned char* p, bf16x8 (&Fr)[4][2], int lane) {
    const srd_t r = __builtin_amdgcn_make_buffer_rsrc((void*)p, (short)0, 8192, 0x00020000);
#pragma unroll
    for (int ks = 0; ks < 4; ++ks)
#pragma unroll
        for (int t = 0; t < 2; ++t) { const v4u_t x = __builtin_amdgcn_raw_buffer_load_b128(r, (unsigned)(lane * 16), (unsigned)((ks * 2 + t) * 1024), 16  ); Fr[ks][t] = __builtin_bit_cast(bf16x8, x); }
}
__device__ __forceinline__ void transpose64(f32x16 (&acc)[2][2], const bf16x8 (&XR)[4][2], const bf16x8 (&Id2)[2]) {
#pragma unroll
    for (int m = 0; m < 2; ++m)
#pragma unroll
        for (int n = 0; n < 2; ++n) { acc[m][n] = f32x16{};
#pragma unroll
            for (int s = 0; s < 2; ++s) acc[m][n] = __builtin_amdgcn_mfma_f32_32x32x16_bf16(XR[2 * n + s][m], Id2[s], acc[m][n], 0, 0, 0); }
    mfma_fence(acc);
}
__device__ __forceinline__ float bld16(srd_t r, unsigned vo, unsigned so) { return __builtin_bit_cast(float, (unsigned)__builtin_amdgcn_raw_buffer_load_b16(r, vo, so, 0) << 16); }
__device__ __forceinline__ unsigned bld16u(srd_t r, unsigned vo, unsigned so) { return (unsigned)__builtin_amdgcn_raw_buffer_load_b16(r, vo, so, 0); }
typedef unsigned v2u_t __attribute__((ext_vector_type(2)));
__device__ __forceinline__ unsigned long long bld64(srd_t r, unsigned vo, unsigned so) { const v2u_t v = __builtin_amdgcn_raw_buffer_load_b64(r, vo, so, 16  ); return (unsigned long long)v.x | ((unsigned long long)v.y << 32); }
__device__ __forceinline__ void bst64(srd_t r, unsigned vo, unsigned so, unsigned long long w) { v2u_t v; v.x = (unsigned)w; v.y = (unsigned)(w >> 32); __builtin_amdgcn_raw_buffer_store_b64(v, r, vo, so, 0); }
__device__ __forceinline__ unsigned long long pack4(float a, float b, float c, float d) { return (unsigned long long)cvtpkn(a, b) | ((unsigned long long)cvtpkn(c, d) << 32); }
template <bool TAIL> __device__ __forceinline__ void solve_T(const f32x16 (&acc)[2][2], bf16x8 (&TR)[4][2], int lane, bool sync, int skip) {
    float Tc[64];
#pragma unroll
    for (int i = 0; i < 64; ++i) Tc[i] = (lane == i) ? 1.f : 0.f;
    if (!(skip & 1))
#pragma unroll
    for (int i = 62; i >= 0; --i) {
        const int mi = i >> 5, ri = (i & 3) + 4 * ((i & 31) >> 3), hi = ((i & 31) >> 2) & 1;
        if (!(TAIL && i >= 16)) {
        float e0 = acc[mi][0][ri], e1 = acc[mi][1][ri];
        asm volatile("" : "+v"(e0)); asm volatile("" : "+v"(e1));
#pragma unroll
        for (int k = i + 1; k < (TAIL ? 16 : 64); ++k) {
            const float nik = __builtin_bit_cast(float, __builtin_amdgcn_readlane(__builtin_bit_cast(int, (k >> 5) ? e1 : e0), (k & 31) + 32 * hi));
            asm volatile("v_fmac_f32 %0, %1, %2" : "+v"(Tc[i]) : "s"(nik), "v"(Tc[k]));
        }
        }
        if ((i & 7) == 0 && sync) __builtin_amdgcn_s_barrier();
        WKV_FENCE();
    }
#pragma unroll
    for (int ks = 0; ks < 4; ++ks) {
        const int b0 = 16 * ks;
        v4u E, O;
        E.x = cvtpk(Tc[b0 + 0], Tc[b0 + 1]); E.y = cvtpk(Tc[b0 + 2], Tc[b0 + 3]); E.z = cvtpk(Tc[b0 + 8], Tc[b0 + 9]); E.w = cvtpk(Tc[b0 + 10], Tc[b0 + 11]);
        O.x = cvtpk(Tc[b0 + 4], Tc[b0 + 5]); O.y = cvtpk(Tc[b0 + 6], Tc[b0 + 7]); O.z = cvtpk(Tc[b0 + 12], Tc[b0 + 13]); O.w = cvtpk(Tc[b0 + 14], Tc[b0 + 15]);
        { auto r = __builtin_amdgcn_permlane32_swap(E.x, O.x, false, false); E.x = r[0]; O.x = r[1]; }
        { auto r = __builtin_amdgcn_permlane32_swap(E.y, O.y, false, false); E.y = r[0]; O.y = r[1]; }
        { auto r = __builtin_amdgcn_permlane32_swap(E.z, O.z, false, false); E.z = r[0]; O.z = r[1]; }
        { auto r = __builtin_amdgcn_permlane32_swap(E.w, O.w, false, false); E.w = r[0]; O.w = r[1]; }
        TR[ks][0] = __builtin_bit_cast(bf16x8, E); TR[ks][1] = __builtin_bit_cast(bf16x8, O);
    }
}
__device__ __forceinline__ void mfma_fence1(f32x16& a) { asm volatile("s_nop 15\n\ts_nop 7" : "+v"(a)); }
__device__ __forceinline__ void make_idn(bf16x8 (&IdN)[2], int c, int hh) {
    asm volatile("" : "+v"(c), "+v"(hh));
#pragma unroll
    for (int s2 = 0; s2 < 2; ++s2) { bf16x8 v;
#pragma unroll
        for (int jj = 0; jj < 8; ++jj) v[jj] = ((16 * s2 + 8 * hh + jj) == c) ? (short)0x3F80 : (short)0;
        IdN[s2] = v; }
}
__device__ __forceinline__ f32x16 tile_from_rows(const bf16x8& a0, const bf16x8& a1, const bf16x8 (&IdN)[2]) {
    f32x16 t = f32x16{};
    t = __builtin_amdgcn_mfma_f32_32x32x16_bf16(a0, IdN[0], t, 0, 0, 0);
    t = __builtin_amdgcn_mfma_f32_32x32x16_bf16(a1, IdN[1], t, 0, 0, 0);
    return t;
}
__device__ __forceinline__ bf16x8 bld128(srd_t r, unsigned vo, unsigned so) { const v4u_t x = __builtin_amdgcn_raw_buffer_load_b128(r, vo, so, 0); return __builtin_bit_cast(bf16x8, x); }
#ifndef WKV_SEQ4
#define WKV_SEQ4 0
#endif
#ifndef WKV_LOCKSTEP
#define WKV_LOCKSTEP 0
#endif
#define WKV_SYNC() do { if (sync) __builtin_amdgcn_s_barrier(); } while (0)
__device__ __forceinline__ void stageA_unit(Frame& F, int uidx, int lane, int wave, bool sync, int lslot) {
    asm volatile("" : "+v"(lane));
    const int c = lane & 31, hh = lane >> 5;
    const int ch = uidx % NCH, bh = uidx / NCH, h = bh % NH, b = bh / NH;
    const int row0 = b * LP + 64 * ch, nvalid = (LP - 64 * ch) < 64 ? (LP - 64 * ch) : 64;
    const float* t12 = (const float*)(F.ws + WS_T12);
    const bf16* w2t = (const bf16*)(F.ws + WS_W2T); const bf16* a2t = (const bf16*)(F.ws + WS_A2T);
    LAS unsigned char* wl = F.lds + RING_OFF + lslot * 16384;
    LAS float* red = (LAS float*)(F.lds + LDSX_OFF + wave * 512);
#if WKV_VAR == 14
    {
        unsigned bad = 0u;
        float x = (float)(lane * 3 + 1); asm volatile("" : "+v"(x));
        f32x16 t; for (int r = 0; r < 16; ++r) t[r] = (float)(lane * 16 + r);
        asm volatile("" : "+v"(t));
#define RLCHK(L) { const float g = __builtin_bit_cast(float, __builtin_amdgcn_readlane(__builtin_bit_cast(int, x), L)); if (g != (float)((L) * 3 + 1)) bad |= 64u; }
        RLCHK(0) RLCHK(5) RLCHK(31) RLCHK(32) RLCHK(40) RLCHK(63)
#undef RLCHK
#define RLCHK2(R, L) { const float g = __builtin_bit_cast(float, __builtin_amdgcn_readlane(__builtin_bit_cast(int, t[R]), L)); if (g != (float)((L) * 16 + (R))) bad |= 128u; }
        RLCHK2(0, 3) RLCHK2(7, 33) RLCHK2(13, 63) RLCHK2(14, 63) RLCHK2(15, 62) RLCHK2(9, 17)
#undef RLCHK2
        f32x16 t2; for (int r = 0; r < 16; ++r) t2[r] = (float)(lane * 16 + r);
#define RLCHK3(R, L) { const float g = __builtin_bit_cast(float, __builtin_amdgcn_readlane(__builtin_bit_cast(int, t2[R]), L)); if (g != (float)((L) * 16 + (R))) bad |= 256u; }
        RLCHK3(0, 3) RLCHK3(7, 33) RLCHK3(13, 63) RLCHK3(14, 63) RLCHK3(15, 62) RLCHK3(9, 17)
#undef RLCHK3
#define RLCHK4(R, L) { float e = t[R]; asm volatile("" : "+v"(e)); const float g = __builtin_bit_cast(float, __builtin_amdgcn_readlane(__builtin_bit_cast(int, e), L)); if (g != (float)((L) * 16 + (R))) bad |= 512u; }
        RLCHK4(0, 3) RLCHK4(7, 33) RLCHK4(13, 63) RLCHK4(14, 63) RLCHK4(15, 62) RLCHK4(9, 17)
#undef RLCHK4
        if (bad) atomicOr((unsigned*)(F.ws + WS_CTL) + 8, bad);
        return;
    }
#endif
#if WKV_VAR == 13
    {
        f32x16 acc[2][2];
#pragma unroll
        for (int m = 0; m < 2; ++m)
#pragma unroll
            for (int n = 0; n < 2; ++n)
#pragma unroll
                for (int r = 0; r < 16; ++r) { const int i_ = 32 * m + crow(r, hh), k_ = 32 * n + c; acc[m][n][r] = (k_ == i_ + 1) ? 0.5f : (k_ == i_ + 2) ? 0.25f : (k_ <= i_) ? 1.0f : 0.f; }
        asm volatile("" : "+v"(acc[0][0]), "+v"(acc[0][1]), "+v"(acc[1][0]), "+v"(acc[1][1]));
        float Tc[64]; unsigned badn = 0u;
#pragma unroll
        for (int i = 0; i < 64; ++i) Tc[i] = (lane == i) ? 1.f : 0.f;
#pragma unroll
        for (int i = 62; i >= 0; --i) {
            const int mi = i >> 5, ri = (i & 3) + 4 * ((i & 31) >> 3), hi = ((i & 31) >> 2) & 1;
#pragma unroll
            for (int k = i + 1; k < 64; ++k) {
                const float nik = __builtin_bit_cast(float, __builtin_amdgcn_readlane(__builtin_bit_cast(int, acc[mi][k >> 5][ri]), (k & 31) + 32 * hi));
                const float exn = (k == i + 1) ? 0.5f : (k == i + 2) ? 0.25f : 0.f;
                if (nik != exn) badn |= 32u;
#if WKV_SUB == 1
                Tc[i] = __builtin_fmaf(nik, Tc[k], Tc[i]);
#else
                asm volatile("v_fmac_f32 %0, %1, %2" : "+v"(Tc[i]) : "s"(nik), "v"(Tc[k]));
#endif
            }
            WKV_FENCE();
        }
        unsigned bad = badn;
#pragma unroll
        for (int i = 0; i < 64; ++i) { const int d = lane - i; float ex = 0.f; if (d >= 0) { float t0 = 1.f, t1 = 0.5f; ex = d == 0 ? 1.f : 0.5f; for (int q = 2; q <= d; ++q) { const float t2 = 0.5f * t1 + 0.25f * t0; t0 = t1; t1 = t2; ex = t2; } }
            if (fabsf(Tc[i] - ex) > 1e-5f * fabsf(ex) + 1e-12f) bad |= 16u; }
        if (bad) atomicOr((unsigned*)(F.ws + WS_CTL) + 8, bad);
        WKV_FENCE();
        return;
    }
#endif
#if WKV_VAR == 12
    {
        f32x16 acc[2][2]; bf16x8 TR[4][2];
#pragma unroll
        for (int m = 0; m < 2; ++m)
#pragma unroll
            for (int n = 0; n < 2; ++n)
#pragma unroll
                for (int r = 0; r < 16; ++r) { const int i_ = 32 * m + crow(r, hh), k_ = 32 * n + c; acc[m][n][r] = (k_ == i_ + 1) ? 0.5f : (k_ == i_ + 2) ? 0.25f : (k_ <= i_) ? 1.0f : 0.f; }
        solve_T<false>(acc, TR, lane, false, 0);
        WKV_FENCE();
        bf16x8 Ir[4][2];
#pragma unroll
        for (int ks = 0; ks < 4; ++ks)
#pragma unroll
            for (int n = 0; n < 2; ++n) { bf16x8 v;
#pragma unroll
                for (int jj = 0; jj < 8; ++jj) v[jj] = ((16 * ks + 8 * (jj >> 2) + 4 * hh + (jj & 3)) == 32 * n + c) ? (short)0x3F80 : (short)0;
                Ir[ks][n] = v; }
        zero_acc(acc); mm64(acc, TR, Ir);
        unsigned bad = 0u;
#pragma unroll
        for (int m = 0; m < 2; ++m)
#pragma unroll
            for (int n = 0; n < 2; ++n)
#pragma unroll
                for (int r = 0; r < 16; ++r) { const int jp = 32 * m + crow(r, hh), j_ = 32 * n + c, d = jp - j_;
                    float ex = 0.f; if (d >= 0) { float t0 = 1.f, t1 = 0.5f; ex = d == 0 ? 1.f : 0.5f; for (int q = 2; q <= d; ++q) { const float t2 = 0.5f * t1 + 0.25f * t0; t0 = t1; t1 = t2; ex = t2; } }
                    const float got = acc[m][n][r]; if (fabsf(got - ex) > 0.01f * fabsf(ex) + 1e-6f) bad |= 8u; }
        if (bad) atomicOr((unsigned*)(F.ws + WS_CTL) + 8, bad);
        WKV_FENCE();
        return;
    }
#endif
#if WKV_VAR == 11
    {
        f32x16 acc[2][2]; bf16x8 IdT[2];
#pragma unroll
        for (int s = 0; s < 2; ++s) { bf16x8 v;
#pragma unroll
            for (int jj = 0; jj < 8; ++jj) v[jj] = ((16 * s + 8 * (jj >> 2) + (jj & 3)) == (c - 4 * hh)) ? (short)0x3F80 : (short)0;
            IdT[s] = v; }
        {
            bf16x8 XA[4][2], XB[4][2];
#pragma unroll
            for (int ks = 0; ks < 4; ++ks)
#pragma unroll
                for (int t = 0; t < 2; ++t) { bf16x8 va, vb;
#pragma unroll
                    for (int jj = 0; jj < 8; ++jj) { const int tk = 16 * ks + 8 * (jj >> 2) + 4 * hh + (jj & 3), chn = 32 * t + c;
                        va[jj] = (short)f2bf((float)(((tk + 2 * chn) & 7) - 3)); vb[jj] = (tk == chn) ? (short)0x3F80 : (short)0; }
                    XA[ks][t] = va; XB[ks][t] = vb; }
            frag_st_lds(wl, XA, lane); frag_st_lds(wl + 8192, XB, lane);
        }
        WKV_FENCE();
        unsigned bad = 0u;
        bf16x8 AC[4][2], BC[4][2];
        { bf16x8 X[4][2]; frag_ld_lds(wl + 8192, X, lane); transpose64(acc, X, IdT);
#pragma unroll
          for (int m = 0; m < 2; ++m)
#pragma unroll
            for (int n = 0; n < 2; ++n)
#pragma unroll
                for (int r = 0; r < 16; ++r) { const int chn = 32 * m + crow(r, hh), tk = 32 * n + c; if (acc[m][n][r] != ((tk == chn) ? 1.f : 0.f)) bad |= 1u; }
          acc2frag(acc, BC); }
        WKV_FENCE();
        { bf16x8 X[4][2]; frag_ld_lds(wl, X, lane); transpose64(acc, X, IdT);
#pragma unroll
          for (int m = 0; m < 2; ++m)
#pragma unroll
            for (int n = 0; n < 2; ++n)
#pragma unroll
                for (int r = 0; r < 16; ++r) { const int chn = 32 * m + crow(r, hh), tk = 32 * n + c; if (acc[m][n][r] != (float)(((tk + 2 * chn) & 7) - 3)) bad |= 2u; }
          acc2frag(acc, AC); }
        WKV_FENCE();
        zero_acc(acc); mm64(acc, BC, AC);
#pragma unroll
        for (int m = 0; m < 2; ++m)
#pragma unroll
            for (int n = 0; n < 2; ++n)
#pragma unroll
                for (int r = 0; r < 16; ++r) { const int i_ = 32 * m + crow(r, hh), j_ = 32 * n + c; if (acc[m][n][r] != (float)(((j_ + 2 * i_) & 7) - 3)) bad |= 4u; }
        if (bad) atomicOr((unsigned*)(F.ws + WS_CTL) + 8, bad);
        WKV_FENCE();
        return;
    }
#endif
#if WKV_VAR == 7
    const int wid = F.vcu * 2 + wave;
#else
    const int wid = F.vcu * NWAVES + wave;
#endif
    unsigned char* gs0 = F.ws + WS_KST + (size_t)wid * 8192;
#if WKV_VAR == 7
    unsigned char* gs1 = F.ws + WS_KST + 4 * MiB + (size_t)wid * 16384;
#else
    unsigned char* gs1 = F.dob + 3 * RKV_STRIDE + (size_t)wid * 16384;
#endif
    if (nvalid < 64) gs1 = F.ws + WS_TST + (size_t)bh * 16384;
    unsigned char* gs2 = gs1 + 8192;
    const size_t rbase = (size_t)row0 * DM + h * HD;
    const bool tail = nvalid < 64;
#define TPAD(m, r) (tail && (32 * (m) + 8 * ((r) >> 2) >= 16))
#define JOK(n) (!tail || ((n) == 0 && c < 16))
    const int dlt = c - 4 * hh;
#define KR(r) (((r) & 3) + 8 * ((r) >> 2))
#define ROW_GT_COL(m, n, r) (((m) > (n)) || ((m) == (n) && KR(r) > dlt))
    const srd_t sD = __builtin_amdgcn_make_buffer_rsrc((void*)F.dob, (short)0, (int)(O_END * 4), 0x00020000);
    const unsigned soR = (unsigned)(rbase * 2), soK = (unsigned)(RKV_STRIDE + rbase * 2), soV = (unsigned)(2 * RKV_STRIDE + rbase * 2);
    const unsigned voE = (unsigned)((4 * hh * DM + c) * 2);
    const unsigned voW = (unsigned)((c * DM + 4 * hh) * 2);
    const unsigned voA = (unsigned)((c * DM + 8 * hh) * 2);
#define CA(m, s) ((unsigned)(((32 * (m)) * DM + 16 * (s)) * 2))
#define CE(m, r, n) ((unsigned)(((32 * (m) + ((r) & 3) + 8 * ((r) >> 2)) * DM + 32 * (n)) * 2))
#define CW(m, q, n) ((unsigned)(((32 * (n)) * DM + 32 * (m) + 8 * (q)) * 2))
    constexpr float L2E = 1.4426950408889634f;
    float kkc[2], kac[2], rkc[2], w0c[2], a0c[2];
#pragma unroll
    for (int n = 0; n < 2; ++n) { const int cc = h * HD + 32 * n + c; kkc[n] = F.k_k[cc]; kac[n] = F.k_a[cc]; rkc[n] = F.r_k[cc]; w0c[n] = F.w0[cc]; a0c[n] = F.a0[cc]; }
    {
        bf16x8 KA[2][4], IdN[2];
#pragma unroll
        for (int m = 0; m < 2; ++m)
#pragma unroll
            for (int s4 = 0; s4 < 4; ++s4) KA[m][s4] = bld128(sD, voA, soK + CA(m, s4));
        make_idn(IdN, c, hh);
        float nv[32];
#pragma unroll
        for (int m = 0; m < 2; ++m) {
            const f32x16 t0 = tile_from_rows(KA[m][0], KA[m][1], IdN), t1 = tile_from_rows(KA[m][2], KA[m][3], IdN);
#pragma unroll
            for (int r = 0; r < 16; ++r) { const float q0 = t0[r] * kkc[0], q1 = t1[r] * kkc[1]; nv[16 * m + r] = TPAD(m, r) ? 0.f : (q0 * q0 + q1 * q1); } }
        const float tot = butterfly32(nv, lane);
        red[32 * (c >> 4) + crow(c & 15, hh)] = __builtin_amdgcn_rsqf(fmaxf(tot, 1e-24f));
        asm volatile("s_waitcnt lgkmcnt(0)" ::: "memory");
    }
    WKV_FENCE();
    WKV_SYNC();
    float gC[2], erk[32];
#pragma unroll
    for (int i = 0; i < 32; ++i) erk[i] = 0.f;
    gC[0] = gC[1] = 1.f;
    if (!(F.skip & 2))
#pragma unroll
    for (int n = 0; n < 2; ++n) {
        f32x16 z[2], az[2];
        {
            bf16x8 wf[4], af[4];
#pragma unroll
            for (int s = 0; s < 4; ++s) { wf[s] = *(const GAS bf16x8*)(w2t + (size_t)(h * HD + 32 * n + c) * 64 + 16 * s + 8 * hh); af[s] = *(const GAS bf16x8*)(a2t + (size_t)(h * HD + 32 * n + c) * 64 + 16 * s + 8 * hh); }
#pragma unroll
            for (int m = 0; m < 2; ++m) { z[m] = f32x16{}; az[m] = f32x16{};
                const unsigned char* tp = F.ws + WS_T12B + (size_t)((b * 129 + 2 * ch + m) * 8) * 1024 + lane * 16;
                if (!(tail && m == 1))
#pragma unroll
                for (int s = 0; s < 4; ++s) {
                    const bf16x8 xa = *(const GAS bf16x8*)(tp + s * 1024), ya = *(const GAS bf16x8*)(tp + (4 + s) * 1024);
                    z[m] = __builtin_amdgcn_mfma_f32_32x32x16_bf16(xa, wf[s], z[m], 0, 0, 0);
                    az[m] = __builtin_amdgcn_mfma_f32_32x32x16_bf16(ya, af[s], az[m], 0, 0, 0); } }
        }
        WKV_FENCE();
        bf16x8 KA2[2][2], RA2[2][2];
#pragma unroll
        for (int m = 0; m < 2; ++m)
#pragma unroll
            for (int s2 = 0; s2 < 2; ++s2) { KA2[m][s2] = bld128(sD, voA, soK + CA(m, 2 * n + s2)); RA2[m][s2] = bld128(sD, voA, soR + CA(m, 2 * n + s2)); }
#pragma unroll
        for (int m = 0; m < 2; ++m)
#pragma unroll
            for (int r = 0; r < 16; ++r) { const int t = 32 * m + crow(r, hh);
                const float sg = __builtin_amdgcn_rcpf(1.0f + __builtin_amdgcn_exp2f(-(z[m][r] + w0c[n]) * L2E)); z[m][r] = TPAD(m, r) ? 0.f : (-0.6065306597126334f * L2E) * sg;
                az[m][r] = __builtin_amdgcn_rcpf(1.0f + __builtin_amdgcn_exp2f(-(az[m][r] + a0c[n]) * L2E)); }
        float gt[8], ot[8], base[8];
#pragma unroll
        for (int g = 0; g < 8; ++g) { const int m = g >> 2, q = g & 3; gt[g] = (z[m][4 * q] + z[m][4 * q + 1]) + (z[m][4 * q + 2] + z[m][4 * q + 3]); ot[g] = __shfl_xor(gt[g], 32); }
        { float run = 0.f;
#pragma unroll
          for (int g = 0; g < 8; ++g) { base[g] = run + (hh ? ot[g] : 0.f); run += gt[g] + ot[g]; }
          gC[n] = __builtin_amdgcn_exp2f(run); }
#pragma unroll
        for (int m = 0; m < 2; ++m) {
            bf16x8 IdN[2]; make_idn(IdN, c, hh);
            const f32x16 ktile = tile_from_rows(KA2[m][0], KA2[m][1], IdN), rtile = tile_from_rows(RA2[m][0], RA2[m][1], IdN);
#pragma unroll
            for (int s = 0; s < 2; ++s) {
                float at[8], bt[8], kt[8], rt[8];
#pragma unroll
                for (int e = 0; e < 8; ++e) { at[e] = 0.f; bt[e] = 0.f; kt[e] = 0.f; rt[e] = 0.f; }
                if (!(tail && (m | s)))
#pragma unroll
                for (int qq = 0; qq < 2; ++qq) { const int q = 2 * s + qq; float acc = base[4 * m + q];
#pragma unroll
                    for (int i = 0; i < 4; ++i) { const int r = 4 * q + i, t = 32 * m + crow(r, hh), e = 4 * qq + i;
                        const float lw = z[m][r]; acc += lw; const float LG = acc;
                        const float eLG = __builtin_amdgcn_exp2f(LG), ieLG = __builtin_amdgcn_exp2f(-LG), eLGp = __builtin_amdgcn_exp2f(LG - lw);
                        float k = ktile[r], rr = rtile[r];
                        if (TPAD(m, r)) { k = 0.f; rr = 0.f; }
                        const float a = az[m][r];
                        const float kkn = k * kkc[n] * red[t];
                        const float kh = k * (1.0f + (a - 1.0f) * kac[n]);
                        at[e] = -kkn * eLGp; bt[e] = kkn * a * ieLG; kt[e] = kh * ieLG; rt[e] = rr * eLG;
                        erk[16 * m + r] += rr * kh * rkc[n]; } }
                const int fo = ((2 * m + s) * 2 + n) * 1024 + lane * 16; v4u w;
                w.x = cvtpkn(at[0], at[1]); w.y = cvtpkn(at[2], at[3]); w.z = cvtpkn(at[4], at[5]); w.w = cvtpkn(at[6], at[7]); *(LAS v4u*)(wl + fo) = w;
                w.x = cvtpkn(bt[0], bt[1]); w.y = cvtpkn(bt[2], bt[3]); w.z = cvtpkn(bt[4], bt[5]); w.w = cvtpkn(bt[6], bt[7]); *(LAS v4u*)(wl + 8192 + fo) = w;
                w.x = cvtpkn(kt[0], kt[1]); w.y = cvtpkn(kt[2], kt[3]); w.z = cvtpkn(kt[4], kt[5]); w.w = cvtpkn(kt[6], kt[7]); *(GAS v4u*)(gs0 + fo) = w;
                w.x = cvtpkn(rt[0], rt[1]); w.y = cvtpkn(rt[2], rt[3]); w.z = cvtpkn(rt[4], rt[5]); w.w = cvtpkn(rt[6], rt[7]); *(GAS v4u*)(gs1 + fo) = w;
                WKV_SYNC();
                WKV_FENCE();
            } }
        WKV_FENCE();
    }
    WKV_SYNC();
    {
        const float tot = butterfly32(erk, lane); const int t = 32 * (c >> 4) + crow(c & 15, hh);
        if (t < nvalid) ((float*)(F.ws + WS_RK))[(size_t)(row0 + t) * 16 + h] = tot;
    }
    WKV_FENCE();
#define MAKE_ID2(Id) do { int dl_ = dlt; asm volatile("" : "+v"(dl_)); _Pragma("unroll") for (int s_ = 0; s_ < 2; ++s_) { bf16x8 v_; \
        _Pragma("unroll") for (int jj = 0; jj < 8; ++jj) v_[jj] = ((16 * s_ + 8 * (jj >> 2) + (jj & 3)) == dl_) ? (short)0x3F80 : (short)0; \
        Id[s_] = v_; } } while (0)
    f32x16 acc[2][2];
    bf16x8 MbrR[4][2], MkaTR[4][2];
    {
        bf16x8 KtC[4][2];
        { bf16x8 X[4][2], Id2[2]; frag_ld_g(gs0, X, lane); MAKE_ID2(Id2); transpose64(acc, X, Id2); acc2frag(acc, KtC); }
        WKV_FENCE();
        {
            bf16x8 RtC[4][2];
            { bf16x8 X[4][2], Id2[2]; frag_ld_g(gs1, X, lane); MAKE_ID2(Id2); transpose64(acc, X, Id2); acc2frag(acc, RtC); }
            WKV_FENCE();
            WKV_SYNC();
            {
                zero_acc(acc); mm64(acc, KtC, RtC);
#pragma unroll
                for (int m = 0; m < 2; ++m)
#pragma unroll
                    for (int n = 0; n < 2; ++n)
#pragma unroll
                        for (int r = 0; r < 16; ++r) { if (ROW_GT_COL(m, n, r)) acc[m][n][r] = 0.f; }
                bf16x8 MkrR[4][2]; acc2frag(acc, MkrR); frag_st_g(gs2, MkrR, lane);
            }
            WKV_FENCE();
            WKV_SYNC();
            bf16x8 BtC[4][2];
            { bf16x8 X[4][2], Id2[2]; frag_ld_lds(wl + 8192, X, lane); MAKE_ID2(Id2); transpose64(acc, X, Id2); acc2frag(acc, BtC); }
            {
                zero_acc(acc); mm64(acc, BtC, RtC);
#pragma unroll
                for (int m = 0; m < 2; ++m)
#pragma unroll
                    for (int n = 0; n < 2; ++n)
#pragma unroll
                        for (int r = 0; r < 16; ++r) { if (ROW_GT_COL(m, n, r)) acc[m][n][r] = 0.f; }
                acc2frag(acc, MbrR);
            }
            WKV_FENCE();
            WKV_SYNC();
            bf16x8 AtC[4][2];
            { bf16x8 X[4][2], Id2[2]; frag_ld_lds(wl, X, lane); MAKE_ID2(Id2); transpose64(acc, X, Id2); acc2frag(acc, AtC); }
            {
                zero_acc(acc); mm64(acc, AtC, KtC);
#pragma unroll
                for (int m = 0; m < 2; ++m)
#pragma unroll
                    for (int n = 0; n < 2; ++n)
#pragma unroll
                        for (int r = 0; r < 16; ++r) { if (!ROW_GT_COL(m, n, r)) acc[m][n][r] = 0.f; }
                acc2frag(acc, MkaTR);
            }
            WKV_FENCE();
            zero_acc(acc); mm64(acc, BtC, AtC);
        }
    }
    WKV_FENCE();
    WKV_SYNC();
    bf16x8 TR[4][2];
    if (tail) solve_T<true>(acc, TR, lane, false, F.skip); else solve_T<false>(acc, TR, lane, sync, F.skip);
    WKV_FENCE();
    WKV_SYNC();
    if (!(F.skip & 4)) {
    unsigned char* gt_out = F.ws + WS_GT + (size_t)uidx * 8192; unsigned char* ht_out = F.ws + WS_HT + (size_t)uidx * 8192;
    unsigned char* wy_out = F.ws + WS_WYF + (size_t)uidx * 8192; unsigned char* y0_out = F.ws + WS_Y0F + (size_t)uidx * 8192;
    bf16x8 BtL[4][2];
    {
        bf16x8 P1R[4][2];
        { bf16x8 X[4][2]; frag_ld_lds(wl, X, lane); zero_acc(acc); mm64(acc, TR, X); acc2frag(acc, P1R); }
        WKV_FENCE();
        { bf16x8 X[4][2], Id2[2]; frag_ld_g(gs1, X, lane); MAKE_ID2(Id2); transpose64(acc, X, Id2); }
        mm64(acc, P1R, MbrR);
        { bf16x8 WyR[4][2]; acc2frag(acc, WyR); frag_st_g(wy_out, WyR, lane); }
        WKV_FENCE();
        frag_ld_lds(wl + 8192, BtL, lane);
        zero_acc(acc); mm64(acc, P1R, BtL);
#pragma unroll
        for (int m = 0; m < 2; ++m)
#pragma unroll
            for (int n = 0; n < 2; ++n)
#pragma unroll
                for (int s = 0; s < 2; ++s) { float v[8];
#pragma unroll
                    for (int i = 0; i < 8; ++i) v[i] = (acc[m][n][8 * s + i] + ((m == n && KR(8 * s + i) == dlt) ? 1.f : 0.f)) * gC[n];
                    v4u w; w.x = cvtpk(v[0], v[1]); w.y = cvtpk(v[2], v[3]); w.z = cvtpk(v[4], v[5]); w.w = cvtpk(v[6], v[7]);
                    *(GAS v4u*)(gt_out + ((2 * m + s) * 2 + n) * 1024 + lane * 16) = w; }
    }
    WKV_FENCE();
    WKV_SYNC();
    bf16x8 NyR[4][2], HkR[4][2];
    {
        bf16x8 P2TR[4][2];
        zero_acc(acc); mm64(acc, TR, MkaTR); acc2frag(acc, P2TR);
        WKV_FENCE();
        zero_acc(acc); mm64(acc, P2TR, MbrR); acc2frag(acc, NyR);
        WKV_FENCE();
        zero_acc(acc); mm64(acc, P2TR, BtL);
#pragma unroll
        for (int m = 0; m < 2; ++m)
#pragma unroll
            for (int n = 0; n < 2; ++n)
#pragma unroll
                for (int s = 0; s < 2; ++s) { const v4u kw = __builtin_amdgcn_raw_buffer_load_b128(__builtin_amdgcn_make_buffer_rsrc((void*)gs0, (short)0, 8192, 0x00020000), (unsigned)(lane * 16), (unsigned)(((2 * m + s) * 2 + n) * 1024), 16); const unsigned kk4[4] = {kw.x, kw.y, kw.z, kw.w}; unsigned ww[4];
#pragma unroll
                    for (int p = 0; p < 4; ++p) ww[p] = cvtpk((acc[m][n][8 * s + 2 * p] + lo16(kk4[p])) * gC[n], (acc[m][n][8 * s + 2 * p + 1] + hi16(kk4[p])) * gC[n]);
                    HkR[2 * m + s][n] = __builtin_bit_cast(bf16x8, (v4u){ww[0], ww[1], ww[2], ww[3]}); }
    }
    WKV_FENCE();
    WKV_SYNC();
    bf16x8 VtR[4][2];
    { bf16x8 VA[2][4], IdN[2];
#pragma unroll
      for (int m = 0; m < 2; ++m)
#pragma unroll
        for (int s4 = 0; s4 < 4; ++s4) VA[m][s4] = bld128(sD, voA, soV + CA(m, s4));
      make_idn(IdN, c, hh);
#pragma unroll
      for (int m = 0; m < 2; ++m)
#pragma unroll
        for (int n = 0; n < 2; ++n) { f32x16 t = tile_from_rows(VA[m][2 * n], VA[m][2 * n + 1], IdN);
#pragma unroll
            for (int r = 0; r < 16; ++r) if (TPAD(m, r)) t[r] = 0.f;
            mfma_fence1(t);
#pragma unroll
            for (int s = 0; s < 2; ++s) { v4u w; w.x = cvtpk(t[8 * s + 0], t[8 * s + 1]); w.y = cvtpk(t[8 * s + 2], t[8 * s + 3]); w.z = cvtpk(t[8 * s + 4], t[8 * s + 5]); w.w = cvtpk(t[8 * s + 6], t[8 * s + 7]); VtR[2 * m + s][n] = __builtin_bit_cast(bf16x8, w); } } }
    zero_acc(acc);
    { bf16x8 MkrR[4][2]; frag_ld_g(gs2, MkrR, lane); mm64(acc, VtR, MkrR); }
    mm64(acc, VtR, NyR);
#pragma unroll
    for (int m = 0; m < 2; ++m)
#pragma unroll
        for (int n = 0; n < 2; ++n)
#pragma unroll
            for (int q = 0; q < 4; ++q) { const f32x16& a = acc[m][n];
                *(GAS unsigned long long*)(y0_out + ((m * 2 + n) * 4 + q) * 512 + lane * 8) = pack4(a[4 * q], a[4 * q + 1], a[4 * q + 2], a[4 * q + 3]); }
    WKV_FENCE();
    zero_acc(acc); mm64(acc, HkR, VtR);
#pragma unroll
    for (int m = 0; m < 2; ++m)
#pragma unroll
        for (int n = 0; n < 2; ++n)
#pragma unroll
            for (int q = 0; q < 4; ++q) { const f32x16& a = acc[m][n];
                *(GAS unsigned long long*)(ht_out + ((n * 2 + m) * 4 + q) * 512 + lane * 8) = pack4(a[4 * q], a[4 * q + 1], a[4 * q + 2], a[4 * q + 3]); }
    WKV_FENCE();
    }
#undef MAKE_ID2
#undef CE
#undef CW
#undef CA
#undef TPAD
#undef JOK
#undef KR
#undef ROW_GT_COL
}

__device__ __forceinline__ void stageB_unit(Frame& F, int ub, int lane, unsigned* tflag) {
    asm volatile("" : "+v"(lane));
    const int c = lane & 31, hh = lane >> 5;
    const int n0 = ub & 1, bh = ub >> 1;
    const bf16* gt = (const bf16*)(F.ws + WS_GT) + (size_t)bh * NCH * 4096; bf16* ht = (bf16*)(F.ws + WS_HT) + (size_t)bh * NCH * 4096;
    const int nu = 32 * n0 + c;
#if WKV_EXP == 45
    {
        const bf16* ha = gt + (size_t)(NCH - 1) * 4096 + (size_t)nu * 64; const bf16* hx = ht + (size_t)(NCH - 1) * 4096 + (size_t)nu * 64;
        float* so = (float*)(F.ws + WS_WKVP) + (size_t)bh * 4096 + (size_t)nu * 64;
        for (int i = hh; i < 64; i += 2) so[i] += bf2f(ha[i]) - bf2f(hx[i]);
        return;
    }
#endif
    f32x16 S[2]; S[0] = f32x16{}; S[1] = f32x16{};
#ifndef WKB_DEPTH
#define WKB_DEPTH 2
#endif
    v4u gqA[2][4], gqB[2][4]; unsigned long long hqA[2][4], hqB[2][4];
#if WKB_DEPTH == 3
    v4u gqC[2][4]; unsigned long long hqC[2][4];
#endif
    const unsigned char* gtb = (const unsigned char*)gt; unsigned char* htb = (unsigned char*)ht;
#define WKB_LOAD(gq, hq, cc) do { const unsigned char* g_ = gtb + (size_t)(cc) * 8192 + lane * 16; const unsigned char* h_ = htb + (size_t)(cc) * 8192 + n0 * 4096 + lane * 8; \
        _Pragma("unroll") for (int m = 0; m < 2; ++m) { \
            _Pragma("unroll") for (int ks = 0; ks < 4; ++ks) gq[m][ks] = *(const GAS v4u*)(g_ + (ks * 2 + m) * 1024); \
            _Pragma("unroll") for (int q = 0; q < 4; ++q) hq[m][q] = *(const GAS unsigned long long*)(h_ + (m * 4 + q) * 512); } } while (0)
#define WKB_STEP(gq, hq, chv) do { const int ch = (chv); \
        bf16x8 SB[4]; \
        _Pragma("unroll") for (int m = 0; m < 2; ++m) \
            _Pragma("unroll") for (int s = 0; s < 2; ++s) { v4u w; w.x = cvtpkn(S[m][8 * s + 0], S[m][8 * s + 1]); w.y = cvtpkn(S[m][8 * s + 2], S[m][8 * s + 3]); w.z = cvtpkn(S[m][8 * s + 4], S[m][8 * s + 5]); w.w = cvtpkn(S[m][8 * s + 6], S[m][8 * s + 7]); SB[2 * m + s] = __builtin_bit_cast(bf16x8, w); } \
        f32x16 N[2]; \
        _Pragma("unroll") for (int m = 0; m < 2; ++m) \
            _Pragma("unroll") for (int q = 0; q < 4; ++q) { const unsigned long long w = hq[m][q]; N[m][4 * q] = lo16((unsigned)w); N[m][4 * q + 1] = hi16((unsigned)w); N[m][4 * q + 2] = lo16((unsigned)(w >> 32)); N[m][4 * q + 3] = hi16((unsigned)(w >> 32)); } \
        _Pragma("unroll") for (int m = 0; m < 2; ++m) \
            _Pragma("unroll") for (int ks = 0; ks < 4; ++ks) N[m] = __builtin_amdgcn_mfma_f32_32x32x16_bf16(__builtin_bit_cast(bf16x8, gq[m][ks]), SB[ks], N[m], 0, 0, 0); \
        if (ch + WKB_DEPTH < NCH) { \
            if (ch + WKB_DEPTH == NCH - 1) {     \
                while (__hip_atomic_load(tflag, __ATOMIC_RELAXED, __HIP_MEMORY_SCOPE_AGENT) == 0u) __builtin_amdgcn_s_sleep(4); \
                __builtin_amdgcn_fence(__ATOMIC_ACQUIRE, "agent"); } \
            WKB_LOAD(gq, hq, ch + WKB_DEPTH); } \
        if (ch > 0) {     \
            unsigned char* sp = htb + (size_t)(ch - 1) * 8192 + n0 * 4096 + lane * 16; \
            _Pragma("unroll") for (int ks = 0; ks < 4; ++ks) *(GAS bf16x8*)(sp + ks * 1024) = SB[ks]; } \
        mfma_fence2(N[0], N[1]); \
        S[0] = N[0]; S[1] = N[1]; } while (0)
#if WKB_DEPTH == 3
    WKB_LOAD(gqA, hqA, 0); WKB_LOAD(gqB, hqB, 1); WKB_LOAD(gqC, hqC, 2);
    static_assert(NCH == 65, "stage B step schedule");
#pragma unroll 1
    for (int ch0 = 0; ch0 < 63; ch0 += 3) { WKB_STEP(gqA, hqA, ch0); WKB_STEP(gqB, hqB, ch0 + 1); WKB_STEP(gqC, hqC, ch0 + 2); }
    WKB_STEP(gqA, hqA, 63); WKB_STEP(gqB, hqB, 64);
#else
    WKB_LOAD(gqA, hqA, 0); WKB_LOAD(gqB, hqB, 1);
    static_assert(NCH == 65, "stage B step schedule");
#pragma unroll 1
    for (int ch0 = 0; ch0 < 64; ch0 += 2) { WKB_STEP(gqA, hqA, ch0); WKB_STEP(gqB, hqB, ch0 + 1); }
    WKB_STEP(gqA, hqA, 64);
#endif
#undef WKB_STEP
#undef WKB_LOAD
#if WKV_EXP == 2 || WKV_EXP == 4 || WKV_EXP == 10
    float* so = (float*)(F.ws + WS_KST) + (size_t)bh * 4096 + (size_t)nu * 64;
#else
    float* so = (float*)(F.ws + WS_WKVP) + (size_t)bh * 4096 + (size_t)nu * 64;
#endif
#pragma unroll
    for (int m = 0; m < 2; ++m)
#pragma unroll
        for (int q = 0; q < 4; ++q) *(GAS f32x4*)(so + 32 * m + 8 * q + 4 * hh) = (f32x4){S[m][4 * q], S[m][4 * q + 1], S[m][4 * q + 2], S[m][4 * q + 3]};
}

__device__ __forceinline__ void stageC_unit(Frame& F, int uidx, int lane) {
    asm volatile("" : "+v"(lane));
    const int c = lane & 31, hh = lane >> 5;
    const int ch = uidx % NCH, bh = uidx / NCH, h = bh % NH, b = bh / NH;
    const int row0 = b * LP + 64 * ch, nvalid = (LP - 64 * ch) < 64 ? (LP - 64 * ch) : 64;
    const bf16* Vb = (const bf16*)(F.dob + 2 * RKV_STRIDE);
    const bf16* Gb = (const bf16*)(F.ws + WS_G); bf16* og2 = (bf16*)(F.dob + DO_OG2);
    const unsigned char* wyf = F.ws + WS_WYF + (size_t)uidx * 8192; const unsigned char* y0f = F.ws + WS_Y0F + (size_t)uidx * 8192;
    const size_t rbase = (size_t)row0 * DM + h * HD;
    unsigned long long vq[2][2][4], gq[2][2][4]; float rkv[2];
#define WKC_PREF(n) do { rkv[n] = ((const GAS float*)(F.ws + WS_RK))[(size_t)(row0 + 32 * (n) + c) * 16 + h]; \
        _Pragma("unroll") for (int m = 0; m < 2; ++m) \
            _Pragma("unroll") for (int q = 0; q < 4; ++q) { const size_t e = (size_t)(row0 + 32 * (n) + c) * DM + h * HD + 32 * m + 8 * q + 4 * hh; vq[n][m][q] = *(const GAS unsigned long long*)(Vb + e); gq[n][m][q] = *(const GAS unsigned long long*)(Gb + e); } } while (0)
    WKC_PREF(0);
    f32x16 acc[2][2];
#pragma unroll
    for (int m = 0; m < 2; ++m)
#pragma unroll
        for (int n = 0; n < 2; ++n)
#pragma unroll
            for (int q = 0; q < 4; ++q) { const unsigned long long w = *(const GAS unsigned long long*)(y0f + ((m * 2 + n) * 4 + q) * 512 + lane * 8);
                acc[m][n][4 * q] = lo16((unsigned)w); acc[m][n][4 * q + 1] = hi16((unsigned)w); acc[m][n][4 * q + 2] = lo16((unsigned)(w >> 32)); acc[m][n][4 * q + 3] = hi16((unsigned)(w >> 32)); }
    if (ch > 0) {
        const unsigned char* sc = F.ws + WS_HT + (size_t)(uidx - 1) * 8192;
        bf16x8 SA[4][2], WB[4][2];
#pragma unroll
        for (int ks = 0; ks < 4; ++ks)
#pragma unroll
            for (int t = 0; t < 2; ++t) { SA[ks][t] = *(const GAS bf16x8*)(sc + t * 4096 + ks * 1024 + lane * 16); WB[ks][t] = *(const GAS bf16x8*)(wyf + (ks * 2 + t) * 1024 + lane * 16); }
        mm64(acc, SA, WB);
    }
    WKV_FENCE();
    WKC_PREF(1);
#undef WKC_PREF
    float s[2], mean[2], rstd[2];
#pragma unroll
    for (int n = 0; n < 2; ++n) { float t = 0.f;
#pragma unroll
        for (int m = 0; m < 2; ++m)
#pragma unroll
            for (int r = 0; r < 16; ++r) t += acc[m][n][r];
        t += __shfl_xor(t, 32); mean[n] = t * (1.f / 64.f); float v = 0.f;
#pragma unroll
        for (int m = 0; m < 2; ++m)
#pragma unroll
            for (int r = 0; r < 16; ++r) { const float d = acc[m][n][r] - mean[n]; v += d * d; }
        v += __shfl_xor(v, 32); rstd[n] = __builtin_amdgcn_rsqf(v * (1.f / 64.f) + GN_EPS); s[n] = 0.f; }
    (void)s;
#pragma unroll
    for (int n = 0; n < 2; ++n) { const int j = 32 * n + c;
        if (j < nvalid) {
            const float rk = rkv[n];
#pragma unroll
            for (int m = 0; m < 2; ++m)
#pragma unroll
                for (int q = 0; q < 4; ++q) { const int nu0 = h * HD + 32 * m + 8 * q + 4 * hh; const size_t e = (size_t)(row0 + j) * DM + nu0;
                    const f32x4 lg = *(const GAS f32x4*)(F.ln_g + nu0), lb = *(const GAS f32x4*)(F.ln_b + nu0);
                    const unsigned long long vw = vq[n][m][q], gw = gq[n][m][q];
                    const float vv[4] = {lo16((unsigned)vw), hi16((unsigned)vw), lo16((unsigned)(vw >> 32)), hi16((unsigned)(vw >> 32))};
                    const float gg[4] = {lo16((unsigned)gw), hi16((unsigned)gw), lo16((unsigned)(gw >> 32)), hi16((unsigned)(gw >> 32))};
                    float o[4];
#pragma unroll
                    for (int i = 0; i < 4; ++i) { const float yn = (acc[m][n][4 * q + i] - mean[n]) * rstd[n] * lg[i] + lb[i] + rk * vv[i]; o[i] = yn * gg[i] * __builtin_amdgcn_rcpf(1.0f + __builtin_amdgcn_exp2f(-1.4426950408889634f * gg[i])); }
                    *(GAS unsigned long long*)(og2 + e) = (unsigned long long)cvtpkn(o[0], o[1]) | ((unsigned long long)cvtpkn(o[2], o[3]) << 32); } } }
}
}
__device__ __forceinline__ void p8a_wkvA(Frame& F) {
#if WKV_VAR == 7
    if (F.wave >= 2) return;
#pragma unroll 1
    for (int u = F.wave * F.G + F.vcu; u < wkv::NUNITS; u += 2 * F.G) wkv::stageA_unit(F, u, F.lane, F.wave, false, F.wave);
#else
    const bool sync = WKV_LOCKSTEP && (NB * NH * (wkv::NCH - 1)) % (NWAVES * F.G) == 0;
#pragma unroll 1
    for (int u = F.wave * F.G + F.vcu; u < NB * NH * (wkv::NCH - 1); u += NWAVES * F.G) wkv::stageA_unit(F, (u >> 6) * wkv::NCH + (u & 63), F.lane, F.wave, sync, F.wave);
#endif
}
__device__ __forceinline__ void p8b_wkvB(Frame& F, int mode, unsigned* tflags) {
    LAS float* wl = (LAS float*)(F.lds + RING_OFF) + F.wave * 2048;
    static_assert(DSEQ == 4, "wkv_seq4_unit");
    const int NBW = 2 * NB * NH, NTW = NB * NH;
    const bool bwave = (F.wave == 1 && F.vcu < NBW), twave = (F.wave == 2 && F.vcu < NTW);
    if ((mode & 1) && bwave) {
        if (!(F.skip & 16)) wkv::stageB_unit(F, F.vcu, F.lane, tflags + (F.vcu >> 1));
        __builtin_amdgcn_fence(__ATOMIC_RELEASE, "agent");
        if (F.lane == 0) __hip_atomic_fetch_add(tflags + 64 + (F.vcu >> 1), 1u, __ATOMIC_RELAXED, __HIP_MEMORY_SCOPE_AGENT);
    }
    if ((mode & 1) && twave) {
        if (!(F.skip & 8)) wkv::stageA_unit(F, F.vcu * wkv::NCH + (wkv::NCH - 1), F.lane, F.wave, false, 4);
        __builtin_amdgcn_fence(__ATOMIC_RELEASE, "agent");
        if (F.lane == 0) __hip_atomic_store(tflags + F.vcu, 1u, __ATOMIC_RELAXED, __HIP_MEMORY_SCOPE_AGENT);
    }
    const int sid = F.vcu >= NBW ? (F.vcu - NBW) * NWAVES + F.wave : 0;
    const int nslots = (F.G - NBW) * NWAVES;
    const int u_hi = ((mode & 2) && F.vcu >= NBW && !(F.skip & 32)) ? DBATCH * NH : 0;
#pragma unroll 1
    for (int u = sid; u < u_hi; u += nslots) {
        const int sb = u / NH, h = u % NH;
#if WKV_SEQ4
        wkv_seq4_unit(F, wl, MPR + sb * DSEQ, h, F.state_wkv + (size_t)u * 4096, F.out + O_WKVS + (size_t)u * 4096, F.lane);
#else
        wkv_seq_unit(F, wl, MPR + sb * DSEQ, DSEQ, h, F.state_wkv + (size_t)u * 4096, F.out + O_WKVS + (size_t)u * 4096, F.lane);
#endif
    }
}
__device__ __forceinline__ void p8c_wkvC(Frame& F, bool tailmode, unsigned* tflags) {
    int u, uend, ustep;
    if (tailmode) {
        const bool twave = (F.wave == 2 && F.vcu < NB * NH);
        u = F.vcu; uend = (twave && !(F.skip & 8)) ? F.vcu + 1 : 0; ustep = 1;
        if (twave) { while (__hip_atomic_load(tflags + 64 + F.vcu, __ATOMIC_RELAXED, __HIP_MEMORY_SCOPE_AGENT) < 2u) __builtin_amdgcn_s_sleep(8);
            __builtin_amdgcn_fence(__ATOMIC_ACQUIRE, "agent"); }
    } else { u = F.wave * F.G + F.vcu; uend = NB * NH * (wkv::NCH - 1); ustep = NWAVES * F.G; }
#pragma unroll 1
    for (; u < uend; u += ustep) wkv::stageC_unit(F, tailmode ? u * wkv::NCH + (wkv::NCH - 1) : (u >> 6) * wkv::NCH + (u & 63), F.lane);
}
#ifndef PROBE_REPS
#define PROBE_REPS 0
#define PROBE_PHASE 0
#endif
#ifndef WKV_FLOW
#define WKV_FLOW 0
#endif
#ifndef PROBE_STEP
#define PROBE_STEP 0
#endif
#ifndef WKV_ZERO_ROWS
#define WKV_ZERO_ROWS 0
#endif
#ifndef WKV_DELAY
#define WKV_DELAY 0
#endif
#ifndef WKV_EXP
#define WKV_EXP 0
#endif
#ifndef MK_ONE_LAUNCH
#define MK_ONE_LAUNCH 1
#endif
constexpr int N_PHASES = 11;
struct Args { const float* in[27]; float* out; unsigned char* ws; int ph_lo, ph_hi, li, pad; };
__device__ __forceinline__ bool in_phase(int lo, int hi, int k) { asm volatile("" : "+s"(lo), "+s"(hi)); return lo <= k && k < hi; }
__global__ void __launch_bounds__(NWAVES * 64, 2) mega_fwd(Args args) {
    extern __shared__ __attribute__((aligned(16))) unsigned char lds[];
    Frame F;
    F.lds = (LAS unsigned char*)lds;
    F.MISC = (volatile LAS unsigned*)(F.lds + MISC_OFF);
    F.tid = threadIdx.x; F.lane = F.tid & 63; F.wave = __builtin_amdgcn_readfirstlane(F.tid >> 6);
    F.G = gridDim.x; { const int bx = blockIdx.x; F.vcu = (F.G % 8 == 0) ? (bx % 8) * (F.G / 8) + bx / 8 : bx; }
    F.ws = args.ws; F.out = args.out; F.dob = (unsigned char*)args.out;
    F.ctl = (gu32*)(F.ws + WS_CTL); F.skip = args.pad >> 8;
    F.xp = args.in[0]; F.xs = args.in[1]; F.cache_k = args.in[2]; F.cache_v = args.in[3]; F.state_wkv = args.in[4]; F.state_shift = args.in[5];
    F.meta = args.in[6]; F.table = args.in[7]; F.norm_gain = args.in[8]; F.final_gain = args.in[9]; F.a_w_in = args.in[10]; F.sinks = args.in[11]; F.a_w_out = args.in[12];
    F.mu = args.in[13]; F.r_w_in = args.in[14]; F.w0 = args.in[15]; F.w1 = args.in[16]; F.w2 = args.in[17]; F.a0 = args.in[18]; F.a1 = args.in[19]; F.a2 = args.in[20];
    F.k_k = args.in[21]; F.k_a = args.in[22]; F.r_k = args.in[23]; F.ln_g = args.in[24]; F.ln_b = args.in[25]; F.r_w_out = args.in[26];
    for (int u = F.tid; u < (LDS_BYTES - LDSCTL_OFF) / 4; u += NWAVES * 64) ((LAS unsigned*)(F.lds + LDSCTL_OFF))[u] = 0u;
    __syncthreads();
    XcdBarrier bar; bar.bar = (unsigned*)(F.ctl + CW_BAR) + args.li * XCD_BAR_WORDS; bar.x = 0; bar.st = nullptr;
    const int lo = args.ph_lo, hi = args.ph_hi;
    if (hi - lo > 1 || lo == 8) bar = xcd_barrier_post((unsigned*)(F.ctl + CW_BAR) + args.li * XCD_BAR_WORDS, F.MISC + 8);
#define flow (WKV_FLOW && (gridDim.x == 256) && (args.ph_hi - args.ph_lo > 1))
#define rc2 ((unsigned*)(args.ws + WS_CTL) + CW_RC2 + args.li * 256)
#define rc4 ((unsigned*)(args.ws + WS_CTL) + CW_RC4 + args.li * 256)
#define IN(k) (lo <= (k) && (k) < hi)
#define SEAM(k) do { if (IN(k) && IN((k) + 1)) xcd_barrier(bar); } while (0)
    bf16* XA = (bf16*)(F.ws + WS_XA); bf16* QKVG = (bf16*)(F.ws + WS_QKVG); bf16* H1 = (bf16*)(F.ws + WS_H1);
    bf16* Rb = (bf16*)(F.dob); bf16* Kb = (bf16*)(F.dob + RKV_STRIDE); bf16* Vb = (bf16*)(F.dob + 2 * RKV_STRIDE); bf16* Gb = (bf16*)(F.ws + WS_G);

    if (IN(0)) { p0_prologue(F, 2, F.vcu * NWAVES + F.wave, F.G * NWAVES); } SEAM(0);
    if (IN(1)) {
        pg8::Gemm g{XA, (const bf16*)(F.ws + WS_WAIN), MPAD, LDQ, DM, 1 << 30, 0}; pg8::StaticOrder S; S.init(MPAD, LDQ, F.G, (int)blockIdx.x);
        pg8::EpiBf16G E{QKVG, QKVG, QKVG, QKVG, LDQ, 64, MPAD, 4, QSCALE};
        pg8::gemm_phase<pg8::EpiBf16G, pg8::StaticOrder, true, true>(F.lds + RING_OFF, g, S, E);
    } SEAM(1);
    if (IN(2)) { p2_attention(F); } SEAM(2);
    if (IN(3)) {
        pg8::Gemm g{XA, (const bf16*)(F.ws + WS_WAOUT), MPAD, DM, DM, 1 << 30, 0};
        pg8::EpiResB E{nullptr, H1, F.meta, F.xp, F.xs, MTOK};
        if (flow) { pg8::SplitOrder S; S.init(MPAD, DM, F.G, (int)blockIdx.x, rc2); pg8::gemm_phase<pg8::EpiResB, pg8::SplitOrder, true, true>(F.lds + RING_OFF, g, S, E); }
        else { pg8::StaticOrder S; S.init(MPAD, DM, F.G, (int)blockIdx.x); pg8::gemm_phase<pg8::EpiResB, pg8::StaticOrder, true, true>(F.lds + RING_OFF, g, S, E); }
    } if (IN(3) && IN(4) && !flow) xcd_barrier(bar);
    if (IN(4)) { p4_mix(F); } if (IN(4) && IN(6)) xcd_barrier(bar);
    if (IN(6)) {
        {
            pg8::Gemm g{(const bf16*)(F.ws + WS_MIX), (const bf16*)(F.ws + WS_WRIN), MPAD, 4 * DM, DM, 4, MIX_STRIDE}; pg8::StaticOrder S; S.init(MPAD, 4 * DM, F.G, (int)blockIdx.x);
            pg8::EpiBf16G E{Rb, Kb, Vb, Gb, DM, 4, MTOK, 0, 1.f};
            pg8::gemm_phase<pg8::EpiBf16G, pg8::StaticOrder, true, true>(F.lds + RING_OFF, g, S, E);
        }
        __syncthreads();
        {
            const int rot = (((MPAD / 256) * (4 * DM / 256)) % F.G + 7) & ~7;
            const int cid = ((int)blockIdx.x - rot + 4 * F.G) % F.G;
            pg8::Gemm g{(const bf16*)(F.dob + DO_XN1), (const bf16*)(F.ws + WS_W1A1), U_SROW, 256, DM, 1 << 30, 0}; pg8::StaticOrder S; S.init(U_SROW, 256, F.G, cid);
            pg8::EpiF32 E{(float*)(F.ws + WS_U), 256};
            pg8::gemm_phase<pg8::EpiF32, pg8::StaticOrder, true, true>(F.lds + RING_OFF, g, S, E);
            __syncthreads();
            pg8::Gemm g2{(const bf16*)(F.ws + WS_XN1S), (const bf16*)(F.ws + WS_W1A1), 768, 256, DM, 1 << 30, 0}; pg8::StaticOrder S2; S2.init(768, 256, F.G, (cid - 72 + F.G) % F.G);
            pg8::EpiF32 E2{(float*)(F.ws + WS_U) + (size_t)U_SROW * 256, 256};
            pg8::gemm_phase<pg8::EpiF32, pg8::StaticOrder, true, true>(F.lds + RING_OFF, g2, S2, E2);
        }
    } if (IN(6) && IN(7)) xcd_barrier(bar);
    if (IN(7)) { p5_lora1_combine(F); } SEAM(7);
    if (IN(8)) {
#if WKV_EXP == 40 || WKV_EXP == 45
        const int nst = 4; const int prog[4] = {3, 6, 0, 1};
#elif WKV_EXP >= 30
        const int nst = 3; const int prog[4] = {3, 0, 1, 1};
#elif WKV_EXP == 21
        const int nst = 4; const int prog[4] = {0, 1, 2, 4};
#elif WKV_EXP == 0
        const int nst = 3; const int prog[4] = {0, 1, 2, 2};
#elif WKV_EXP == 1
        const int nst = 3; const int prog[4] = {3, 0, 1, 1};
#elif WKV_EXP == 16 || WKV_EXP == 19
        const int nst = 2; const int prog[4] = {3, 1, 1, 1};
#elif WKV_EXP == 10
        const int nst = 4; const int prog[4] = {3, 0, 4, 5};
#elif WKV_EXP == 5 || WKV_EXP == 12
        const int nst = 3; const int prog[4] = {3, 0, 4, 4};
#elif WKV_EXP == 4 || WKV_EXP == 7 || WKV_EXP == 8 || WKV_EXP == 14 || WKV_EXP == 15
        const int nst = 3; const int prog[4] = {3, 0, 1, 1};
#elif WKV_EXP == 2
        const int nst = 4; const int prog[4] = {3, 0, 1, 2};
#else
        const int nst = 2; const int prog[4] = {3, 4, 4, 4};
#endif
#pragma unroll 1
        for (int st = 0; st < nst; ++st) {
            const int kind = st == 0 ? prog[0] : st == 1 ? prog[1] : st == 2 ? prog[2] : prog[3];
            if ((args.pad & 255) && st + 1 != (args.pad & 255)) continue;
            unsigned* tflags = (unsigned*)(F.ctl + CW_TFLAG) + args.li * 128;
            if (kind == 0) p8a_wkvA(F);
            else { if (kind != 2) p8b_wkvB(F, 3, tflags); p8c_wkvC(F, kind != 2, tflags); }
            if (st + 1 < nst && !args.pad) xcd_barrier(bar);
        }
    } SEAM(8);
#if WKV_ZERO_ROWS
    if (blockIdx.x == 0) { bf16* o_ = (bf16*)(F.ws + WS_OG2) + (size_t)16864 * DM; for (int i = F.tid; i < 32 * DM; i += NWAVES * 64) o_[i] = 0; }
    xcd_barrier(bar);
#endif
#if WKV_DELAY
    { const unsigned long long t0_ = __builtin_amdgcn_s_memrealtime(); while (__builtin_amdgcn_s_memrealtime() - t0_ < 20000ull) __builtin_amdgcn_s_sleep(8); }
#endif
    if (IN(9)) {
        pg8::Gemm g{(const bf16*)(F.dob + DO_OG2), (const bf16*)(F.ws + WS_WROUT), MPAD, DM, DM, 1 << 30, 0};
        pg8::EpiResB E{H1, H1, F.meta, F.xp, F.xs, MTOK};
        if (flow) { pg8::SplitOrder S; S.init(MPAD, DM, F.G, (int)blockIdx.x, rc4); pg8::gemm_phase<pg8::EpiResB, pg8::SplitOrder, true, true>(F.lds + RING_OFF, g, S, E); }
        else { pg8::StaticOrder S; S.init(MPAD, DM, F.G, (int)blockIdx.x); pg8::gemm_phase<pg8::EpiResB, pg8::StaticOrder, true, true>(F.lds + RING_OFF, g, S, E); }
    } if (IN(9) && IN(10) && !flow) xcd_barrier(bar);
#ifdef EXTRA_BARRIERS
    if (hi - lo > 1) { for (int e_ = 0; e_ < EXTRA_BARRIERS; ++e_) xcd_barrier(bar); }
#endif
    if (IN(10)) { p8_final(F); }
#undef IN
#undef SEAM
}

extern "C" void kernel_launch(void* const* d_in, const int* in_sizes, int n_in, void* d_out, int out_size, void* d_ws, size_t ws_size, hipStream_t stream) {
    static int grid = 0;
    if (grid == 0) {
        if (n_in != 27 || (size_t)out_size != O_END || ws_size < WS_END) { fprintf(stderr, "kernel_launch: unexpected shapes n_in %d out %d ws %zu\n", n_in, out_size, ws_size); grid = -1; return; }
        int dev = 0, cus = 0, per_cu = 0;
        if (hipGetDevice(&dev) != hipSuccess || hipDeviceGetAttribute(&cus, hipDeviceAttributeMultiprocessorCount, dev) != hipSuccess) { grid = -1; return; }
        if (hipFuncSetAttribute((const void*)mega_fwd, hipFuncAttributeMaxDynamicSharedMemorySize, LDS_BYTES) != hipSuccess) { fprintf(stderr, "kernel_launch: hipFuncSetAttribute failed\n"); grid = -1; return; }
        if (hipOccupancyMaxActiveBlocksPerMultiprocessor(&per_cu, (const void*)mega_fwd, NWAVES * 64, LDS_BYTES) != hipSuccess || per_cu < 1) fprintf(stderr, "kernel_launch: occupancy query says %d\n", per_cu);
        (void)hipGetLastError();
        grid = cus;
    }
    if (grid < 0) return;
    if (hipMemsetAsync((char*)d_ws + WS_CTL, 0, CTL_ZERO_BYTES, stream) != hipSuccess) return;
    Args a{};
    for (int i = 0; i < 27; ++i) a.in[i] = (const float*)d_in[i];
    a.out = (float*)d_out; a.ws = (unsigned char*)d_ws;
#if PROBE_REPS > 0
    for (int r_ = 0; r_ < PROBE_REPS; ++r_) { a.ph_lo = PROBE_PHASE; a.ph_hi = PROBE_PHASE + 1; a.li = 1 + r_; a.pad = PROBE_STEP; hipLaunchKernelGGL(mega_fwd, dim3(grid), dim3(NWAVES * 64), LDS_BYTES, stream, a); }
#endif
#if MK_ONE_LAUNCH
    a.ph_lo = 0; a.ph_hi = N_PHASES; a.li = 0; a.pad = 0;
    hipLaunchKernelGGL(mega_fwd, dim3(grid), dim3(NWAVES * 64), LDS_BYTES, stream, a);
#else
    for (int p = 0; p < N_PHASES; ++p) { a.ph_lo = p; a.ph_hi = p + 1; a.li = p;
        hipLaunchKernelGGL(mega_fwd, dim3(grid), dim3(NWAVES * 64), LDS_BYTES, stream, a); }
#endif
}
```

```cpp
#include <hip/hip_runtime.h>
#include <cstdio>
#include <cstdint>
#define WKV_EXP 0
#define WKV_DUMP_T 4096
#define WKV_VAR 0
#define WKV_SUB 0
#define PROBE_PHASE 0
#define PROBE_REPS 0
#define PROBE_STEP 0
namespace pg8 {
#define PG8_LAS __attribute__((address_space(3)))
typedef unsigned short bf16_t;
typedef short bf16x8 __attribute__((ext_vector_type(8)));
typedef float f32x4 __attribute__((ext_vector_type(4)));
typedef unsigned u32x4 __attribute__((ext_vector_type(4)));
constexpr int BM = 256, BK = 64, HALF = 128, HTB = HALF * BK * 2  , STAGE_BYTES = 8 * HTB, NXCD = 8, WGM = 8;

__host__ __device__ __forceinline__ int lds_byte(int r, int c) { const int st = (r >> 4) * 2 + (c >> 5), rr = r & 15, cc = c & 31, ob = rr * 64 + cc * 2; return st * 1024 + (ob ^ (((ob >> 9) & 1) << 5)); }
__host__ __device__ __forceinline__ void stage_rc(int b, int& R, int& C) { const int st = b / 1024, sb = b % 1024, swz = sb ^ (((sb >> 9) & 1) << 5); R = (st >> 1) * 16 + swz / 64; C = (st & 1) * 32 + (swz % 64) / 2; }
__host__ __device__ __forceinline__ int perm32(int rho) { const int n = rho >> 4, i = rho & 15; return 8 * (i >> 2) + 4 * n + (i & 3); }

struct Unit { int pm, pn; };
struct Gemm { const bf16_t* A; const bf16_t* Bt; int M, N, K; int gdiv; size_t a_gstride; };

struct SplitOrder;
struct StaticOrder {
    int nM, nN, nwg, G, c;
    __host__ __device__ void init(int M, int N, int G_, int c_) { nM = M / BM; nN = N / BM; nwg = nM * nN; G = G_; c = c_; }
    __host__ __device__ bool next(int i, Unit& u) const {
        const long L = (long)i * G + c; if (L >= nwg) return false;
        int wgid = (int)L; { const int q = nwg / NXCD, r = nwg % NXCD, xcd = wgid % NXCD, off = wgid / NXCD; wgid = (xcd < r ? xcd * (q + 1) : r * (q + 1) + (xcd - r) * q) + off; }
        const int nig = WGM * nN, gid = wgid / nig, fm = gid * WGM, gsz = (nM - fm) < WGM ? (nM - fm) : WGM;
        u.pm = fm + ((wgid % nig) % gsz); u.pn = (wgid % nig) / gsz; return true;
    }
    __device__ __forceinline__ void a_ready(const Unit&) const {}
    __device__ __forceinline__ void done(const Unit&) const {}
};
struct TailFreeOrder {
    StaticOrder a, lin; int q, nq, base;
    __device__ void init(int M, int N, int G_, int c_, int q_, int nq_) { a.init(M, N, G_, c_); lin.init(M, N, 1, 0); q = q_; nq = nq_; base = 3 * G_; }
    __device__ bool next(int i, Unit& u) const {
        if (i < 3) return a.next(i, u);
        if (q < 0) return false;
        const int L = base + (i - 3) * nq + q; if (L >= a.nwg) return false;
        return lin.next(L, u);
    }
    __device__ __forceinline__ void a_ready(const Unit&) const {}
    __device__ __forceinline__ void done(const Unit&) const {}
};
struct SplitOrder {
    StaticOrder a, b; int nMa; unsigned* cnt;
    __device__ void init(int M, int N, int G_, int c_, unsigned* cnt_) { const int nN = N / BM; nMa = G_ / nN; a.init(nMa * BM, N, G_, c_); b.init(M - nMa * BM, N, G_, c_); cnt = cnt_; }
    __device__ bool next(int i, Unit& u) const { if (i == 0) return a.next(0, u); const bool ok = b.next(i - 1, u); u.pm += nMa; return ok; }
    __device__ __forceinline__ void a_ready(const Unit&) const {}
    __device__ __forceinline__ void done(const Unit& u) const {
        __syncthreads();
        if (threadIdx.x < 64) { __builtin_amdgcn_fence(__ATOMIC_RELEASE, "agent");
            if (threadIdx.x == 0) __hip_atomic_fetch_add(cnt + u.pm, 1u, __ATOMIC_RELAXED, __HIP_MEMORY_SCOPE_AGENT); }
    }
};

__device__ __forceinline__ unsigned cvt_pk_bf16(float lo, float hi) { unsigned r; asm volatile("v_cvt_pk_bf16_f32 %0, %1, %2" : "=v"(r) : "v"(lo), "v"(hi)); return r; }
struct EpiBf16G {
    static constexpr bool PERM = true, AFTER_DRAIN = false;
    bf16_t *O0, *O1, *O2, *O3; int ldc, tpg, Mvalid, scale_tiles; float scale0;
    __device__ __forceinline__ void operator()(const f32x4 (&acc)[2][2][4][2], const Unit& u, int wr, int wc, int fr, int fq) const {
        const int grp = u.pn / tpg, colt = (u.pn - grp * tpg) * BM;
        bf16_t* base = grp == 0 ? O0 : grp == 1 ? O1 : grp == 2 ? O2 : O3;
        const float sc = (u.pn < scale_tiles) ? scale0 : 1.f;
        const int row0 = u.pm * BM + wr * 64 + fr, col0 = colt + wc * 32 + 8 * fq;
#pragma unroll
        for (int ai = 0; ai < 2; ++ai)
#pragma unroll
            for (int m = 0; m < 4; ++m) { const int row = row0 + ai * HALF + m * 16; const unsigned roff = (unsigned)(((size_t)row * ldc + col0) * 2);
                if (row < Mvalid) {
#pragma unroll
                for (int bj = 0; bj < 2; ++bj) { const f32x4 v0 = acc[ai][bj][m][0] * sc, v1 = acc[ai][bj][m][1] * sc;
                    u32x4 w; w.x = cvt_pk_bf16(v0[0], v0[1]); w.y = cvt_pk_bf16(v0[2], v0[3]); w.z = cvt_pk_bf16(v1[0], v1[1]); w.w = cvt_pk_bf16(v1[2], v1[3]);
                    *(u32x4*)((char*)base + roff + bj * HALF * 2) = w; } } }
    }
};
struct EpiRes {
    static constexpr bool PERM = false, AFTER_DRAIN = false;
    const float* base; float* out; const float *meta, *xp, *xs; int Mvalid;
    __device__ __forceinline__ void operator()(const f32x4 (&acc)[2][2][4][2], const Unit& u, int wr, int wc, int fr, int fq) const {
        const int row0 = u.pm * BM + wr * 64 + fr, col0 = u.pn * BM + wc * 32 + 4 * fq;
#pragma unroll
        for (int ai = 0; ai < 2; ++ai)
#pragma unroll
            for (int m = 0; m < 4; ++m) { const int row = row0 + ai * HALF + m * 16;
                if (row < Mvalid) {
                    const float* b;
                    if (base) b = base + (size_t)row * 1024;
                    else if (row < 16448) { const int bb = row / 4112, t = row - bb * 4112; b = t < 16 ? meta + t * 1024 : xp + ((size_t)bb * 4096 + (t - 16)) * 1024; }
                    else b = xs + (size_t)(row - 16448) * 1024;
                    float* o = out + (size_t)row * 1024;
#pragma unroll
                    for (int bj = 0; bj < 2; ++bj)
#pragma unroll
                        for (int n = 0; n < 2; ++n) { const int c = col0 + bj * HALF + n * 16; const f32x4 r = *(const f32x4*)(b + c); *(f32x4*)(o + c) = r + acc[ai][bj][m][n]; } } }
    }
};

struct EpiResB {
    static constexpr bool PERM = true, AFTER_DRAIN = false;
    const bf16_t* base; bf16_t* out; const float *meta, *xp, *xs; int Mvalid;
    __device__ __forceinline__ void operator()(const f32x4 (&acc)[2][2][4][2], const Unit& u, int wr, int wc, int fr, int fq) const {
        const int row0 = u.pm * BM + wr * 64 + fr, col0 = u.pn * BM + wc * 32 + 8 * fq;
#pragma unroll
        for (int ai = 0; ai < 2; ++ai)
#pragma unroll
            for (int m = 0; m < 4; ++m) { const int row = row0 + ai * HALF + m * 16;
                if (row < Mvalid) {
                    const unsigned ooff = (unsigned)(((size_t)row * 1024 + col0) * 2);
                    if (base) {
                        const bf16_t* b = base + (size_t)row * 1024 + col0;
#pragma unroll
                        for (int bj = 0; bj < 2; ++bj) { const u32x4 rw = *(const u32x4*)(b + bj * HALF); const f32x4 a0 = acc[ai][bj][m][0], a1 = acc[ai][bj][m][1]; u32x4 w;
                            w.x = cvt_pk_bf16(a0[0] + __builtin_bit_cast(float, rw.x << 16), a0[1] + __builtin_bit_cast(float, rw.x & 0xffff0000u));
                            w.y = cvt_pk_bf16(a0[2] + __builtin_bit_cast(float, rw.y << 16), a0[3] + __builtin_bit_cast(float, rw.y & 0xffff0000u));
                            w.z = cvt_pk_bf16(a1[0] + __builtin_bit_cast(float, rw.z << 16), a1[1] + __builtin_bit_cast(float, rw.z & 0xffff0000u));
                            w.w = cvt_pk_bf16(a1[2] + __builtin_bit_cast(float, rw.w << 16), a1[3] + __builtin_bit_cast(float, rw.w & 0xffff0000u));
                            *(u32x4*)((char*)out + ooff + bj * HALF * 2) = w; }
                    } else {
                        const float* b;
                        if (row < 16448) { const int bb = row / 4112, t = row - bb * 4112; b = t < 16 ? meta + t * 1024 : xp + ((size_t)bb * 4096 + (t - 16)) * 1024; }
                        else b = xs + (size_t)(row - 16448) * 1024;
                        b += col0;
#pragma unroll
                        for (int bj = 0; bj < 2; ++bj) { const f32x4 r0 = *(const f32x4*)(b + bj * HALF), r1 = *(const f32x4*)(b + bj * HALF + 4); const f32x4 v0 = acc[ai][bj][m][0] + r0, v1 = acc[ai][bj][m][1] + r1; u32x4 w;
                            w.x = cvt_pk_bf16(v0[0], v0[1]); w.y = cvt_pk_bf16(v0[2], v0[3]); w.z = cvt_pk_bf16(v1[0], v1[1]); w.w = cvt_pk_bf16(v1[2], v1[3]);
                            *(u32x4*)((char*)out + ooff + bj * HALF * 2) = w; }
                    } } }
    }
};

struct EpiT12 {
    static constexpr bool PERM = false, AFTER_DRAIN = false;
    float* t12; int Mvalid; unsigned char* t12b;
    __device__ __forceinline__ void operator()(const f32x4 (&acc)[2][2][4][2], const Unit& u, int wr, int wc, int fr, int fq) const {
        if (wc >= 2) return;
        const int row0 = u.pm * BM + wr * 64 + fr, col0 = wc * 32 + 4 * fq;
#pragma unroll
        for (int ai = 0; ai < 2; ++ai)
#pragma unroll
            for (int m = 0; m < 4; ++m) { const int row = row0 + ai * HALF + m * 16;
                if (row < Mvalid) {
                    float* o = t12 + (size_t)row * 128 + u.pn * 64 + col0;
                    const int bb = row / 4112, t = row - bb * 4112;
                    unsigned char* ob = t12b + ((size_t)((bb * 129 + (t >> 5)) * 8 + u.pn * 4) * 64 + (t & 31)) * 16;
#pragma unroll
                    for (int n = 0; n < 2; ++n) { f32x4 v = acc[ai][0][m][n];
                        if (u.pn == 0) { v[0] = tanhf(v[0]); v[1] = tanhf(v[1]); v[2] = tanhf(v[2]); v[3] = tanhf(v[3]); }
                        *(f32x4*)(o + n * 16) = v;
                        if (row < 16448) { const int j = col0 + n * 16;
                            *(unsigned long long*)(ob + ((j >> 4) * 64 + 32 * ((j >> 3) & 1)) * 16 + (j & 7) * 2) = (unsigned long long)cvt_pk_bf16(v[0], v[1]) | ((unsigned long long)cvt_pk_bf16(v[2], v[3]) << 32); } } } }
    }
};

struct EpiF32 {
    static constexpr bool PERM = false, AFTER_DRAIN = false;
    float* out; int ldc;
    __device__ __forceinline__ void operator()(const f32x4 (&acc)[2][2][4][2], const Unit& u, int wr, int wc, int fr, int fq) const {
        const int row0 = u.pm * BM + wr * 64 + fr, col0 = u.pn * BM + wc * 32 + 4 * fq;
#pragma unroll
        for (int ai = 0; ai < 2; ++ai)
#pragma unroll
            for (int m = 0; m < 4; ++m) { const int row = row0 + ai * HALF + m * 16; const unsigned ooff = (unsigned)(((size_t)row * ldc + col0) * 4);
#pragma unroll
                for (int bj = 0; bj < 2; ++bj)
#pragma unroll
                    for (int n = 0; n < 2; ++n) *(f32x4*)((char*)out + ooff + (bj * HALF + n * 16) * 4) = acc[ai][bj][m][n]; }
    }
};
template <class Epi, class Sched, bool ALIGN_EPI = false, bool SP2 = false>
__device__ __forceinline__ void gemm_phase(PG8_LAS unsigned char* lds, const Gemm g, const Sched& S, const Epi& E) {
    const int tid = threadIdx.x, wid = __builtin_amdgcn_readfirstlane(tid >> 6), lane = tid & 63, wr = wid >> 2, wc = wid & 3, fr = lane & 15, fq = lane >> 4;
    const int K = g.K, nt = K / BK;
    unsigned voffA[2], voffB[2];
#pragma unroll
    for (int i = 0; i < 2; ++i) { int R, C; stage_rc(tid * 16 + i * 8192, R, C); const int Rb = Epi::PERM ? ((R & ~31) + perm32(R & 31)) : R;
        voffA[i] = (unsigned)(R * K + C) * 2u; voffB[i] = (unsigned)(Rb * K + C) * 2u; }
    const size_t kstep = (size_t)(BK * 2);
    const size_t hstep = (size_t)HALF * K * 2;
    const size_t tstep = 2 * hstep;
    const unsigned ldsw = (unsigned)wid * 1024u;
    const int aoff = lds_byte(wr * 64 + fr, fq * 8), boff = lds_byte(wc * 32 + fr, fq * 8);
#define PG8_SA(b, h) (((b) * 2 + (h)) * HTB)
#define PG8_SB(b, h) ((4 + (b) * 2 + (h)) * HTB)
#define PG8_STAGE(bufoff, gbase, voff) do { _Pragma("unroll") for (int _i = 0; _i < 2; ++_i) \
        __builtin_amdgcn_global_load_lds((const unsigned*)((const char*)(gbase) + (voff)[_i]), (PG8_LAS unsigned*)(lds + (bufoff) + ldsw + _i * 8192), 16, 0, 0); } while (0)
#define PG8_LDA(dst, b, h) do { _Pragma("unroll") for (int m = 0; m < 4; ++m) _Pragma("unroll") for (int k = 0; k < 2; ++k) dst[m][k] = *(const PG8_LAS bf16x8*)(lds + PG8_SA(b, h) + aoff + m * 2048 + k * 1024); } while (0)
#define PG8_LDB(dst, b, h) do { _Pragma("unroll") for (int n = 0; n < 2; ++n) _Pragma("unroll") for (int k = 0; k < 2; ++k) dst[n][k] = *(const PG8_LAS bf16x8*)(lds + PG8_SB(b, h) + boff + n * 2048 + k * 1024); } while (0)
#define PG8_MMA(ai, bj, At, Bt) do { __builtin_amdgcn_s_setprio(1); _Pragma("unroll") for (int m = 0; m < 4; ++m) _Pragma("unroll") for (int n = 0; n < 2; ++n) _Pragma("unroll") for (int k = 0; k < 2; ++k) \
        acc[ai][bj][m][n] = __builtin_amdgcn_mfma_f32_16x16x32_bf16(Bt[n][k], At[m][k], acc[ai][bj][m][n], 0, 0, 0); __builtin_amdgcn_s_setprio(0); } while (0)
#define PG8_WAIT_V(n) asm volatile("s_waitcnt vmcnt(" #n ")" ::: "memory")
#define PG8_WAIT_L(n) asm volatile("s_waitcnt lgkmcnt(" #n ")" ::: "memory")
#define PG8_BAR __builtin_amdgcn_s_barrier()
#define PG8_SCHED __builtin_amdgcn_sched_barrier(0)
    Unit cur, nxt; int ui = 0;
    if (!S.next(0, cur)) return;
    f32x4 acc[2][2][4][2];
#pragma unroll
    for (int a = 0; a < 2; ++a)
#pragma unroll
        for (int b = 0; b < 2; ++b)
#pragma unroll
            for (int m = 0; m < 4; ++m)
#pragma unroll
                for (int n = 0; n < 2; ++n) acc[a][b][m][n] = (f32x4){0.f, 0.f, 0.f, 0.f};
    bf16x8 At[4][2], B0[2][2], B1[2][2];
    const char* cA = (const char*)g.A + (size_t)(cur.pn / g.gdiv) * g.a_gstride + (size_t)cur.pm * tstep; const char* cB = (const char*)g.Bt + (size_t)cur.pn * tstep;
    S.a_ready(cur);
    if constexpr (SP2) {
        PG8_STAGE(PG8_SB(0, 0), cB, voffB); PG8_STAGE(PG8_SB(0, 1), cB + hstep, voffB); PG8_STAGE(PG8_SA(0, 0), cA, voffA); PG8_STAGE(PG8_SA(0, 1), cA + hstep, voffA);
        if (wr == 1) PG8_BAR;
        PG8_WAIT_V(2); PG8_BAR;
        PG8_STAGE(PG8_SB(1, 0), cB + kstep, voffB); PG8_STAGE(PG8_SA(1, 0), cA + kstep, voffA); PG8_STAGE(PG8_SB(1, 1), cB + hstep + kstep, voffB);
        PG8_WAIT_V(6); PG8_BAR;
    } else {
        PG8_STAGE(PG8_SB(0, 0), cB, voffB); PG8_STAGE(PG8_SA(0, 0), cA, voffA); PG8_STAGE(PG8_SB(0, 1), cB + hstep, voffB); PG8_STAGE(PG8_SA(0, 1), cA + hstep, voffA);
        if (wr == 1) PG8_BAR;
        PG8_WAIT_V(4); PG8_BAR;
        PG8_STAGE(PG8_SB(1, 0), cB + kstep, voffB); PG8_STAGE(PG8_SA(1, 0), cA + kstep, voffA); PG8_STAGE(PG8_SB(1, 1), cB + hstep + kstep, voffB);
        PG8_WAIT_V(6); PG8_BAR;
    }
    for (;;) {
        const bool has_next = S.next(ui + 1, nxt);
        const char* nA = has_next ? (const char*)g.A + (size_t)(nxt.pn / g.gdiv) * g.a_gstride + (size_t)nxt.pm * tstep : cA; const char* nB = has_next ? (const char*)g.Bt + (size_t)nxt.pn * tstep : cB;
        for (int t = 0; t < nt; t += 2) {
            const bool last = (t == nt - 2);
            const char* a1 = cA + (size_t)(t + 1) * kstep;
            const char* a2 = last ? nA : cA + (size_t)(t + 2) * kstep; const char* b2 = last ? nB : cB + (size_t)(t + 2) * kstep;
            const char* a3 = a2 + kstep; const char* b3 = b2 + kstep;
            if (last && has_next) S.a_ready(nxt);
            if constexpr (SP2) {
            PG8_LDB(B0, 0, 0); PG8_LDB(B1, 0, 1); PG8_SCHED; PG8_LDA(At, 0, 0); PG8_STAGE(PG8_SA(1, 1), a1 + hstep, voffA);
            PG8_WAIT_V(8); PG8_WAIT_L(0); PG8_BAR; PG8_MMA(0, 0, At, B0); PG8_MMA(0, 1, At, B1); PG8_BAR; PG8_SCHED;
            PG8_LDA(At, 0, 1); PG8_STAGE(PG8_SB(0, 0), b2, voffB); PG8_STAGE(PG8_SB(0, 1), b2 + hstep, voffB); PG8_STAGE(PG8_SA(0, 0), a2, voffA);
            PG8_WAIT_V(8); PG8_WAIT_L(0); PG8_BAR; PG8_MMA(1, 0, At, B0); PG8_MMA(1, 1, At, B1); PG8_BAR; PG8_SCHED;
            PG8_LDB(B0, 1, 0); PG8_LDB(B1, 1, 1); PG8_SCHED; PG8_LDA(At, 1, 0); PG8_STAGE(PG8_SA(0, 1), a2 + hstep, voffA);
            PG8_WAIT_V(8); PG8_WAIT_L(0); PG8_BAR; PG8_MMA(0, 0, At, B0); PG8_MMA(0, 1, At, B1); PG8_BAR; PG8_SCHED;
            PG8_LDA(At, 1, 1); PG8_STAGE(PG8_SB(1, 0), b3, voffB); PG8_STAGE(PG8_SB(1, 1), b3 + hstep, voffB); PG8_STAGE(PG8_SA(1, 0), a3, voffA);
            PG8_WAIT_V(8); PG8_WAIT_L(0); PG8_BAR; PG8_MMA(1, 0, At, B0); PG8_MMA(1, 1, At, B1); PG8_BAR; PG8_SCHED;
            } else {
            PG8_LDB(B0, 0, 0); PG8_SCHED; PG8_LDA(At, 0, 0); PG8_STAGE(PG8_SA(1, 1), a1 + hstep, voffA);
            PG8_WAIT_L(8); PG8_BAR; PG8_WAIT_L(0); PG8_MMA(0, 0, At, B0); PG8_BAR; PG8_SCHED;
            PG8_LDB(B1, 0, 1); PG8_STAGE(PG8_SB(0, 0), b2, voffB);
            PG8_BAR; PG8_WAIT_L(0); PG8_MMA(0, 1, At, B1); PG8_BAR;
            PG8_LDA(At, 0, 1); PG8_STAGE(PG8_SA(0, 0), a2, voffA);
            PG8_BAR; PG8_WAIT_L(0); PG8_MMA(1, 0, At, B0); PG8_BAR; PG8_SCHED;
            PG8_STAGE(PG8_SB(0, 1), b2 + hstep, voffB);
            PG8_WAIT_V(6); PG8_BAR; PG8_MMA(1, 1, At, B1); PG8_BAR;
            PG8_LDB(B0, 1, 0); PG8_SCHED; PG8_LDA(At, 1, 0); PG8_STAGE(PG8_SA(0, 1), a2 + hstep, voffA);
            PG8_WAIT_L(8); PG8_BAR; PG8_WAIT_L(0); PG8_MMA(0, 0, At, B0); PG8_BAR; PG8_SCHED;
            PG8_LDB(B1, 1, 1); PG8_STAGE(PG8_SB(1, 0), b3, voffB);
            PG8_BAR; PG8_WAIT_L(0); PG8_MMA(0, 1, At, B1); PG8_BAR;
            PG8_LDA(At, 1, 1); PG8_STAGE(PG8_SA(1, 0), a3, voffA);
            PG8_BAR; PG8_WAIT_L(0); PG8_MMA(1, 0, At, B0); PG8_BAR; PG8_SCHED;
            PG8_STAGE(PG8_SB(1, 1), b3 + hstep, voffB);
            PG8_WAIT_V(6); PG8_BAR; PG8_MMA(1, 1, At, B1); PG8_BAR;
            }
        }
        if constexpr (ALIGN_EPI) { if (wr == 0) PG8_BAR; }
        if constexpr (!Epi::AFTER_DRAIN) { E(acc, cur, wr, wc, fr, fq); S.done(cur); }
        if (!has_next) break;
#pragma unroll
        for (int a = 0; a < 2; ++a)
#pragma unroll
            for (int b = 0; b < 2; ++b)
#pragma unroll
                for (int m = 0; m < 4; ++m)
#pragma unroll
                    for (int n = 0; n < 2; ++n) acc[a][b][m][n] = (f32x4){0.f, 0.f, 0.f, 0.f};
        cur = nxt; cA = nA; cB = nB; ++ui;
        if constexpr (ALIGN_EPI) { if (wr == 1) PG8_BAR; }
    }
    PG8_WAIT_V(0);
    if constexpr (!ALIGN_EPI) { if (wr == 0) PG8_BAR; }
    PG8_BAR;
    if constexpr (Epi::AFTER_DRAIN) { E.fused(acc, cur, wr, wc, fr, fq, lds, wid, lane); S.done(cur); }
#undef PG8_SA
#undef PG8_SB
#undef PG8_STAGE
#undef PG8_LDA
#undef PG8_LDB
#undef PG8_MMA
#undef PG8_WAIT_V
#undef PG8_WAIT_L
#undef PG8_BAR
#undef PG8_SCHED
}
}
#define GAS __attribute__((address_space(1)))
#define LAS __attribute__((address_space(3)))
typedef unsigned short bf16;
typedef unsigned v4u __attribute__((ext_vector_type(4)));
typedef float f32x4 __attribute__((ext_vector_type(4)));
typedef short bf16x8 __attribute__((ext_vector_type(8)));
typedef GAS unsigned gu32;
typedef GAS unsigned long long gu64;
#define RLX_AGENT __ATOMIC_RELAXED, __HIP_MEMORY_SCOPE_AGENT
#define LDS_WAIT() asm volatile("s_waitcnt lgkmcnt(0)" ::: "memory")
#define VM_WAIT() asm volatile("s_waitcnt vmcnt(0)" ::: "memory")
__device__ __forceinline__ unsigned long long rt() { return __builtin_amdgcn_s_memrealtime(); }
__device__ __forceinline__ unsigned f2bf(float f) { unsigned u = __builtin_bit_cast(unsigned, f); return (u + 0x7fffu + ((u >> 16) & 1u)) >> 16; }
typedef __bf16 pk_bf2_t __attribute__((ext_vector_type(2))); typedef float pk_f2_t __attribute__((ext_vector_type(2)));
__device__ __forceinline__ unsigned pk2(float lo, float hi) { const pk_f2_t v = {lo, hi}; return __builtin_bit_cast(unsigned, __builtin_convertvector(v, pk_bf2_t)); }

#define XB_TMO      128
#define XB_XCNT(j)  (256  + 64 * (j))
#define XB_XSUB(j)  (1280 + 64 * (j))
#define XB_XGEN(j)  (2304 + 64 * (j))
#define XB_TOP      3328
#define XB_TOPGEN   3392
#define XCD_BAR_WORDS 3456
#define XB_SPIN_CAP (1u << 18)

__device__ __forceinline__ unsigned xb_ld(unsigned* p)              { return __hip_atomic_load(p, __ATOMIC_RELAXED, __HIP_MEMORY_SCOPE_AGENT); }
__device__ __forceinline__ unsigned xb_add(unsigned* p, unsigned v) { return __hip_atomic_fetch_add(p, v, __ATOMIC_RELAXED, __HIP_MEMORY_SCOPE_AGENT); }
__device__ __forceinline__ unsigned xb_xcc_id() { return (unsigned)__builtin_amdgcn_s_getreg((3 << 11) | 20) & 0xFu; }
#define XB_SPIN(cond, bar) do { unsigned _sp = 0; while (cond) { __builtin_amdgcn_s_sleep(1); \
    if ((++_sp & 255u) == 0u) { if (xb_ld(&(bar)[XB_TMO])) break; if (_sp > XB_SPIN_CAP) { atomicAdd(&(bar)[XB_TMO], 1u); break; } } } } while (0)

struct XcdBarrier {
    unsigned* bar; unsigned x;
    volatile LAS unsigned* st;
};

__device__ __forceinline__ XcdBarrier xcd_barrier_post(unsigned* bar, volatile LAS unsigned* st) {
    XcdBarrier b; b.bar = bar; b.x = xb_xcc_id(); b.st = st;
    if (threadIdx.x == 0) (void)xb_add(&bar[XB_XCNT(b.x)], 1u);
    return b;
}
__device__ __forceinline__ void xcd_barrier_complete(unsigned* bar, unsigned x, unsigned& nloc, unsigned& nx) {
    const unsigned G = gridDim.x * gridDim.y * gridDim.z;
    unsigned sum, cnt, mine, sp = 0u;
    for (;;) {
        sum = 0u; cnt = 0u; mine = 0u;
#pragma unroll
        for (unsigned j = 0; j < 16; ++j) { const unsigned c = xb_ld(&bar[XB_XCNT(j)]); sum += c; cnt += (c > 0u) ? 1u : 0u; mine = (j == x) ? c : mine; }
        if (sum == G) break;
        __builtin_amdgcn_s_sleep(1);
        if ((++sp & 255u) == 0u) { if (xb_ld(&bar[XB_TMO])) break; if (sp > XB_SPIN_CAP) { atomicAdd(&bar[XB_TMO], 1u); break; } }
    }
    nloc = mine > 0u ? mine : 1u; nx = cnt > 0u ? cnt : 1u;
}

__device__ __forceinline__ void xcd_barrier(const XcdBarrier& b) {
    asm volatile("s_waitcnt vmcnt(0)" ::: "memory");
    __syncthreads();
    if (threadIdx.x == 0) {
        unsigned* bar = b.bar;
        __builtin_amdgcn_s_waitcnt(0);
        unsigned nloc = b.st[0], nx = b.st[1];
        if (nloc == 0u) { xcd_barrier_complete(bar, b.x, nloc, nx); b.st[0] = nloc; b.st[1] = nx; }
        const unsigned old = xb_add(&bar[XB_XSUB(b.x)], 1u);
        const unsigned gen = old / nloc;
        if (old + 1u == (gen + 1u) * nloc) {
            __builtin_amdgcn_fence(__ATOMIC_RELEASE, "agent");
            asm volatile("s_waitcnt vmcnt(0)" ::: "memory");
            const unsigned og = xb_add(&bar[XB_TOP], 1u);
            const unsigned tg = og / nx;
            if (og + 1u == (tg + 1u) * nx) xb_add(&bar[XB_TOPGEN], 1u);
            else XB_SPIN(xb_ld(&bar[XB_TOPGEN]) == tg, bar);
            __builtin_amdgcn_fence(__ATOMIC_ACQUIRE, "agent");
            xb_add(&bar[XB_XGEN(b.x)], 1u);
            asm volatile("s_waitcnt vmcnt(0)" ::: "memory");
        } else {
            XB_SPIN(xb_ld(&bar[XB_XGEN(b.x)]) == gen, bar);
            __builtin_amdgcn_fence(__ATOMIC_ACQUIRE, "agent");
            asm volatile("s_waitcnt vmcnt(0)" ::: "memory");
        }
    }
    __syncthreads();
}
constexpr int NWAVES = 8;
constexpr int DM = 1024, NB = 4, SEQ = 4096, NMETA = 16, LP = 4112, MPR = 16448, DBATCH = 128, DSEQ = 4, MSAMP = 512, MTOK = 16960, MPAD = 17152;
constexpr int NH = 16, HD = 64, NKV = 4, LDQ = 2560, WIN = 128;
constexpr float RMS_EPS = 1e-6f, GN_EPS = 64e-5f, LOG2E = 1.4426950408889634f, QSCALE = 0.125f * 1.4426950408889634f;
constexpr size_t O_YP = 0, O_YS = 16777216, O_WKP = 17301504, O_WVP = 17432576, O_WKVP = 17563648, O_SHP = 17825792, O_WKS = 17829888, O_WVS = 22024192, O_WKVS = 26218496, O_SHS = 34607104, O_END = 34738176;
constexpr size_t MiB = 1u << 20;
constexpr size_t WS_CTL = 0, CTL_ZERO_BYTES = 1 * MiB;
constexpr size_t WS_T12B = 1 * MiB;
constexpr size_t WS_WAIN = 1 * MiB, WS_WAOUT = 6 * MiB, WS_WRIN = 8 * MiB, WS_WROUT = 16 * MiB, WS_W1A1 = 185 * MiB;
constexpr size_t WS_XN1S = 186 * MiB, WS_U = 164 * MiB;
constexpr int U_SROW = 16640;
constexpr size_t WS_KVP = 18 * MiB + 512 * 1024, WS_KVS = 19 * MiB, WS_SHP = 19 * MiB + 512 * 1024, WS_WKVP = 20 * MiB, WS_T12 = 21 * MiB;
constexpr size_t WS_XA = 30 * MiB, WS_QKVG = 64 * MiB, WS_H1 = 189 * MiB, WS_MIX = 30 * MiB, MIX_STRIDE = (size_t)MPAD * DM * 2, WS_G = 222 * MiB + 512 * 1024, WS_OG2 = 64 * MiB, WS_END = 256 * MiB;
constexpr size_t RKV_STRIDE = (size_t)MTOK * DM * 2, DO_XN1 = 3 * RKV_STRIDE,
     DO_OG2 = 2 * RKV_STRIDE;
static_assert(WS_T12 + (size_t)MTOK * 128 * 4 <= WS_XA && WS_XA + MIX_STRIDE <= WS_QKVG && WS_QKVG + (size_t)MPAD * LDQ * 2 <= WS_H1 && WS_MIX + 4 * MIX_STRIDE <= WS_H1 && WS_H1 + (size_t)MPAD * DM * 4 <= WS_END, "ws map");
static_assert(3 * RKV_STRIDE <= O_WKVS * 4 && 2 * MIX_STRIDE <= O_END * 4, "d_out scratch map");
constexpr int CW_TMO = 0, CW_CODE = 1, CW_BAR = 4096, CW_TFLAG = 65536, CW_RC2 = 70000, CW_RC4 = 70128;
constexpr int RING_OFF = 0, RING_BYTES = 131072, LDSCTL_OFF = RING_BYTES, MISC_OFF = LDSCTL_OFF + 320, LDS_BYTES = 147456;

typedef short s16x4 __attribute__((ext_vector_type(4)));
typedef float f32x16 __attribute__((ext_vector_type(16)));
struct Frame {
    LAS unsigned char* lds;
    volatile LAS unsigned* MISC;
    gu32* ctl;
    int tid, lane, wave, vcu, G, skip;
    const float *xp, *xs, *cache_k, *cache_v, *state_wkv, *state_shift, *meta, *table, *norm_gain, *final_gain, *a_w_in, *sinks, *a_w_out;
    const float *mu, *r_w_in, *w0, *w1, *w2, *a0, *a1, *a2, *k_k, *k_a, *r_k, *ln_g, *ln_b, *r_w_out;
    float* out; unsigned char* ws; unsigned char* dob;
};
template <int CTRL> __device__ __forceinline__ float dpp_mov(float v) { return __builtin_bit_cast(float, __builtin_amdgcn_update_dpp(0, __builtin_bit_cast(int, v), CTRL, 0xF, 0xF, true)); }
__device__ __forceinline__ float wave_sum(float v) {
    v += dpp_mov<0xB1>(v);
    v += dpp_mov<0x4E>(v);
    v += dpp_mov<0x141>(v);
    v += dpp_mov<0x140>(v);
    v += __shfl_xor(v, 16);
    { const unsigned u = __builtin_bit_cast(unsigned, v); auto r = __builtin_amdgcn_permlane32_swap(u, u, false, false); v = __builtin_bit_cast(float, (unsigned)r[0]) + __builtin_bit_cast(float, (unsigned)r[1]); }
    return v;
}
__device__ __forceinline__ float bf2f(bf16 b) { return __builtin_bit_cast(float, (unsigned)b << 16); }
__device__ __forceinline__ const float* h0_row(const Frame& F, int m) {
    if (m < MPR) { const int b = m / LP, t = m - b * LP; return t < NMETA ? F.meta + t * DM : F.xp + ((size_t)b * SEQ + (t - NMETA)) * DM; }
    return F.xs + (size_t)(m - MPR) * DM;
}
__device__ __forceinline__ void p0_transpose_item(const float* W, int K, int N, bf16* WT, int row_off, LAS float* scr, int item, int lane, const float* sc = nullptr, bool one_minus = false) {
    const int nblk = N / 32, kb = item / nblk, nb = item % nblk, k0 = 64 * kb, n0 = 32 * nb;
#pragma unroll 8
    for (int i = 0; i < 32; ++i) { const int kk = 2 * i + (lane >> 5); float w = W[(size_t)(k0 + kk) * N + n0 + (lane & 31)]; if (sc) { const float s_ = sc[k0 + kk]; w *= one_minus ? 1.0f - s_ : s_; } scr[kk * 33 + (lane & 31)] = w; }
    LDS_WAIT(); asm volatile("" ::: "memory");
    const int c = lane & 7;
#pragma unroll
    for (int j = 0; j < 4; ++j) { const int n = (lane >> 3) + 8 * j; const LAS float* s = scr + (8 * c) * 33 + n;
        v4u o; o.x = pk2(s[0 * 33], s[1 * 33]); o.y = pk2(s[2 * 33], s[3 * 33]); o.z = pk2(s[4 * 33], s[5 * 33]); o.w = pk2(s[6 * 33], s[7 * 33]);
        *(GAS v4u*)(WT + (size_t)(row_off + n0 + n) * K + k0 + 8 * c) = o; }
    LDS_WAIT(); asm volatile("" ::: "memory");
}
__device__ __forceinline__ void rms_row(const float* xrow, const float* gain, int lane, f32x4 (&v)[4]) {
    const GAS f32x4* xr = (const GAS f32x4*)xrow + lane; float s = 0.f;
#pragma unroll
    for (int j = 0; j < 4; ++j) { v[j] = xr[64 * j]; s += (v[j].x * v[j].x + v[j].y * v[j].y) + (v[j].z * v[j].z + v[j].w * v[j].w); }
    const float rstd = 1.0f / sqrtf(wave_sum(s) * (1.f / DM) + RMS_EPS);
    const GAS f32x4* gr = (const GAS f32x4*)gain + lane;
#pragma unroll
    for (int j = 0; j < 4; ++j) v[j] = v[j] * rstd * gr[64 * j];
}
__device__ __forceinline__ void rms_row_b(const bf16* xrow, const float* gain, int lane, f32x4 (&v)[4]) {
    const GAS unsigned long long* xr = (const GAS unsigned long long*)xrow + lane; float s = 0.f;
#pragma unroll
    for (int j = 0; j < 4; ++j) { const unsigned long long w = xr[64 * j];
        v[j].x = __builtin_bit_cast(float, (unsigned)w << 16); v[j].y = __builtin_bit_cast(float, (unsigned)w & 0xffff0000u); v[j].z = __builtin_bit_cast(float, (unsigned)(w >> 32) << 16); v[j].w = __builtin_bit_cast(float, (unsigned)(w >> 32) & 0xffff0000u);
        s += (v[j].x * v[j].x + v[j].y * v[j].y) + (v[j].z * v[j].z + v[j].w * v[j].w); }
    const float rstd = 1.0f / sqrtf(wave_sum(s) * (1.f / DM) + RMS_EPS);
    const GAS f32x4* gr = (const GAS f32x4*)gain + lane;
#pragma unroll
    for (int j = 0; j < 4; ++j) v[j] = v[j] * rstd * gr[64 * j];
}
__device__ __forceinline__ void store_bf16_row(bf16* orow, int lane, const f32x4 (&v)[4]) {
    GAS unsigned long long* o8 = (GAS unsigned long long*)orow + lane;
#pragma unroll
    for (int j = 0; j < 4; ++j) o8[64 * j] = (unsigned long long)pk2(v[j].x, v[j].y) | ((unsigned long long)pk2(v[j].z, v[j].w) << 32);
}
__device__ __forceinline__ void p0_prologue(Frame& F, int part, int gw, int NGW) {
    LAS float* scr = (LAS float*)(F.lds + RING_OFF + F.wave * 16384);
    bf16* wain = (bf16*)(F.ws + WS_WAIN); bf16* waout = (bf16*)(F.ws + WS_WAOUT); bf16* wrin = (bf16*)(F.ws + WS_WRIN); bf16* wrout = (bf16*)(F.ws + WS_WROUT); bf16* w1a1 = (bf16*)(F.ws + WS_W1A1);
    constexpr int I_AIN = 16 * 80, I_SQ = 16 * 32, I_L1 = 16 * 2;
    constexpr int I_L2 = 32;
    constexpr int NITEMS = I_AIN + 6 * I_SQ + 4 * I_L1 + 2 * I_L2;
    for (int it = (part == 1 ? I_AIN : 0) + gw; it < (part == 0 ? I_AIN : NITEMS); it += NGW) {
        int r = it;
        if (r < I_AIN) { p0_transpose_item(F.a_w_in, DM, LDQ, wain, 0, scr, r, F.lane); continue; } r -= I_AIN;
        if (r < I_SQ) { p0_transpose_item(F.a_w_out, DM, DM, waout, 0, scr, r, F.lane); continue; } r -= I_SQ;
        if (r < 4 * I_SQ) { const int c = r / I_SQ; p0_transpose_item(F.r_w_in + (size_t)c * DM * DM, DM, DM, wrin, c * DM, scr, r - c * I_SQ, F.lane); continue; } r -= 4 * I_SQ;
        if (r < I_SQ) { p0_transpose_item(F.r_w_out, DM, DM, wrout, 0, scr, r, F.lane); continue; } r -= I_SQ;
        if (r < 4 * I_L1) { const int q = r / I_L1; p0_transpose_item(q < 2 ? F.w1 : F.a1, DM, 64, w1a1, 64 * q, scr, r - q * I_L1, F.lane, F.mu + (q < 2 ? 4 : 5) * DM, (q & 1) == 0); continue; } r -= 4 * I_L1;
        if (r < I_L2) { p0_transpose_item(F.w2, 64, DM, (bf16*)(F.ws + 18 * MiB + 256 * 1024), 0, scr, r, F.lane); continue; } r -= I_L2;
        p0_transpose_item(F.a2, 64, DM, (bf16*)(F.ws + 18 * MiB + 384 * 1024), 0, scr, r, F.lane);
    }
    if (part == 1) return;
    bf16* xa = (bf16*)(F.ws + WS_XA);
    for (int m = gw; m < MPAD; m += NGW) {
        f32x4 v[4];
        if (m < MTOK) rms_row(h0_row(F, m), F.norm_gain, F.lane, v);
        else { for (int j = 0; j < 4; ++j) v[j] = (f32x4){0.f, 0.f, 0.f, 0.f}; }
        store_bf16_row(xa + (size_t)m * DM, F.lane, v);
    }
}

namespace att {
constexpr int KSTR = 72, VSTR = 260;
constexpr int BEXT = 192;
constexpr int K_OFF = 0, V_OFF = 256 * KSTR * 2, B_OFF = V_OFF + 64 * VSTR * 2, ST_OFF = B_OFF + NH * BEXT * 4, END_OFF = ST_OFF + NWAVES * 4096;
static_assert(END_OFF <= RING_BYTES && (B_OFF % 16) == 0 && (ST_OFF % 16) == 0, "attention LDS");
__device__ __forceinline__ int crow(int r, int hi) { return (r & 3) + 8 * (r >> 2) + 4 * hi; }
__device__ __forceinline__ int t5_bucket(int rel) {
    if (rel < 16) return rel;
    int b = 16;
    b += rel >= 19; b += rel >= 21; b += rel >= 24; b += rel >= 27; b += rel >= 31; b += rel >= 35; b += rel >= 40; b += rel >= 46;
    b += rel >= 52; b += rel >= 59; b += rel >= 67; b += rel >= 77; b += rel >= 87; b += rel >= 99; b += rel >= 113;
    return b;
}
__device__ __forceinline__ void attn_wave(LAS unsigned char* lds, const bf16* qkvg, bf16* og, int qrow0, int nq, int jt, int kt_lo, int h, float sink2, int lane, int wave) {
    const int c = lane & 31, hh = lane >> 5;
    const LAS float* bp = (const LAS float*)(lds + B_OFF) + h * BEXT + 5 + c - 4 * hh;
    const int qrow = qrow0 + (c < nq ? c : nq - 1);
    bf16x8 qf[4];
#pragma unroll
    for (int s = 0; s < 4; ++s) qf[s] = *(const GAS bf16x8*)(qkvg + (size_t)qrow * LDQ + h * HD + 16 * s + 8 * hh);
    const LAS unsigned char* kbase = lds + K_OFF + ((32 * jt + c) * KSTR + 8 * hh) * 2;
    const LAS unsigned char* vbase = lds + V_OFF + (c * VSTR + 32 * jt + 4 * hh) * 2;
    f32x16 sc[5];
#pragma unroll
    for (int kt = 0; kt < 5; ++kt) {
        f32x16 a;
#pragma unroll
        for (int r = 0; r < 16; ++r) a[r] = bp[155 - (32 * kt + (r & 3) + 8 * (r >> 2))];
#pragma unroll
        for (int s = 0; s < 4; ++s) { const bf16x8 kf = *(const LAS bf16x8*)(kbase + kt * (32 * KSTR * 2) + 32 * s); a = __builtin_amdgcn_mfma_f32_32x32x16_bf16(kf, qf[s], a, 0, 0, 0); }
        if (kt < kt_lo) {
#pragma unroll
            for (int r = 0; r < 16; ++r) a[r] = -1e30f;
        }
        sc[kt] = a;
    }
    float mx = -1e30f;
#pragma unroll
    for (int kt = 0; kt < 5; ++kt)
#pragma unroll
        for (int r = 0; r < 16; ++r) mx = fmaxf(mx, sc[kt][r]);
    mx = fmaxf(mx, __shfl_xor(mx, 32)); mx = fmaxf(mx, sink2);
    float l = 0.f;
#pragma unroll
    for (int kt = 0; kt < 5; ++kt)
#pragma unroll
        for (int r = 0; r < 16; ++r) { const float p = __builtin_amdgcn_exp2f(sc[kt][r] - mx); sc[kt][r] = p; l += p; }
    l += __shfl_xor(l, 32); l += __builtin_amdgcn_exp2f(sink2 - mx);
    const float linv = __builtin_amdgcn_rcpf(l);
    f32x16 o[2]; o[0] = f32x16{}; o[1] = f32x16{};
#pragma unroll
    for (int kt = 0; kt < 5; ++kt) {
#pragma unroll
        for (int s2 = 0; s2 < 2; ++s2) {
            v4u pw; pw.x = pk2(sc[kt][8 * s2 + 0] * linv, sc[kt][8 * s2 + 1] * linv); pw.y = pk2(sc[kt][8 * s2 + 2] * linv, sc[kt][8 * s2 + 3] * linv);
            pw.z = pk2(sc[kt][8 * s2 + 4] * linv, sc[kt][8 * s2 + 5] * linv); pw.w = pk2(sc[kt][8 * s2 + 6] * linv, sc[kt][8 * s2 + 7] * linv);
            const bf16x8 pf = __builtin_bit_cast(bf16x8, pw);
#pragma unroll
            for (int dh = 0; dh < 2; ++dh) {
                const LAS unsigned char* vp = vbase + (32 * dh * VSTR + 32 * kt + 16 * s2) * 2;
                const s16x4 lo = *(const LAS s16x4*)vp, hi = *(const LAS s16x4*)(vp + 16);
                const bf16x8 vf = (bf16x8){lo[0], lo[1], lo[2], lo[3], hi[0], hi[1], hi[2], hi[3]};
                o[dh] = __builtin_amdgcn_mfma_f32_32x32x16_bf16(pf, vf, o[dh], 0, 0, 0);
            }
        }
    }
    LAS float* stg = (LAS float*)(lds + ST_OFF + wave * 4096);
    const int srow = lane >> 1, sc0 = (lane & 1) * 16;
    const size_t grow = (size_t)(qrow0 + srow);
#pragma unroll
    for (int dh = 0; dh < 2; ++dh) {
#pragma unroll
        for (int r = 0; r < 16; ++r) stg[((r & 3) + 8 * (r >> 2) + 4 * hh) * 32 + c] = o[dh][r];
        asm volatile("s_waitcnt lgkmcnt(0)" ::: "memory");
        f32x4 x[4];
#pragma unroll
        for (int i = 0; i < 4; ++i) x[i] = *(const LAS f32x4*)(stg + srow * 32 + sc0 + 4 * i);
        asm volatile("s_waitcnt lgkmcnt(0)" ::: "memory");
        if (srow < nq) {
            const int col = h * HD + 32 * dh + sc0;
            const v4u g0 = *(const GAS v4u*)(qkvg + grow * LDQ + 1536 + col), g1 = *(const GAS v4u*)(qkvg + grow * LDQ + 1536 + col + 8);
            const unsigned gw[8] = {g0.x, g0.y, g0.z, g0.w, g1.x, g1.y, g1.z, g1.w};
            unsigned ow[8];
#pragma unroll
            for (int e = 0; e < 8; ++e) { const float ga = __builtin_bit_cast(float, gw[e] << 16), gb = __builtin_bit_cast(float, gw[e] & 0xffff0000u);
                const float ya = x[e >> 1][(e & 1) * 2] * ga * __builtin_amdgcn_rcpf(1.0f + __builtin_amdgcn_exp2f(-1.4426950408889634f * ga)), yb = x[e >> 1][(e & 1) * 2 + 1] * gb * __builtin_amdgcn_rcpf(1.0f + __builtin_amdgcn_exp2f(-1.4426950408889634f * gb)); ow[e] = pk2(ya, yb); }
            *(GAS v4u*)(og + grow * DM + col) = (v4u){ow[0], ow[1], ow[2], ow[3]}; *(GAS v4u*)(og + grow * DM + col + 8) = (v4u){ow[4], ow[5], ow[6], ow[7]};
        }
    }
}
constexpr int N_PROMPT_UNITS = NB * NKV * 33, N_SAMPLE_UNITS = DBATCH * NKV, N_COPY_UNITS = 8, N_UNITS = N_PROMPT_UNITS + N_SAMPLE_UNITS + N_COPY_UNITS;
}
__device__ __forceinline__ void p2_attention(Frame& F) {
    using namespace att;
    const bf16* qkvg = (const bf16*)(F.ws + WS_QKVG); bf16* og = (bf16*)(F.ws + WS_XA);
    LAS unsigned char* lds = F.lds + RING_OFF;
    for (int i = F.tid; i < NH * BEXT; i += NWAVES * 64) { const int h = i / BEXT, rel = i % BEXT - 32;
        ((LAS float*)(lds + B_OFF))[i] = (rel >= 0 && rel < 128) ? F.table[t5_bucket(rel) * NH + h] * LOG2E : -1e30f; }
    __syncthreads();
#pragma unroll 1
    for (int ui = F.vcu; ui < N_UNITS; ui += F.G) {
        int u;
        if (ui < 512) u = (ui >> 5) * 33 + (ui & 31);
        else if (ui < 528) u = (ui - 512) * 33 + 32;
        else u = ui;
        if (u >= N_PROMPT_UNITS + N_SAMPLE_UNITS) {
            const int cu = u - (N_PROMPT_UNITS + N_SAMPLE_UNITS);
            bf16* kvp = (bf16*)(F.ws + WS_KVP); bf16* kvs = (bf16*)(F.ws + WS_KVS);
            for (int i = cu * 512 + F.tid; i < 1024 * 64; i += N_COPY_UNITS * 512) {
                const int rr = i >> 6, ch = i & 63;
                const int srow = rr < 512 ? (rr >> 7) * LP + (LP - WIN) + (rr & 127) : MPR + (rr - 512);
                const v4u x = *(const GAS v4u*)(qkvg + (size_t)srow * LDQ + 1024 + 8 * ch);
                bf16* dst = rr < 512 ? kvp + (size_t)rr * 512 + 8 * ch : kvs + (size_t)(rr - 512) * 512 + 8 * ch;
                *(GAS v4u*)dst = x;
            }
            continue;
        }
        int kvh, nwu, qbase, q0, kt0;
        const bool is_prompt = u < N_PROMPT_UNITS;
        const int row = F.tid >> 1, half = F.tid & 1;
        if (is_prompt) {
            const int qblk = u % 33, b = u / (33 * NKV); kvh = (u / 33) % NKV;
            q0 = 128 * qblk; nwu = 16; qbase = b * LP + q0; kt0 = qblk == 0 ? 4 : 0;
            int pos = q0 - 128 + row; pos = pos < 0 ? 0 : (pos > LP - 1 ? LP - 1 : pos);
            const bf16* src = qkvg + (size_t)(b * LP + pos) * LDQ + 1024 + kvh * HD + half * 32;
#pragma unroll
            for (int i = 0; i < 4; ++i) { const v4u kv = *(const GAS v4u*)(src + 8 * i); *(LAS v4u*)(lds + K_OFF + (row * KSTR + half * 32 + 8 * i) * 2) = kv; }
#pragma unroll
            for (int i = 0; i < 4; ++i) { const v4u vv = *(const GAS v4u*)(src + 256 + 8 * i); const unsigned w[4] = {vv.x, vv.y, vv.z, vv.w};
#pragma unroll
                for (int e = 0; e < 8; ++e) { const bf16 x = (bf16)((w[e >> 1] >> ((e & 1) * 16)) & 0xffffu); *(LAS bf16*)(lds + V_OFF + ((half * 32 + 8 * i + e) * VSTR + row) * 2) = x; } }
        } else {
            const int su = u - N_PROMPT_UNITS, sb = su / NKV; kvh = su % NKV;
            q0 = LP; nwu = 4; qbase = MPR + sb * DSEQ; kt0 = 0;
            if (row < 160) {
#pragma unroll
                for (int i = 0; i < 4; ++i) {
                    v4u kq = (v4u){0u, 0u, 0u, 0u}, vq = (v4u){0u, 0u, 0u, 0u};
                    if (row < 128) {
                        const float* ck = F.cache_k + (((size_t)sb * WIN + row) * NKV + kvh) * HD + half * 32 + 8 * i; const float* cv = F.cache_v + (((size_t)sb * WIN + row) * NKV + kvh) * HD + half * 32 + 8 * i;
                        const f32x4 a0 = *(const GAS f32x4*)ck, a1 = *(const GAS f32x4*)(ck + 4), b0 = *(const GAS f32x4*)cv, b1 = *(const GAS f32x4*)(cv + 4);
                        kq = (v4u){pk2(a0.x, a0.y), pk2(a0.z, a0.w), pk2(a1.x, a1.y), pk2(a1.z, a1.w)}; vq = (v4u){pk2(b0.x, b0.y), pk2(b0.z, b0.w), pk2(b1.x, b1.y), pk2(b1.z, b1.w)};
                    } else if (row < 132) {
                        const bf16* src = qkvg + (size_t)(MPR + sb * DSEQ + (row - 128)) * LDQ + 1024 + kvh * HD + half * 32 + 8 * i;
                        kq = *(const GAS v4u*)src; vq = *(const GAS v4u*)(src + 256);
                    }
                    *(LAS v4u*)(lds + K_OFF + (row * KSTR + half * 32 + 8 * i) * 2) = kq;
                    const unsigned w[4] = {vq.x, vq.y, vq.z, vq.w};
#pragma unroll
                    for (int e = 0; e < 8; ++e) { const bf16 x = (bf16)((w[e >> 1] >> ((e & 1) * 16)) & 0xffffu); *(LAS bf16*)(lds + V_OFF + ((half * 32 + 8 * i + e) * VSTR + row) * 2) = x; }
                }
            }
        }
        __syncthreads();
#pragma unroll 1
        for (int wu = F.wave; wu < nwu; wu += NWAVES) {
            const int hg = wu & 3, j = wu >> 2, h = kvh * 4 + hg;
            int nq = is_prompt ? LP - (q0 + 32 * j) : DSEQ; nq = nq < 32 ? nq : 32;
            if (nq > 0) attn_wave(lds, qkvg, og, qbase + 32 * j, nq, j, kt0 - j, h, F.sinks[h] * LOG2E, F.lane, F.wave);
        }
        __syncthreads();
    }
}

__device__ __forceinline__ void rms_row8(const bf16* xrow, const float (&g8)[2][8], int lane, float (&x)[2][8]) {
    float s = 0.f;
#pragma unroll
    for (int j = 0; j < 2; ++j) { const v4u w = *(const GAS v4u*)(xrow + 8 * lane + 512 * j); const unsigned ww[4] = {w.x, w.y, w.z, w.w};
#pragma unroll
        for (int i = 0; i < 4; ++i) { x[j][2 * i] = __builtin_bit_cast(float, ww[i] << 16); x[j][2 * i + 1] = __builtin_bit_cast(float, ww[i] & 0xffff0000u); s += x[j][2 * i] * x[j][2 * i] + x[j][2 * i + 1] * x[j][2 * i + 1]; } }
    const float rstd = 1.0f / sqrtf(wave_sum(s) * (1.f / DM) + RMS_EPS);
#pragma unroll
    for (int j = 0; j < 2; ++j)
#pragma unroll
        for (int i = 0; i < 8; ++i) x[j][i] = x[j][i] * rstd * g8[j][i];
}
__device__ __forceinline__ void wait_row_tiles(const unsigned* cnt, int ra, int rb, unsigned full) {
    if (threadIdx.x < 64) {
        for (int pm = (ra < 0 ? 0 : ra) >> 8; pm <= (rb >> 8); ++pm)
            while (__hip_atomic_load(cnt + pm, __ATOMIC_RELAXED, __HIP_MEMORY_SCOPE_AGENT) < full) __builtin_amdgcn_s_sleep(8);
        __builtin_amdgcn_fence(__ATOMIC_ACQUIRE, "agent");
    }
    __syncthreads();
}
__device__ __forceinline__ void flow_range(const Frame& F, int seg, int nlate_wg, int rows_early, int& r0, int& r1, int& g0, int& g1) {
    const int bx = (int)blockIdx.x;
    if (seg == 0) { if (bx < nlate_wg) { r0 = r1 = g0 = g1 = 0; return; } const long wb = (long)(bx - nlate_wg) * NWAVES, w = wb + F.wave, NW = (long)(F.G - nlate_wg) * NWAVES;
        r0 = (int)((w * rows_early) / NW); r1 = (int)(((w + 1) * rows_early) / NW); g0 = (int)((wb * rows_early) / NW); g1 = (int)(((wb + NWAVES) * rows_early) / NW); }
    else { const long wb = (long)bx * NWAVES, w = wb + F.wave, NW = (long)F.G * NWAVES; const int nl = MTOK - rows_early;
        r0 = rows_early + (int)((w * nl) / NW); r1 = rows_early + (int)(((w + 1) * nl) / NW); g0 = rows_early + (int)((wb * nl) / NW); g1 = rows_early + (int)(((wb + NWAVES) * nl) / NW); }
}
__device__ __forceinline__ void p4_mix(Frame& F) {
    const int gw = F.vcu * NWAVES + F.wave, NGW = F.G * NWAVES;
    const bf16* h1 = (const bf16*)(F.ws + WS_H1); const float* gain = F.norm_gain + DM;
    float g8[2][8], mu8[4][2][8];
#pragma unroll
    for (int j = 0; j < 2; ++j) { const f32x4 a = *(const GAS f32x4*)(gain + 8 * F.lane + 512 * j), b = *(const GAS f32x4*)(gain + 8 * F.lane + 512 * j + 4);
        g8[j][0] = a.x; g8[j][1] = a.y; g8[j][2] = a.z; g8[j][3] = a.w; g8[j][4] = b.x; g8[j][5] = b.y; g8[j][6] = b.z; g8[j][7] = b.w;
#pragma unroll
        for (int c = 0; c < 4; ++c) { const f32x4 a2 = *(const GAS f32x4*)(F.mu + c * DM + 8 * F.lane + 512 * j), b2 = *(const GAS f32x4*)(F.mu + c * DM + 8 * F.lane + 512 * j + 4);
            mu8[c][j][0] = a2.x; mu8[c][j][1] = a2.y; mu8[c][j][2] = a2.z; mu8[c][j][3] = a2.w; mu8[c][j][4] = b2.x; mu8[c][j][5] = b2.y; mu8[c][j][6] = b2.z; mu8[c][j][7] = b2.w; } }
    float xp[2][8];
#pragma unroll
    for (int j = 0; j < 2; ++j)
#pragma unroll
        for (int i = 0; i < 8; ++i) xp[j][i] = 0.f;
    const int r0 = (int)(((long)gw * MTOK) / NGW), r1 = (int)(((long)(gw + 1) * MTOK) / NGW);
    bool have_prev = false;
#pragma unroll 1
    for (int m = r0; m < r1; ++m) {
        float x[2][8];
        rms_row8(h1 + (size_t)m * DM, g8, F.lane, x);
        bool first; const float* sh = nullptr;
        if (m < MPR) { first = (m % LP) == 0; } else { first = ((m - MPR) & 3) == 0; sh = F.state_shift + (size_t)((m - MPR) >> 2) * DM; }
        if (first) {
#pragma unroll
            for (int j = 0; j < 2; ++j) { f32x4 a = (f32x4){0.f, 0.f, 0.f, 0.f}, b = a; if (sh) { a = *(const GAS f32x4*)(sh + 8 * F.lane + 512 * j); b = *(const GAS f32x4*)(sh + 8 * F.lane + 512 * j + 4); }
                xp[j][0] = a.x; xp[j][1] = a.y; xp[j][2] = a.z; xp[j][3] = a.w; xp[j][4] = b.x; xp[j][5] = b.y; xp[j][6] = b.z; xp[j][7] = b.w; }
        } else if (!have_prev) rms_row8(h1 + (size_t)(m - 1) * DM, g8, F.lane, xp);
        {
            bf16* xr = m < MPR ? (bf16*)(F.dob + DO_XN1) + (size_t)m * DM : (bf16*)(F.ws + WS_XN1S) + (size_t)(m - MPR) * DM;
#pragma unroll
            for (int j = 0; j < 2; ++j) { v4u o; o.x = pk2(x[j][0], x[j][1]); o.y = pk2(x[j][2], x[j][3]); o.z = pk2(x[j][4], x[j][5]); o.w = pk2(x[j][6], x[j][7]); *(GAS v4u*)(xr + 8 * F.lane + 512 * j) = o; }
            if (first && sh) { bf16* sr = (bf16*)(F.ws + WS_XN1S) + (size_t)(DBATCH * DSEQ + ((m - MPR) >> 2)) * DM;
#pragma unroll
                for (int j = 0; j < 2; ++j) { v4u o; o.x = pk2(xp[j][0], xp[j][1]); o.y = pk2(xp[j][2], xp[j][3]); o.z = pk2(xp[j][4], xp[j][5]); o.w = pk2(xp[j][6], xp[j][7]); *(GAS v4u*)(sr + 8 * F.lane + 512 * j) = o; } }
        }
#pragma unroll
        for (int c = 0; c < 4; ++c) {
            bf16* dst = (bf16*)(F.ws + WS_MIX + c * MIX_STRIDE) + (size_t)m * DM;
#pragma unroll
            for (int j = 0; j < 2; ++j) { float v[8];
#pragma unroll
                for (int i = 0; i < 8; ++i) v[i] = x[j][i] + (xp[j][i] - x[j][i]) * mu8[c][j][i];
                v4u o; o.x = pk2(v[0], v[1]); o.y = pk2(v[2], v[3]); o.z = pk2(v[4], v[5]); o.w = pk2(v[6], v[7]);
                *(GAS v4u*)(dst + 8 * F.lane + 512 * j) = o; }
        }
        float* d = nullptr;
        if (m < MPR) { if ((m % LP) == LP - 1) d = (float*)(F.ws + WS_SHP) + (size_t)(m / LP) * DM; }
        else if (((m - MPR) & 3) == 3) d = F.out + O_SHS + (size_t)((m - MPR) >> 2) * DM;
        if (d) {
#pragma unroll
            for (int j = 0; j < 2; ++j) { *(GAS f32x4*)(d + 8 * F.lane + 512 * j) = (f32x4){x[j][0], x[j][1], x[j][2], x[j][3]}; *(GAS f32x4*)(d + 8 * F.lane + 512 * j + 4) = (f32x4){x[j][4], x[j][5], x[j][6], x[j][7]}; } }
#pragma unroll
        for (int j = 0; j < 2; ++j)
#pragma unroll
            for (int i = 0; i < 8; ++i) xp[j][i] = x[j][i];
        have_prev = true;
    }
}

__device__ __forceinline__ void p5_lora1_combine(Frame& F) {
    const int gw = F.vcu * NWAVES + F.wave, NGW = F.G * NWAVES;
    const float* U = (const float*)(F.ws + WS_U); float* t12 = (float*)(F.ws + WS_T12); unsigned char* t12b = F.ws + WS_T12B;
    const int j = F.lane;
    const int r0 = (int)(((long)gw * MTOK) / NGW), r1 = (int)(((long)(gw + 1) * MTOK) / NGW);
    for (int m = r0; m < r1; ++m) {
        const float* cur; const float* prev = nullptr;
        if (m < MPR) { cur = U + (size_t)m * 256; if ((m % LP) != 0) prev = cur - 256; }
        else { const int i = m - MPR; cur = U + (size_t)(U_SROW + i) * 256; prev = (i & 3) == 0 ? U + (size_t)(U_SROW + DBATCH * DSEQ + (i >> 2)) * 256 : cur - 256; }
        float a = cur[j], b2 = cur[128 + j];
        if (prev) { a += prev[64 + j]; b2 += prev[192 + j]; }
        a = tanhf(a);
        t12[(size_t)m * 128 + j] = a; t12[(size_t)m * 128 + 64 + j] = b2;
        if (m < MPR) { const int bb = m / LP, t = m - bb * LP;
            unsigned char* ob = t12b + ((size_t)((bb * 129 + (t >> 5)) * 8) * 64 + (t & 31)) * 16 + ((j >> 4) * 64 + 32 * ((j >> 3) & 1)) * 16 + (j & 7) * 2;
            *(bf16*)ob = (bf16)f2bf(a); *(bf16*)(ob + 4 * 1024) = (bf16)f2bf(b2); }
    }
}

__device__ __forceinline__ void wkv_seq_unit(Frame& F, LAS float* wl, int row0, int T, int h, const float* S0, float* Sout, int lane, bf16* hout = nullptr) {
    asm volatile("" : "+v"(lane));
    const bf16* R = (const bf16*)(F.dob); const bf16* Kb = (const bf16*)(F.dob + RKV_STRIDE); const bf16* Vb = (const bf16*)(F.dob + 2 * RKV_STRIDE);
    const bf16* Gb = (const bf16*)(F.ws + WS_G); const float* t12 = (const float*)(F.ws + WS_T12); bf16* og2 = (bf16*)(F.dob + DO_OG2);
    const int ch = h * HD + lane;
    unsigned w2p[32], a2p[32]; float S[64];
#pragma unroll
    for (int i = 0; i < 32; ++i) { w2p[i] = pk2(F.w2[(2 * i) * DM + ch], F.w2[(2 * i + 1) * DM + ch]); a2p[i] = pk2(F.a2[(2 * i) * DM + ch], F.a2[(2 * i + 1) * DM + ch]); }
    const float w0c = F.w0[ch], a0c = F.a0[ch], kkc = F.k_k[ch], kac = F.k_a[ch], rkc = F.r_k[ch], lng = F.ln_g[ch], lnb = F.ln_b[ch];
    if (S0) {
#pragma unroll
        for (int i = 0; i < 16; ++i) { const f32x4 v = *(const GAS f32x4*)(S0 + (size_t)lane * 64 + 4 * i); S[4 * i] = v.x; S[4 * i + 1] = v.y; S[4 * i + 2] = v.z; S[4 * i + 3] = v.w; }
    } else {
#pragma unroll
        for (int i = 0; i < 64; ++i) S[i] = 0.f;
    }
    for (int t = 0; t < T; ++t) {
        const size_t m = (size_t)(row0 + t);
#if WKV_EXP >= 30
        if (T == LP && t == WKV_DUMP_T) { float* dp = (float*)(F.ws + 184 * MiB) + (size_t)((row0 / LP) * NH + h) * 4096;
#pragma unroll
            for (int i = 0; i < 16; ++i) *(GAS f32x4*)(dp + (size_t)lane * 64 + 4 * i) = (f32x4){S[4 * i], S[4 * i + 1], S[4 * i + 2], S[4 * i + 3]}; }
#endif
#pragma unroll
        for (int i = 0; i < 32; ++i) { asm volatile("" : "+v"(w2p[i])); asm volatile("" : "+v"(a2p[i])); }
        const float r = bf2f(R[m * DM + ch]), k = bf2f(Kb[m * DM + ch]), v = bf2f(Vb[m * DM + ch]), g = bf2f(Gb[m * DM + ch]);
        wl[lane] = t12[m * 128 + lane]; wl[64 + lane] = t12[m * 128 + 64 + lane];
        asm volatile("s_waitcnt lgkmcnt(0)" ::: "memory");
        float z = w0c, az = a0c;
#pragma unroll
        for (int i = 0; i < 16; ++i) { const f32x4 x = *(const LAS f32x4*)(wl + 4 * i), y = *(const LAS f32x4*)(wl + 64 + 4 * i);
            z += x.x * __builtin_bit_cast(float, w2p[2 * i] << 16) + x.y * __builtin_bit_cast(float, w2p[2 * i] & 0xffff0000u) + x.z * __builtin_bit_cast(float, w2p[2 * i + 1] << 16) + x.w * __builtin_bit_cast(float, w2p[2 * i + 1] & 0xffff0000u);
            az += y.x * __builtin_bit_cast(float, a2p[2 * i] << 16) + y.y * __builtin_bit_cast(float, a2p[2 * i] & 0xffff0000u) + y.z * __builtin_bit_cast(float, a2p[2 * i + 1] << 16) + y.w * __builtin_bit_cast(float, a2p[2 * i + 1] & 0xffff0000u); }
        const float a = 1.0f / (1.0f + __expf(-az)), sg = 1.0f / (1.0f + __expf(-z)), dec = __expf(-0.6065306597126334f * sg);
        float kk = k * kkc; const float n2 = wave_sum(kk * kk); kk = kk / fmaxf(sqrtf(n2), 1e-12f);
        const float kh = k * (1.0f + (a - 1.0f) * kac);
        const float rk = wave_sum(r * kh * rkc);
        wl[128 + lane] = -kk; wl[192 + lane] = kk * a; wl[256 + lane] = dec; wl[320 + lane] = kh; wl[384 + lane] = r;
        asm volatile("s_waitcnt lgkmcnt(0)" ::: "memory");
        float sa = 0.f;
#pragma unroll
        for (int i = 0; i < 16; ++i) { const f32x4 x = *(const LAS f32x4*)(wl + 128 + 4 * i); sa += S[4 * i] * x.x + S[4 * i + 1] * x.y + S[4 * i + 2] * x.z + S[4 * i + 3] * x.w; }
        float y = 0.f;
#pragma unroll
        for (int i = 0; i < 16; ++i) {
            const f32x4 bq = *(const LAS f32x4*)(wl + 192 + 4 * i), wq = *(const LAS f32x4*)(wl + 256 + 4 * i), kq = *(const LAS f32x4*)(wl + 320 + 4 * i), rq = *(const LAS f32x4*)(wl + 384 + 4 * i);
#if WKV_EXP == 45 && WKV_VAR == 2
            if (hout) sa = 0.f;
#endif
            S[4 * i] = S[4 * i] * wq.x + sa * bq.x + v * kq.x; S[4 * i + 1] = S[4 * i + 1] * wq.y + sa * bq.y + v * kq.y;
            S[4 * i + 2] = S[4 * i + 2] * wq.z + sa * bq.z + v * kq.z; S[4 * i + 3] = S[4 * i + 3] * wq.w + sa * bq.w + v * kq.w;
            y += S[4 * i] * rq.x + S[4 * i + 1] * rq.y + S[4 * i + 2] * rq.z + S[4 * i + 3] * rq.w; }
        const float mean = wave_sum(y) * (1.f / 64.f), dv = y - mean, var = wave_sum(dv * dv) * (1.f / 64.f);
        const float yn = dv * (1.0f / sqrtf(var + GN_EPS)) * lng + lnb + rk * v;
        if (!hout) og2[m * DM + ch] = (bf16)f2bf(yn * g / (1.0f + __expf(-g)));
        asm volatile("" ::: "memory");
    }
    if (hout) {
#pragma unroll
        for (int i = 0; i < 16; ++i) *(GAS unsigned long long*)(hout + (size_t)lane * 64 + 4 * i) = (unsigned long long)pk2(S[4 * i], S[4 * i + 1]) | ((unsigned long long)pk2(S[4 * i + 2], S[4 * i + 3]) << 32);
        return;
    }
#pragma unroll
    for (int i = 0; i < 16; ++i) *(GAS f32x4*)(Sout + (size_t)lane * 64 + 4 * i) = (f32x4){S[4 * i], S[4 * i + 1], S[4 * i + 2], S[4 * i + 3]};
}
#define SEQ_FENCE() do { asm volatile("" ::: "memory"); __builtin_amdgcn_sched_barrier(0); } while (0)
__device__ __forceinline__ void wkv_seq4_unit(Frame& F, LAS float* wl, int row0, int h, const float* S0, float* Sout, int lane) {
    asm volatile("" : "+v"(lane));
    const bf16* R = (const bf16*)(F.dob); const bf16* Kb = (const bf16*)(F.dob + RKV_STRIDE); const bf16* Vb = (const bf16*)(F.dob + 2 * RKV_STRIDE);
    const bf16* Gb = (const bf16*)(F.ws + WS_G); const float* t12 = (const float*)(F.ws + WS_T12); bf16* og2 = (bf16*)(F.dob + DO_OG2);
    const int ch = h * HD + lane;
    constexpr float L2E = 1.4426950408889634f;
    {
        float r[4], k[4], v[4], g[4];
#pragma unroll
        for (int t = 0; t < 4; ++t) { const size_t m = (size_t)(row0 + t); r[t] = bf2f(R[m * DM + ch]); k[t] = bf2f(Kb[m * DM + ch]); v[t] = bf2f(Vb[m * DM + ch]); g[t] = bf2f(Gb[m * DM + ch]);
            wl[t * 128 + lane] = t12[m * 128 + lane]; wl[t * 128 + 64 + lane] = t12[m * 128 + 64 + lane]; }
        const float w0c = F.w0[ch], a0c = F.a0[ch], kkc = F.k_k[ch], kac = F.k_a[ch], rkc = F.r_k[ch];
        float z[4], az[4];
#pragma unroll
        for (int t = 0; t < 4; ++t) { z[t] = w0c; az[t] = a0c; }
        asm volatile("s_waitcnt lgkmcnt(0)" ::: "memory");
        SEQ_FENCE();
#pragma unroll
        for (int i = 0; i < 16; ++i) {
            float w4[4], a4[4];
#pragma unroll
            for (int e = 0; e < 4; ++e) { w4[e] = F.w2[(4 * i + e) * DM + ch]; a4[e] = F.a2[(4 * i + e) * DM + ch]; }
#pragma unroll
            for (int t = 0; t < 4; ++t) { const f32x4 x = *(const LAS f32x4*)(wl + t * 128 + 4 * i), y = *(const LAS f32x4*)(wl + t * 128 + 64 + 4 * i);
                z[t] += x.x * w4[0] + x.y * w4[1] + x.z * w4[2] + x.w * w4[3]; az[t] += y.x * a4[0] + y.y * a4[1] + y.z * a4[2] + y.w * a4[3]; }
            if ((i & 3) == 3) SEQ_FENCE(); }
        asm volatile("s_waitcnt lgkmcnt(0)" ::: "memory");
#pragma unroll
        for (int t = 0; t < 4; ++t) {
            const float a = __builtin_amdgcn_rcpf(1.0f + __builtin_amdgcn_exp2f(-az[t] * L2E)), sg = __builtin_amdgcn_rcpf(1.0f + __builtin_amdgcn_exp2f(-z[t] * L2E)), dec = __builtin_amdgcn_exp2f((-0.6065306597126334f * L2E) * sg);
            float kk = k[t] * kkc; const float n2 = wave_sum(kk * kk); kk = kk * __builtin_amdgcn_rsqf(fmaxf(n2, 1e-24f));
            const float kh = k[t] * (1.0f + (a - 1.0f) * kac);
            const float rk = wave_sum(r[t] * kh * rkc);
            LAS float* w = wl + t * 512;
            w[lane] = -kk; w[64 + lane] = kk * a; w[128 + lane] = dec; w[192 + lane] = kh; w[256 + lane] = r[t]; w[320 + lane] = v[t]; w[384 + lane] = g[t]; w[448 + lane] = rk;
        }
    }
    SEQ_FENCE();
    float S[64];
#pragma unroll
    for (int i = 0; i < 16; ++i) { const f32x4 x = *(const GAS f32x4*)(S0 + (size_t)lane * 64 + 4 * i); S[4 * i] = x.x; S[4 * i + 1] = x.y; S[4 * i + 2] = x.z; S[4 * i + 3] = x.w; }
    const float lng = F.ln_g[ch], lnb = F.ln_b[ch];
    asm volatile("s_waitcnt lgkmcnt(0)" ::: "memory");
#pragma unroll 1
    for (int t = 0; t < 4; ++t) {
        const LAS float* w = wl + t * 512;
        float sa = 0.f;
#pragma unroll
        for (int i = 0; i < 16; ++i) { const f32x4 x = *(const LAS f32x4*)(w + 4 * i); sa += S[4 * i] * x.x + S[4 * i + 1] * x.y + S[4 * i + 2] * x.z + S[4 * i + 3] * x.w; }
        const float v = w[320 + lane], g = w[384 + lane], rk = w[448 + lane];
        float y = 0.f;
#pragma unroll
        for (int i = 0; i < 16; ++i) {
            const f32x4 bq = *(const LAS f32x4*)(w + 64 + 4 * i), wq = *(const LAS f32x4*)(w + 128 + 4 * i), kq = *(const LAS f32x4*)(w + 192 + 4 * i), rq = *(const LAS f32x4*)(w + 256 + 4 * i);
            S[4 * i] = S[4 * i] * wq.x + sa * bq.x + v * kq.x; S[4 * i + 1] = S[4 * i + 1] * wq.y + sa * bq.y + v * kq.y;
            S[4 * i + 2] = S[4 * i + 2] * wq.z + sa * bq.z + v * kq.z; S[4 * i + 3] = S[4 * i + 3] * wq.w + sa * bq.w + v * kq.w;
            y += S[4 * i] * rq.x + S[4 * i + 1] * rq.y + S[4 * i + 2] * rq.z + S[4 * i + 3] * rq.w; }
        const float mean = wave_sum(y) * (1.f / 64.f), dv = y - mean, var = wave_sum(dv * dv) * (1.f / 64.f);
        const float yn = dv * __builtin_amdgcn_rsqf(var + GN_EPS) * lng + lnb + rk * v;
        og2[(size_t)(row0 + t) * DM + ch] = (bf16)f2bf(yn * g * __builtin_amdgcn_rcpf(1.0f + __builtin_amdgcn_exp2f(-g * L2E)));
        asm volatile("" ::: "memory");
    }
#pragma unroll
    for (int i = 0; i < 16; ++i) *(GAS f32x4*)(Sout + (size_t)lane * 64 + 4 * i) = (f32x4){S[4 * i], S[4 * i + 1], S[4 * i + 2], S[4 * i + 3]};
    asm volatile("s_waitcnt lgkmcnt(0)" ::: "memory");
}
__device__ __forceinline__ void p6_wkv_seq(Frame& F) {
    LAS float* wl = (LAS float*)(F.lds + RING_OFF) + F.wave * 512;
    constexpr int NSU = DBATCH * NH;
    for (int u = F.wave * F.G + F.vcu; u < NSU + NB * NH; u += NWAVES * F.G) {
        if (u < NSU) { const int sb = u / NH, h = u % NH;
            wkv_seq_unit(F, wl, MPR + sb * DSEQ, DSEQ, h, F.state_wkv + (size_t)u * 4096, F.out + O_WKVS + (size_t)u * 4096, F.lane); }
        else { const int pu = u - NSU, b = pu / NH, h = pu % NH;
            wkv_seq_unit(F, wl, b * LP, LP, h, nullptr, (float*)(F.ws + WS_WKVP) + (size_t)pu * 4096, F.lane); }
    }
}

__device__ __forceinline__ void p8_final(Frame& F) {
#if WKV_VAR >= 11 && WKV_VAR <= 19
    { const unsigned flag = __hip_atomic_load((unsigned*)(F.ws + WS_CTL) + 8, __ATOMIC_RELAXED, __HIP_MEMORY_SCOPE_AGENT); if (flag && blockIdx.x == 0 && F.tid < 64) { const float e = (flag & 1u ? 100.f : 0.f) + (flag & 2u ? 1000.f : 0.f) + (flag & 4u ? 10000.f : 0.f) + (flag & 8u ? 31.f : 0.f) + (flag & 16u ? 7.f : 0.f) + (flag & 32u ? 3.f : 0.f) + (flag & 64u ? 50.f : 0.f) + (flag & 128u ? 200.f : 0.f) + (flag & 256u ? 1000.f : 0.f) + (flag & 512u ? 5000.f : 0.f); F.out[O_SHS + F.tid] += e; } }
#endif
    const int gw = F.vcu * NWAVES + F.wave, NGW = F.G * NWAVES;
    const bf16* h2 = (const bf16*)(F.ws + WS_H1);
    for (int m = gw; m < MTOK; m += NGW) {
        float* dst;
        if (m < MPR) { const int b = m / LP, t = m - b * LP; if (t < NMETA) continue; dst = F.out + O_YP + ((size_t)b * SEQ + (t - NMETA)) * DM; }
        else dst = F.out + O_YS + (size_t)(m - MPR) * DM;
        f32x4 v[4]; rms_row_b(h2 + (size_t)m * DM, F.final_gain, F.lane, v);
#pragma unroll
        for (int j = 0; j < 4; ++j) ((GAS f32x4*)dst)[F.lane + 64 * j] = v[j];
    }
    const int gt = F.vcu * (NWAVES * 64) + F.tid, NGT = F.G * NWAVES * 64;
    const bf16* kvp = (const bf16*)(F.ws + WS_KVP); const bf16* kvs = (const bf16*)(F.ws + WS_KVS);
    for (int i = gt; i < 2 * NB * WIN * 256; i += NGT) { const int kv = i / (NB * WIN * 256), r = i % (NB * WIN * 256), row = r >> 8, col = r & 255;
        F.out[(kv ? O_WVP : O_WKP) + r] = bf2f(kvp[(size_t)row * 512 + kv * 256 + col]); }
    for (int i = gt; i < NB * NH * 4096; i += NGT) F.out[O_WKVP + i] = ((const float*)(F.ws + WS_WKVP))[i];
    for (int i = gt; i < NB * DM; i += NGT) F.out[O_SHP + i] = ((const float*)(F.ws + WS_SHP))[i];
    for (int i = gt; i < 2 * DBATCH * WIN * 64; i += NGT) {
        const int kv = i / (DBATCH * WIN * 64), r = i % (DBATCH * WIN * 64), sb = r / (WIN * 64), j = (r / 64) % WIN, c4 = r % 64;
        f32x4 v;
        if (j < WIN - DSEQ) v = *(const GAS f32x4*)((kv ? F.cache_v : F.cache_k) + ((size_t)sb * WIN + j + DSEQ) * 256 + 4 * c4);
        else { const bf16* s = kvs + (size_t)(sb * DSEQ + (j - (WIN - DSEQ))) * 512 + kv * 256 + 4 * c4; v = (f32x4){bf2f(s[0]), bf2f(s[1]), bf2f(s[2]), bf2f(s[3])}; }
        *(GAS f32x4*)(F.out + (kv ? O_WVS : O_WKS) + (size_t)r * 4) = v;
    }
}
namespace wkv {
typedef __amdgpu_buffer_rsrc_t srd_t;
constexpr int NCH = 65, NUNITS = NB * NH * NCH;
constexpr size_t WS_W2T = 18 * MiB + 256 * 1024, WS_A2T = 18 * MiB + 384 * 1024;
constexpr size_t WS_GT = 98 * MiB, WS_HT = 131 * MiB, WS_KST = 164 * MiB, WS_RK = 181 * MiB, WS_TST = 183 * MiB, WS_Y0F = 30 * MiB, WS_WYF = 64 * MiB;
static_assert(3 * RKV_STRIDE + (size_t)2048 * 16384 <= O_SHS * 4 && WS_GT + (size_t)NUNITS * 8192 <= WS_HT && WS_HT + (size_t)NUNITS * 8192 <= WS_KST && WS_KST + (size_t)2048 * 8192 <= WS_RK && WS_RK + (size_t)MTOK * 16 * 4 <= WS_H1 && WS_Y0F + (size_t)NUNITS * 8192 <= WS_WYF && WS_WYF + (size_t)NUNITS * 8192 <= WS_GT, "wkv ws map");
constexpr int LDSX_OFF = 132096;
static_assert(LDSX_OFF + NWAVES * 512 <= LDS_BYTES, "lds");
__device__ __forceinline__ unsigned cvtpk(float lo, float hi) { unsigned r; asm volatile("v_cvt_pk_bf16_f32 %0, %1, %2\n\ts_nop 1" : "=v"(r) : "v"(lo), "v"(hi)); return r; }
__device__ __forceinline__ unsigned cvtpkn(float lo, float hi) { return pk2(lo, hi); }
__device__ __forceinline__ void mfma_fence(f32x16 (&acc)[2][2]) { asm volatile("s_nop 15\n\ts_nop 7" : "+v"(acc[0][0]), "+v"(acc[0][1]), "+v"(acc[1][0]), "+v"(acc[1][1])); }
__device__ __forceinline__ void mfma_fence2(f32x16& a, f32x16& b) { asm volatile("s_nop 15\n\ts_nop 7" : "+v"(a), "+v"(b)); }
__device__ __forceinline__ float lo16(unsigned w) { return __builtin_bit_cast(float, w << 16); }
__device__ __forceinline__ float hi16(unsigned w) { return __builtin_bit_cast(float, w & 0xffff0000u); }
__device__ __forceinline__ void mm64(f32x16 (&acc)[2][2], const bf16x8 (&A)[4][2], const bf16x8 (&B)[4][2]) {
#pragma unroll
    for (int m = 0; m < 2; ++m)
#pragma unroll
        for (int n = 0; n < 2; ++n)
#pragma unroll
            for (int ks = 0; ks < 4; ++ks) acc[m][n] = __builtin_amdgcn_mfma_f32_32x32x16_bf16(A[ks][m], B[ks][n], acc[m][n], 0, 0, 0);
    mfma_fence(acc);
}
__device__ __forceinline__ void acc2frag(const f32x16 (&acc)[2][2], bf16x8 (&Fr)[4][2]) {
#pragma unroll
    for (int m = 0; m < 2; ++m)
#pragma unroll
        for (int n = 0; n < 2; ++n)
#pragma unroll
            for (int s = 0; s < 2; ++s) { const f32x16& a = acc[m][n]; v4u w;
                w.x = cvtpk(a[8 * s + 0], a[8 * s + 1]); w.y = cvtpk(a[8 * s + 2], a[8 * s + 3]); w.z = cvtpk(a[8 * s + 4], a[8 * s + 5]); w.w = cvtpk(a[8 * s + 6], a[8 * s + 7]);
                Fr[2 * m + s][n] = __builtin_bit_cast(bf16x8, w); }
}
__device__ __forceinline__ void zero_acc(f32x16 (&acc)[2][2]) {
#pragma unroll
    for (int m = 0; m < 2; ++m)
#pragma unroll
        for (int n = 0; n < 2; ++n) acc[m][n] = f32x16{};
}
__device__ __forceinline__ void frag_st_lds(LAS unsigned char* p, const bf16x8 (&Fr)[4][2], int lane) {
#pragma unroll
    for (int ks = 0; ks < 4; ++ks)
#pragma unroll
        for (int t = 0; t < 2; ++t) *(LAS bf16x8*)(p + (ks * 2 + t) * 1024 + lane * 16) = Fr[ks][t];
}
__device__ __forceinline__ void frag_ld_lds(const LAS unsigned char* p, bf16x8 (&Fr)[4][2], int lane) {
#pragma unroll
    for (int ks = 0; ks < 4; ++ks)
#pragma unroll
        for (int t = 0; t < 2; ++t) Fr[ks][t] = *(const LAS bf16x8*)(p + (ks * 2 + t) * 1024 + lane * 16);
}
template <int D> __device__ __forceinline__ void bfly_step(float (&v)[32], int lane) {
    const bool up = (lane & D) != 0;
#pragma unroll
    for (int s = 0; s < D; ++s) { const float send = up ? v[s] : v[s + D], keep = up ? v[s + D] : v[s]; v[s] = keep + __shfl_xor(send, D); }
}
__device__ __forceinline__ float butterfly32(float (&v)[32], int lane) {
    bfly_step<16>(v, lane); bfly_step<8>(v, lane); bfly_step<4>(v, lane); bfly_step<2>(v, lane); bfly_step<1>(v, lane);
    return v[0];
}
__device__ __forceinline__ int crow(int r, int hi) { return (r & 3) + 8 * (r >> 2) + 4 * hi; }

#define WKV_FENCE() do { asm volatile("" ::: "memory"); __builtin_amdgcn_sched_barrier(0); } while (0)
__device__ __forceinline__ void frag_st_g(unsigned char* p, const bf16x8 (&Fr)[4][2], int lane) {
#pragma unroll
    for (int ks = 0; ks < 4; ++ks)
#pragma unroll
        for (int t = 0; t < 2; ++t) *(GAS bf16x8*)(p + (ks * 2 + t) * 1024 + lane * 16) = Fr[ks][t];
}
typedef unsigned v4u_t __attribute__((ext_vector_type(4)));
__device__ __forceinline__ void frag_ld_g(const unsigned char* p, bf16x8 (&Fr)[4][2], int lane) {
    const srd_t r = __builtin_amdgcn_make_buffer_rsrc((void*)p, (short)0, 8192, 0x00020000);
#pragma unroll
    for (int ks = 0; ks < 4; ++ks)
#pragma unroll
        for (int t = 0; t < 2; ++t) { const v4u_t x = __builtin_amdgcn_raw_buffer_load_b128(r, (unsigned)(lane * 16), (unsigned)((ks * 2 + t) * 1024), 16  ); Fr[ks][t] = __builtin_bit_cast(bf16x8, x); }
}
__device__ __forceinline__ void transpose64(f32x16 (&acc)[2][2], const bf16x8 (&XR)[4][2], const bf16x8 (&Id2)[2]) {
#pragma unroll
    for (int m = 0; m < 2; ++m)
#pragma unroll
        for (int n = 0; n < 2; ++n) { acc[m][n] = f32x16{};
#pragma unroll
            for (int s = 0; s < 2; ++s) acc[m][n] = __builtin_amdgcn_mfma_f32_32x32x16_bf16(XR[2 * n + s][m], Id2[s], acc[m][n], 0, 0, 0); }
    mfma_fence(acc);
}
__device__ __forceinline__ float bld16(srd_t r, unsigned vo, unsigned so) { return __builtin_bit_cast(float, (unsigned)__builtin_amdgcn_raw_buffer_load_b16(r, vo, so, 0) << 16); }
__device__ __forceinline__ unsigned bld16u(srd_t r, unsigned vo, unsigned so) { return (unsigned)__builtin_amdgcn_raw_buffer_load_b16(r, vo, so, 0); }
typedef unsigned v2u_t __attribute__((ext_vector_type(2)));
__device__ __forceinline__ unsigned long long bld64(srd_t r, unsigned vo, unsigned so) { const v2u_t v = __builtin_amdgcn_raw_buffer_load_b64(r, vo, so, 16  ); return (unsigned long long)v.x | ((unsigned long long)v.y << 32); }
__device__ __forceinline__ void bst64(srd_t r, unsigned vo, unsigned so, unsigned long long w) { v2u_t v; v.x = (unsigned)w; v.y = (unsigned)(w >> 32); __builtin_amdgcn_raw_buffer_store_b64(v, r, vo, so, 0); }
__device__ __forceinline__ unsigned long long pack4(float a, float b, float c, float d) { return (unsigned long long)cvtpkn(a, b) | ((unsigned long long)cvtpkn(c, d) << 32); }
template <bool TAIL> __device__ __forceinline__ void solve_T(const f32x16 (&acc)[2][2], bf16x8 (&TR)[4][2], int lane, bool sync, int skip) {
    float Tc[64];
#pragma unroll
    for (int i = 0; i < 64; ++i) Tc[i] = (lane == i) ? 1.f : 0.f;
    if (!(skip & 1))
#pragma unroll
    for (int i = 62; i >= 0; --i) {
        const int mi = i >> 5, ri = (i & 3) + 4 * ((i & 31) >> 3), hi = ((i & 31) >> 2) & 1;
        if (!(TAIL && i >= 16)) {
        float e0 = acc[mi][0][ri], e1 = acc[mi][1][ri];
        asm volatile("" : "+v"(e0)); asm volatile("" : "+v"(e1));
#pragma unroll
        for (int k = i + 1; k < (TAIL ? 16 : 64); ++k) {
            const float nik = __builtin_bit_cast(float, __builtin_amdgcn_readlane(__builtin_bit_cast(int, (k >> 5) ? e1 : e0), (k & 31) + 32 * hi));
            asm volatile("v_fmac_f32 %0, %1, %2" : "+v"(Tc[i]) : "s"(nik), "v"(Tc[k]));
        }
        }
        if ((i & 7) == 0 && sync) __builtin_amdgcn_s_barrier();
        WKV_FENCE();
    }
#pragma unroll
    for (int ks = 0; ks < 4; ++ks) {
        const int b0 = 16 * ks;
        v4u E, O;
        E.x = cvtpk(Tc[b0 + 0], Tc[b0 + 1]); E.y = cvtpk(Tc[b0 + 2], Tc[b0 + 3]); E.z = cvtpk(Tc[b0 + 8], Tc[b0 + 9]); E.w = cvtpk(Tc[b0 + 10], Tc[b0 + 11]);
        O.x = cvtpk(Tc[b0 + 4], Tc[b0 + 5]); O.y = cvtpk(Tc[b0 + 6], Tc[b0 + 7]); O.z = cvtpk(Tc[b0 + 12], Tc[b0 + 13]); O.w = cvtpk(Tc[b0 + 14], Tc[b0 + 15]);
        { auto r = __builtin_amdgcn_permlane32_swap(E.x, O.x, false, false); E.x = r[0]; O.x = r[1]; }
        { auto r = __builtin_amdgcn_permlane32_swap(E.y, O.y, false, false); E.y = r[0]; O.y = r[1]; }
        { auto r = __builtin_amdgcn_permlane32_swap(E.z, O.z, false, false); E.z = r[0]; O.z = r[1]; }
        { auto r = __builtin_amdgcn_permlane32_swap(E.w, O.w, false, false); E.w = r[0]; O.w = r[1]; }
        TR[ks][0] = __builtin_bit_cast(bf16x8, E); TR[ks][1] = __builtin_bit_cast(bf16x8, O);
    }
}
__device__ __forceinline__ void mfma_fence1(f32x16& a) { asm volatile("s_nop 15\n\ts_nop 7" : "+v"(a)); }
__device__ __forceinline__ void make_idn(bf16x8 (&IdN)[2], int c, int hh) {
    asm volatile("" : "+v"(c), "+v"(hh));
#pragma unroll
    for (int s2 = 0; s2 < 2; ++s2) { bf16x8 v;
#pragma unroll
        for (int jj = 0; jj < 8; ++jj) v[jj] = ((16 * s2 + 8 * hh + jj) == c) ? (short)0x3F80 : (short)0;
        IdN[s2] = v; }
}
__device__ __forceinline__ f32x16 tile_from_rows(const bf16x8& a0, const bf16x8& a1, const bf16x8 (&IdN)[2]) {
    f32x16 t = f32x16{};
    t = __builtin_amdgcn_mfma_f32_32x32x16_bf16(a0, IdN[0], t, 0, 0, 0);
    t = __builtin_amdgcn_mfma_f32_32x32x16_bf16(a1, IdN[1], t, 0, 0, 0);
    return t;
}
__device__ __forceinline__ bf16x8 bld128(srd_t r, unsigned vo, unsigned so) { const v4u_t x = __builtin_amdgcn_raw_buffer_load_b128(r, vo, so, 0); return __builtin_bit_cast(bf16x8, x); }
#ifndef WKV_SEQ4
#define WKV_SEQ4 0
#endif
#ifndef WKV_LOCKSTEP
#define WKV_LOCKSTEP 0
#endif
#define WKV_SYNC() do { if (sync) __builtin_amdgcn_s_barrier(); } while (0)
__device__ __forceinline__ void stageA_unit(Frame& F, int uidx, int lane, int wave, bool sync, int lslot) {
    asm volatile("" : "+v"(lane));
    const int c = lane & 31, hh = lane >> 5;
    const int ch = uidx % NCH, bh = uidx / NCH, h = bh % NH, b = bh / NH;
    const int row0 = b * LP + 64 * ch, nvalid = (LP - 64 * ch) < 64 ? (LP - 64 * ch) : 64;
    const float* t12 = (const float*)(F.ws + WS_T12);
    const bf16* w2t = (const bf16*)(F.ws + WS_W2T); const bf16* a2t = (const bf16*)(F.ws + WS_A2T);
    LAS unsigned char* wl = F.lds + RING_OFF + lslot * 16384;
    LAS float* red = (LAS float*)(F.lds + LDSX_OFF + wave * 512);
#if WKV_VAR == 14
    {
        unsigned bad = 0u;
        float x = (float)(lane * 3 + 1); asm volatile("" : "+v"(x));
        f32x16 t; for (int r = 0; r < 16; ++r) t[r] = (float)(lane * 16 + r);
        asm volatile("" : "+v"(t));
#define RLCHK(L) { const float g = __builtin_bit_cast(float, __builtin_amdgcn_readlane(__builtin_bit_cast(int, x), L)); if (g != (float)((L) * 3 + 1)) bad |= 64u; }
        RLCHK(0) RLCHK(5) RLCHK(31) RLCHK(32) RLCHK(40) RLCHK(63)
#undef RLCHK
#define RLCHK2(R, L) { const float g = __builtin_bit_cast(float, __builtin_amdgcn_readlane(__builtin_bit_cast(int, t[R]), L)); if (g != (float)((L) * 16 + (R))) bad |= 128u; }
        RLCHK2(0, 3) RLCHK2(7, 33) RLCHK2(13, 63) RLCHK2(14, 63) RLCHK2(15, 62) RLCHK2(9, 17)
#undef RLCHK2
        f32x16 t2; for (int r = 0; r < 16; ++r) t2[r] = (float)(lane * 16 + r);
#define RLCHK3(R, L) { const float g = __builtin_bit_cast(float, __builtin_amdgcn_readlane(__builtin_bit_cast(int, t2[R]), L)); if (g != (float)((L) * 16 + (R))) bad |= 256u; }
        RLCHK3(0, 3) RLCHK3(7, 33) RLCHK3(13, 63) RLCHK3(14, 63) RLCHK3(15, 62) RLCHK3(9, 17)
#undef RLCHK3
#define RLCHK4(R, L) { float e = t[R]; asm volatile("" : "+v"(e)); const float g = __builtin_bit_cast(float, __builtin_amdgcn_readlane(__builtin_bit_cast(int, e), L)); if (g != (float)((L) * 16 + (R))) bad |= 512u; }
        RLCHK4(0, 3) RLCHK4(7, 33) RLCHK4(13, 63) RLCHK4(14, 63) RLCHK4(15, 62) RLCHK4(9, 17)
#undef RLCHK4
        if (bad) atomicOr((unsigned*)(F.ws + WS_CTL) + 8, bad);
        return;
    }
#endif
#if WKV_VAR == 13
    {
        f32x16 acc[2][2];
#pragma unroll
        for (int m = 0; m < 2; ++m)
#pragma unroll
            for (int n = 0; n < 2; ++n)
#pragma unroll
                for (int r = 0; r < 16; ++r) { const int i_ = 32 * m + crow(r, hh), k_ = 32 * n + c; acc[m][n][r] = (k_ == i_ + 1) ? 0.5f : (k_ == i_ + 2) ? 0.25f : (k_ <= i_) ? 1.0f : 0.f; }
        asm volatile("" : "+v"(acc[0][0]), "+v"(acc[0][1]), "+v"(acc[1][0]), "+v"(acc[1][1]));
        float Tc[64]; unsigned badn = 0u;
#pragma unroll
        for (int i = 0; i < 64; ++i) Tc[i] = (lane == i) ? 1.f : 0.f;
#pragma unroll
        for (int i = 62; i >= 0; --i) {
            const int mi = i >> 5, ri = (i & 3) + 4 * ((i & 31) >> 3), hi = ((i & 31) >> 2) & 1;
#pragma unroll
            for (int k = i + 1; k < 64; ++k) {
                const float nik = __builtin_bit_cast(float, __builtin_amdgcn_readlane(__builtin_bit_cast(int, acc[mi][k >> 5][ri]), (k & 31) + 32 * hi));
                const float exn = (k == i + 1) ? 0.5f : (k == i + 2) ? 0.25f : 0.f;
                if (nik != exn) badn |= 32u;
#if WKV_SUB == 1
                Tc[i] = __builtin_fmaf(nik, Tc[k], Tc[i]);
#else
                asm volatile("v_fmac_f32 %0, %1, %2" : "+v"(Tc[i]) : "s"(nik), "v"(Tc[k]));
#endif
            }
            WKV_FENCE();
        }
        unsigned bad = badn;
#pragma unroll
        for (int i = 0; i < 64; ++i) { const int d = lane - i; float ex = 0.f; if (d >= 0) { float t0 = 1.f, t1 = 0.5f; ex = d == 0 ? 1.f : 0.5f; for (int q = 2; q <= d; ++q) { const float t2 = 0.5f * t1 + 0.25f * t0; t0 = t1; t1 = t2; ex = t2; } }
            if (fabsf(Tc[i] - ex) > 1e-5f * fabsf(ex) + 1e-12f) bad |= 16u; }
        if (bad) atomicOr((unsigned*)(F.ws + WS_CTL) + 8, bad);
        WKV_FENCE();
        return;
    }
#endif
#if WKV_VAR == 12
    {
        f32x16 acc[2][2]; bf16x8 TR[4][2];
#pragma unroll
        for (int m = 0; m < 2; ++m)
#pragma unroll
            for (int n = 0; n < 2; ++n)
#pragma unroll
                for (int r = 0; r < 16; ++r) { const int i_ = 32 * m + crow(r, hh), k_ = 32 * n + c; acc[m][n][r] = (k_ == i_ + 1) ? 0.5f : (k_ == i_ + 2) ? 0.25f : (k_ <= i_) ? 1.0f : 0.f; }
        solve_T<false>(acc, TR, lane, false, 0);
        WKV_FENCE();
        bf16x8 Ir[4][2];
#pragma unroll
        for (int ks = 0; ks < 4; ++ks)
#pragma unroll
            for (int n = 0; n < 2; ++n) { bf16x8 v;
#pragma unroll
                for (int jj = 0; jj < 8; ++jj) v[jj] = ((16 * ks + 8 * (jj >> 2) + 4 * hh + (jj & 3)) == 32 * n + c) ? (short)0x3F80 : (short)0;
                Ir[ks][n] = v; }
        zero_acc(acc); mm64(acc, TR, Ir);
        unsigned bad = 0u;
#pragma unroll
        for (int m = 0; m < 2; ++m)
#pragma unroll
            for (int n = 0; n < 2; ++n)
#pragma unroll
                for (int r = 0; r < 16; ++r) { const int jp = 32 * m + crow(r, hh), j_ = 32 * n + c, d = jp - j_;
                    float ex = 0.f; if (d >= 0) { float t0 = 1.f, t1 = 0.5f; ex = d == 0 ? 1.f : 0.5f; for (int q = 2; q <= d; ++q) { const float t2 = 0.5f * t1 + 0.25f * t0; t0 = t1; t1 = t2; ex = t2; } }
                    const float got = acc[m][n][r]; if (fabsf(got - ex) > 0.01f * fabsf(ex) + 1e-6f) bad |= 8u; }
        if (bad) atomicOr((unsigned*)(F.ws + WS_CTL) + 8, bad);
        WKV_FENCE();
        return;
    }
#endif
#if WKV_VAR == 11
    {
        f32x16 acc[2][2]; bf16x8 IdT[2];
#pragma unroll
        for (int s = 0; s < 2; ++s) { bf16x8 v;
#pragma unroll
            for (int jj = 0; jj < 8; ++jj) v[jj] = ((16 * s + 8 * (jj >> 2) + (jj & 3)) == (c - 4 * hh)) ? (short)0x3F80 : (short)0;
            IdT[s] = v; }
        {
            bf16x8 XA[4][2], XB[4][2];
#pragma unroll
            for (int ks = 0; ks < 4; ++ks)
#pragma unroll
                for (int t = 0; t < 2; ++t) { bf16x8 va, vb;
#pragma unroll
                    for (int jj = 0; jj < 8; ++jj) { const int tk = 16 * ks + 8 * (jj >> 2) + 4 * hh + (jj & 3), chn = 32 * t + c;
                        va[jj] = (short)f2bf((float)(((tk + 2 * chn) & 7) - 3)); vb[jj] = (tk == chn) ? (short)0x3F80 : (short)0; }
                    XA[ks][t] = va; XB[ks][t] = vb; }
            frag_st_lds(wl, XA, lane); frag_st_lds(wl + 8192, XB, lane);
        }
        WKV_FENCE();
        unsigned bad = 0u;
        bf16x8 AC[4][2], BC[4][2];
        { bf16x8 X[4][2]; frag_ld_lds(wl + 8192, X, lane); transpose64(acc, X, IdT);
#pragma unroll
          for (int m = 0; m < 2; ++m)
#pragma unroll
            for (int n = 0; n < 2; ++n)
#pragma unroll
                for (int r = 0; r < 16; ++r) { const int chn = 32 * m + crow(r, hh), tk = 32 * n + c; if (acc[m][n][r] != ((tk == chn) ? 1.f : 0.f)) bad |= 1u; }
          acc2frag(acc, BC); }
        WKV_FENCE();
        { bf16x8 X[4][2]; frag_ld_lds(wl, X, lane); transpose64(acc, X, IdT);
#pragma unroll
          for (int m = 0; m < 2; ++m)
#pragma unroll
            for (int n = 0; n < 2; ++n)
#pragma unroll
                for (int r = 0; r < 16; ++r) { const int chn = 32 * m + crow(r, hh), tk = 32 * n + c; if (acc[m][n][r] != (float)(((tk + 2 * chn) & 7) - 3)) bad |= 2u; }
          acc2frag(acc, AC); }
        WKV_FENCE();
        zero_acc(acc); mm64(acc, BC, AC);
#pragma unroll
        for (int m = 0; m < 2; ++m)
#pragma unroll
            for (int n = 0; n < 2; ++n)
#pragma unroll
                for (int r = 0; r < 16; ++r) { const int i_ = 32 * m + crow(r, hh), j_ = 32 * n + c; if (acc[m][n][r] != (float)(((j_ + 2 * i_) & 7) - 3)) bad |= 4u; }
        if (bad) atomicOr((unsigned*)(F.ws + WS_CTL) + 8, bad);
        WKV_FENCE();
        return;
    }
#endif
#if WKV_VAR == 7
    const int wid = F.vcu * 2 + wave;
#else
    const int wid = F.vcu * NWAVES + wave;
#endif
    unsigned char* gs0 = F.ws + WS_KST + (size_t)wid * 8192;
#if WKV_VAR == 7
    unsigned char* gs1 = F.ws + WS_KST + 4 * MiB + (size_t)wid * 16384;
#else
    unsigned char* gs1 = F.dob + 3 * RKV_STRIDE + (size_t)wid * 16384;
#endif
    if (nvalid < 64) gs1 = F.ws + WS_TST + (size_t)bh * 16384;
    unsigned char* gs2 = gs1 + 8192;
    const size_t rbase = (size_t)row0 * DM + h * HD;
    const bool tail = nvalid < 64;
#define TPAD(m, r) (tail && (32 * (m) + 8 * ((r) >> 2) >= 16))
#define JOK(n) (!tail || ((n) == 0 && c < 16))
    const int dlt = c - 4 * hh;
#define KR(r) (((r) & 3) + 8 * ((r) >> 2))
#define ROW_GT_COL(m, n, r) (((m) > (n)) || ((m) == (n) && KR(r) > dlt))
    const srd_t sD = __builtin_amdgcn_make_buffer_rsrc((void*)F.dob, (short)0, (int)(O_END * 4), 0x00020000);
    const unsigned soR = (unsigned)(rbase * 2), soK = (unsigned)(RKV_STRIDE + rbase * 2), soV = (unsigned)(2 * RKV_STRIDE + rbase * 2);
    const unsigned voE = (unsigned)((4 * hh * DM + c) * 2);
    const unsigned voW = (unsigned)((c * DM + 4 * hh) * 2);
    const unsigned voA = (unsigned)((c * DM + 8 * hh) * 2);
#define CA(m, s) ((unsigned)(((32 * (m)) * DM + 16 * (s)) * 2))
#define CE(m, r, n) ((unsigned)(((32 * (m) + ((r) & 3) + 8 * ((r) >> 2)) * DM + 32 * (n)) * 2))
#define CW(m, q, n) ((unsigned)(((32 * (n)) * DM + 32 * (m) + 8 * (q)) * 2))
    constexpr float L2E = 1.4426950408889634f;
    float kkc[2], kac[2], rkc[2], w0c[2], a0c[2];
#pragma unroll
    for (int n = 0; n < 2; ++n) { const int cc = h * HD + 32 * n + c; kkc[n] = F.k_k[cc]; kac[n] = F.k_a[cc]; rkc[n] = F.r_k[cc]; w0c[n] = F.w0[cc]; a0c[n] = F.a0[cc]; }
    {
        bf16x8 KA[2][4], IdN[2];
#pragma unroll
        for (int m = 0; m < 2; ++m)
#pragma unroll
            for (int s4 = 0; s4 < 4; ++s4) KA[m][s4] = bld128(sD, voA, soK + CA(m, s4));
        make_idn(IdN, c, hh);
        float nv[32];
#pragma unroll
        for (int m = 0; m < 2; ++m) {
            const f32x16 t0 = tile_from_rows(KA[m][0], KA[m][1], IdN), t1 = tile_from_rows(KA[m][2], KA[m][3], IdN);
#pragma unroll
            for (int r = 0; r < 16; ++r) { const float q0 = t0[r] * kkc[0], q1 = t1[r] * kkc[1]; nv[16 * m + r] = TPAD(m, r) ? 0.f : (q0 * q0 + q1 * q1); } }
        const float tot = butterfly32(nv, lane);
        red[32 * (c >> 4) + crow(c & 15, hh)] = __builtin_amdgcn_rsqf(fmaxf(tot, 1e-24f));
        asm volatile("s_waitcnt lgkmcnt(0)" ::: "memory");
    }
    WKV_FENCE();
    WKV_SYNC();
    float gC[2], erk[32];
#pragma unroll
    for (int i = 0; i < 32; ++i) erk[i] = 0.f;
    gC[0] = gC[1] = 1.f;
    if (!(F.skip & 2))
#pragma unroll
    for (int n = 0; n < 2; ++n) {
        f32x16 z[2], az[2];
        {
            bf16x8 wf[4], af[4];
#pragma unroll
            for (int s = 0; s < 4; ++s) { wf[s] = *(const GAS bf16x8*)(w2t + (size_t)(h * HD + 32 * n + c) * 64 + 16 * s + 8 * hh); af[s] = *(const GAS bf16x8*)(a2t + (size_t)(h * HD + 32 * n + c) * 64 + 16 * s + 8 * hh); }
#pragma unroll
            for (int m = 0; m < 2; ++m) { z[m] = f32x16{}; az[m] = f32x16{};
                const unsigned char* tp = F.ws + WS_T12B + (size_t)((b * 129 + 2 * ch + m) * 8) * 1024 + lane * 16;
                if (!(tail && m == 1))
#pragma unroll
                for (int s = 0; s < 4; ++s) {
                    const bf16x8 xa = *(const GAS bf16x8*)(tp + s * 1024), ya = *(const GAS bf16x8*)(tp + (4 + s) * 1024);
                    z[m] = __builtin_amdgcn_mfma_f32_32x32x16_bf16(xa, wf[s], z[m], 0, 0, 0);
                    az[m] = __builtin_amdgcn_mfma_f32_32x32x16_bf16(ya, af[s], az[m], 0, 0, 0); } }
        }
        WKV_FENCE();
        bf16x8 KA2[2][2], RA2[2][2];
#pragma unroll
        for (int m = 0; m < 2; ++m)
#pragma unroll
            for (int s2 = 0; s2 < 2; ++s2) { KA2[m][s2] = bld128(sD, voA, soK + CA(m, 2 * n + s2)); RA2[m][s2] = bld128(sD, voA, soR + CA(m, 2 * n + s2)); }
#pragma unroll
        for (int m = 0; m < 2; ++m)
#pragma unroll
            for (int r = 0; r < 16; ++r) { const int t = 32 * m + crow(r, hh);
                const float sg = __builtin_amdgcn_rcpf(1.0f + __builtin_amdgcn_exp2f(-(z[m][r] + w0c[n]) * L2E)); z[m][r] = TPAD(m, r) ? 0.f : (-0.6065306597126334f * L2E) * sg;
                az[m][r] = __builtin_amdgcn_rcpf(1.0f + __builtin_amdgcn_exp2f(-(az[m][r] + a0c[n]) * L2E)); }
        float gt[8], ot[8], base[8];
#pragma unroll
        for (int g = 0; g < 8; ++g) { const int m = g >> 2, q = g & 3; gt[g] = (z[m][4 * q] + z[m][4 * q + 1]) + (z[m][4 * q + 2] + z[m][4 * q + 3]); ot[g] = __shfl_xor(gt[g], 32); }
        { float run = 0.f;
#pragma unroll
          for (int g = 0; g < 8; ++g) { base[g] = run + (hh ? ot[g] : 0.f); run += gt[g] + ot[g]; }
          gC[n] = __builtin_amdgcn_exp2f(run); }
#pragma unroll
        for (int m = 0; m < 2; ++m) {
            bf16x8 IdN[2]; make_idn(IdN, c, hh);
            const f32x16 ktile = tile_from_rows(KA2[m][0], KA2[m][1], IdN), rtile = tile_from_rows(RA2[m][0], RA2[m][1], IdN);
#pragma unroll
            for (int s = 0; s < 2; ++s) {
                float at[8], bt[8], kt[8], rt[8];
#pragma unroll
                for (int e = 0; e < 8; ++e) { at[e] = 0.f; bt[e] = 0.f; kt[e] = 0.f; rt[e] = 0.f; }
                if (!(tail && (m | s)))
#pragma unroll
                for (int qq = 0; qq < 2; ++qq) { const int q = 2 * s + qq; float acc = base[4 * m + q];
#pragma unroll
                    for (int i = 0; i < 4; ++i) { const int r = 4 * q + i, t = 32 * m + crow(r, hh), e = 4 * qq + i;
                        const float lw = z[m][r]; acc += lw; const float LG = acc;
                        const float eLG = __builtin_amdgcn_exp2f(LG), ieLG = __builtin_amdgcn_exp2f(-LG), eLGp = __builtin_amdgcn_exp2f(LG - lw);
                        float k = ktile[r], rr = rtile[r];
                        if (TPAD(m, r)) { k = 0.f; rr = 0.f; }
                        const float a = az[m][r];
                        const float kkn = k * kkc[n] * red[t];
                        const float kh = k * (1.0f + (a - 1.0f) * kac[n]);
                        at[e] = -kkn * eLGp; bt[e] = kkn * a * ieLG; kt[e] = kh * ieLG; rt[e] = rr * eLG;
                        erk[16 * m + r] += rr * kh * rkc[n]; } }
                const int fo = ((2 * m + s) * 2 + n) * 1024 + lane * 16; v4u w;
                w.x = cvtpkn(at[0], at[1]); w.y = cvtpkn(at[2], at[3]); w.z = cvtpkn(at[4], at[5]); w.w = cvtpkn(at[6], at[7]); *(LAS v4u*)(wl + fo) = w;
                w.x = cvtpkn(bt[0], bt[1]); w.y = cvtpkn(bt[2], bt[3]); w.z = cvtpkn(bt[4], bt[5]); w.w = cvtpkn(bt[6], bt[7]); *(LAS v4u*)(wl + 8192 + fo) = w;
                w.x = cvtpkn(kt[0], kt[1]); w.y = cvtpkn(kt[2], kt[3]); w.z = cvtpkn(kt[4], kt[5]); w.w = cvtpkn(kt[6], kt[7]); *(GAS v4u*)(gs0 + fo) = w;
                w.x = cvtpkn(rt[0], rt[1]); w.y = cvtpkn(rt[2], rt[3]); w.z = cvtpkn(rt[4], rt[5]); w.w = cvtpkn(rt[6], rt[7]); *(GAS v4u*)(gs1 + fo) = w;
                WKV_SYNC();
                WKV_FENCE();
            } }
        WKV_FENCE();
    }
    WKV_SYNC();
    {
        const float tot = butterfly32(erk, lane); const int t = 32 * (c >> 4) + crow(c & 15, hh);
        if (t < nvalid) ((float*)(F.ws + WS_RK))[(size_t)(row0 + t) * 16 + h] = tot;
    }
    WKV_FENCE();
#define MAKE_ID2(Id) do { int dl_ = dlt; asm volatile("" : "+v"(dl_)); _Pragma("unroll") for (int s_ = 0; s_ < 2; ++s_) { bf16x8 v_; \
        _Pragma("unroll") for (int jj = 0; jj < 8; ++jj) v_[jj] = ((16 * s_ + 8 * (jj >> 2) + (jj & 3)) == dl_) ? (short)0x3F80 : (short)0; \
        Id[s_] = v_; } } while (0)
    f32x16 acc[2][2];
    bf16x8 MbrR[4][2], MkaTR[4][2];
    {
        bf16x8 KtC[4][2];
        { bf16x8 X[4][2], Id2[2]; frag_ld_g(gs0, X, lane); MAKE_ID2(Id2); transpose64(acc, X, Id2); acc2frag(acc, KtC); }
        WKV_FENCE();
        {
            bf16x8 RtC[4][2];
            { bf16x8 X[4][2], Id2[2]; frag_ld_g(gs1, X, lane); MAKE_ID2(Id2); transpose64(acc, X, Id2); acc2frag(acc, RtC); }
            WKV_FENCE();
            WKV_SYNC();
            {
                zero_acc(acc); mm64(acc, KtC, RtC);
#pragma unroll
                for (int m = 0; m < 2; ++m)
#pragma unroll
                    for (int n = 0; n < 2; ++n)
#pragma unroll
                        for (int r = 0; r < 16; ++r) { if (ROW_GT_COL(m, n, r)) acc[m][n][r] = 0.f; }
                bf16x8 MkrR[4][2]; acc2frag(acc, MkrR); frag_st_g(gs2, MkrR, lane);
            }
            WKV_FENCE();
            WKV_SYNC();
            bf16x8 BtC[4][2];
            { bf16x8 X[4][2], Id2[2]; frag_ld_lds(wl + 8192, X, lane); MAKE_ID2(Id2); transpose64(acc, X, Id2); acc2frag(acc, BtC); }
            {
                zero_acc(acc); mm64(acc, BtC, RtC);
#pragma unroll
                for (int m = 0; m < 2; ++m)
#pragma unroll
                    for (int n = 0; n < 2; ++n)
#pragma unroll
                        for (int r = 0; r < 16; ++r) { if (ROW_GT_COL(m, n, r)) acc[m][n][r] = 0.f; }
                acc2frag(acc, MbrR);
            }
            WKV_FENCE();
            WKV_SYNC();
            bf16x8 AtC[4][2];
            { bf16x8 X[4][2], Id2[2]; frag_ld_lds(wl, X, lane); MAKE_ID2(Id2); transpose64(acc, X, Id2); acc2frag(acc, AtC); }
            {
                zero_acc(acc); mm64(acc, AtC, KtC);
#pragma unroll
                for (int m = 0; m < 2; ++m)
#pragma unroll
                    for (int n = 0; n < 2; ++n)
#pragma unroll
                        for (int r = 0; r < 16; ++r) { if (!ROW_GT_COL(m, n, r)) acc[m][n][r] = 0.f; }
                acc2frag(acc, MkaTR);
            }
            WKV_FENCE();
            zero_acc(acc); mm64(acc, BtC, AtC);
        }
    }
    WKV_FENCE();
    WKV_SYNC();
    bf16x8 TR[4][2];
    if (tail) solve_T<true>(acc, TR, lane, false, F.skip); else solve_T<false>(acc, TR, lane, sync, F.skip);
    WKV_FENCE();
    WKV_SYNC();
    if (!(F.skip & 4)) {
    unsigned char* gt_out = F.ws + WS_GT + (size_t)uidx * 8192; unsigned char* ht_out = F.ws + WS_HT + (size_t)uidx * 8192;
    unsigned char* wy_out = F.ws + WS_WYF + (size_t)uidx * 8192; unsigned char* y0_out = F.ws + WS_Y0F + (size_t)uidx * 8192;
    bf16x8 BtL[4][2];
    {
        bf16x8 P1R[4][2];
        { bf16x8 X[4][2]; frag_ld_lds(wl, X, lane); zero_acc(acc); mm64(acc, TR, X); acc2frag(acc, P1R); }
        WKV_FENCE();
        { bf16x8 X[4][2], Id2[2]; frag_ld_g(gs1, X, lane); MAKE_ID2(Id2); transpose64(acc, X, Id2); }
        mm64(acc, P1R, MbrR);
        { bf16x8 WyR[4][2]; acc2frag(acc, WyR); frag_st_g(wy_out, WyR, lane); }
        WKV_FENCE();
        frag_ld_lds(wl + 8192, BtL, lane);
        zero_acc(acc); mm64(acc, P1R, BtL);
#pragma unroll
        for (int m = 0; m < 2; ++m)
#pragma unroll
            for (int n = 0; n < 2; ++n)
#pragma unroll
                for (int s = 0; s < 2; ++s) { float v[8];
#pragma unroll
                    for (int i = 0; i < 8; ++i) v[i] = (acc[m][n][8 * s + i] + ((m == n && KR(8 * s + i) == dlt) ? 1.f : 0.f)) * gC[n];
                    v4u w; w.x = cvtpk(v[0], v[1]); w.y = cvtpk(v[2], v[3]); w.z = cvtpk(v[4], v[5]); w.w = cvtpk(v[6], v[7]);
                    *(GAS v4u*)(gt_out + ((2 * m + s) * 2 + n) * 1024 + lane * 16) = w; }
    }
    WKV_FENCE();
    WKV_SYNC();
    bf16x8 NyR[4][2], HkR[4][2];
    {
        bf16x8 P2TR[4][2];
        zero_acc(acc); mm64(acc, TR, MkaTR); acc2frag(acc, P2TR);
        WKV_FENCE();
        zero_acc(acc); mm64(acc, P2TR, MbrR); acc2frag(acc, NyR);
        WKV_FENCE();
        zero_acc(acc); mm64(acc, P2TR, BtL);
#pragma unroll
        for (int m = 0; m < 2; ++m)
#pragma unroll
            for (int n = 0; n < 2; ++n)
#pragma unroll
                for (int s = 0; s < 2; ++s) { const v4u kw = __builtin_amdgcn_raw_buffer_load_b128(__builtin_amdgcn_make_buffer_rsrc((void*)gs0, (short)0, 8192, 0x00020000), (unsigned)(lane * 16), (unsigned)(((2 * m + s) * 2 + n) * 1024), 16); const unsigned kk4[4] = {kw.x, kw.y, kw.z, kw.w}; unsigned ww[4];
#pragma unroll
                    for (int p = 0; p < 4; ++p) ww[p] = cvtpk((acc[m][n][8 * s + 2 * p] + lo16(kk4[p])) * gC[n], (acc[m][n][8 * s + 2 * p + 1] + hi16(kk4[p])) * gC[n]);
                    HkR[2 * m + s][n] = __builtin_bit_cast(bf16x8, (v4u){ww[0], ww[1], ww[2], ww[3]}); }
    }
    WKV_FENCE();
    WKV_SYNC();
    bf16x8 VtR[4][2];
    { bf16x8 VA[2][4], IdN[2];
#pragma unroll
      for (int m = 0; m < 2; ++m)
#pragma unroll
        for (int s4 = 0; s4 < 4; ++s4) VA[m][s4] = bld128(sD, voA, soV + CA(m, s4));
      make_idn(IdN, c, hh);
#pragma unroll
      for (int m = 0; m < 2; ++m)
#pragma unroll
        for (int n = 0; n < 2; ++n) { f32x16 t = tile_from_rows(VA[m][2 * n], VA[m][2 * n + 1], IdN);
#pragma unroll
            for (int r = 0; r < 16; ++r) if (TPAD(m, r)) t[r] = 0.f;
            mfma_fence1(t);
#pragma unroll
            for (int s = 0; s < 2; ++s) { v4u w; w.x = cvtpk(t[8 * s + 0], t[8 * s + 1]); w.y = cvtpk(t[8 * s + 2], t[8 * s + 3]); w.z = cvtpk(t[8 * s + 4], t[8 * s + 5]); w.w = cvtpk(t[8 * s + 6], t[8 * s + 7]); VtR[2 * m + s][n] = __builtin_bit_cast(bf16x8, w); } } }
    zero_acc(acc);
    { bf16x8 MkrR[4][2]; frag_ld_g(gs2, MkrR, lane); mm64(acc, VtR, MkrR); }
    mm64(acc, VtR, NyR);
#pragma unroll
    for (int m = 0; m < 2; ++m)
#pragma unroll
        for (int n = 0; n < 2; ++n)
#pragma unroll
            for (int q = 0; q < 4; ++q) { const f32x16& a = acc[m][n];
                *(GAS unsigned long long*)(y0_out + ((m * 2 + n) * 4 + q) * 512 + lane * 8) = pack4(a[4 * q], a[4 * q + 1], a[4 * q + 2], a[4 * q + 3]); }
    WKV_FENCE();
    zero_acc(acc); mm64(acc, HkR, VtR);
#pragma unroll
    for (int m = 0; m < 2; ++m)
#pragma unroll
        for (int n = 0; n < 2; ++n)
#pragma unroll
            for (int q = 0; q < 4; ++q) { const f32x16& a = acc[m][n];
                *(GAS unsigned long long*)(ht_out + ((n * 2 + m) * 4 + q) * 512 + lane * 8) = pack4(a[4 * q], a[4 * q + 1], a[4 * q + 2], a[4 * q + 3]); }
    WKV_FENCE();
    }
#undef MAKE_ID2
#undef CE
#undef CW
#undef CA
#undef TPAD
#undef JOK
#undef KR
#undef ROW_GT_COL
}

__device__ __forceinline__ void stageB_unit(Frame& F, int ub, int lane, unsigned* tflag) {
    asm volatile("" : "+v"(lane));
    const int c = lane & 31, hh = lane >> 5;
    const int n0 = ub & 1, bh = ub >> 1;
    const bf16* gt = (const bf16*)(F.ws + WS_GT) + (size_t)bh * NCH * 4096; bf16* ht = (bf16*)(F.ws + WS_HT) + (size_t)bh * NCH * 4096;
    const int nu = 32 * n0 + c;
#if WKV_EXP == 45
    {
        const bf16* ha = gt + (size_t)(NCH - 1) * 4096 + (size_t)nu * 64; const bf16* hx = ht + (size_t)(NCH - 1) * 4096 + (size_t)nu * 64;
        float* so = (float*)(F.ws + WS_WKVP) + (size_t)bh * 4096 + (size_t)nu * 64;
        for (int i = hh; i < 64; i += 2) so[i] += bf2f(ha[i]) - bf2f(hx[i]);
        return;
    }
#endif
    f32x16 S[2]; S[0] = f32x16{}; S[1] = f32x16{};
#ifndef WKB_DEPTH
#define WKB_DEPTH 2
#endif
    v4u gqA[2][4], gqB[2][4]; unsigned long long hqA[2][4], hqB[2][4];
#if WKB_DEPTH == 3
    v4u gqC[2][4]; unsigned long long hqC[2][4];
#endif
    const unsigned char* gtb = (const unsigned char*)gt; unsigned char* htb = (unsigned char*)ht;
#define WKB_LOAD(gq, hq, cc) do { const unsigned char* g_ = gtb + (size_t)(cc) * 8192 + lane * 16; const unsigned char* h_ = htb + (size_t)(cc) * 8192 + n0 * 4096 + lane * 8; \
        _Pragma("unroll") for (int m = 0; m < 2; ++m) { \
            _Pragma("unroll") for (int ks = 0; ks < 4; ++ks) gq[m][ks] = *(const GAS v4u*)(g_ + (ks * 2 + m) * 1024); \
            _Pragma("unroll") for (int q = 0; q < 4; ++q) hq[m][q] = *(const GAS unsigned long long*)(h_ + (m * 4 + q) * 512); } } while (0)
#define WKB_STEP(gq, hq, chv) do { const int ch = (chv); \
        bf16x8 SB[4]; \
        _Pragma("unroll") for (int m = 0; m < 2; ++m) \
            _Pragma("unroll") for (int s = 0; s < 2; ++s) { v4u w; w.x = cvtpkn(S[m][8 * s + 0], S[m][8 * s + 1]); w.y = cvtpkn(S[m][8 * s + 2], S[m][8 * s + 3]); w.z = cvtpkn(S[m][8 * s + 4], S[m][8 * s + 5]); w.w = cvtpkn(S[m][8 * s + 6], S[m][8 * s + 7]); SB[2 * m + s] = __builtin_bit_cast(bf16x8, w); } \
        f32x16 N[2]; \
        _Pragma("unroll") for (int m = 0; m < 2; ++m) \
            _Pragma("unroll") for (int q = 0; q < 4; ++q) { const unsigned long long w = hq[m][q]; N[m][4 * q] = lo16((unsigned)w); N[m][4 * q + 1] = hi16((unsigned)w); N[m][4 * q + 2] = lo16((unsigned)(w >> 32)); N[m][4 * q + 3] = hi16((unsigned)(w >> 32)); } \
        _Pragma("unroll") for (int m = 0; m < 2; ++m) \
            _Pragma("unroll") for (int ks = 0; ks < 4; ++ks) N[m] = __builtin_amdgcn_mfma_f32_32x32x16_bf16(__builtin_bit_cast(bf16x8, gq[m][ks]), SB[ks], N[m], 0, 0, 0); \
        if (ch + WKB_DEPTH < NCH) { \
            if (ch + WKB_DEPTH == NCH - 1) {     \
                while (__hip_atomic_load(tflag, __ATOMIC_RELAXED, __HIP_MEMORY_SCOPE_AGENT) == 0u) __builtin_amdgcn_s_sleep(4); \
                __builtin_amdgcn_fence(__ATOMIC_ACQUIRE, "agent"); } \
            WKB_LOAD(gq, hq, ch + WKB_DEPTH); } \
        if (ch > 0) {     \
            unsigned char* sp = htb + (size_t)(ch - 1) * 8192 + n0 * 4096 + lane * 16; \
            _Pragma("unroll") for (int ks = 0; ks < 4; ++ks) *(GAS bf16x8*)(sp + ks * 1024) = SB[ks]; } \
        mfma_fence2(N[0], N[1]); \
        S[0] = N[0]; S[1] = N[1]; } while (0)
#if WKB_DEPTH == 3
    WKB_LOAD(gqA, hqA, 0); WKB_LOAD(gqB, hqB, 1); WKB_LOAD(gqC, hqC, 2);
    static_assert(NCH == 65, "stage B step schedule");
#pragma unroll 1
    for (int ch0 = 0; ch0 < 63; ch0 += 3) { WKB_STEP(gqA, hqA, ch0); WKB_STEP(gqB, hqB, ch0 + 1); WKB_STEP(gqC, hqC, ch0 + 2); }
    WKB_STEP(gqA, hqA, 63); WKB_STEP(gqB, hqB, 64);
#else
    WKB_LOAD(gqA, hqA, 0); WKB_LOAD(gqB, hqB, 1);
    static_assert(NCH == 65, "stage B step schedule");
#pragma unroll 1
    for (int ch0 = 0; ch0 < 64; ch0 += 2) { WKB_STEP(gqA, hqA, ch0); WKB_STEP(gqB, hqB, ch0 + 1); }
    WKB_STEP(gqA, hqA, 64);
#endif
#undef WKB_STEP
#undef WKB_LOAD
#if WKV_EXP == 2 || WKV_EXP == 4 || WKV_EXP == 10
    float* so = (float*)(F.ws + WS_KST) + (size_t)bh * 4096 + (size_t)nu * 64;
#else
    float* so = (float*)(F.ws + WS_WKVP) + (size_t)bh * 4096 + (size_t)nu * 64;
#endif
#pragma unroll
    for (int m = 0; m < 2; ++m)
#pragma unroll
        for (int q = 0; q < 4; ++q) *(GAS f32x4*)(so + 32 * m + 8 * q + 4 * hh) = (f32x4){S[m][4 * q], S[m][4 * q + 1], S[m][4 * q + 2], S[m][4 * q + 3]};
}

__device__ __forceinline__ void stageC_unit(Frame& F, int uidx, int lane) {
    asm volatile("" : "+v"(lane));
    const int c = lane & 31, hh = lane >> 5;
    const int ch = uidx % NCH, bh = uidx / NCH, h = bh % NH, b = bh / NH;
    const int row0 = b * LP + 64 * ch, nvalid = (LP - 64 * ch) < 64 ? (LP - 64 * ch) : 64;
    const bf16* Vb = (const bf16*)(F.dob + 2 * RKV_STRIDE);
    const bf16* Gb = (const bf16*)(F.ws + WS_G); bf16* og2 = (bf16*)(F.dob + DO_OG2);
    const unsigned char* wyf = F.ws + WS_WYF + (size_t)uidx * 8192; const unsigned char* y0f = F.ws + WS_Y0F + (size_t)uidx * 8192;
    const size_t rbase = (size_t)row0 * DM + h * HD;
    unsigned long long vq[2][2][4], gq[2][2][4]; float rkv[2];
#define WKC_PREF(n) do { rkv[n] = ((const GAS float*)(F.ws + WS_RK))[(size_t)(row0 + 32 * (n) + c) * 16 + h]; \
        _Pragma("unroll") for (int m = 0; m < 2; ++m) \
            _Pragma("unroll") for (int q = 0; q < 4; ++q) { const size_t e = (size_t)(row0 + 32 * (n) + c) * DM + h * HD + 32 * m + 8 * q + 4 * hh; vq[n][m][q] = *(const GAS unsigned long long*)(Vb + e); gq[n][m][q] = *(const GAS unsigned long long*)(Gb + e); } } while (0)
    WKC_PREF(0);
    f32x16 acc[2][2];
#pragma unroll
    for (int m = 0; m < 2; ++m)
#pragma unroll
        for (int n = 0; n < 2; ++n)
#pragma unroll
            for (int q = 0; q < 4; ++q) { const unsigned long long w = *(const GAS unsigned long long*)(y0f + ((m * 2 + n) * 4 + q) * 512 + lane * 8);
                acc[m][n][4 * q] = lo16((unsigned)w); acc[m][n][4 * q + 1] = hi16((unsigned)w); acc[m][n][4 * q + 2] = lo16((unsigned)(w >> 32)); acc[m][n][4 * q + 3] = hi16((unsigned)(w >> 32)); }
    if (ch > 0) {
        const unsigned char* sc = F.ws + WS_HT + (size_t)(uidx - 1) * 8192;
        bf16x8 SA[4][2], WB[4][2];
#pragma unroll
        for (int ks = 0; ks < 4; ++ks)
#pragma unroll
            for (int t = 0; t < 2; ++t) { SA[ks][t] = *(const GAS bf16x8*)(sc + t * 4096 + ks * 1024 + lane * 16); WB[ks][t] = *(const GAS bf16x8*)(wyf + (ks * 2 + t) * 1024 + lane * 16); }
        mm64(acc, SA, WB);
    }
    WKV_FENCE();
    WKC_PREF(1);
#undef WKC_PREF
    float s[2], mean[2], rstd[2];
#pragma unroll
    for (int n = 0; n < 2; ++n) { float t = 0.f;
#pragma unroll
        for (int m = 0; m < 2; ++m)
#pragma unroll
            for (int r = 0; r < 16; ++r) t += acc[m][n][r];
        t += __shfl_xor(t, 32); mean[n] = t * (1.f / 64.f); float v = 0.f;
#pragma unroll
        for (int m = 0; m < 2; ++m)
#pragma unroll
            for (int r = 0; r < 16; ++r) { const float d = acc[m][n][r] - mean[n]; v += d * d; }
        v += __shfl_xor(v, 32); rstd[n] = __builtin_amdgcn_rsqf(v * (1.f / 64.f) + GN_EPS); s[n] = 0.f; }
    (void)s;
#pragma unroll
    for (int n = 0; n < 2; ++n) { const int j = 32 * n + c;
        if (j < nvalid) {
            const float rk = rkv[n];
#pragma unroll
            for (int m = 0; m < 2; ++m)
#pragma unroll
                for (int q = 0; q < 4; ++q) { const int nu0 = h * HD + 32 * m + 8 * q + 4 * hh; const size_t e = (size_t)(row0 + j) * DM + nu0;
                    const f32x4 lg = *(const GAS f32x4*)(F.ln_g + nu0), lb = *(const GAS f32x4*)(F.ln_b + nu0);
                    const unsigned long long vw = vq[n][m][q], gw = gq[n][m][q];
                    const float vv[4] = {lo16((unsigned)vw), hi16((unsigned)vw), lo16((unsigned)(vw >> 32)), hi16((unsigned)(vw >> 32))};
                    const float gg[4] = {lo16((unsigned)gw), hi16((unsigned)gw), lo16((unsigned)(gw >> 32)), hi16((unsigned)(gw >> 32))};
                    float o[4];
#pragma unroll
                    for (int i = 0; i < 4; ++i) { const float yn = (acc[m][n][4 * q + i] - mean[n]) * rstd[n] * lg[i] + lb[i] + rk * vv[i]; o[i] = yn * gg[i] * __builtin_amdgcn_rcpf(1.0f + __builtin_amdgcn_exp2f(-1.4426950408889634f * gg[i])); }
                    *(GAS unsigned long long*)(og2 + e) = (unsigned long long)cvtpkn(o[0], o[1]) | ((unsigned long long)cvtpkn(o[2], o[3]) << 32); } } }
}
}
__device__ __forceinline__ void p8a_wkvA(Frame& F) {
#if WKV_VAR == 7
    if (F.wave >= 2) return;
#pragma unroll 1
    for (int u = F.wave * F.G + F.vcu; u < wkv::NUNITS; u += 2 * F.G) wkv::stageA_unit(F, u, F.lane, F.wave, false, F.wave);
#else
    const bool sync = WKV_LOCKSTEP && (NB * NH * (wkv::NCH - 1)) % (NWAVES * F.G) == 0;
#pragma unroll 1
    for (int u = F.wave * F.G + F.vcu; u < NB * NH * (wkv::NCH - 1); u += NWAVES * F.G) wkv::stageA_unit(F, (u >> 6) * wkv::NCH + (u & 63), F.lane, F.wave, sync, F.wave);
#endif
}
__device__ __forceinline__ void p8b_wkvB(Frame& F, int mode, unsigned* tflags) {
    LAS float* wl = (LAS float*)(F.lds + RING_OFF) + F.wave * 2048;
    static_assert(DSEQ == 4, "wkv_seq4_unit");
    const int NBW = 2 * NB * NH, NTW = NB * NH;
    const bool bwave = (F.wave == 1 && F.vcu < NBW), twave = (F.wave == 2 && F.vcu < NTW);
    if ((mode & 1) && bwave) {
        if (!(F.skip & 16)) wkv::stageB_unit(F, F.vcu, F.lane, tflags + (F.vcu >> 1));
        __builtin_amdgcn_fence(__ATOMIC_RELEASE, "agent");
        if (F.lane == 0) __hip_atomic_fetch_add(tflags + 64 + (F.vcu >> 1), 1u, __ATOMIC_RELAXED, __HIP_MEMORY_SCOPE_AGENT);
    }
    if ((mode & 1) && twave) {
        if (!(F.skip & 8)) wkv::stageA_unit(F, F.vcu * wkv::NCH + (wkv::NCH - 1), F.lane, F.wave, false, 4);
        __builtin_amdgcn_fence(__ATOMIC_RELEASE, "agent");
        if (F.lane == 0) __hip_atomic_store(tflags + F.vcu, 1u, __ATOMIC_RELAXED, __HIP_MEMORY_SCOPE_AGENT);
    }
    const int sid = F.vcu >= NBW ? (F.vcu - NBW) * NWAVES + F.wave : 0;
    const int nslots = (F.G - NBW) * NWAVES;
    const int u_hi = ((mode & 2) && F.vcu >= NBW && !(F.skip & 32)) ? DBATCH * NH : 0;
#pragma unroll 1
    for (int u = sid; u < u_hi; u += nslots) {
        const int sb = u / NH, h = u % NH;
#if WKV_SEQ4
        wkv_seq4_unit(F, wl, MPR + sb * DSEQ, h, F.state_wkv + (size_t)u * 4096, F.out + O_WKVS + (size_t)u * 4096, F.lane);
#else
        wkv_seq_unit(F, wl, MPR + sb * DSEQ, DSEQ, h, F.state_wkv + (size_t)u * 4096, F.out + O_WKVS + (size_t)u * 4096, F.lane);
#endif
    }
}
__device__ __forceinline__ void p8c_wkvC(Frame& F, bool tailmode, unsigned* tflags) {
    int u, uend, ustep;
    if (tailmode) {
        const bool twave = (F.wave == 2 && F.vcu < NB * NH);
        u = F.vcu; uend = (twave && !(F.skip & 8)) ? F.vcu + 1 : 0; ustep = 1;
        if (twave) { while (__hip_atomic_load(tflags + 64 + F.vcu, __ATOMIC_RELAXED, __HIP_MEMORY_SCOPE_AGENT) < 2u) __builtin_amdgcn_s_sleep(8);
            __builtin_amdgcn_fence(__ATOMIC_ACQUIRE, "agent"); }
    } else { u = F.wave * F.G + F.vcu; uend = NB * NH * (wkv::NCH - 1); ustep = NWAVES * F.G; }
#pragma unroll 1
    for (; u < uend; u += ustep) wkv::stageC_unit(F, tailmode ? u * wkv::NCH + (wkv::NCH - 1) : (u >> 6) * wkv::NCH + (u & 63), F.lane);
}
#ifndef PROBE_REPS
#define PROBE_REPS 0
#define PROBE_PHASE 0
#endif
#ifndef WKV_FLOW
#define WKV_FLOW 0
#endif
#ifndef PROBE_STEP
#define PROBE_STEP 0
#endif
#ifndef WKV_ZERO_ROWS
#define WKV_ZERO_ROWS 0
#endif
#ifndef WKV_DELAY
#define WKV_DELAY 0
#endif
#ifndef WKV_EXP
#define WKV_EXP 0
#endif
#ifndef MK_ONE_LAUNCH
#define MK_ONE_LAUNCH 1
#endif
constexpr int N_PHASES = 11;
struct Args { const float* in[27]; float* out; unsigned char* ws; int ph_lo, ph_hi, li, pad; };
__device__ __forceinline__ bool in_phase(int lo, int hi, int k) { asm volatile("" : "+s"(lo), "+s"(hi)); return lo <= k && k < hi; }
__global__ void __launch_bounds__(NWAVES * 64, 2) mega_fwd(Args args) {
    extern __shared__ __attribute__((aligned(16))) unsigned char lds[];
    Frame F;
    F.lds = (LAS unsigned char*)lds;
    F.MISC = (volatile LAS unsigned*)(F.lds + MISC_OFF);
    F.tid = threadIdx.x; F.lane = F.tid & 63; F.wave = __builtin_amdgcn_readfirstlane(F.tid >> 6);
    F.G = gridDim.x; { const int bx = blockIdx.x; F.vcu = (F.G % 8 == 0) ? (bx % 8) * (F.G / 8) + bx / 8 : bx; }
    F.ws = args.ws; F.out = args.out; F.dob = (unsigned char*)args.out;
    F.ctl = (gu32*)(F.ws + WS_CTL); F.skip = args.pad >> 8;
    F.xp = args.in[0]; F.xs = args.in[1]; F.cache_k = args.in[2]; F.cache_v = args.in[3]; F.state_wkv = args.in[4]; F.state_shift = args.in[5];
    F.meta = args.in[6]; F.table = args.in[7]; F.norm_gain = args.in[8]; F.final_gain = args.in[9]; F.a_w_in = args.in[10]; F.sinks = args.in[11]; F.a_w_out = args.in[12];
    F.mu = args.in[13]; F.r_w_in = args.in[14]; F.w0 = args.in[15]; F.w1 = args.in[16]; F.w2 = args.in[17]; F.a0 = args.in[18]; F.a1 = args.in[19]; F.a2 = args.in[20];
    F.k_k = args.in[21]; F.k_a = args.in[22]; F.r_k = args.in[23]; F.ln_g = args.in[24]; F.ln_b = args.in[25]; F.r_w_out = args.in[26];
    for (int u = F.tid; u < (LDS_BYTES - LDSCTL_OFF) / 4; u += NWAVES * 64) ((LAS unsigned*)(F.lds + LDSCTL_OFF))[u] = 0u;
    __syncthreads();
    XcdBarrier bar; bar.bar = (unsigned*)(F.ctl + CW_BAR) + args.li * XCD_BAR_WORDS; bar.x = 0; bar.st = nullptr;
    const int lo = args.ph_lo, hi = args.ph_hi;
    if (hi - lo > 1 || lo == 8) bar = xcd_barrier_post((unsigned*)(F.ctl + CW_BAR) + args.li * XCD_BAR_WORDS, F.MISC + 8);
#define flow (WKV_FLOW && (gridDim.x == 256) && (args.ph_hi - args.ph_lo > 1))
#define rc2 ((unsigned*)(args.ws + WS_CTL) + CW_RC2 + args.li * 256)
#define rc4 ((unsigned*)(args.ws + WS_CTL) + CW_RC4 + args.li * 256)
#define IN(k) (lo <= (k) && (k) < hi)
#define SEAM(k) do { if (IN(k) && IN((k) + 1)) xcd_barrier(bar); } while (0)
    bf16* XA = (bf16*)(F.ws + WS_XA); bf16* QKVG = (bf16*)(F.ws + WS_QKVG); bf16* H1 = (bf16*)(F.ws + WS_H1);
    bf16* Rb = (bf16*)(F.dob); bf16* Kb = (bf16*)(F.dob + RKV_STRIDE); bf16* Vb = (bf16*)(F.dob + 2 * RKV_STRIDE); bf16* Gb = (bf16*)(F.ws + WS_G);

    if (IN(0)) { p0_prologue(F, 2, F.vcu * NWAVES + F.wave, F.G * NWAVES); } SEAM(0);
    if (IN(1)) {
        pg8::Gemm g{XA, (const bf16*)(F.ws + WS_WAIN), MPAD, LDQ, DM, 1 << 30, 0}; pg8::StaticOrder S; S.init(MPAD, LDQ, F.G, (int)blockIdx.x);
        pg8::EpiBf16G E{QKVG, QKVG, QKVG, QKVG, LDQ, 64, MPAD, 4, QSCALE};
        pg8::gemm_phase<pg8::EpiBf16G, pg8::StaticOrder, true, true>(F.lds + RING_OFF, g, S, E);
    } SEAM(1);
    if (IN(2)) { p2_attention(F); } SEAM(2);
    if (IN(3)) {
        pg8::Gemm g{XA, (const bf16*)(F.ws + WS_WAOUT), MPAD, DM, DM, 1 << 30, 0};
        pg8::EpiResB E{nullptr, H1, F.meta, F.xp, F.xs, MTOK};
        if (flow) { pg8::SplitOrder S; S.init(MPAD, DM, F.G, (int)blockIdx.x, rc2); pg8::gemm_phase<pg8::EpiResB, pg8::SplitOrder, true, true>(F.lds + RING_OFF, g, S, E); }
        else { pg8::StaticOrder S; S.init(MPAD, DM, F.G, (int)blockIdx.x); pg8::gemm_phase<pg8::EpiResB, pg8::StaticOrder, true, true>(F.lds + RING_OFF, g, S, E); }
    } if (IN(3) && IN(4) && !flow) xcd_barrier(bar);
    if (IN(4)) { p4_mix(F); } if (IN(4) && IN(6)) xcd_barrier(bar);
    if (IN(6)) {
        {
            pg8::Gemm g{(const bf16*)(F.ws + WS_MIX), (const bf16*)(F.ws + WS_WRIN), MPAD, 4 * DM, DM, 4, MIX_STRIDE};
            pg8::EpiBf16G E{Rb, Kb, Vb, Gb, DM, 4, MTOK, 0, 1.f};
            const int bx = (int)blockIdx.x; const int uq = bx < 48 ? bx : (bx < 113 ? -1 : (bx < 120 ? 48 + (bx - 113) : (bx < 123 ? -1 : 55 + (bx - 123))));
            if (F.G == 256) { pg8::TailFreeOrder S; S.init(MPAD, 4 * DM, F.G, bx, uq, 188); pg8::gemm_phase<pg8::EpiBf16G, pg8::TailFreeOrder, true, true>(F.lds + RING_OFF, g, S, E); }
            else { pg8::StaticOrder S; S.init(MPAD, 4 * DM, F.G, bx); pg8::gemm_phase<pg8::EpiBf16G, pg8::StaticOrder, true, true>(F.lds + RING_OFF, g, S, E); }
        }
        __syncthreads();
        if (!(F.skip & 128))
        {
            const int rot = (((MPAD / 256) * (4 * DM / 256)) % F.G + 7) & ~7;
            const int cid = ((int)blockIdx.x - rot + 4 * F.G) % F.G;
            pg8::Gemm g{(const bf16*)(F.dob + DO_XN1), (const bf16*)(F.ws + WS_W1A1), U_SROW, 256, DM, 1 << 30, 0}; pg8::StaticOrder S; S.init(U_SROW, 256, F.G, cid);
            pg8::EpiF32 E{(float*)(F.ws + WS_U), 256};
            pg8::gemm_phase<pg8::EpiF32, pg8::StaticOrder, true, true>(F.lds + RING_OFF, g, S, E);
            __syncthreads();
            pg8::Gemm g2{(const bf16*)(F.ws + WS_XN1S), (const bf16*)(F.ws + WS_W1A1), 768, 256, DM, 1 << 30, 0}; pg8::StaticOrder S2; S2.init(768, 256, F.G, (cid - 72 + F.G) % F.G);
            pg8::EpiF32 E2{(float*)(F.ws + WS_U) + (size_t)U_SROW * 256, 256};
            pg8::gemm_phase<pg8::EpiF32, pg8::StaticOrder, true, true>(F.lds + RING_OFF, g2, S2, E2);
        }
    } if (IN(6) && IN(7)) xcd_barrier(bar);
    if (IN(7)) { p5_lora1_combine(F); } SEAM(7);
    if (IN(8)) {
#if WKV_EXP == 40 || WKV_EXP == 45
        const int nst = 4; const int prog[4] = {3, 6, 0, 1};
#elif WKV_EXP >= 30
        const int nst = 3; const int prog[4] = {3, 0, 1, 1};
#elif WKV_EXP == 21
        const int nst = 4; const int prog[4] = {0, 1, 2, 4};
#elif WKV_EXP == 0
        const int nst = 3; const int prog[4] = {0, 1, 2, 2};
#elif WKV_EXP == 1
        const int nst = 3; const int prog[4] = {3, 0, 1, 1};
#elif WKV_EXP == 16 || WKV_EXP == 19
        const int nst = 2; const int prog[4] = {3, 1, 1, 1};
#elif WKV_EXP == 10
        const int nst = 4; const int prog[4] = {3, 0, 4, 5};
#elif WKV_EXP == 5 || WKV_EXP == 12
        const int nst = 3; const int prog[4] = {3, 0, 4, 4};
#elif WKV_EXP == 4 || WKV_EXP == 7 || WKV_EXP == 8 || WKV_EXP == 14 || WKV_EXP == 15
        const int nst = 3; const int prog[4] = {3, 0, 1, 1};
#elif WKV_EXP == 2
        const int nst = 4; const int prog[4] = {3, 0, 1, 2};
#else
        const int nst = 2; const int prog[4] = {3, 4, 4, 4};
#endif
#pragma unroll 1
        for (int st = 0; st < nst; ++st) {
            const int kind = st == 0 ? prog[0] : st == 1 ? prog[1] : st == 2 ? prog[2] : prog[3];
            if ((args.pad & 255) && st + 1 != (args.pad & 255)) continue;
            unsigned* tflags = (unsigned*)(F.ctl + CW_TFLAG) + args.li * 128;
            if (kind == 0) p8a_wkvA(F);
            else { if (kind != 2) p8b_wkvB(F, 3, tflags); p8c_wkvC(F, kind != 2, tflags); }
            if (st + 1 < nst && !args.pad) xcd_barrier(bar);
        }
    } SEAM(8);
#if WKV_ZERO_ROWS
    if (blockIdx.x == 0) { bf16* o_ = (bf16*)(F.ws + WS_OG2) + (size_t)16864 * DM; for (int i = F.tid; i < 32 * DM; i += NWAVES * 64) o_[i] = 0; }
    xcd_barrier(bar);
#endif
#if WKV_DELAY
    { const unsigned long long t0_ = __builtin_amdgcn_s_memrealtime(); while (__builtin_amdgcn_s_memrealtime() - t0_ < 20000ull) __builtin_amdgcn_s_sleep(8); }
#endif
    if (IN(9)) {
        pg8::Gemm g{(const bf16*)(F.dob + DO_OG2), (const bf16*)(F.ws + WS_WROUT), MPAD, DM, DM, 1 << 30, 0};
        pg8::EpiResB E{H1, H1, F.meta, F.xp, F.xs, MTOK};
        if (flow) { pg8::SplitOrder S; S.init(MPAD, DM, F.G, (int)blockIdx.x, rc4); pg8::gemm_phase<pg8::EpiResB, pg8::SplitOrder, true, true>(F.lds + RING_OFF, g, S, E); }
        else { pg8::StaticOrder S; S.init(MPAD, DM, F.G, (int)blockIdx.x); pg8::gemm_phase<pg8::EpiResB, pg8::StaticOrder, true, true>(F.lds + RING_OFF, g, S, E); }
    } if (IN(9) && IN(10) && !flow) xcd_barrier(bar);
#ifdef EXTRA_BARRIERS
    if (hi - lo > 1) { for (int e_ = 0; e_ < EXTRA_BARRIERS; ++e_) xcd_barrier(bar); }
#endif
    if (IN(10)) { p8_final(F); }
#undef IN
#undef SEAM
}

extern "C" void kernel_launch(void* const* d_in, const int* in_sizes, int n_in, void* d_out, int out_size, void* d_ws, size_t ws_size, hipStream_t stream) {
    static int grid = 0;
    if (grid == 0) {
        if (n_in != 27 || (size_t)out_size != O_END || ws_size < WS_END) { fprintf(stderr, "kernel_launch: unexpected shapes n_in %d out %d ws %zu\n", n_in, out_size, ws_size); grid = -1; return; }
        int dev = 0, cus = 0, per_cu = 0;
        if (hipGetDevice(&dev) != hipSuccess || hipDeviceGetAttribute(&cus, hipDeviceAttributeMultiprocessorCount, dev) != hipSuccess) { grid = -1; return; }
        if (hipFuncSetAttribute((const void*)mega_fwd, hipFuncAttributeMaxDynamicSharedMemorySize, LDS_BYTES) != hipSuccess) { fprintf(stderr, "kernel_launch: hipFuncSetAttribute failed\n"); grid = -1; return; }
        if (hipOccupancyMaxActiveBlocksPerMultiprocessor(&per_cu, (const void*)mega_fwd, NWAVES * 64, LDS_BYTES) != hipSuccess || per_cu < 1) fprintf(stderr, "kernel_launch: occupancy query says %d\n", per_cu);
        (void)hipGetLastError();
        grid = cus;
    }
    if (grid < 0) return;
    if (hipMemsetAsync((char*)d_ws + WS_CTL, 0, CTL_ZERO_BYTES, stream) != hipSuccess) return;
    Args a{};
    for (int i = 0; i < 27; ++i) a.in[i] = (const float*)d_in[i];
    a.out = (float*)d_out; a.ws = (unsigned char*)d_ws;
#if PROBE_REPS > 0
    for (int r_ = 0; r_ < PROBE_REPS; ++r_) { a.ph_lo = PROBE_PHASE; a.ph_hi = PROBE_PHASE + 1; a.li = 1 + r_; a.pad = PROBE_STEP; hipLaunchKernelGGL(mega_fwd, dim3(grid), dim3(NWAVES * 64), LDS_BYTES, stream, a); }
#endif
#if MK_ONE_LAUNCH
    a.ph_lo = 0; a.ph_hi = N_PHASES; a.li = 0; a.pad = 0;
    hipLaunchKernelGGL(mega_fwd, dim3(grid), dim3(NWAVES * 64), LDS_BYTES, stream, a);
#else
    for (int p = 0; p < N_PHASES; ++p) { a.ph_lo = p; a.ph_hi = p + 1; a.li = p;
        hipLaunchKernelGGL(mega_fwd, dim3(grid), dim3(NWAVES * 64), LDS_BYTES, stream, a); }
#endif
}
```

```cpp
#include <hip/hip_runtime.h>
#include <cstdio>
#include <cstdint>
#define WKV_EXP 0
#define WKV_DUMP_T 4096
#define WKV_VAR 0
#define WKV_SUB 0
#define PROBE_PHASE 0
#define PROBE_REPS 0
#define PROBE_STEP 0
namespace pg8 {
#define PG8_LAS __attribute__((address_space(3)))
typedef unsigned short bf16_t;
typedef short bf16x8 __attribute__((ext_vector_type(8)));
typedef float f32x4 __attribute__((ext_vector_type(4)));
typedef unsigned u32x4 __attribute__((ext_vector_type(4)));
constexpr int BM = 256, BK = 64, HALF = 128, HTB = HALF * BK * 2  , STAGE_BYTES = 8 * HTB, NXCD = 8, WGM = 8;

__host__ __device__ __forceinline__ int lds_byte(int r, int c) { const int st = (r >> 4) * 2 + (c >> 5), rr = r & 15, cc = c & 31, ob = rr * 64 + cc * 2; return st * 1024 + (ob ^ (((ob >> 9) & 1) << 5)); }
__host__ __device__ __forceinline__ void stage_rc(int b, int& R, int& C) { const int st = b / 1024, sb = b % 1024, swz = sb ^ (((sb >> 9) & 1) << 5); R = (st >> 1) * 16 + swz / 64; C = (st & 1) * 32 + (swz % 64) / 2; }
__host__ __device__ __forceinline__ int perm32(int rho) { const int n = rho >> 4, i = rho & 15; return 8 * (i >> 2) + 4 * n + (i & 3); }

struct Unit { int pm, pn; };
struct Gemm { const bf16_t* A; const bf16_t* Bt; int M, N, K; int gdiv; size_t a_gstride; };

struct SplitOrder;
struct StaticOrder {
    int nM, nN, nwg, G, c;
    __host__ __device__ void init(int M, int N, int G_, int c_) { nM = M / BM; nN = N / BM; nwg = nM * nN; G = G_; c = c_; }
    __host__ __device__ bool next(int i, Unit& u) const {
        const long L = (long)i * G + c; if (L >= nwg) return false;
        int wgid = (int)L; { const int q = nwg / NXCD, r = nwg % NXCD, xcd = wgid % NXCD, off = wgid / NXCD; wgid = (xcd < r ? xcd * (q + 1) : r * (q + 1) + (xcd - r) * q) + off; }
        const int nig = WGM * nN, gid = wgid / nig, fm = gid * WGM, gsz = (nM - fm) < WGM ? (nM - fm) : WGM;
        u.pm = fm + ((wgid % nig) % gsz); u.pn = (wgid % nig) / gsz; return true;
    }
    __device__ __forceinline__ void a_ready(const Unit&) const {}
    __device__ __forceinline__ void done(const Unit&) const {}
};
struct TailFreeOrder {
    StaticOrder a, lin; int q, nq, base;
    __device__ void init(int M, int N, int G_, int c_, int q_, int nq_) { a.init(M, N, G_, c_); lin.init(M, N, 1, 0); q = q_; nq = nq_; base = 3 * G_; }
    __device__ bool next(int i, Unit& u) const {
        if (i < 3) return a.next(i, u);
        if (q < 0) return false;
        const int L = base + (i - 3) * nq + q; if (L >= a.nwg) return false;
        return lin.next(L, u);
    }
    __device__ __forceinline__ void a_ready(const Unit&) const {}
    __device__ __forceinline__ void done(const Unit&) const {}
};
struct CountOrder {
    StaticOrder a; unsigned* cnt;
    __device__ void init(int M, int N, int G_, int c_, unsigned* cnt_) { a.init(M, N, G_, c_); cnt = cnt_; }
    __device__ bool next(int i, Unit& u) const { return a.next(i, u); }
    __device__ __forceinline__ void a_ready(const Unit&) const {}
    __device__ __forceinline__ void done(const Unit&) const {
        __syncthreads();
        if (threadIdx.x < 64) { __builtin_amdgcn_fence(__ATOMIC_RELEASE, "agent"); if (threadIdx.x == 0) __hip_atomic_fetch_add(cnt, 1u, __ATOMIC_RELAXED, __HIP_MEMORY_SCOPE_AGENT); }
    }
};
struct SplitOrder {
    StaticOrder a, b; int nMa; unsigned* cnt; int mode;
    __device__ void init(int M, int N, int G_, int c_, unsigned* cnt_, int mode_ = 0) { const int nN = N / BM; nMa = G_ / nN; a.init(nMa * BM, N, G_, c_); b.init(M - nMa * BM, N, G_, c_); cnt = cnt_; mode = mode_; }
    __device__ bool next(int i, Unit& u) const {
        if (mode == 1) return i == 0 ? a.next(0, u) : false;
        if (mode == 2) { const bool ok = b.next(i, u); u.pm += nMa; return ok; }
        if (i == 0) return a.next(0, u); const bool ok = b.next(i - 1, u); u.pm += nMa; return ok; }
    __device__ __forceinline__ void a_ready(const Unit&) const {}
    __device__ __forceinline__ void done(const Unit& u) const {
        if (cnt == nullptr) return;
        __syncthreads();
        if (threadIdx.x < 64) { __builtin_amdgcn_fence(__ATOMIC_RELEASE, "agent");
            if (threadIdx.x == 0) __hip_atomic_fetch_add(cnt + u.pm, 1u, __ATOMIC_RELAXED, __HIP_MEMORY_SCOPE_AGENT); }
    }
};

__device__ __forceinline__ unsigned cvt_pk_bf16(float lo, float hi) { unsigned r; asm volatile("v_cvt_pk_bf16_f32 %0, %1, %2" : "=v"(r) : "v"(lo), "v"(hi)); return r; }
struct EpiBf16G {
    static constexpr bool PERM = true, AFTER_DRAIN = false;
    bf16_t *O0, *O1, *O2, *O3; int ldc, tpg, Mvalid, scale_tiles; float scale0;
    __device__ __forceinline__ void operator()(const f32x4 (&acc)[2][2][4][2], const Unit& u, int wr, int wc, int fr, int fq) const {
        const int grp = u.pn / tpg, colt = (u.pn - grp * tpg) * BM;
        bf16_t* base = grp == 0 ? O0 : grp == 1 ? O1 : grp == 2 ? O2 : O3;
        const float sc = (u.pn < scale_tiles) ? scale0 : 1.f;
        const int row0 = u.pm * BM + wr * 64 + fr, col0 = colt + wc * 32 + 8 * fq;
#pragma unroll
        for (int ai = 0; ai < 2; ++ai)
#pragma unroll
            for (int m = 0; m < 4; ++m) { const int row = row0 + ai * HALF + m * 16; const unsigned roff = (unsigned)(((size_t)row * ldc + col0) * 2);
                if (row < Mvalid) {
#pragma unroll
                for (int bj = 0; bj < 2; ++bj) { const f32x4 v0 = acc[ai][bj][m][0] * sc, v1 = acc[ai][bj][m][1] * sc;
                    u32x4 w; w.x = cvt_pk_bf16(v0[0], v0[1]); w.y = cvt_pk_bf16(v0[2], v0[3]); w.z = cvt_pk_bf16(v1[0], v1[1]); w.w = cvt_pk_bf16(v1[2], v1[3]);
                    *(u32x4*)((char*)base + roff + bj * HALF * 2) = w; } } }
    }
};
struct EpiRes {
    static constexpr bool PERM = false, AFTER_DRAIN = false;
    const float* base; float* out; const float *meta, *xp, *xs; int Mvalid;
    __device__ __forceinline__ void operator()(const f32x4 (&acc)[2][2][4][2], const Unit& u, int wr, int wc, int fr, int fq) const {
        const int row0 = u.pm * BM + wr * 64 + fr, col0 = u.pn * BM + wc * 32 + 4 * fq;
#pragma unroll
        for (int ai = 0; ai < 2; ++ai)
#pragma unroll
            for (int m = 0; m < 4; ++m) { const int row = row0 + ai * HALF + m * 16;
                if (row < Mvalid) {
                    const float* b;
                    if (base) b = base + (size_t)row * 1024;
                    else if (row < 16448) { const int bb = row / 4112, t = row - bb * 4112; b = t < 16 ? meta + t * 1024 : xp + ((size_t)bb * 4096 + (t - 16)) * 1024; }
                    else b = xs + (size_t)(row - 16448) * 1024;
                    float* o = out + (size_t)row * 1024;
#pragma unroll
                    for (int bj = 0; bj < 2; ++bj)
#pragma unroll
                        for (int n = 0; n < 2; ++n) { const int c = col0 + bj * HALF + n * 16; const f32x4 r = *(const f32x4*)(b + c); *(f32x4*)(o + c) = r + acc[ai][bj][m][n]; } } }
    }
};

struct EpiResB {
    static constexpr bool PERM = true, AFTER_DRAIN = false;
    const bf16_t* base; bf16_t* out; const float *meta, *xp, *xs; int Mvalid;
    __device__ __forceinline__ void operator()(const f32x4 (&acc)[2][2][4][2], const Unit& u, int wr, int wc, int fr, int fq) const {
        const int row0 = u.pm * BM + wr * 64 + fr, col0 = u.pn * BM + wc * 32 + 8 * fq;
#pragma unroll
        for (int ai = 0; ai < 2; ++ai)
#pragma unroll
            for (int m = 0; m < 4; ++m) { const int row = row0 + ai * HALF + m * 16;
                if (row < Mvalid) {
                    const unsigned ooff = (unsigned)(((size_t)row * 1024 + col0) * 2);
                    if (base) {
                        const bf16_t* b = base + (size_t)row * 1024 + col0;
#pragma unroll
                        for (int bj = 0; bj < 2; ++bj) { const u32x4 rw = *(const u32x4*)(b + bj * HALF); const f32x4 a0 = acc[ai][bj][m][0], a1 = acc[ai][bj][m][1]; u32x4 w;
                            w.x = cvt_pk_bf16(a0[0] + __builtin_bit_cast(float, rw.x << 16), a0[1] + __builtin_bit_cast(float, rw.x & 0xffff0000u));
                            w.y = cvt_pk_bf16(a0[2] + __builtin_bit_cast(float, rw.y << 16), a0[3] + __builtin_bit_cast(float, rw.y & 0xffff0000u));
                            w.z = cvt_pk_bf16(a1[0] + __builtin_bit_cast(float, rw.z << 16), a1[1] + __builtin_bit_cast(float, rw.z & 0xffff0000u));
                            w.w = cvt_pk_bf16(a1[2] + __builtin_bit_cast(float, rw.w << 16), a1[3] + __builtin_bit_cast(float, rw.w & 0xffff0000u));
                            *(u32x4*)((char*)out + ooff + bj * HALF * 2) = w; }
                    } else {
                        const float* b;
                        if (row < 16448) { const int bb = row / 4112, t = row - bb * 4112; b = t < 16 ? meta + t * 1024 : xp + ((size_t)bb * 4096 + (t - 16)) * 1024; }
                        else b = xs + (size_t)(row - 16448) * 1024;
                        b += col0;
#pragma unroll
                        for (int bj = 0; bj < 2; ++bj) { const f32x4 r0 = *(const f32x4*)(b + bj * HALF), r1 = *(const f32x4*)(b + bj * HALF + 4); const f32x4 v0 = acc[ai][bj][m][0] + r0, v1 = acc[ai][bj][m][1] + r1; u32x4 w;
                            w.x = cvt_pk_bf16(v0[0], v0[1]); w.y = cvt_pk_bf16(v0[2], v0[3]); w.z = cvt_pk_bf16(v1[0], v1[1]); w.w = cvt_pk_bf16(v1[2], v1[3]);
                            *(u32x4*)((char*)out + ooff + bj * HALF * 2) = w; }
                    } } }
    }
};

struct EpiT12 {
    static constexpr bool PERM = false, AFTER_DRAIN = false;
    float* t12; int Mvalid; unsigned char* t12b;
    __device__ __forceinline__ void operator()(const f32x4 (&acc)[2][2][4][2], const Unit& u, int wr, int wc, int fr, int fq) const {
        if (wc >= 2) return;
        const int row0 = u.pm * BM + wr * 64 + fr, col0 = wc * 32 + 4 * fq;
#pragma unroll
        for (int ai = 0; ai < 2; ++ai)
#pragma unroll
            for (int m = 0; m < 4; ++m) { const int row = row0 + ai * HALF + m * 16;
                if (row < Mvalid) {
                    float* o = t12 + (size_t)row * 128 + u.pn * 64 + col0;
                    const int bb = row / 4112, t = row - bb * 4112;
                    unsigned char* ob = t12b + ((size_t)((bb * 129 + (t >> 5)) * 8 + u.pn * 4) * 64 + (t & 31)) * 16;
#pragma unroll
                    for (int n = 0; n < 2; ++n) { f32x4 v = acc[ai][0][m][n];
                        if (u.pn == 0) { v[0] = tanhf(v[0]); v[1] = tanhf(v[1]); v[2] = tanhf(v[2]); v[3] = tanhf(v[3]); }
                        *(f32x4*)(o + n * 16) = v;
                        if (row < 16448) { const int j = col0 + n * 16;
                            *(unsigned long long*)(ob + ((j >> 4) * 64 + 32 * ((j >> 3) & 1)) * 16 + (j & 7) * 2) = (unsigned long long)cvt_pk_bf16(v[0], v[1]) | ((unsigned long long)cvt_pk_bf16(v[2], v[3]) << 32); } } } }
    }
};

struct EpiF32 {
    static constexpr bool PERM = false, AFTER_DRAIN = false;
    float* out; int ldc;
    __device__ __forceinline__ void operator()(const f32x4 (&acc)[2][2][4][2], const Unit& u, int wr, int wc, int fr, int fq) const {
        const int row0 = u.pm * BM + wr * 64 + fr, col0 = u.pn * BM + wc * 32 + 4 * fq;
#pragma unroll
        for (int ai = 0; ai < 2; ++ai)
#pragma unroll
            for (int m = 0; m < 4; ++m) { const int row = row0 + ai * HALF + m * 16; const unsigned ooff = (unsigned)(((size_t)row * ldc + col0) * 4);
#pragma unroll
                for (int bj = 0; bj < 2; ++bj)
#pragma unroll
                    for (int n = 0; n < 2; ++n) *(f32x4*)((char*)out + ooff + (bj * HALF + n * 16) * 4) = acc[ai][bj][m][n]; }
    }
};
template <class Epi, class Sched, bool ALIGN_EPI = false, bool SP2 = false>
__device__ __forceinline__ void gemm_phase(PG8_LAS unsigned char* lds, const Gemm g, const Sched& S, const Epi& E) {
    const int tid = threadIdx.x, wid = __builtin_amdgcn_readfirstlane(tid >> 6), lane = tid & 63, wr = wid >> 2, wc = wid & 3, fr = lane & 15, fq = lane >> 4;
    const int K = g.K, nt = K / BK;
    unsigned voffA[2], voffB[2];
#pragma unroll
    for (int i = 0; i < 2; ++i) { int R, C; stage_rc(tid * 16 + i * 8192, R, C); const int Rb = Epi::PERM ? ((R & ~31) + perm32(R & 31)) : R;
        voffA[i] = (unsigned)(R * K + C) * 2u; voffB[i] = (unsigned)(Rb * K + C) * 2u; }
    const size_t kstep = (size_t)(BK * 2);
    const size_t hstep = (size_t)HALF * K * 2;
    const size_t tstep = 2 * hstep;
    const unsigned ldsw = (unsigned)wid * 1024u;
    const int aoff = lds_byte(wr * 64 + fr, fq * 8), boff = lds_byte(wc * 32 + fr, fq * 8);
#define PG8_SA(b, h) (((b) * 2 + (h)) * HTB)
#define PG8_SB(b, h) ((4 + (b) * 2 + (h)) * HTB)
#define PG8_STAGE(bufoff, gbase, voff) do { _Pragma("unroll") for (int _i = 0; _i < 2; ++_i) \
        __builtin_amdgcn_global_load_lds((const unsigned*)((const char*)(gbase) + (voff)[_i]), (PG8_LAS unsigned*)(lds + (bufoff) + ldsw + _i * 8192), 16, 0, 0); } while (0)
#define PG8_LDA(dst, b, h) do { _Pragma("unroll") for (int m = 0; m < 4; ++m) _Pragma("unroll") for (int k = 0; k < 2; ++k) dst[m][k] = *(const PG8_LAS bf16x8*)(lds + PG8_SA(b, h) + aoff + m * 2048 + k * 1024); } while (0)
#define PG8_LDB(dst, b, h) do { _Pragma("unroll") for (int n = 0; n < 2; ++n) _Pragma("unroll") for (int k = 0; k < 2; ++k) dst[n][k] = *(const PG8_LAS bf16x8*)(lds + PG8_SB(b, h) + boff + n * 2048 + k * 1024); } while (0)
#define PG8_MMA(ai, bj, At, Bt) do { __builtin_amdgcn_s_setprio(1); _Pragma("unroll") for (int m = 0; m < 4; ++m) _Pragma("unroll") for (int n = 0; n < 2; ++n) _Pragma("unroll") for (int k = 0; k < 2; ++k) \
        acc[ai][bj][m][n] = __builtin_amdgcn_mfma_f32_16x16x32_bf16(Bt[n][k], At[m][k], acc[ai][bj][m][n], 0, 0, 0); __builtin_amdgcn_s_setprio(0); } while (0)
#define PG8_WAIT_V(n) asm volatile("s_waitcnt vmcnt(" #n ")" ::: "memory")
#define PG8_WAIT_L(n) asm volatile("s_waitcnt lgkmcnt(" #n ")" ::: "memory")
#define PG8_BAR __builtin_amdgcn_s_barrier()
#define PG8_SCHED __builtin_amdgcn_sched_barrier(0)
    Unit cur, nxt; int ui = 0;
    if (!S.next(0, cur)) return;
    f32x4 acc[2][2][4][2];
#pragma unroll
    for (int a = 0; a < 2; ++a)
#pragma unroll
        for (int b = 0; b < 2; ++b)
#pragma unroll
            for (int m = 0; m < 4; ++m)
#pragma unroll
                for (int n = 0; n < 2; ++n) acc[a][b][m][n] = (f32x4){0.f, 0.f, 0.f, 0.f};
    bf16x8 At[4][2], B0[2][2], B1[2][2];
    const char* cA = (const char*)g.A + (size_t)(cur.pn / g.gdiv) * g.a_gstride + (size_t)cur.pm * tstep; const char* cB = (const char*)g.Bt + (size_t)cur.pn * tstep;
    S.a_ready(cur);
    if constexpr (SP2) {
        PG8_STAGE(PG8_SB(0, 0), cB, voffB); PG8_STAGE(PG8_SB(0, 1), cB + hstep, voffB); PG8_STAGE(PG8_SA(0, 0), cA, voffA); PG8_STAGE(PG8_SA(0, 1), cA + hstep, voffA);
        if (wr == 1) PG8_BAR;
        PG8_WAIT_V(2); PG8_BAR;
        PG8_STAGE(PG8_SB(1, 0), cB + kstep, voffB); PG8_STAGE(PG8_SA(1, 0), cA + kstep, voffA); PG8_STAGE(PG8_SB(1, 1), cB + hstep + kstep, voffB);
        PG8_WAIT_V(6); PG8_BAR;
    } else {
        PG8_STAGE(PG8_SB(0, 0), cB, voffB); PG8_STAGE(PG8_SA(0, 0), cA, voffA); PG8_STAGE(PG8_SB(0, 1), cB + hstep, voffB); PG8_STAGE(PG8_SA(0, 1), cA + hstep, voffA);
        if (wr == 1) PG8_BAR;
        PG8_WAIT_V(4); PG8_BAR;
        PG8_STAGE(PG8_SB(1, 0), cB + kstep, voffB); PG8_STAGE(PG8_SA(1, 0), cA + kstep, voffA); PG8_STAGE(PG8_SB(1, 1), cB + hstep + kstep, voffB);
        PG8_WAIT_V(6); PG8_BAR;
    }
    for (;;) {
        const bool has_next = S.next(ui + 1, nxt);
        const char* nA = has_next ? (const char*)g.A + (size_t)(nxt.pn / g.gdiv) * g.a_gstride + (size_t)nxt.pm * tstep : cA; const char* nB = has_next ? (const char*)g.Bt + (size_t)nxt.pn * tstep : cB;
        for (int t = 0; t < nt; t += 2) {
            const bool last = (t == nt - 2);
            const char* a1 = cA + (size_t)(t + 1) * kstep;
            const char* a2 = last ? nA : cA + (size_t)(t + 2) * kstep; const char* b2 = last ? nB : cB + (size_t)(t + 2) * kstep;
            const char* a3 = a2 + kstep; const char* b3 = b2 + kstep;
            if (last && has_next) S.a_ready(nxt);
            if constexpr (SP2) {
            PG8_LDB(B0, 0, 0); PG8_LDB(B1, 0, 1); PG8_SCHED; PG8_LDA(At, 0, 0); PG8_STAGE(PG8_SA(1, 1), a1 + hstep, voffA);
            PG8_WAIT_V(8); PG8_WAIT_L(0); PG8_BAR; PG8_MMA(0, 0, At, B0); PG8_MMA(0, 1, At, B1); PG8_BAR; PG8_SCHED;
            PG8_LDA(At, 0, 1); PG8_STAGE(PG8_SB(0, 0), b2, voffB); PG8_STAGE(PG8_SB(0, 1), b2 + hstep, voffB); PG8_STAGE(PG8_SA(0, 0), a2, voffA);
            PG8_WAIT_V(8); PG8_WAIT_L(0); PG8_BAR; PG8_MMA(1, 0, At, B0); PG8_MMA(1, 1, At, B1); PG8_BAR; PG8_SCHED;
            PG8_LDB(B0, 1, 0); PG8_LDB(B1, 1, 1); PG8_SCHED; PG8_LDA(At, 1, 0); PG8_STAGE(PG8_SA(0, 1), a2 + hstep, voffA);
            PG8_WAIT_V(8); PG8_WAIT_L(0); PG8_BAR; PG8_MMA(0, 0, At, B0); PG8_MMA(0, 1, At, B1); PG8_BAR; PG8_SCHED;
            PG8_LDA(At, 1, 1); PG8_STAGE(PG8_SB(1, 0), b3, voffB); PG8_STAGE(PG8_SB(1, 1), b3 + hstep, voffB); PG8_STAGE(PG8_SA(1, 0), a3, voffA);
            PG8_WAIT_V(8); PG8_WAIT_L(0); PG8_BAR; PG8_MMA(1, 0, At, B0); PG8_MMA(1, 1, At, B1); PG8_BAR; PG8_SCHED;
            } else {
            PG8_LDB(B0, 0, 0); PG8_SCHED; PG8_LDA(At, 0, 0); PG8_STAGE(PG8_SA(1, 1), a1 + hstep, voffA);
            PG8_WAIT_L(8); PG8_BAR; PG8_WAIT_L(0); PG8_MMA(0, 0, At, B0); PG8_BAR; PG8_SCHED;
            PG8_LDB(B1, 0, 1); PG8_STAGE(PG8_SB(0, 0), b2, voffB);
            PG8_BAR; PG8_WAIT_L(0); PG8_MMA(0, 1, At, B1); PG8_BAR;
            PG8_LDA(At, 0, 1); PG8_STAGE(PG8_SA(0, 0), a2, voffA);
            PG8_BAR; PG8_WAIT_L(0); PG8_MMA(1, 0, At, B0); PG8_BAR; PG8_SCHED;
            PG8_STAGE(PG8_SB(0, 1), b2 + hstep, voffB);
            PG8_WAIT_V(6); PG8_BAR; PG8_MMA(1, 1, At, B1); PG8_BAR;
            PG8_LDB(B0, 1, 0); PG8_SCHED; PG8_LDA(At, 1, 0); PG8_STAGE(PG8_SA(0, 1), a2 + hstep, voffA);
            PG8_WAIT_L(8); PG8_BAR; PG8_WAIT_L(0); PG8_MMA(0, 0, At, B0); PG8_BAR; PG8_SCHED;
            PG8_LDB(B1, 1, 1); PG8_STAGE(PG8_SB(1, 0), b3, voffB);
            PG8_BAR; PG8_WAIT_L(0); PG8_MMA(0, 1, At, B1); PG8_BAR;
            PG8_LDA(At, 1, 1); PG8_STAGE(PG8_SA(1, 0), a3, voffA);
            PG8_BAR; PG8_WAIT_L(0); PG8_MMA(1, 0, At, B0); PG8_BAR; PG8_SCHED;
            PG8_STAGE(PG8_SB(1, 1), b3 + hstep, voffB);
            PG8_WAIT_V(6); PG8_BAR; PG8_MMA(1, 1, At, B1); PG8_BAR;
            }
        }
        if constexpr (ALIGN_EPI) { if (wr == 0) PG8_BAR; }
        if constexpr (!Epi::AFTER_DRAIN) { E(acc, cur, wr, wc, fr, fq); S.done(cur); }
        if (!has_next) break;
#pragma unroll
        for (int a = 0; a < 2; ++a)
#pragma unroll
            for (int b = 0; b < 2; ++b)
#pragma unroll
                for (int m = 0; m < 4; ++m)
#pragma unroll
                    for (int n = 0; n < 2; ++n) acc[a][b][m][n] = (f32x4){0.f, 0.f, 0.f, 0.f};
        cur = nxt; cA = nA; cB = nB; ++ui;
        if constexpr (ALIGN_EPI) { if (wr == 1) PG8_BAR; }
    }
    PG8_WAIT_V(0);
    if constexpr (!ALIGN_EPI) { if (wr == 0) PG8_BAR; }
    PG8_BAR;
    if constexpr (Epi::AFTER_DRAIN) { E.fused(acc, cur, wr, wc, fr, fq, lds, wid, lane); S.done(cur); }
#undef PG8_SA
#undef PG8_SB
#undef PG8_STAGE
#undef PG8_LDA
#undef PG8_LDB
#undef PG8_MMA
#undef PG8_WAIT_V
#undef PG8_WAIT_L
#undef PG8_BAR
#undef PG8_SCHED
}
}
#define GAS __attribute__((address_space(1)))
#define LAS __attribute__((address_space(3)))
typedef unsigned short bf16;
typedef unsigned v4u __attribute__((ext_vector_type(4)));
typedef float f32x4 __attribute__((ext_vector_type(4)));
typedef short bf16x8 __attribute__((ext_vector_type(8)));
typedef GAS unsigned gu32;
typedef GAS unsigned long long gu64;
#define RLX_AGENT __ATOMIC_RELAXED, __HIP_MEMORY_SCOPE_AGENT
#define LDS_WAIT() asm volatile("s_waitcnt lgkmcnt(0)" ::: "memory")
#define VM_WAIT() asm volatile("s_waitcnt vmcnt(0)" ::: "memory")
__device__ __forceinline__ unsigned long long rt() { return __builtin_amdgcn_s_memrealtime(); }
__device__ __forceinline__ unsigned f2bf(float f) { unsigned u = __builtin_bit_cast(unsigned, f); return (u + 0x7fffu + ((u >> 16) & 1u)) >> 16; }
typedef __bf16 pk_bf2_t __attribute__((ext_vector_type(2))); typedef float pk_f2_t __attribute__((ext_vector_type(2)));
__device__ __forceinline__ unsigned pk2(float lo, float hi) { const pk_f2_t v = {lo, hi}; return __builtin_bit_cast(unsigned, __builtin_convertvector(v, pk_bf2_t)); }

#define XB_TMO      128
#define XB_XCNT(j)  (256  + 64 * (j))
#define XB_XSUB(j)  (1280 + 64 * (j))
#define XB_XGEN(j)  (2304 + 64 * (j))
#define XB_TOP      3328
#define XB_TOPGEN   3392
#define XCD_BAR_WORDS 3456
#define XB_SPIN_CAP (1u << 18)

__device__ __forceinline__ unsigned xb_ld(unsigned* p)              { return __hip_atomic_load(p, __ATOMIC_RELAXED, __HIP_MEMORY_SCOPE_AGENT); }
__device__ __forceinline__ unsigned xb_add(unsigned* p, unsigned v) { return __hip_atomic_fetch_add(p, v, __ATOMIC_RELAXED, __HIP_MEMORY_SCOPE_AGENT); }
__device__ __forceinline__ unsigned xb_xcc_id() { return (unsigned)__builtin_amdgcn_s_getreg((3 << 11) | 20) & 0xFu; }
#define XB_SPIN(cond, bar) do { unsigned _sp = 0; while (cond) { __builtin_amdgcn_s_sleep(1); \
    if ((++_sp & 255u) == 0u) { if (xb_ld(&(bar)[XB_TMO])) break; if (_sp > XB_SPIN_CAP) { atomicAdd(&(bar)[XB_TMO], 1u); break; } } } } while (0)

struct XcdBarrier {
    unsigned* bar; unsigned x;
    volatile LAS unsigned* st;
};

__device__ __forceinline__ XcdBarrier xcd_barrier_post(unsigned* bar, volatile LAS unsigned* st) {
    XcdBarrier b; b.bar = bar; b.x = xb_xcc_id(); b.st = st;
    if (threadIdx.x == 0) (void)xb_add(&bar[XB_XCNT(b.x)], 1u);
    return b;
}
__device__ __forceinline__ void xcd_barrier_complete(unsigned* bar, unsigned x, unsigned& nloc, unsigned& nx) {
    const unsigned G = gridDim.x * gridDim.y * gridDim.z;
    unsigned sum, cnt, mine, sp = 0u;
    for (;;) {
        sum = 0u; cnt = 0u; mine = 0u;
#pragma unroll
        for (unsigned j = 0; j < 16; ++j) { const unsigned c = xb_ld(&bar[XB_XCNT(j)]); sum += c; cnt += (c > 0u) ? 1u : 0u; mine = (j == x) ? c : mine; }
        if (sum == G) break;
        __builtin_amdgcn_s_sleep(1);
        if ((++sp & 255u) == 0u) { if (xb_ld(&bar[XB_TMO])) break; if (sp > XB_SPIN_CAP) { atomicAdd(&bar[XB_TMO], 1u); break; } }
    }
    nloc = mine > 0u ? mine : 1u; nx = cnt > 0u ? cnt : 1u;
}

__device__ __forceinline__ void xcd_barrier(const XcdBarrier& b) {
    asm volatile("s_waitcnt vmcnt(0)" ::: "memory");
    __syncthreads();
    if (threadIdx.x == 0) {
        unsigned* bar = b.bar;
        __builtin_amdgcn_s_waitcnt(0);
        unsigned nloc = b.st[0], nx = b.st[1];
        if (nloc == 0u) { xcd_barrier_complete(bar, b.x, nloc, nx); b.st[0] = nloc; b.st[1] = nx; }
        const unsigned old = xb_add(&bar[XB_XSUB(b.x)], 1u);
        const unsigned gen = old / nloc;
        if (old + 1u == (gen + 1u) * nloc) {
            __builtin_amdgcn_fence(__ATOMIC_RELEASE, "agent");
            asm volatile("s_waitcnt vmcnt(0)" ::: "memory");
            const unsigned og = xb_add(&bar[XB_TOP], 1u);
            const unsigned tg = og / nx;
            if (og + 1u == (tg + 1u) * nx) xb_add(&bar[XB_TOPGEN], 1u);
            else XB_SPIN(xb_ld(&bar[XB_TOPGEN]) == tg, bar);
            __builtin_amdgcn_fence(__ATOMIC_ACQUIRE, "agent");
            xb_add(&bar[XB_XGEN(b.x)], 1u);
            asm volatile("s_waitcnt vmcnt(0)" ::: "memory");
        } else {
            XB_SPIN(xb_ld(&bar[XB_XGEN(b.x)]) == gen, bar);
            __builtin_amdgcn_fence(__ATOMIC_ACQUIRE, "agent");
            asm volatile("s_waitcnt vmcnt(0)" ::: "memory");
        }
    }
    __syncthreads();
}
constexpr int NWAVES = 8;
constexpr int DM = 1024, NB = 4, SEQ = 4096, NMETA = 16, LP = 4112, MPR = 16448, DBATCH = 128, DSEQ = 4, MSAMP = 512, MTOK = 16960, MPAD = 17152;
constexpr int NH = 16, HD = 64, NKV = 4, LDQ = 2560, WIN = 128;
constexpr float RMS_EPS = 1e-6f, GN_EPS = 64e-5f, LOG2E = 1.4426950408889634f, QSCALE = 0.125f * 1.4426950408889634f;
constexpr size_t O_YP = 0, O_YS = 16777216, O_WKP = 17301504, O_WVP = 17432576, O_WKVP = 17563648, O_SHP = 17825792, O_WKS = 17829888, O_WVS = 22024192, O_WKVS = 26218496, O_SHS = 34607104, O_END = 34738176;
constexpr size_t MiB = 1u << 20;
constexpr size_t WS_CTL = 0, CTL_ZERO_BYTES = 1 * MiB;
constexpr size_t WS_T12B = 1 * MiB;
constexpr size_t WS_WAIN = 1 * MiB, WS_WAOUT = 6 * MiB, WS_WRIN = 8 * MiB, WS_WROUT = 16 * MiB, WS_W1A1 = 185 * MiB;
constexpr size_t WS_XN1S = 186 * MiB, WS_U = 164 * MiB;
constexpr int U_SROW = 16640;
constexpr size_t WS_CKB = 164 * MiB;
constexpr size_t WS_KVP = 18 * MiB + 512 * 1024, WS_KVS = 19 * MiB, WS_SHP = 19 * MiB + 512 * 1024, WS_WKVP = 20 * MiB, WS_T12 = 21 * MiB;
constexpr size_t WS_XA = 30 * MiB, WS_QKVG = 64 * MiB, WS_H1 = 189 * MiB, WS_MIX = 30 * MiB, MIX_STRIDE = (size_t)MPAD * DM * 2, WS_G = 222 * MiB + 512 * 1024, WS_OG2 = 64 * MiB, WS_END = 256 * MiB;
constexpr size_t RKV_STRIDE = (size_t)MTOK * DM * 2, DO_XN1 = 3 * RKV_STRIDE,
     DO_K = 2 * RKV_STRIDE, DO_V = RKV_STRIDE,
     DO_OG2 = DO_V;
static_assert(WS_T12 + (size_t)MTOK * 128 * 4 <= WS_XA && WS_XA + MIX_STRIDE <= WS_QKVG && WS_QKVG + (size_t)MPAD * LDQ * 2 <= WS_H1 && WS_MIX + 4 * MIX_STRIDE <= WS_H1 && WS_H1 + (size_t)MPAD * DM * 4 <= WS_END, "ws map");
static_assert(3 * RKV_STRIDE <= O_WKVS * 4 && 2 * MIX_STRIDE <= O_END * 4, "d_out scratch map");
constexpr int CW_TMO = 0, CW_CODE = 1, CW_BAR = 4096, CW_TFLAG = 65536, CW_RC2 = 70000, CW_RC4 = 70128, CW_UCNT = 70256;
constexpr int RING_OFF = 0, RING_BYTES = 131072, LDSCTL_OFF = RING_BYTES, MISC_OFF = LDSCTL_OFF + 320, LDS_BYTES = 147456;

typedef short s16x4 __attribute__((ext_vector_type(4)));
typedef float f32x16 __attribute__((ext_vector_type(16)));
struct Frame {
    LAS unsigned char* lds;
    volatile LAS unsigned* MISC;
    gu32* ctl;
    int tid, lane, wave, vcu, G, skip;
    const float *xp, *xs, *cache_k, *cache_v, *state_wkv, *state_shift, *meta, *table, *norm_gain, *final_gain, *a_w_in, *sinks, *a_w_out;
    const float *mu, *r_w_in, *w0, *w1, *w2, *a0, *a1, *a2, *k_k, *k_a, *r_k, *ln_g, *ln_b, *r_w_out;
    float* out; unsigned char* ws; unsigned char* dob;
};
template <int CTRL> __device__ __forceinline__ float dpp_mov(float v) { return __builtin_bit_cast(float, __builtin_amdgcn_update_dpp(0, __builtin_bit_cast(int, v), CTRL, 0xF, 0xF, true)); }
__device__ __forceinline__ float wave_sum(float v) {
    v += dpp_mov<0xB1>(v);
    v += dpp_mov<0x4E>(v);
    v += dpp_mov<0x141>(v);
    v += dpp_mov<0x140>(v);
    v += __shfl_xor(v, 16);
    { const unsigned u = __builtin_bit_cast(unsigned, v); auto r = __builtin_amdgcn_permlane32_swap(u, u, false, false); v = __builtin_bit_cast(float, (unsigned)r[0]) + __builtin_bit_cast(float, (unsigned)r[1]); }
    return v;
}
__device__ __forceinline__ float bf2f(bf16 b) { return __builtin_bit_cast(float, (unsigned)b << 16); }
__device__ __forceinline__ const float* h0_row(const Frame& F, int m) {
    if (m < MPR) { const int b = m / LP, t = m - b * LP; return t < NMETA ? F.meta + t * DM : F.xp + ((size_t)b * SEQ + (t - NMETA)) * DM; }
    return F.xs + (size_t)(m - MPR) * DM;
}
__device__ __forceinline__ void p0_transpose_item(const float* W, int K, int N, bf16* WT, int row_off, LAS float* scr, int item, int lane, const float* sc = nullptr, bool one_minus = false) {
    const int nblk = N / 32, kb = item / nblk, nb = item % nblk, k0 = 64 * kb, n0 = 32 * nb;
#pragma unroll 8
    for (int i = 0; i < 32; ++i) { const int kk = 2 * i + (lane >> 5); float w = W[(size_t)(k0 + kk) * N + n0 + (lane & 31)]; if (sc) { const float s_ = sc[k0 + kk]; w *= one_minus ? 1.0f - s_ : s_; } scr[kk * 33 + (lane & 31)] = w; }
    LDS_WAIT(); asm volatile("" ::: "memory");
    const int c = lane & 7;
#pragma unroll
    for (int j = 0; j < 4; ++j) { const int n = (lane >> 3) + 8 * j; const LAS float* s = scr + (8 * c) * 33 + n;
        v4u o; o.x = pk2(s[0 * 33], s[1 * 33]); o.y = pk2(s[2 * 33], s[3 * 33]); o.z = pk2(s[4 * 33], s[5 * 33]); o.w = pk2(s[6 * 33], s[7 * 33]);
        *(GAS v4u*)(WT + (size_t)(row_off + n0 + n) * K + k0 + 8 * c) = o; }
    LDS_WAIT(); asm volatile("" ::: "memory");
}
__device__ __forceinline__ void rms_row(const float* xrow, const float* gain, int lane, f32x4 (&v)[4]) {
    const GAS f32x4* xr = (const GAS f32x4*)xrow + lane; float s = 0.f;
#pragma unroll
    for (int j = 0; j < 4; ++j) { v[j] = xr[64 * j]; s += (v[j].x * v[j].x + v[j].y * v[j].y) + (v[j].z * v[j].z + v[j].w * v[j].w); }
    const float rstd = 1.0f / sqrtf(wave_sum(s) * (1.f / DM) + RMS_EPS);
    const GAS f32x4* gr = (const GAS f32x4*)gain + lane;
#pragma unroll
    for (int j = 0; j < 4; ++j) v[j] = v[j] * rstd * gr[64 * j];
}
__device__ __forceinline__ void rms_row_b(const bf16* xrow, const float* gain, int lane, f32x4 (&v)[4]) {
    const GAS unsigned long long* xr = (const GAS unsigned long long*)xrow + lane; float s = 0.f;
#pragma unroll
    for (int j = 0; j < 4; ++j) { const unsigned long long w = xr[64 * j];
        v[j].x = __builtin_bit_cast(float, (unsigned)w << 16); v[j].y = __builtin_bit_cast(float, (unsigned)w & 0xffff0000u); v[j].z = __builtin_bit_cast(float, (unsigned)(w >> 32) << 16); v[j].w = __builtin_bit_cast(float, (unsigned)(w >> 32) & 0xffff0000u);
        s += (v[j].x * v[j].x + v[j].y * v[j].y) + (v[j].z * v[j].z + v[j].w * v[j].w); }
    const float rstd = 1.0f / sqrtf(wave_sum(s) * (1.f / DM) + RMS_EPS);
    const GAS f32x4* gr = (const GAS f32x4*)gain + lane;
#pragma unroll
    for (int j = 0; j < 4; ++j) v[j] = v[j] * rstd * gr[64 * j];
}
__device__ __forceinline__ void store_bf16_row(bf16* orow, int lane, const f32x4 (&v)[4]) {
    GAS unsigned long long* o8 = (GAS unsigned long long*)orow + lane;
#pragma unroll
    for (int j = 0; j < 4; ++j) o8[64 * j] = (unsigned long long)pk2(v[j].x, v[j].y) | ((unsigned long long)pk2(v[j].z, v[j].w) << 32);
}
__device__ __forceinline__ void p0_prologue(Frame& F, int part, int gw, int NGW) {
    LAS float* scr = (LAS float*)(F.lds + RING_OFF + F.wave * 16384);
    bf16* wain = (bf16*)(F.ws + WS_WAIN); bf16* waout = (bf16*)(F.ws + WS_WAOUT); bf16* wrin = (bf16*)(F.ws + WS_WRIN); bf16* wrout = (bf16*)(F.ws + WS_WROUT); bf16* w1a1 = (bf16*)(F.ws + WS_W1A1);
    constexpr int I_AIN = 16 * 80, I_SQ = 16 * 32, I_L1 = 16 * 2;
    constexpr int I_L2 = 32;
    constexpr int NITEMS = I_AIN + 6 * I_SQ + 4 * I_L1 + 2 * I_L2;
    const int it_lo = part == 1 ? I_AIN + I_SQ : (part == 3 ? I_AIN : 0), it_hi = part == 0 ? I_AIN : (part == 3 ? I_AIN + I_SQ : NITEMS);
    for (int it = it_lo + gw; it < it_hi; it += NGW) {
        int r = it;
        if (r < I_AIN) { p0_transpose_item(F.a_w_in, DM, LDQ, wain, 0, scr, r, F.lane); continue; } r -= I_AIN;
        if (r < I_SQ) { p0_transpose_item(F.a_w_out, DM, DM, waout, 0, scr, r, F.lane); continue; } r -= I_SQ;
        if (r < 4 * I_SQ) { const int c = r / I_SQ; p0_transpose_item(F.r_w_in + (size_t)c * DM * DM, DM, DM, wrin, c * DM, scr, r - c * I_SQ, F.lane); continue; } r -= 4 * I_SQ;
        if (r < I_SQ) { p0_transpose_item(F.r_w_out, DM, DM, wrout, 0, scr, r, F.lane); continue; } r -= I_SQ;
        if (r < 4 * I_L1) { const int q = r / I_L1; p0_transpose_item(q < 2 ? F.w1 : F.a1, DM, 64, w1a1, 64 * q, scr, r - q * I_L1, F.lane, F.mu + (q < 2 ? 4 : 5) * DM, (q & 1) == 0); continue; } r -= 4 * I_L1;
        if (r < I_L2) { p0_transpose_item(F.w2, 64, DM, (bf16*)(F.ws + 18 * MiB + 256 * 1024), 0, scr, r, F.lane); continue; } r -= I_L2;
        p0_transpose_item(F.a2, 64, DM, (bf16*)(F.ws + 18 * MiB + 384 * 1024), 0, scr, r, F.lane);
    }
    if (part == 1 || part == 3) return;
    bf16* xa = (bf16*)(F.ws + WS_XA);
    for (int m = gw; m < MPAD; m += NGW) {
        f32x4 v[4];
        if (m < MTOK) rms_row(h0_row(F, m), F.norm_gain, F.lane, v);
        else { for (int j = 0; j < 4; ++j) v[j] = (f32x4){0.f, 0.f, 0.f, 0.f}; }
        store_bf16_row(xa + (size_t)m * DM, F.lane, v);
    }
}

namespace att {
constexpr int KSTR = 72, VSTR = 324, KROWS = 320;
constexpr int BEXT = 192;
constexpr int K_OFF = 0, V_OFF = KROWS * KSTR * 2, ST_OFF = V_OFF + 64 * VSTR * 2, END_OFF = ST_OFF + NWAVES * 4096, B_OFF = 132096;
static_assert(END_OFF <= RING_BYTES && (B_OFF % 16) == 0 && (ST_OFF % 16) == 0 && B_OFF + NH * BEXT * 4 <= LDS_BYTES, "attention LDS");
__device__ __forceinline__ int crow(int r, int hi) { return (r & 3) + 8 * (r >> 2) + 4 * hi; }
__device__ __forceinline__ int t5_bucket(int rel) {
    if (rel < 16) return rel;
    int b = 16;
    b += rel >= 19; b += rel >= 21; b += rel >= 24; b += rel >= 27; b += rel >= 31; b += rel >= 35; b += rel >= 40; b += rel >= 46;
    b += rel >= 52; b += rel >= 59; b += rel >= 67; b += rel >= 77; b += rel >= 87; b += rel >= 99; b += rel >= 113;
    return b;
}
__device__ __forceinline__ void attn_wave(LAS unsigned char* lds, const bf16* qkvg, bf16* og, int qrow0, int nq, int jt, int kt_lo, int h, float sink2, int lane, int wave) {
    const int c = lane & 31, hh = lane >> 5;
    const LAS float* bp = (const LAS float*)(lds + B_OFF) + h * BEXT + 5 + c - 4 * hh;
    const int qrow = qrow0 + (c < nq ? c : nq - 1);
    bf16x8 qf[4];
#pragma unroll
    for (int s = 0; s < 4; ++s) qf[s] = *(const GAS bf16x8*)(qkvg + (size_t)qrow * LDQ + h * HD + 16 * s + 8 * hh);
    const LAS unsigned char* kbase = lds + K_OFF + ((32 * jt + c) * KSTR + 8 * hh) * 2;
    const LAS unsigned char* vbase = lds + V_OFF + (c * VSTR + 32 * jt + 4 * hh) * 2;
    f32x16 sc[5];
#pragma unroll
    for (int kt = 0; kt < 5; ++kt) {
        f32x16 a;
#pragma unroll
        for (int r = 0; r < 16; ++r) a[r] = bp[155 - (32 * kt + (r & 3) + 8 * (r >> 2))];
#pragma unroll
        for (int s = 0; s < 4; ++s) { const bf16x8 kf = *(const LAS bf16x8*)(kbase + kt * (32 * KSTR * 2) + 32 * s); a = __builtin_amdgcn_mfma_f32_32x32x16_bf16(kf, qf[s], a, 0, 0, 0); }
        if (kt < kt_lo) {
#pragma unroll
            for (int r = 0; r < 16; ++r) a[r] = -1e30f;
        }
        sc[kt] = a;
    }
    float mx = -1e30f;
#pragma unroll
    for (int kt = 0; kt < 5; ++kt)
#pragma unroll
        for (int r = 0; r < 16; ++r) mx = fmaxf(mx, sc[kt][r]);
    mx = fmaxf(mx, __shfl_xor(mx, 32)); mx = fmaxf(mx, sink2);
    float l = 0.f;
#pragma unroll
    for (int kt = 0; kt < 5; ++kt)
#pragma unroll
        for (int r = 0; r < 16; ++r) { const float p = __builtin_amdgcn_exp2f(sc[kt][r] - mx); sc[kt][r] = p; l += p; }
    l += __shfl_xor(l, 32); l += __builtin_amdgcn_exp2f(sink2 - mx);
    const float linv = __builtin_amdgcn_rcpf(l);
    f32x16 o[2]; o[0] = f32x16{}; o[1] = f32x16{};
#pragma unroll
    for (int kt = 0; kt < 5; ++kt) {
#pragma unroll
        for (int s2 = 0; s2 < 2; ++s2) {
            v4u pw; pw.x = pk2(sc[kt][8 * s2 + 0] * linv, sc[kt][8 * s2 + 1] * linv); pw.y = pk2(sc[kt][8 * s2 + 2] * linv, sc[kt][8 * s2 + 3] * linv);
            pw.z = pk2(sc[kt][8 * s2 + 4] * linv, sc[kt][8 * s2 + 5] * linv); pw.w = pk2(sc[kt][8 * s2 + 6] * linv, sc[kt][8 * s2 + 7] * linv);
            const bf16x8 pf = __builtin_bit_cast(bf16x8, pw);
#pragma unroll
            for (int dh = 0; dh < 2; ++dh) {
                const LAS unsigned char* vp = vbase + (32 * dh * VSTR + 32 * kt + 16 * s2) * 2;
                const s16x4 lo = *(const LAS s16x4*)vp, hi = *(const LAS s16x4*)(vp + 16);
                const bf16x8 vf = (bf16x8){lo[0], lo[1], lo[2], lo[3], hi[0], hi[1], hi[2], hi[3]};
                o[dh] = __builtin_amdgcn_mfma_f32_32x32x16_bf16(pf, vf, o[dh], 0, 0, 0);
            }
        }
    }
    LAS float* stg = (LAS float*)(lds + ST_OFF + wave * 4096);
    const int srow = lane >> 1, sc0 = (lane & 1) * 16;
    const size_t grow = (size_t)(qrow0 + srow);
#pragma unroll
    for (int dh = 0; dh < 2; ++dh) {
#pragma unroll
        for (int r = 0; r < 16; ++r) stg[((r & 3) + 8 * (r >> 2) + 4 * hh) * 32 + c] = o[dh][r];
        asm volatile("s_waitcnt lgkmcnt(0)" ::: "memory");
        f32x4 x[4];
#pragma unroll
        for (int i = 0; i < 4; ++i) x[i] = *(const LAS f32x4*)(stg + srow * 32 + sc0 + 4 * i);
        asm volatile("s_waitcnt lgkmcnt(0)" ::: "memory");
        if (srow < nq) {
            const int col = h * HD + 32 * dh + sc0;
            const v4u g0 = *(const GAS v4u*)(qkvg + grow * LDQ + 1536 + col), g1 = *(const GAS v4u*)(qkvg + grow * LDQ + 1536 + col + 8);
            const unsigned gw[8] = {g0.x, g0.y, g0.z, g0.w, g1.x, g1.y, g1.z, g1.w};
            unsigned ow[8];
#pragma unroll
            for (int e = 0; e < 8; ++e) { const float ga = __builtin_bit_cast(float, gw[e] << 16), gb = __builtin_bit_cast(float, gw[e] & 0xffff0000u);
                const float ya = x[e >> 1][(e & 1) * 2] * ga * __builtin_amdgcn_rcpf(1.0f + __builtin_amdgcn_exp2f(-1.4426950408889634f * ga)), yb = x[e >> 1][(e & 1) * 2 + 1] * gb * __builtin_amdgcn_rcpf(1.0f + __builtin_amdgcn_exp2f(-1.4426950408889634f * gb)); ow[e] = pk2(ya, yb); }
            *(GAS v4u*)(og + grow * DM + col) = (v4u){ow[0], ow[1], ow[2], ow[3]}; *(GAS v4u*)(og + grow * DM + col + 8) = (v4u){ow[4], ow[5], ow[6], ow[7]};
        }
    }
}
constexpr int N_PROMPT_UNITS = NB * NKV * 33, N_SAMPLE_PAIRS = DBATCH * NKV / 2, N_COPY_UNITS = 8, N_UNITS = N_PROMPT_UNITS + N_SAMPLE_PAIRS + N_COPY_UNITS;
}
__device__ __forceinline__ void p1_cache_to_bf16(Frame& F, int gt, int NGT) {
    bf16* ckb = (bf16*)(F.ws + WS_CKB);
    constexpr int NE = DBATCH * WIN * NKV * HD;
    for (int i = gt; i < 2 * NE / 8; i += NGT) { const int kv = i >= NE / 8, e = (i - kv * (NE / 8)) * 8; const float* src = (kv ? F.cache_v : F.cache_k) + e;
        const f32x4 a = *(const GAS f32x4*)src, b = *(const GAS f32x4*)(src + 4);
        *(GAS v4u*)(ckb + (size_t)kv * NE + e) = (v4u){pk2(a.x, a.y), pk2(a.z, a.w), pk2(b.x, b.y), pk2(b.z, b.w)}; }
}
__device__ __forceinline__ void p2_attention(Frame& F, bool cache_bf16) {
    using namespace att;
    const bf16* qkvg = (const bf16*)(F.ws + WS_QKVG); bf16* og = (bf16*)(F.ws + WS_XA);
    LAS unsigned char* lds = F.lds + RING_OFF;
    for (int i = F.tid; i < NH * BEXT; i += NWAVES * 64) { const int h = i / BEXT, rel = i % BEXT - 32;
        ((LAS float*)(lds + B_OFF))[i] = (rel >= 0 && rel < 128) ? F.table[t5_bucket(rel) * NH + h] * LOG2E : -1e30f; }
    __syncthreads();
#pragma unroll 1
    for (int ui = F.vcu; ui < N_UNITS; ui += F.G) {
        int u;
        if (ui < 512) u = (ui >> 5) * 33 + (ui & 31);
        else if (ui < 528) u = (ui - 512) * 33 + 32;
        else u = ui;
        if (u >= N_PROMPT_UNITS + N_SAMPLE_PAIRS) {
            const int cu = u - (N_PROMPT_UNITS + N_SAMPLE_PAIRS);
            bf16* kvp = (bf16*)(F.ws + WS_KVP); bf16* kvs = (bf16*)(F.ws + WS_KVS);
            for (int i = cu * 512 + F.tid; i < 1024 * 64; i += N_COPY_UNITS * 512) {
                const int rr = i >> 6, ch = i & 63;
                const int srow = rr < 512 ? (rr >> 7) * LP + (LP - WIN) + (rr & 127) : MPR + (rr - 512);
                const v4u x = *(const GAS v4u*)(qkvg + (size_t)srow * LDQ + 1024 + 8 * ch);
                bf16* dst = rr < 512 ? kvp + (size_t)rr * 512 + 8 * ch : kvs + (size_t)(rr - 512) * 512 + 8 * ch;
                *(GAS v4u*)dst = x;
            }
            continue;
        }
        int kvh, nwu, qbase, q0, kt0;
        const bool is_prompt = u < N_PROMPT_UNITS;
        const int row = F.tid >> 1, half = F.tid & 1;
        if (is_prompt) {
            const int qblk = u % 33, b = u / (33 * NKV); kvh = (u / 33) % NKV;
            q0 = 128 * qblk; nwu = 16; qbase = b * LP + q0; kt0 = qblk == 0 ? 4 : 0;
            int pos = q0 - 128 + row; pos = pos < 0 ? 0 : (pos > LP - 1 ? LP - 1 : pos);
            const bf16* src = qkvg + (size_t)(b * LP + pos) * LDQ + 1024 + kvh * HD + half * 32;
#pragma unroll
            for (int i = 0; i < 4; ++i) { const v4u kv = *(const GAS v4u*)(src + 8 * i); *(LAS v4u*)(lds + K_OFF + (row * KSTR + half * 32 + 8 * i) * 2) = kv; }
#pragma unroll
            for (int i = 0; i < 4; ++i) { const v4u vv = *(const GAS v4u*)(src + 256 + 8 * i); const unsigned w[4] = {vv.x, vv.y, vv.z, vv.w};
#pragma unroll
                for (int e = 0; e < 8; ++e) { const bf16 x = (bf16)((w[e >> 1] >> ((e & 1) * 16)) & 0xffffu); *(LAS bf16*)(lds + V_OFF + ((half * 32 + 8 * i + e) * VSTR + row) * 2) = x; } }
        } else {
            const int sp = u - N_PROMPT_UNITS, sb = sp >> 1; kvh = 2 * (sp & 1);
            q0 = LP; nwu = 8; qbase = MPR + sb * DSEQ; kt0 = 0;
            if (row < 160) {
#pragma unroll 1
                for (int pp = 0; pp < 2; ++pp) {
                const int kvx = kvh + pp, irow = 160 * pp + row;
#pragma unroll
                for (int i = 0; i < 4; ++i) {
                    v4u kq = (v4u){0u, 0u, 0u, 0u}, vq = (v4u){0u, 0u, 0u, 0u};
                    if (row < 128) {
                        const size_t ce = (((size_t)sb * WIN + row) * NKV + kvx) * HD + half * 32 + 8 * i;
                        if (cache_bf16) { const bf16* cb = (const bf16*)(F.ws + WS_CKB) + ce; kq = *(const GAS v4u*)cb; vq = *(const GAS v4u*)(cb + (size_t)DBATCH * WIN * NKV * HD); }
                        else {
                        const float* ck = F.cache_k + ce; const float* cv = F.cache_v + ce;
                        const f32x4 a0 = *(const GAS f32x4*)ck, a1 = *(const GAS f32x4*)(ck + 4), b0 = *(const GAS f32x4*)cv, b1 = *(const GAS f32x4*)(cv + 4);
                        kq = (v4u){pk2(a0.x, a0.y), pk2(a0.z, a0.w), pk2(a1.x, a1.y), pk2(a1.z, a1.w)}; vq = (v4u){pk2(b0.x, b0.y), pk2(b0.z, b0.w), pk2(b1.x, b1.y), pk2(b1.z, b1.w)};
                        }
                    } else if (row < 132) {
                        const bf16* src = qkvg + (size_t)(MPR + sb * DSEQ + (row - 128)) * LDQ + 1024 + kvx * HD + half * 32 + 8 * i;
                        kq = *(const GAS v4u*)src; vq = *(const GAS v4u*)(src + 256);
                    }
                    *(LAS v4u*)(lds + K_OFF + (irow * KSTR + half * 32 + 8 * i) * 2) = kq;
                    const unsigned w[4] = {vq.x, vq.y, vq.z, vq.w};
#pragma unroll
                    for (int e = 0; e < 8; ++e) { const bf16 x = (bf16)((w[e >> 1] >> ((e & 1) * 16)) & 0xffffu); *(LAS bf16*)(lds + V_OFF + ((half * 32 + 8 * i + e) * VSTR + irow) * 2) = x; }
                }
                }
            }
        }
        __syncthreads();
#pragma unroll 1
        for (int wu = F.wave; wu < nwu; wu += NWAVES) {
            const int hg = wu & 3, j = wu >> 2;
            int h, nq, jt, ktlo, qrow0;
            if (is_prompt) { h = kvh * 4 + hg; nq = LP - (q0 + 32 * j); nq = nq < 32 ? nq : 32; jt = j; ktlo = kt0 - j; qrow0 = qbase + 32 * j; }
            else { h = (kvh + j) * 4 + hg; nq = DSEQ; jt = 5 * j; ktlo = 0; qrow0 = qbase; }
            if (nq > 0) attn_wave(lds, qkvg, og, qrow0, nq, jt, ktlo, h, F.sinks[h] * LOG2E, F.lane, F.wave);
        }
        __syncthreads();
    }
}

__device__ __forceinline__ void rms_row8(const bf16* xrow, const float (&g8)[2][8], int lane, float (&x)[2][8]) {
    float s = 0.f;
#pragma unroll
    for (int j = 0; j < 2; ++j) { const v4u w = *(const GAS v4u*)(xrow + 8 * lane + 512 * j); const unsigned ww[4] = {w.x, w.y, w.z, w.w};
#pragma unroll
        for (int i = 0; i < 4; ++i) { x[j][2 * i] = __builtin_bit_cast(float, ww[i] << 16); x[j][2 * i + 1] = __builtin_bit_cast(float, ww[i] & 0xffff0000u); s += x[j][2 * i] * x[j][2 * i] + x[j][2 * i + 1] * x[j][2 * i + 1]; } }
    const float rstd = 1.0f / sqrtf(wave_sum(s) * (1.f / DM) + RMS_EPS);
#pragma unroll
    for (int j = 0; j < 2; ++j)
#pragma unroll
        for (int i = 0; i < 8; ++i) x[j][i] = x[j][i] * rstd * g8[j][i];
}
__device__ __forceinline__ void wait_row_tiles(const unsigned* cnt, int ra, int rb, unsigned full) {
    if (threadIdx.x < 64) {
        for (int pm = (ra < 0 ? 0 : ra) >> 8; pm <= (rb >> 8); ++pm)
            while (__hip_atomic_load(cnt + pm, __ATOMIC_RELAXED, __HIP_MEMORY_SCOPE_AGENT) < full) __builtin_amdgcn_s_sleep(8);
        __builtin_amdgcn_fence(__ATOMIC_ACQUIRE, "agent");
    }
    __syncthreads();
}
__device__ __forceinline__ void flow_range(const Frame& F, int seg, int nlate_wg, int rows_early, int& r0, int& r1, int& g0, int& g1) {
    const int bx = (int)blockIdx.x;
    if (seg == 0) { if (bx < nlate_wg) { r0 = r1 = g0 = g1 = 0; return; } const long wb = (long)(bx - nlate_wg) * NWAVES, w = wb + F.wave, NW = (long)(F.G - nlate_wg) * NWAVES;
        r0 = (int)((w * rows_early) / NW); r1 = (int)(((w + 1) * rows_early) / NW); g0 = (int)((wb * rows_early) / NW); g1 = (int)(((wb + NWAVES) * rows_early) / NW); }
    else { const long wb = (long)bx * NWAVES, w = wb + F.wave, NW = (long)F.G * NWAVES; const int nl = MTOK - rows_early;
        r0 = rows_early + (int)((w * nl) / NW); r1 = rows_early + (int)(((w + 1) * nl) / NW); g0 = rows_early + (int)((wb * nl) / NW); g1 = rows_early + (int)(((wb + NWAVES) * nl) / NW); }
}
__device__ __forceinline__ void p4_mix(Frame& F) {
    const int gw = F.vcu * NWAVES + F.wave, NGW = F.G * NWAVES;
    const bf16* h1 = (const bf16*)(F.ws + WS_H1); const float* gain = F.norm_gain + DM;
    float g8[2][8], mu8[4][2][8];
#pragma unroll
    for (int j = 0; j < 2; ++j) { const f32x4 a = *(const GAS f32x4*)(gain + 8 * F.lane + 512 * j), b = *(const GAS f32x4*)(gain + 8 * F.lane + 512 * j + 4);
        g8[j][0] = a.x; g8[j][1] = a.y; g8[j][2] = a.z; g8[j][3] = a.w; g8[j][4] = b.x; g8[j][5] = b.y; g8[j][6] = b.z; g8[j][7] = b.w;
#pragma unroll
        for (int c = 0; c < 4; ++c) { const f32x4 a2 = *(const GAS f32x4*)(F.mu + c * DM + 8 * F.lane + 512 * j), b2 = *(const GAS f32x4*)(F.mu + c * DM + 8 * F.lane + 512 * j + 4);
            mu8[c][j][0] = a2.x; mu8[c][j][1] = a2.y; mu8[c][j][2] = a2.z; mu8[c][j][3] = a2.w; mu8[c][j][4] = b2.x; mu8[c][j][5] = b2.y; mu8[c][j][6] = b2.z; mu8[c][j][7] = b2.w; } }
    float xp[2][8];
#pragma unroll
    for (int j = 0; j < 2; ++j)
#pragma unroll
        for (int i = 0; i < 8; ++i) xp[j][i] = 0.f;
    const int r0 = (int)(((long)gw * MTOK) / NGW), r1 = (int)(((long)(gw + 1) * MTOK) / NGW);
    bool have_prev = false;
#pragma unroll 1
    for (int m = r0; m < r1; ++m) {
        float x[2][8];
        rms_row8(h1 + (size_t)m * DM, g8, F.lane, x);
        bool first; const float* sh = nullptr;
        if (m < MPR) { first = (m % LP) == 0; } else { first = ((m - MPR) & 3) == 0; sh = F.state_shift + (size_t)((m - MPR) >> 2) * DM; }
        if (first) {
#pragma unroll
            for (int j = 0; j < 2; ++j) { f32x4 a = (f32x4){0.f, 0.f, 0.f, 0.f}, b = a; if (sh) { a = *(const GAS f32x4*)(sh + 8 * F.lane + 512 * j); b = *(const GAS f32x4*)(sh + 8 * F.lane + 512 * j + 4); }
                xp[j][0] = a.x; xp[j][1] = a.y; xp[j][2] = a.z; xp[j][3] = a.w; xp[j][4] = b.x; xp[j][5] = b.y; xp[j][6] = b.z; xp[j][7] = b.w; }
        } else if (!have_prev) rms_row8(h1 + (size_t)(m - 1) * DM, g8, F.lane, xp);
        {
            bf16* xr = m < MPR ? (bf16*)(F.dob + DO_XN1) + (size_t)m * DM : (bf16*)(F.ws + WS_XN1S) + (size_t)(m - MPR) * DM;
#pragma unroll
            for (int j = 0; j < 2; ++j) { v4u o; o.x = pk2(x[j][0], x[j][1]); o.y = pk2(x[j][2], x[j][3]); o.z = pk2(x[j][4], x[j][5]); o.w = pk2(x[j][6], x[j][7]); *(GAS v4u*)(xr + 8 * F.lane + 512 * j) = o; }
            if (first && sh) { bf16* sr = (bf16*)(F.ws + WS_XN1S) + (size_t)(DBATCH * DSEQ + ((m - MPR) >> 2)) * DM;
#pragma unroll
                for (int j = 0; j < 2; ++j) { v4u o; o.x = pk2(xp[j][0], xp[j][1]); o.y = pk2(xp[j][2], xp[j][3]); o.z = pk2(xp[j][4], xp[j][5]); o.w = pk2(xp[j][6], xp[j][7]); *(GAS v4u*)(sr + 8 * F.lane + 512 * j) = o; } }
        }
#pragma unroll
        for (int c = 0; c < 4; ++c) {
            bf16* dst = (bf16*)(F.ws + WS_MIX + c * MIX_STRIDE) + (size_t)m * DM;
#pragma unroll
            for (int j = 0; j < 2; ++j) { float v[8];
#pragma unroll
                for (int i = 0; i < 8; ++i) v[i] = x[j][i] + (xp[j][i] - x[j][i]) * mu8[c][j][i];
                v4u o; o.x = pk2(v[0], v[1]); o.y = pk2(v[2], v[3]); o.z = pk2(v[4], v[5]); o.w = pk2(v[6], v[7]);
                *(GAS v4u*)(dst + 8 * F.lane + 512 * j) = o; }
        }
        float* d = nullptr;
        if (m < MPR) { if ((m % LP) == LP - 1) d = (float*)(F.ws + WS_SHP) + (size_t)(m / LP) * DM; }
        else if (((m - MPR) & 3) == 3) d = F.out + O_SHS + (size_t)((m - MPR) >> 2) * DM;
        if (d) {
#pragma unroll
            for (int j = 0; j < 2; ++j) { *(GAS f32x4*)(d + 8 * F.lane + 512 * j) = (f32x4){x[j][0], x[j][1], x[j][2], x[j][3]}; *(GAS f32x4*)(d + 8 * F.lane + 512 * j + 4) = (f32x4){x[j][4], x[j][5], x[j][6], x[j][7]}; } }
#pragma unroll
        for (int j = 0; j < 2; ++j)
#pragma unroll
            for (int i = 0; i < 8; ++i) xp[j][i] = x[j][i];
        have_prev = true;
    }
}

__device__ __forceinline__ void p5_lora1_combine(Frame& F) {
    const int gw = F.vcu * NWAVES + F.wave, NGW = F.G * NWAVES;
    const float* U = (const float*)(F.ws + WS_U); float* t12 = (float*)(F.ws + WS_T12); unsigned char* t12b = F.ws + WS_T12B;
    const int j = F.lane;
    const int r0 = (int)(((long)gw * MTOK) / NGW), r1 = (int)(((long)(gw + 1) * MTOK) / NGW);
    for (int m = r0; m < r1; ++m) {
        const float* cur; const float* prev = nullptr;
        if (m < MPR) { cur = U + (size_t)m * 256; if ((m % LP) != 0) prev = cur - 256; }
        else { const int i = m - MPR; cur = U + (size_t)(U_SROW + i) * 256; prev = (i & 3) == 0 ? U + (size_t)(U_SROW + DBATCH * DSEQ + (i >> 2)) * 256 : cur - 256; }
        float a = cur[j], b2 = cur[128 + j];
        if (prev) { a += prev[64 + j]; b2 += prev[192 + j]; }
        a = tanhf(a);
        t12[(size_t)m * 128 + j] = a; t12[(size_t)m * 128 + 64 + j] = b2;
        if (m < MPR) { const int bb = m / LP, t = m - bb * LP;
            unsigned char* ob = t12b + ((size_t)((bb * 129 + (t >> 5)) * 8) * 64 + (t & 31)) * 16 + ((j >> 4) * 64 + 32 * ((j >> 3) & 1)) * 16 + (j & 7) * 2;
            *(bf16*)ob = (bf16)f2bf(a); *(bf16*)(ob + 4 * 1024) = (bf16)f2bf(b2); }
    }
}

__device__ __forceinline__ void wkv_seq_unit(Frame& F, LAS float* wl, int row0, int T, int h, const float* S0, float* Sout, int lane, bf16* hout = nullptr) {
    asm volatile("" : "+v"(lane));
    const bf16* R = (const bf16*)(F.dob); const bf16* Kb = (const bf16*)(F.dob + DO_K); const bf16* Vb = (const bf16*)(F.dob + DO_V);
    const bf16* Gb = (const bf16*)(F.ws + WS_G); const float* t12 = (const float*)(F.ws + WS_T12); bf16* og2 = (bf16*)(F.dob + DO_OG2);
    const int ch = h * HD + lane;
    unsigned w2p[32], a2p[32]; float S[64];
#pragma unroll
    for (int i = 0; i < 32; ++i) { w2p[i] = pk2(F.w2[(2 * i) * DM + ch], F.w2[(2 * i + 1) * DM + ch]); a2p[i] = pk2(F.a2[(2 * i) * DM + ch], F.a2[(2 * i + 1) * DM + ch]); }
    const float w0c = F.w0[ch], a0c = F.a0[ch], kkc = F.k_k[ch], kac = F.k_a[ch], rkc = F.r_k[ch], lng = F.ln_g[ch], lnb = F.ln_b[ch];
    if (S0) {
#pragma unroll
        for (int i = 0; i < 16; ++i) { const f32x4 v = *(const GAS f32x4*)(S0 + (size_t)lane * 64 + 4 * i); S[4 * i] = v.x; S[4 * i + 1] = v.y; S[4 * i + 2] = v.z; S[4 * i + 3] = v.w; }
    } else {
#pragma unroll
        for (int i = 0; i < 64; ++i) S[i] = 0.f;
    }
    for (int t = 0; t < T; ++t) {
        const size_t m = (size_t)(row0 + t);
#if WKV_EXP >= 30
        if (T == LP && t == WKV_DUMP_T) { float* dp = (float*)(F.ws + 184 * MiB) + (size_t)((row0 / LP) * NH + h) * 4096;
#pragma unroll
            for (int i = 0; i < 16; ++i) *(GAS f32x4*)(dp + (size_t)lane * 64 + 4 * i) = (f32x4){S[4 * i], S[4 * i + 1], S[4 * i + 2], S[4 * i + 3]}; }
#endif
#pragma unroll
        for (int i = 0; i < 32; ++i) { asm volatile("" : "+v"(w2p[i])); asm volatile("" : "+v"(a2p[i])); }
        const float r = bf2f(R[m * DM + ch]), k = bf2f(Kb[m * DM + ch]), v = bf2f(Vb[m * DM + ch]), g = bf2f(Gb[m * DM + ch]);
        wl[lane] = t12[m * 128 + lane]; wl[64 + lane] = t12[m * 128 + 64 + lane];
        asm volatile("s_waitcnt lgkmcnt(0)" ::: "memory");
        float z = w0c, az = a0c;
#pragma unroll
        for (int i = 0; i < 16; ++i) { const f32x4 x = *(const LAS f32x4*)(wl + 4 * i), y = *(const LAS f32x4*)(wl + 64 + 4 * i);
            z += x.x * __builtin_bit_cast(float, w2p[2 * i] << 16) + x.y * __builtin_bit_cast(float, w2p[2 * i] & 0xffff0000u) + x.z * __builtin_bit_cast(float, w2p[2 * i + 1] << 16) + x.w * __builtin_bit_cast(float, w2p[2 * i + 1] & 0xffff0000u);
            az += y.x * __builtin_bit_cast(float, a2p[2 * i] << 16) + y.y * __builtin_bit_cast(float, a2p[2 * i] & 0xffff0000u) + y.z * __builtin_bit_cast(float, a2p[2 * i + 1] << 16) + y.w * __builtin_bit_cast(float, a2p[2 * i + 1] & 0xffff0000u); }
        const float a = 1.0f / (1.0f + __expf(-az)), sg = 1.0f / (1.0f + __expf(-z)), dec = __expf(-0.6065306597126334f * sg);
        float kk = k * kkc; const float n2 = wave_sum(kk * kk); kk = kk / fmaxf(sqrtf(n2), 1e-12f);
        const float kh = k * (1.0f + (a - 1.0f) * kac);
        const float rk = wave_sum(r * kh * rkc);
        wl[128 + lane] = -kk; wl[192 + lane] = kk * a; wl[256 + lane] = dec; wl[320 + lane] = kh; wl[384 + lane] = r;
        asm volatile("s_waitcnt lgkmcnt(0)" ::: "memory");
        float sa = 0.f;
#pragma unroll
        for (int i = 0; i < 16; ++i) { const f32x4 x = *(const LAS f32x4*)(wl + 128 + 4 * i); sa += S[4 * i] * x.x + S[4 * i + 1] * x.y + S[4 * i + 2] * x.z + S[4 * i + 3] * x.w; }
        float y = 0.f;
#pragma unroll
        for (int i = 0; i < 16; ++i) {
            const f32x4 bq = *(const LAS f32x4*)(wl + 192 + 4 * i), wq = *(const LAS f32x4*)(wl + 256 + 4 * i), kq = *(const LAS f32x4*)(wl + 320 + 4 * i), rq = *(const LAS f32x4*)(wl + 384 + 4 * i);
#if WKV_EXP == 45 && WKV_VAR == 2
            if (hout) sa = 0.f;
#endif
            S[4 * i] = S[4 * i] * wq.x + sa * bq.x + v * kq.x; S[4 * i + 1] = S[4 * i + 1] * wq.y + sa * bq.y + v * kq.y;
            S[4 * i + 2] = S[4 * i + 2] * wq.z + sa * bq.z + v * kq.z; S[4 * i + 3] = S[4 * i + 3] * wq.w + sa * bq.w + v * kq.w;
            y += S[4 * i] * rq.x + S[4 * i + 1] * rq.y + S[4 * i + 2] * rq.z + S[4 * i + 3] * rq.w; }
        const float mean = wave_sum(y) * (1.f / 64.f), dv = y - mean, var = wave_sum(dv * dv) * (1.f / 64.f);
        const float yn = dv * (1.0f / sqrtf(var + GN_EPS)) * lng + lnb + rk * v;
        if (!hout) og2[m * DM + ch] = (bf16)f2bf(yn * g / (1.0f + __expf(-g)));
        asm volatile("" ::: "memory");
    }
    if (hout) {
#pragma unroll
        for (int i = 0; i < 16; ++i) *(GAS unsigned long long*)(hout + (size_t)lane * 64 + 4 * i) = (unsigned long long)pk2(S[4 * i], S[4 * i + 1]) | ((unsigned long long)pk2(S[4 * i + 2], S[4 * i + 3]) << 32);
        return;
    }
#pragma unroll
    for (int i = 0; i < 16; ++i) *(GAS f32x4*)(Sout + (size_t)lane * 64 + 4 * i) = (f32x4){S[4 * i], S[4 * i + 1], S[4 * i + 2], S[4 * i + 3]};
}
#define SEQ_FENCE() do { asm volatile("" ::: "memory"); __builtin_amdgcn_sched_barrier(0); } while (0)
__device__ __forceinline__ void wkv_seq4_unit(Frame& F, LAS float* wl, int row0, int h, const float* S0, float* Sout, int lane) {
    asm volatile("" : "+v"(lane));
    const bf16* R = (const bf16*)(F.dob); const bf16* Kb = (const bf16*)(F.dob + DO_K); const bf16* Vb = (const bf16*)(F.dob + DO_V);
    const bf16* Gb = (const bf16*)(F.ws + WS_G); const float* t12 = (const float*)(F.ws + WS_T12); bf16* og2 = (bf16*)(F.dob + DO_OG2);
    const int ch = h * HD + lane;
    constexpr float L2E = 1.4426950408889634f;
    {
        float r[4], k[4], v[4], g[4];
#pragma unroll
        for (int t = 0; t < 4; ++t) { const size_t m = (size_t)(row0 + t); r[t] = bf2f(R[m * DM + ch]); k[t] = bf2f(Kb[m * DM + ch]); v[t] = bf2f(Vb[m * DM + ch]); g[t] = bf2f(Gb[m * DM + ch]);
            wl[t * 128 + lane] = t12[m * 128 + lane]; wl[t * 128 + 64 + lane] = t12[m * 128 + 64 + lane]; }
        const float w0c = F.w0[ch], a0c = F.a0[ch], kkc = F.k_k[ch], kac = F.k_a[ch], rkc = F.r_k[ch];
        float z[4], az[4];
#pragma unroll
        for (int t = 0; t < 4; ++t) { z[t] = w0c; az[t] = a0c; }
        asm volatile("s_waitcnt lgkmcnt(0)" ::: "memory");
        SEQ_FENCE();
#pragma unroll
        for (int i = 0; i < 16; ++i) {
            float w4[4], a4[4];
#pragma unroll
            for (int e = 0; e < 4; ++e) { w4[e] = F.w2[(4 * i + e) * DM + ch]; a4[e] = F.a2[(4 * i + e) * DM + ch]; }
#pragma unroll
            for (int t = 0; t < 4; ++t) { const f32x4 x = *(const LAS f32x4*)(wl + t * 128 + 4 * i), y = *(const LAS f32x4*)(wl + t * 128 + 64 + 4 * i);
                z[t] += x.x * w4[0] + x.y * w4[1] + x.z * w4[2] + x.w * w4[3]; az[t] += y.x * a4[0] + y.y * a4[1] + y.z * a4[2] + y.w * a4[3]; }
            if ((i & 3) == 3) SEQ_FENCE(); }
        asm volatile("s_waitcnt lgkmcnt(0)" ::: "memory");
#pragma unroll
        for (int t = 0; t < 4; ++t) {
            const float a = __builtin_amdgcn_rcpf(1.0f + __builtin_amdgcn_exp2f(-az[t] * L2E)), sg = __builtin_amdgcn_rcpf(1.0f + __builtin_amdgcn_exp2f(-z[t] * L2E)), dec = __builtin_amdgcn_exp2f((-0.6065306597126334f * L2E) * sg);
            float kk = k[t] * kkc; const float n2 = wave_sum(kk * kk); kk = kk * __builtin_amdgcn_rsqf(fmaxf(n2, 1e-24f));
            const float kh = k[t] * (1.0f + (a - 1.0f) * kac);
            const float rk = wave_sum(r[t] * kh * rkc);
            LAS float* w = wl + t * 512;
            w[lane] = -kk; w[64 + lane] = kk * a; w[128 + lane] = dec; w[192 + lane] = kh; w[256 + lane] = r[t]; w[320 + lane] = v[t]; w[384 + lane] = g[t]; w[448 + lane] = rk;
        }
    }
    SEQ_FENCE();
    float S[64];
#pragma unroll
    for (int i = 0; i < 16; ++i) { const f32x4 x = *(const GAS f32x4*)(S0 + (size_t)lane * 64 + 4 * i); S[4 * i] = x.x; S[4 * i + 1] = x.y; S[4 * i + 2] = x.z; S[4 * i + 3] = x.w; }
    const float lng = F.ln_g[ch], lnb = F.ln_b[ch];
    asm volatile("s_waitcnt lgkmcnt(0)" ::: "memory");
#pragma unroll 1
    for (int t = 0; t < 4; ++t) {
        const LAS float* w = wl + t * 512;
        float sa = 0.f;
#pragma unroll
        for (int i = 0; i < 16; ++i) { const f32x4 x = *(const LAS f32x4*)(w + 4 * i); sa += S[4 * i] * x.x + S[4 * i + 1] * x.y + S[4 * i + 2] * x.z + S[4 * i + 3] * x.w; }
        const float v = w[320 + lane], g = w[384 + lane], rk = w[448 + lane];
        float y = 0.f;
#pragma unroll
        for (int i = 0; i < 16; ++i) {
            const f32x4 bq = *(const LAS f32x4*)(w + 64 + 4 * i), wq = *(const LAS f32x4*)(w + 128 + 4 * i), kq = *(const LAS f32x4*)(w + 192 + 4 * i), rq = *(const LAS f32x4*)(w + 256 + 4 * i);
            S[4 * i] = S[4 * i] * wq.x + sa * bq.x + v * kq.x; S[4 * i + 1] = S[4 * i + 1] * wq.y + sa * bq.y + v * kq.y;
            S[4 * i + 2] = S[4 * i + 2] * wq.z + sa * bq.z + v * kq.z; S[4 * i + 3] = S[4 * i + 3] * wq.w + sa * bq.w + v * kq.w;
            y += S[4 * i] * rq.x + S[4 * i + 1] * rq.y + S[4 * i + 2] * rq.z + S[4 * i + 3] * rq.w; }
        const float mean = wave_sum(y) * (1.f / 64.f), dv = y - mean, var = wave_sum(dv * dv) * (1.f / 64.f);
        const float yn = dv * __builtin_amdgcn_rsqf(var + GN_EPS) * lng + lnb + rk * v;
        og2[(size_t)(row0 + t) * DM + ch] = (bf16)f2bf(yn * g * __builtin_amdgcn_rcpf(1.0f + __builtin_amdgcn_exp2f(-g * L2E)));
        asm volatile("" ::: "memory");
    }
#pragma unroll
    for (int i = 0; i < 16; ++i) *(GAS f32x4*)(Sout + (size_t)lane * 64 + 4 * i) = (f32x4){S[4 * i], S[4 * i + 1], S[4 * i + 2], S[4 * i + 3]};
    asm volatile("s_waitcnt lgkmcnt(0)" ::: "memory");
}
__device__ __forceinline__ void p6_wkv_seq(Frame& F) {
    LAS float* wl = (LAS float*)(F.lds + RING_OFF) + F.wave * 512;
    constexpr int NSU = DBATCH * NH;
    for (int u = F.wave * F.G + F.vcu; u < NSU + NB * NH; u += NWAVES * F.G) {
        if (u < NSU) { const int sb = u / NH, h = u % NH;
            wkv_seq_unit(F, wl, MPR + sb * DSEQ, DSEQ, h, F.state_wkv + (size_t)u * 4096, F.out + O_WKVS + (size_t)u * 4096, F.lane); }
        else { const int pu = u - NSU, b = pu / NH, h = pu % NH;
            wkv_seq_unit(F, wl, b * LP, LP, h, nullptr, (float*)(F.ws + WS_WKVP) + (size_t)pu * 4096, F.lane); }
    }
}

__device__ __forceinline__ void p8_sample_windows(Frame& F, int gt, int NGT) {
    const bf16* kvs = (const bf16*)(F.ws + WS_KVS);
    for (int i = gt; i < 2 * DBATCH * WIN * 64; i += NGT) {
        const int kv = i / (DBATCH * WIN * 64), r = i % (DBATCH * WIN * 64), sb = r / (WIN * 64), j = (r / 64) % WIN, c4 = r % 64;
        f32x4 v;
        if (j < WIN - DSEQ) v = *(const GAS f32x4*)((kv ? F.cache_v : F.cache_k) + ((size_t)sb * WIN + j + DSEQ) * 256 + 4 * c4);
        else { const bf16* s = kvs + (size_t)(sb * DSEQ + (j - (WIN - DSEQ))) * 512 + kv * 256 + 4 * c4; v = (f32x4){bf2f(s[0]), bf2f(s[1]), bf2f(s[2]), bf2f(s[3])}; }
        *(GAS f32x4*)(F.out + (kv ? O_WVS : O_WKS) + (size_t)r * 4) = v;
    }
}
__device__ __forceinline__ void p8_final(Frame& F, int part, bool sample_windows) {
#if WKV_VAR >= 11 && WKV_VAR <= 19
    { const unsigned flag = __hip_atomic_load((unsigned*)(F.ws + WS_CTL) + 8, __ATOMIC_RELAXED, __HIP_MEMORY_SCOPE_AGENT); if (flag && blockIdx.x == 0 && F.tid < 64) { const float e = (flag & 1u ? 100.f : 0.f) + (flag & 2u ? 1000.f : 0.f) + (flag & 4u ? 10000.f : 0.f) + (flag & 8u ? 31.f : 0.f) + (flag & 16u ? 7.f : 0.f) + (flag & 32u ? 3.f : 0.f) + (flag & 64u ? 50.f : 0.f) + (flag & 128u ? 200.f : 0.f) + (flag & 256u ? 1000.f : 0.f) + (flag & 512u ? 5000.f : 0.f); F.out[O_SHS + F.tid] += e; } }
#endif
    const int gw = F.vcu * NWAVES + F.wave, NGW = F.G * NWAVES;
    const bf16* h2 = (const bf16*)(F.ws + WS_H1);
    int m0 = gw, m1 = MTOK, ms = NGW;
    if (part != 0) {
        const int nlate = (MPAD / 256 - F.G / (DM / 256)) * (DM / 256), rows_early = (F.G / (DM / 256)) * 256, bx = (int)blockIdx.x;
        if (part == 1) { if (bx < nlate) { m0 = 0; m1 = 0; } else { m0 = (bx - nlate) * NWAVES + F.wave; m1 = rows_early; ms = (F.G - nlate) * NWAVES; } }
        else { m0 = rows_early + bx * NWAVES + F.wave; m1 = MTOK; ms = NGW; } }
    for (int m = m0; m < m1; m += ms) {
        float* dst;
        if (m < MPR) { const int b = m / LP, t = m - b * LP; if (t < NMETA) continue; dst = F.out + O_YP + ((size_t)b * SEQ + (t - NMETA)) * DM; }
        else dst = F.out + O_YS + (size_t)(m - MPR) * DM;
        f32x4 v[4]; rms_row_b(h2 + (size_t)m * DM, F.final_gain, F.lane, v);
#pragma unroll
        for (int j = 0; j < 4; ++j) ((GAS f32x4*)dst)[F.lane + 64 * j] = v[j];
    }
    if (part == 1) return;
    const int gt = F.vcu * (NWAVES * 64) + F.tid, NGT = F.G * NWAVES * 64;
    const bf16* kvp = (const bf16*)(F.ws + WS_KVP); const bf16* kvs = (const bf16*)(F.ws + WS_KVS);
    for (int i = gt; i < 2 * NB * WIN * 256; i += NGT) { const int kv = i / (NB * WIN * 256), r = i % (NB * WIN * 256), row = r >> 8, col = r & 255;
        F.out[(kv ? O_WVP : O_WKP) + r] = bf2f(kvp[(size_t)row * 512 + kv * 256 + col]); }
    for (int i = gt; i < NB * NH * 4096; i += NGT) F.out[O_WKVP + i] = ((const float*)(F.ws + WS_WKVP))[i];
    for (int i = gt; i < NB * DM; i += NGT) F.out[O_SHP + i] = ((const float*)(F.ws + WS_SHP))[i];
    if (sample_windows) p8_sample_windows(F, gt, NGT);
}
namespace wkv {
typedef __amdgpu_buffer_rsrc_t srd_t;
constexpr int NCH = 65, NUNITS = NB * NH * NCH;
constexpr size_t WS_W2T = 18 * MiB + 256 * 1024, WS_A2T = 18 * MiB + 384 * 1024;
constexpr size_t WS_GT = 98 * MiB, WS_HT = 131 * MiB, WS_KST = 164 * MiB, WS_RK = 181 * MiB, WS_TST = 183 * MiB, WS_Y0F = 30 * MiB, WS_WYF = 64 * MiB;
static_assert(3 * RKV_STRIDE + (size_t)2048 * 16384 <= O_SHS * 4 && WS_GT + (size_t)NUNITS * 8192 <= WS_HT && WS_HT + (size_t)NUNITS * 8192 <= WS_KST && WS_KST + (size_t)2048 * 8192 <= WS_RK && WS_RK + (size_t)MTOK * 16 * 4 <= WS_H1 && WS_Y0F + (size_t)NUNITS * 8192 <= WS_WYF && WS_WYF + (size_t)NUNITS * 8192 <= WS_GT, "wkv ws map");
constexpr int LDSX_OFF = 132096;
static_assert(LDSX_OFF + NWAVES * 512 + NWAVES * 1024 <= LDS_BYTES, "lds");
__device__ __forceinline__ unsigned cvtpk(float lo, float hi) { unsigned r; asm volatile("v_cvt_pk_bf16_f32 %0, %1, %2\n\ts_nop 1" : "=v"(r) : "v"(lo), "v"(hi)); return r; }
__device__ __forceinline__ unsigned cvtpkn(float lo, float hi) { return pk2(lo, hi); }
__device__ __forceinline__ void mfma_fence(f32x16 (&acc)[2][2]) { asm volatile("s_nop 15\n\ts_nop 7" : "+v"(acc[0][0]), "+v"(acc[0][1]), "+v"(acc[1][0]), "+v"(acc[1][1])); }
__device__ __forceinline__ void mfma_fence2(f32x16& a, f32x16& b) { asm volatile("s_nop 15\n\ts_nop 7" : "+v"(a), "+v"(b)); }
__device__ __forceinline__ float lo16(unsigned w) { return __builtin_bit_cast(float, w << 16); }
__device__ __forceinline__ float hi16(unsigned w) { return __builtin_bit_cast(float, w & 0xffff0000u); }
__device__ __forceinline__ void mm64(f32x16 (&acc)[2][2], const bf16x8 (&A)[4][2], const bf16x8 (&B)[4][2]) {
#pragma unroll
    for (int m = 0; m < 2; ++m)
#pragma unroll
        for (int n = 0; n < 2; ++n)
#pragma unroll
            for (int ks = 0; ks < 4; ++ks) acc[m][n] = __builtin_amdgcn_mfma_f32_32x32x16_bf16(A[ks][m], B[ks][n], acc[m][n], 0, 0, 0);
    mfma_fence(acc);
}
__device__ __forceinline__ void acc2frag(const f32x16 (&acc)[2][2], bf16x8 (&Fr)[4][2]) {
#pragma unroll
    for (int m = 0; m < 2; ++m)
#pragma unroll
        for (int n = 0; n < 2; ++n)
#pragma unroll
            for (int s = 0; s < 2; ++s) { const f32x16& a = acc[m][n]; v4u w;
                w.x = cvtpk(a[8 * s + 0], a[8 * s + 1]); w.y = cvtpk(a[8 * s + 2], a[8 * s + 3]); w.z = cvtpk(a[8 * s + 4], a[8 * s + 5]); w.w = cvtpk(a[8 * s + 6], a[8 * s + 7]);
                Fr[2 * m + s][n] = __builtin_bit_cast(bf16x8, w); }
}
__device__ __forceinline__ void zero_acc(f32x16 (&acc)[2][2]) {
#pragma unroll
    for (int m = 0; m < 2; ++m)
#pragma unroll
        for (int n = 0; n < 2; ++n) acc[m][n] = f32x16{};
}
__device__ __forceinline__ void frag_st_lds(LAS unsigned char* p, const bf16x8 (&Fr)[4][2], int lane) {
#pragma unroll
    for (int ks = 0; ks < 4; ++ks)
#pragma unroll
        for (int t = 0; t < 2; ++t) *(LAS bf16x8*)(p + (ks * 2 + t) * 1024 + lane * 16) = Fr[ks][t];
}
__device__ __forceinline__ void frag_ld_lds(const LAS unsigned char* p, bf16x8 (&Fr)[4][2], int lane) {
#pragma unroll
    for (int ks = 0; ks < 4; ++ks)
#pragma unroll
        for (int t = 0; t < 2; ++t) Fr[ks][t] = *(const LAS bf16x8*)(p + (ks * 2 + t) * 1024 + lane * 16);
}
template <int D> __device__ __forceinline__ void bfly_step(float (&v)[32], int lane) {
    const bool up = (lane & D) != 0;
#pragma unroll
    for (int s = 0; s < D; ++s) { const float send = up ? v[s] : v[s + D], keep = up ? v[s + D] : v[s]; v[s] = keep + __shfl_xor(send, D); }
}
__device__ __forceinline__ float butterfly32(float (&v)[32], int lane) {
    bfly_step<16>(v, lane); bfly_step<8>(v, lane); bfly_step<4>(v, lane); bfly_step<2>(v, lane); bfly_step<1>(v, lane);
    return v[0];
}
__device__ __forceinline__ int crow(int r, int hi) { return (r & 3) + 8 * (r >> 2) + 4 * hi; }

#define WKV_FENCE() do { asm volatile("" ::: "memory"); __builtin_amdgcn_sched_barrier(0); } while (0)
__device__ __forceinline__ void frag_st_g(unsigned char* p, const bf16x8 (&Fr)[4][2], int lane) {
#pragma unroll
    for (int ks = 0; ks < 4; ++ks)
#pragma unroll
        for (int t = 0; t < 2; ++t) *(GAS bf16x8*)(p + (ks * 2 + t) * 1024 + lane * 16) = Fr[ks][t];
}
typedef unsigned v4u_t __attribute__((ext_vector_type(4)));
__device__ __forceinline__ void frag_ld_g(const unsigned char* p, bf16x8 (&Fr)[4][2], int lane) {
    const srd_t r = __builtin_amdgcn_make_buffer_rsrc((void*)p, (short)0, 8192, 0x00020000);
#pragma unroll
    for (int ks = 0; ks < 4; ++ks)
#pragma unroll
        for (int t = 0; t < 2; ++t) { const v4u_t x = __builtin_amdgcn_raw_buffer_load_b128(r, (unsigned)(lane * 16), (unsigned)((ks * 2 + t) * 1024), 16  ); Fr[ks][t] = __builtin_bit_cast(bf16x8, x); }
}
__device__ __forceinline__ void transpose64(f32x16 (&acc)[2][2], const bf16x8 (&XR)[4][2], const bf16x8 (&Id2)[2]) {
#pragma unroll
    for (int m = 0; m < 2; ++m)
#pragma unroll
        for (int n = 0; n < 2; ++n) { acc[m][n] = f32x16{};
#pragma unroll
            for (int s = 0; s < 2; ++s) acc[m][n] = __builtin_amdgcn_mfma_f32_32x32x16_bf16(XR[2 * n + s][m], Id2[s], acc[m][n], 0, 0, 0); }
    mfma_fence(acc);
}
__device__ __forceinline__ float bld16(srd_t r, unsigned vo, unsigned so) { return __builtin_bit_cast(float, (unsigned)__builtin_amdgcn_raw_buffer_load_b16(r, vo, so, 0) << 16); }
__device__ __forceinline__ unsigned bld16u(srd_t r, unsigned vo, unsigned so) { return (unsigned)__builtin_amdgcn_raw_buffer_load_b16(r, vo, so, 0); }
typedef unsigned v2u_t __attribute__((ext_vector_type(2)));
__device__ __forceinline__ unsigned long long bld64(srd_t r, unsigned vo, unsigned so) { const v2u_t v = __builtin_amdgcn_raw_buffer_load_b64(r, vo, so, 16  ); return (unsigned long long)v.x | ((unsigned long long)v.y << 32); }
__device__ __forceinline__ void bst64(srd_t r, unsigned vo, unsigned so, unsigned long long w) { v2u_t v; v.x = (unsigned)w; v.y = (unsigned)(w >> 32); __builtin_amdgcn_raw_buffer_store_b64(v, r, vo, so, 0); }
__device__ __forceinline__ unsigned long long pack4(float a, float b, float c, float d) { return (unsigned long long)cvtpkn(a, b) | ((unsigned long long)cvtpkn(c, d) << 32); }
typedef float wkv_f2 __attribute__((ext_vector_type(2)));
template <bool TAIL> __device__ __forceinline__ void solve_T(const f32x16 (&acc)[2][2], bf16x8 (&TR)[4][2], int lane, bool sync, int skip) {
    wkv_f2 Tp[32];
#pragma unroll
    for (int j = 0; j < 32; ++j) Tp[j] = (wkv_f2){(lane == 2 * j) ? 1.f : 0.f, (lane == 2 * j + 1) ? 1.f : 0.f};
    if (!(skip & 1))
#pragma unroll
    for (int j = 31; j >= 0; --j) {
        const int i0 = 2 * j, i1 = i0 + 1;
        const int mi = i0 >> 5, ri0 = (i0 & 3) + 4 * ((i0 & 31) >> 3), hi = ((i0 & 31) >> 2) & 1;
        if (!(TAIL && i0 >= 16)) {
        float a0 = acc[mi][0][ri0], a1 = acc[mi][1][ri0], b0 = acc[mi][0][ri0 + 1], b1 = acc[mi][1][ri0 + 1];
        asm volatile("" : "+v"(a0)); asm volatile("" : "+v"(a1)); asm volatile("" : "+v"(b0)); asm volatile("" : "+v"(b1));
#pragma unroll
        for (int k = i1 + 1; k < (TAIL ? 16 : 64); ++k) {
            const float n0 = __builtin_bit_cast(float, __builtin_amdgcn_readlane(__builtin_bit_cast(int, (k >> 5) ? a1 : a0), (k & 31) + 32 * hi));
            const float n1 = __builtin_bit_cast(float, __builtin_amdgcn_readlane(__builtin_bit_cast(int, (k >> 5) ? b1 : b0), (k & 31) + 32 * hi));
            const float t = Tp[k >> 1][k & 1];
            Tp[j] = __builtin_elementwise_fma((wkv_f2){n0, n1}, (wkv_f2){t, t}, Tp[j]);
        }
        { const float n01 = __builtin_bit_cast(float, __builtin_amdgcn_readlane(__builtin_bit_cast(int, (i1 >> 5) ? a1 : a0), (i1 & 31) + 32 * hi)); Tp[j].x = __builtin_fmaf(n01, Tp[j].y, Tp[j].x); }
        }
        if ((j & 3) == 0 && sync) __builtin_amdgcn_s_barrier();
        WKV_FENCE();
    }
    float Tc[64];
#pragma unroll
    for (int i = 0; i < 64; ++i) Tc[i] = Tp[i >> 1][i & 1];
#pragma unroll
    for (int ks = 0; ks < 4; ++ks) {
        const int b0 = 16 * ks;
        v4u E, O;
        E.x = cvtpk(Tc[b0 + 0], Tc[b0 + 1]); E.y = cvtpk(Tc[b0 + 2], Tc[b0 + 3]); E.z = cvtpk(Tc[b0 + 8], Tc[b0 + 9]); E.w = cvtpk(Tc[b0 + 10], Tc[b0 + 11]);
        O.x = cvtpk(Tc[b0 + 4], Tc[b0 + 5]); O.y = cvtpk(Tc[b0 + 6], Tc[b0 + 7]); O.z = cvtpk(Tc[b0 + 12], Tc[b0 + 13]); O.w = cvtpk(Tc[b0 + 14], Tc[b0 + 15]);
        { auto r = __builtin_amdgcn_permlane32_swap(E.x, O.x, false, false); E.x = r[0]; O.x = r[1]; }
        { auto r = __builtin_amdgcn_permlane32_swap(E.y, O.y, false, false); E.y = r[0]; O.y = r[1]; }
        { auto r = __builtin_amdgcn_permlane32_swap(E.z, O.z, false, false); E.z = r[0]; O.z = r[1]; }
        { auto r = __builtin_amdgcn_permlane32_swap(E.w, O.w, false, false); E.w = r[0]; O.w = r[1]; }
        TR[ks][0] = __builtin_bit_cast(bf16x8, E); TR[ks][1] = __builtin_bit_cast(bf16x8, O);
    }
}
__device__ __forceinline__ void mfma_fence1(f32x16& a) { asm volatile("s_nop 15\n\ts_nop 7" : "+v"(a)); }
__device__ __forceinline__ void make_idn(bf16x8 (&IdN)[2], int c, int hh) {
    asm volatile("" : "+v"(c), "+v"(hh));
#pragma unroll
    for (int s2 = 0; s2 < 2; ++s2) { bf16x8 v;
#pragma unroll
        for (int jj = 0; jj < 8; ++jj) v[jj] = ((16 * s2 + 8 * hh + jj) == c) ? (short)0x3F80 : (short)0;
        IdN[s2] = v; }
}
__device__ __forceinline__ f32x16 tile_from_rows(const bf16x8& a0, const bf16x8& a1, const bf16x8 (&IdN)[2]) {
    f32x16 t = f32x16{};
    t = __builtin_amdgcn_mfma_f32_32x32x16_bf16(a0, IdN[0], t, 0, 0, 0);
    t = __builtin_amdgcn_mfma_f32_32x32x16_bf16(a1, IdN[1], t, 0, 0, 0);
    return t;
}
__device__ __forceinline__ bf16x8 bld128(srd_t r, unsigned vo, unsigned so) { const v4u_t x = __builtin_amdgcn_raw_buffer_load_b128(r, vo, so, 0); return __builtin_bit_cast(bf16x8, x); }
#ifndef WKV_SEQ4
#define WKV_SEQ4 0
#endif
#ifndef WKV_LOCKSTEP
#define WKV_LOCKSTEP 0
#endif
#define WKV_SYNC() do { if (sync) __builtin_amdgcn_s_barrier(); } while (0)
__device__ __forceinline__ void stageA_unit(Frame& F, int uidx, int lane, int wave, bool sync, int lslot) {
    asm volatile("" : "+v"(lane));
    const int c = lane & 31, hh = lane >> 5;
    const int ch = uidx % NCH, bh = uidx / NCH, h = bh % NH, b = bh / NH;
    const int row0 = b * LP + 64 * ch, nvalid = (LP - 64 * ch) < 64 ? (LP - 64 * ch) : 64;
    const float* t12 = (const float*)(F.ws + WS_T12);
    const bf16* w2t = (const bf16*)(F.ws + WS_W2T); const bf16* a2t = (const bf16*)(F.ws + WS_A2T);
    LAS unsigned char* wl = F.lds + RING_OFF + lslot * 16384;
    LAS float* red = (LAS float*)(F.lds + LDSX_OFF + wave * 512);
#if WKV_VAR == 14
    {
        unsigned bad = 0u;
        float x = (float)(lane * 3 + 1); asm volatile("" : "+v"(x));
        f32x16 t; for (int r = 0; r < 16; ++r) t[r] = (float)(lane * 16 + r);
        asm volatile("" : "+v"(t));
#define RLCHK(L) { const float g = __builtin_bit_cast(float, __builtin_amdgcn_readlane(__builtin_bit_cast(int, x), L)); if (g != (float)((L) * 3 + 1)) bad |= 64u; }
        RLCHK(0) RLCHK(5) RLCHK(31) RLCHK(32) RLCHK(40) RLCHK(63)
#undef RLCHK
#define RLCHK2(R, L) { const float g = __builtin_bit_cast(float, __builtin_amdgcn_readlane(__builtin_bit_cast(int, t[R]), L)); if (g != (float)((L) * 16 + (R))) bad |= 128u; }
        RLCHK2(0, 3) RLCHK2(7, 33) RLCHK2(13, 63) RLCHK2(14, 63) RLCHK2(15, 62) RLCHK2(9, 17)
#undef RLCHK2
        f32x16 t2; for (int r = 0; r < 16; ++r) t2[r] = (float)(lane * 16 + r);
#define RLCHK3(R, L) { const float g = __builtin_bit_cast(float, __builtin_amdgcn_readlane(__builtin_bit_cast(int, t2[R]), L)); if (g != (float)((L) * 16 + (R))) bad |= 256u; }
        RLCHK3(0, 3) RLCHK3(7, 33) RLCHK3(13, 63) RLCHK3(14, 63) RLCHK3(15, 62) RLCHK3(9, 17)
#undef RLCHK3
#define RLCHK4(R, L) { float e = t[R]; asm volatile("" : "+v"(e)); const float g = __builtin_bit_cast(float, __builtin_amdgcn_readlane(__builtin_bit_cast(int, e), L)); if (g != (float)((L) * 16 + (R))) bad |= 512u; }
        RLCHK4(0, 3) RLCHK4(7, 33) RLCHK4(13, 63) RLCHK4(14, 63) RLCHK4(15, 62) RLCHK4(9, 17)
#undef RLCHK4
        if (bad) atomicOr((unsigned*)(F.ws + WS_CTL) + 8, bad);
        return;
    }
#endif
#if WKV_VAR == 13
    {
        f32x16 acc[2][2];
#pragma unroll
        for (int m = 0; m < 2; ++m)
#pragma unroll
            for (int n = 0; n < 2; ++n)
#pragma unroll
                for (int r = 0; r < 16; ++r) { const int i_ = 32 * m + crow(r, hh), k_ = 32 * n + c; acc[m][n][r] = (k_ == i_ + 1) ? 0.5f : (k_ == i_ + 2) ? 0.25f : (k_ <= i_) ? 1.0f : 0.f; }
        asm volatile("" : "+v"(acc[0][0]), "+v"(acc[0][1]), "+v"(acc[1][0]), "+v"(acc[1][1]));
        float Tc[64]; unsigned badn = 0u;
#pragma unroll
        for (int i = 0; i < 64; ++i) Tc[i] = (lane == i) ? 1.f : 0.f;
#pragma unroll
        for (int i = 62; i >= 0; --i) {
            const int mi = i >> 5, ri = (i & 3) + 4 * ((i & 31) >> 3), hi = ((i & 31) >> 2) & 1;
#pragma unroll
            for (int k = i + 1; k < 64; ++k) {
                const float nik = __builtin_bit_cast(float, __builtin_amdgcn_readlane(__builtin_bit_cast(int, acc[mi][k >> 5][ri]), (k & 31) + 32 * hi));
                const float exn = (k == i + 1) ? 0.5f : (k == i + 2) ? 0.25f : 0.f;
                if (nik != exn) badn |= 32u;
#if WKV_SUB == 1
                Tc[i] = __builtin_fmaf(nik, Tc[k], Tc[i]);
#else
                asm volatile("v_fmac_f32 %0, %1, %2" : "+v"(Tc[i]) : "s"(nik), "v"(Tc[k]));
#endif
            }
            WKV_FENCE();
        }
        unsigned bad = badn;
#pragma unroll
        for (int i = 0; i < 64; ++i) { const int d = lane - i; float ex = 0.f; if (d >= 0) { float t0 = 1.f, t1 = 0.5f; ex = d == 0 ? 1.f : 0.5f; for (int q = 2; q <= d; ++q) { const float t2 = 0.5f * t1 + 0.25f * t0; t0 = t1; t1 = t2; ex = t2; } }
            if (fabsf(Tc[i] - ex) > 1e-5f * fabsf(ex) + 1e-12f) bad |= 16u; }
        if (bad) atomicOr((unsigned*)(F.ws + WS_CTL) + 8, bad);
        WKV_FENCE();
        return;
    }
#endif
#if WKV_VAR == 12
    {
        f32x16 acc[2][2]; bf16x8 TR[4][2];
#pragma unroll
        for (int m = 0; m < 2; ++m)
#pragma unroll
            for (int n = 0; n < 2; ++n)
#pragma unroll
                for (int r = 0; r < 16; ++r) { const int i_ = 32 * m + crow(r, hh), k_ = 32 * n + c; acc[m][n][r] = (k_ == i_ + 1) ? 0.5f : (k_ == i_ + 2) ? 0.25f : (k_ <= i_) ? 1.0f : 0.f; }
        solve_T<false>(acc, TR, lane, false, 0);
        WKV_FENCE();
        bf16x8 Ir[4][2];
#pragma unroll
        for (int ks = 0; ks < 4; ++ks)
#pragma unroll
            for (int n = 0; n < 2; ++n) { bf16x8 v;
#pragma unroll
                for (int jj = 0; jj < 8; ++jj) v[jj] = ((16 * ks + 8 * (jj >> 2) + 4 * hh + (jj & 3)) == 32 * n + c) ? (short)0x3F80 : (short)0;
                Ir[ks][n] = v; }
        zero_acc(acc); mm64(acc, TR, Ir);
        unsigned bad = 0u;
#pragma unroll
        for (int m = 0; m < 2; ++m)
#pragma unroll
            for (int n = 0; n < 2; ++n)
#pragma unroll
                for (int r = 0; r < 16; ++r) { const int jp = 32 * m + crow(r, hh), j_ = 32 * n + c, d = jp - j_;
                    float ex = 0.f; if (d >= 0) { float t0 = 1.f, t1 = 0.5f; ex = d == 0 ? 1.f : 0.5f; for (int q = 2; q <= d; ++q) { const float t2 = 0.5f * t1 + 0.25f * t0; t0 = t1; t1 = t2; ex = t2; } }
                    const float got = acc[m][n][r]; if (fabsf(got - ex) > 0.01f * fabsf(ex) + 1e-6f) bad |= 8u; }
        if (bad) atomicOr((unsigned*)(F.ws + WS_CTL) + 8, bad);
        WKV_FENCE();
        return;
    }
#endif
#if WKV_VAR == 11
    {
        f32x16 acc[2][2]; bf16x8 IdT[2];
#pragma unroll
        for (int s = 0; s < 2; ++s) { bf16x8 v;
#pragma unroll
            for (int jj = 0; jj < 8; ++jj) v[jj] = ((16 * s + 8 * (jj >> 2) + (jj & 3)) == (c - 4 * hh)) ? (short)0x3F80 : (short)0;
            IdT[s] = v; }
        {
            bf16x8 XA[4][2], XB[4][2];
#pragma unroll
            for (int ks = 0; ks < 4; ++ks)
#pragma unroll
                for (int t = 0; t < 2; ++t) { bf16x8 va, vb;
#pragma unroll
                    for (int jj = 0; jj < 8; ++jj) { const int tk = 16 * ks + 8 * (jj >> 2) + 4 * hh + (jj & 3), chn = 32 * t + c;
                        va[jj] = (short)f2bf((float)(((tk + 2 * chn) & 7) - 3)); vb[jj] = (tk == chn) ? (short)0x3F80 : (short)0; }
                    XA[ks][t] = va; XB[ks][t] = vb; }
            frag_st_lds(wl, XA, lane); frag_st_lds(wl + 8192, XB, lane);
        }
        WKV_FENCE();
        unsigned bad = 0u;
        bf16x8 AC[4][2], BC[4][2];
        { bf16x8 X[4][2]; frag_ld_lds(wl + 8192, X, lane); transpose64(acc, X, IdT);
#pragma unroll
          for (int m = 0; m < 2; ++m)
#pragma unroll
            for (int n = 0; n < 2; ++n)
#pragma unroll
                for (int r = 0; r < 16; ++r) { const int chn = 32 * m + crow(r, hh), tk = 32 * n + c; if (acc[m][n][r] != ((tk == chn) ? 1.f : 0.f)) bad |= 1u; }
          acc2frag(acc, BC); }
        WKV_FENCE();
        { bf16x8 X[4][2]; frag_ld_lds(wl, X, lane); transpose64(acc, X, IdT);
#pragma unroll
          for (int m = 0; m < 2; ++m)
#pragma unroll
            for (int n = 0; n < 2; ++n)
#pragma unroll
                for (int r = 0; r < 16; ++r) { const int chn = 32 * m + crow(r, hh), tk = 32 * n + c; if (acc[m][n][r] != (float)(((tk + 2 * chn) & 7) - 3)) bad |= 2u; }
          acc2frag(acc, AC); }
        WKV_FENCE();
        zero_acc(acc); mm64(acc, BC, AC);
#pragma unroll
        for (int m = 0; m < 2; ++m)
#pragma unroll
            for (int n = 0; n < 2; ++n)
#pragma unroll
                for (int r = 0; r < 16; ++r) { const int i_ = 32 * m + crow(r, hh), j_ = 32 * n + c; if (acc[m][n][r] != (float)(((j_ + 2 * i_) & 7) - 3)) bad |= 4u; }
        if (bad) atomicOr((unsigned*)(F.ws + WS_CTL) + 8, bad);
        WKV_FENCE();
        return;
    }
#endif
#if WKV_VAR == 7
    const int wid = F.vcu * 2 + wave;
#else
    const int wid = F.vcu * NWAVES + wave;
#endif
    unsigned char* gs0 = F.ws + WS_KST + (size_t)wid * 8192;
#if WKV_VAR == 7
    unsigned char* gs1 = F.ws + WS_KST + 4 * MiB + (size_t)wid * 16384;
#else
    unsigned char* gs1 = F.dob + 3 * RKV_STRIDE + (size_t)wid * 16384;
#endif
    if (nvalid < 64) gs1 = F.ws + WS_TST + (size_t)bh * 16384;
    unsigned char* gs2 = gs1 + 8192;
    const size_t rbase = (size_t)row0 * DM + h * HD;
    const bool tail = nvalid < 64;
#define TPAD(m, r) (tail && (32 * (m) + 8 * ((r) >> 2) >= 16))
#define JOK(n) (!tail || ((n) == 0 && c < 16))
    const int dlt = c - 4 * hh;
#define KR(r) (((r) & 3) + 8 * ((r) >> 2))
#define ROW_GT_COL(m, n, r) (((m) > (n)) || ((m) == (n) && KR(r) > dlt))
    const srd_t sD = __builtin_amdgcn_make_buffer_rsrc((void*)F.dob, (short)0, (int)(O_END * 4), 0x00020000);
    const unsigned soR = (unsigned)(rbase * 2), soK = (unsigned)(DO_K + rbase * 2), soV = (unsigned)(DO_V + rbase * 2);
    const unsigned voE = (unsigned)((4 * hh * DM + c) * 2);
    const unsigned voW = (unsigned)((c * DM + 4 * hh) * 2);
    const unsigned voA = (unsigned)((c * DM + 8 * hh) * 2);
#define CA(m, s) ((unsigned)(((32 * (m)) * DM + 16 * (s)) * 2))
#define CE(m, r, n) ((unsigned)(((32 * (m) + ((r) & 3) + 8 * ((r) >> 2)) * DM + 32 * (n)) * 2))
#define CW(m, q, n) ((unsigned)(((32 * (n)) * DM + 32 * (m) + 8 * (q)) * 2))
    constexpr float L2E = 1.4426950408889634f;
    float kkc[2], kac[2], rkc[2], w0c[2], a0c[2];
#pragma unroll
    for (int n = 0; n < 2; ++n) { const int cc = h * HD + 32 * n + c; kkc[n] = F.k_k[cc]; kac[n] = F.k_a[cc]; rkc[n] = F.r_k[cc]; w0c[n] = F.w0[cc]; a0c[n] = F.a0[cc]; }
    {
        bf16x8 KA[2][4], IdN[2];
#pragma unroll
        for (int m = 0; m < 2; ++m)
#pragma unroll
            for (int s4 = 0; s4 < 4; ++s4) KA[m][s4] = bld128(sD, voA, soK + CA(m, s4));
        make_idn(IdN, c, hh);
        float nv[32];
#pragma unroll
        for (int m = 0; m < 2; ++m) {
            const f32x16 t0 = tile_from_rows(KA[m][0], KA[m][1], IdN), t1 = tile_from_rows(KA[m][2], KA[m][3], IdN);
#pragma unroll
            for (int r = 0; r < 16; ++r) { const float q0 = t0[r] * kkc[0], q1 = t1[r] * kkc[1]; nv[16 * m + r] = TPAD(m, r) ? 0.f : (q0 * q0 + q1 * q1); } }
        const float tot = butterfly32(nv, lane);
        red[32 * (c >> 4) + crow(c & 15, hh)] = __builtin_amdgcn_rsqf(fmaxf(tot, 1e-24f));
        asm volatile("s_waitcnt lgkmcnt(0)" ::: "memory");
    }
    WKV_FENCE();
    WKV_SYNC();
    float gC[2], erk[32];
#pragma unroll
    for (int i = 0; i < 32; ++i) erk[i] = 0.f;
    gC[0] = gC[1] = 1.f;
    if (!(F.skip & 2))
#pragma unroll
    for (int n = 0; n < 2; ++n) {
        f32x16 z[2], az[2];
        {
            bf16x8 wf[4], af[4];
#pragma unroll
            for (int s = 0; s < 4; ++s) { wf[s] = *(const GAS bf16x8*)(w2t + (size_t)(h * HD + 32 * n + c) * 64 + 16 * s + 8 * hh); af[s] = *(const GAS bf16x8*)(a2t + (size_t)(h * HD + 32 * n + c) * 64 + 16 * s + 8 * hh); }
#pragma unroll
            for (int m = 0; m < 2; ++m) { z[m] = f32x16{}; az[m] = f32x16{};
                const unsigned char* tp = F.ws + WS_T12B + (size_t)((b * 129 + 2 * ch + m) * 8) * 1024 + lane * 16;
                if (!(tail && m == 1))
#pragma unroll
                for (int s = 0; s < 4; ++s) {
                    const bf16x8 xa = *(const GAS bf16x8*)(tp + s * 1024), ya = *(const GAS bf16x8*)(tp + (4 + s) * 1024);
                    z[m] = __builtin_amdgcn_mfma_f32_32x32x16_bf16(xa, wf[s], z[m], 0, 0, 0);
                    az[m] = __builtin_amdgcn_mfma_f32_32x32x16_bf16(ya, af[s], az[m], 0, 0, 0); } }
        }
        WKV_FENCE();
        bf16x8 KA2[2][2], RA2[2][2];
#pragma unroll
        for (int m = 0; m < 2; ++m)
#pragma unroll
            for (int s2 = 0; s2 < 2; ++s2) { KA2[m][s2] = bld128(sD, voA, soK + CA(m, 2 * n + s2)); RA2[m][s2] = bld128(sD, voA, soR + CA(m, 2 * n + s2)); }
#pragma unroll
        for (int m = 0; m < 2; ++m)
#pragma unroll
            for (int r = 0; r < 16; ++r) { const int t = 32 * m + crow(r, hh);
                const float sg = __builtin_amdgcn_rcpf(1.0f + __builtin_amdgcn_exp2f(-(z[m][r] + w0c[n]) * L2E)); z[m][r] = TPAD(m, r) ? 0.f : (-0.6065306597126334f * L2E) * sg;
                az[m][r] = __builtin_amdgcn_rcpf(1.0f + __builtin_amdgcn_exp2f(-(az[m][r] + a0c[n]) * L2E)); }
        float gt[8], ot[8], base[8];
#pragma unroll
        for (int g = 0; g < 8; ++g) { const int m = g >> 2, q = g & 3; gt[g] = (z[m][4 * q] + z[m][4 * q + 1]) + (z[m][4 * q + 2] + z[m][4 * q + 3]); ot[g] = __shfl_xor(gt[g], 32); }
        { float run = 0.f;
#pragma unroll
          for (int g = 0; g < 8; ++g) { base[g] = run + (hh ? ot[g] : 0.f); run += gt[g] + ot[g]; }
          gC[n] = __builtin_amdgcn_exp2f(run); }
#pragma unroll
        for (int m = 0; m < 2; ++m) {
            bf16x8 IdN[2]; make_idn(IdN, c, hh);
            const f32x16 ktile = tile_from_rows(KA2[m][0], KA2[m][1], IdN), rtile = tile_from_rows(RA2[m][0], RA2[m][1], IdN);
#pragma unroll
            for (int s = 0; s < 2; ++s) {
                float at[8], bt[8], kt[8], rt[8];
#pragma unroll
                for (int e = 0; e < 8; ++e) { at[e] = 0.f; bt[e] = 0.f; kt[e] = 0.f; rt[e] = 0.f; }
                if (!(tail && (m | s)))
#pragma unroll
                for (int qq = 0; qq < 2; ++qq) { const int q = 2 * s + qq; float acc = base[4 * m + q];
#pragma unroll
                    for (int i = 0; i < 4; ++i) { const int r = 4 * q + i, t = 32 * m + crow(r, hh), e = 4 * qq + i;
                        const float lw = z[m][r]; acc += lw; const float LG = acc;
                        const float eLG = __builtin_amdgcn_exp2f(LG), ieLG = __builtin_amdgcn_exp2f(-LG), eLGp = __builtin_amdgcn_exp2f(LG - lw);
                        float k = ktile[r], rr = rtile[r];
                        if (TPAD(m, r)) { k = 0.f; rr = 0.f; }
                        const float a = az[m][r];
                        const float kkn = k * kkc[n] * red[t];
                        const float kh = k * (1.0f + (a - 1.0f) * kac[n]);
                        at[e] = -kkn * eLGp; bt[e] = kkn * a * ieLG; kt[e] = kh * ieLG; rt[e] = rr * eLG;
                        erk[16 * m + r] += rr * kh * rkc[n]; } }
                const int fo = ((2 * m + s) * 2 + n) * 1024 + lane * 16; v4u w;
                w.x = cvtpkn(at[0], at[1]); w.y = cvtpkn(at[2], at[3]); w.z = cvtpkn(at[4], at[5]); w.w = cvtpkn(at[6], at[7]); *(LAS v4u*)(wl + fo) = w;
                w.x = cvtpkn(bt[0], bt[1]); w.y = cvtpkn(bt[2], bt[3]); w.z = cvtpkn(bt[4], bt[5]); w.w = cvtpkn(bt[6], bt[7]); *(LAS v4u*)(wl + 8192 + fo) = w;
                w.x = cvtpkn(kt[0], kt[1]); w.y = cvtpkn(kt[2], kt[3]); w.z = cvtpkn(kt[4], kt[5]); w.w = cvtpkn(kt[6], kt[7]); *(GAS v4u*)(gs0 + fo) = w;
                w.x = cvtpkn(rt[0], rt[1]); w.y = cvtpkn(rt[2], rt[3]); w.z = cvtpkn(rt[4], rt[5]); w.w = cvtpkn(rt[6], rt[7]); *(GAS v4u*)(gs1 + fo) = w;
                WKV_SYNC();
                WKV_FENCE();
            } }
        WKV_FENCE();
    }
    WKV_SYNC();
    {
        const float tot = butterfly32(erk, lane); const int t = 32 * (c >> 4) + crow(c & 15, hh);
        if (t < nvalid) ((float*)(F.ws + WS_RK))[(size_t)(row0 + t) * 16 + h] = tot;
    }
    WKV_FENCE();
#define MAKE_ID2(Id) do { int dl_ = dlt; asm volatile("" : "+v"(dl_)); _Pragma("unroll") for (int s_ = 0; s_ < 2; ++s_) { bf16x8 v_; \
        _Pragma("unroll") for (int jj = 0; jj < 8; ++jj) v_[jj] = ((16 * s_ + 8 * (jj >> 2) + (jj & 3)) == dl_) ? (short)0x3F80 : (short)0; \
        Id[s_] = v_; } } while (0)
    f32x16 acc[2][2];
    bf16x8 MbrR[4][2], MkaTR[4][2];
    {
        bf16x8 KtC[4][2];
        { bf16x8 X[4][2], Id2[2]; frag_ld_g(gs0, X, lane); MAKE_ID2(Id2); transpose64(acc, X, Id2); acc2frag(acc, KtC); }
        WKV_FENCE();
        {
            bf16x8 RtC[4][2];
            { bf16x8 X[4][2], Id2[2]; frag_ld_g(gs1, X, lane); MAKE_ID2(Id2); transpose64(acc, X, Id2); acc2frag(acc, RtC); }
            WKV_FENCE();
            WKV_SYNC();
            {
                zero_acc(acc); mm64(acc, KtC, RtC);
#pragma unroll
                for (int m = 0; m < 2; ++m)
#pragma unroll
                    for (int n = 0; n < 2; ++n)
#pragma unroll
                        for (int r = 0; r < 16; ++r) { if (ROW_GT_COL(m, n, r)) acc[m][n][r] = 0.f; }
                bf16x8 MkrR[4][2]; acc2frag(acc, MkrR); frag_st_g(gs2, MkrR, lane);
            }
            WKV_FENCE();
            WKV_SYNC();
            bf16x8 BtC[4][2];
            { bf16x8 X[4][2], Id2[2]; frag_ld_lds(wl + 8192, X, lane); MAKE_ID2(Id2); transpose64(acc, X, Id2); acc2frag(acc, BtC); }
            {
                zero_acc(acc); mm64(acc, BtC, RtC);
#pragma unroll
                for (int m = 0; m < 2; ++m)
#pragma unroll
                    for (int n = 0; n < 2; ++n)
#pragma unroll
                        for (int r = 0; r < 16; ++r) { if (ROW_GT_COL(m, n, r)) acc[m][n][r] = 0.f; }
                acc2frag(acc, MbrR);
            }
            WKV_FENCE();
            WKV_SYNC();
            bf16x8 AtC[4][2];
            { bf16x8 X[4][2], Id2[2]; frag_ld_lds(wl, X, lane); MAKE_ID2(Id2); transpose64(acc, X, Id2); acc2frag(acc, AtC); }
            {
                zero_acc(acc); mm64(acc, AtC, KtC);
#pragma unroll
                for (int m = 0; m < 2; ++m)
#pragma unroll
                    for (int n = 0; n < 2; ++n)
#pragma unroll
                        for (int r = 0; r < 16; ++r) { if (!ROW_GT_COL(m, n, r)) acc[m][n][r] = 0.f; }
                acc2frag(acc, MkaTR);
            }
            WKV_FENCE();
            zero_acc(acc); mm64(acc, BtC, AtC);
        }
    }
    WKV_FENCE();
    WKV_SYNC();
    bf16x8 TR[4][2];
    {
        LAS unsigned* junk_ = (LAS unsigned*)(F.lds + LDSX_OFF + NWAVES * 512 + wave * 1024);
        const bf16* vb_ = (const bf16*)(F.dob + DO_V) + (size_t)(row0 + c) * DM + h * HD + 8 * hh;
#pragma unroll
        for (int m = 0; m < 2; ++m) { const unsigned* p_ = (const unsigned*)(vb_ + (size_t)32 * m * DM);
            __builtin_amdgcn_global_load_lds(p_, junk_, 16, 0, 0); __builtin_amdgcn_global_load_lds(p_, junk_, 16, 32, 0); __builtin_amdgcn_global_load_lds(p_, junk_, 16, 64, 0); __builtin_amdgcn_global_load_lds(p_, junk_, 16, 96, 0); }
    }
    if (tail) solve_T<true>(acc, TR, lane, false, F.skip); else solve_T<false>(acc, TR, lane, sync, F.skip);
    WKV_FENCE();
    WKV_SYNC();
    if (!(F.skip & 4)) {
    unsigned char* gt_out = F.ws + WS_GT + (size_t)uidx * 8192; unsigned char* ht_out = F.ws + WS_HT + (size_t)uidx * 8192;
    unsigned char* wy_out = F.ws + WS_WYF + (size_t)uidx * 8192; unsigned char* y0_out = F.ws + WS_Y0F + (size_t)uidx * 8192;
    bf16x8 BtL[4][2];
    {
        bf16x8 P1R[4][2];
        { bf16x8 X[4][2]; frag_ld_lds(wl, X, lane); zero_acc(acc); mm64(acc, TR, X); acc2frag(acc, P1R); }
        WKV_FENCE();
        { bf16x8 X[4][2], Id2[2]; frag_ld_g(gs1, X, lane); MAKE_ID2(Id2); transpose64(acc, X, Id2); }
        mm64(acc, P1R, MbrR);
        { bf16x8 WyR[4][2]; acc2frag(acc, WyR); frag_st_g(wy_out, WyR, lane); }
        WKV_FENCE();
        frag_ld_lds(wl + 8192, BtL, lane);
        zero_acc(acc); mm64(acc, P1R, BtL);
#pragma unroll
        for (int m = 0; m < 2; ++m)
#pragma unroll
            for (int n = 0; n < 2; ++n)
#pragma unroll
                for (int s = 0; s < 2; ++s) { float v[8];
#pragma unroll
                    for (int i = 0; i < 8; ++i) v[i] = (acc[m][n][8 * s + i] + ((m == n && KR(8 * s + i) == dlt) ? 1.f : 0.f)) * gC[n];
                    v4u w; w.x = cvtpk(v[0], v[1]); w.y = cvtpk(v[2], v[3]); w.z = cvtpk(v[4], v[5]); w.w = cvtpk(v[6], v[7]);
                    *(GAS v4u*)(gt_out + ((2 * m + s) * 2 + n) * 1024 + lane * 16) = w; }
    }
    WKV_FENCE();
    WKV_SYNC();
    bf16x8 NyR[4][2], HkR[4][2];
    {
        bf16x8 P2TR[4][2];
        zero_acc(acc); mm64(acc, TR, MkaTR); acc2frag(acc, P2TR);
        WKV_FENCE();
        zero_acc(acc); mm64(acc, P2TR, MbrR); acc2frag(acc, NyR);
        WKV_FENCE();
        zero_acc(acc); mm64(acc, P2TR, BtL);
#pragma unroll
        for (int m = 0; m < 2; ++m)
#pragma unroll
            for (int n = 0; n < 2; ++n)
#pragma unroll
                for (int s = 0; s < 2; ++s) { const v4u kw = __builtin_amdgcn_raw_buffer_load_b128(__builtin_amdgcn_make_buffer_rsrc((void*)gs0, (short)0, 8192, 0x00020000), (unsigned)(lane * 16), (unsigned)(((2 * m + s) * 2 + n) * 1024), 16); const unsigned kk4[4] = {kw.x, kw.y, kw.z, kw.w}; unsigned ww[4];
#pragma unroll
                    for (int p = 0; p < 4; ++p) ww[p] = cvtpk((acc[m][n][8 * s + 2 * p] + lo16(kk4[p])) * gC[n], (acc[m][n][8 * s + 2 * p + 1] + hi16(kk4[p])) * gC[n]);
                    HkR[2 * m + s][n] = __builtin_bit_cast(bf16x8, (v4u){ww[0], ww[1], ww[2], ww[3]}); }
    }
    WKV_FENCE();
    WKV_SYNC();
    bf16x8 VtR[4][2];
    { bf16x8 VA[2][4], IdN[2];
#pragma unroll
      for (int m = 0; m < 2; ++m)
#pragma unroll
        for (int s4 = 0; s4 < 4; ++s4) VA[m][s4] = bld128(sD, voA, soV + CA(m, s4));
      make_idn(IdN, c, hh);
#pragma unroll
      for (int m = 0; m < 2; ++m)
#pragma unroll
        for (int n = 0; n < 2; ++n) { f32x16 t = tile_from_rows(VA[m][2 * n], VA[m][2 * n + 1], IdN);
#pragma unroll
            for (int r = 0; r < 16; ++r) if (TPAD(m, r)) t[r] = 0.f;
            mfma_fence1(t);
#pragma unroll
            for (int s = 0; s < 2; ++s) { v4u w; w.x = cvtpk(t[8 * s + 0], t[8 * s + 1]); w.y = cvtpk(t[8 * s + 2], t[8 * s + 3]); w.z = cvtpk(t[8 * s + 4], t[8 * s + 5]); w.w = cvtpk(t[8 * s + 6], t[8 * s + 7]); VtR[2 * m + s][n] = __builtin_bit_cast(bf16x8, w); } } }
    zero_acc(acc);
    { bf16x8 MkrR[4][2]; frag_ld_g(gs2, MkrR, lane); mm64(acc, VtR, MkrR); }
    mm64(acc, VtR, NyR);
#pragma unroll
    for (int m = 0; m < 2; ++m)
#pragma unroll
        for (int n = 0; n < 2; ++n)
#pragma unroll
            for (int q = 0; q < 4; ++q) { const f32x16& a = acc[m][n];
                *(GAS unsigned long long*)(y0_out + ((m * 2 + n) * 4 + q) * 512 + lane * 8) = pack4(a[4 * q], a[4 * q + 1], a[4 * q + 2], a[4 * q + 3]); }
    WKV_FENCE();
    zero_acc(acc); mm64(acc, HkR, VtR);
#pragma unroll
    for (int m = 0; m < 2; ++m)
#pragma unroll
        for (int n = 0; n < 2; ++n)
#pragma unroll
            for (int q = 0; q < 4; ++q) { const f32x16& a = acc[m][n];
                *(GAS unsigned long long*)(ht_out + ((n * 2 + m) * 4 + q) * 512 + lane * 8) = pack4(a[4 * q], a[4 * q + 1], a[4 * q + 2], a[4 * q + 3]); }
    WKV_FENCE();
    }
#undef MAKE_ID2
#undef CE
#undef CW
#undef CA
#undef TPAD
#undef JOK
#undef KR
#undef ROW_GT_COL
}

__device__ __forceinline__ void stageB_unit(Frame& F, int ub, int lane, unsigned* tflag) {
    asm volatile("" : "+v"(lane));
    const int c = lane & 31, hh = lane >> 5;
    const int n0 = ub & 1, bh = ub >> 1;
    const bf16* gt = (const bf16*)(F.ws + WS_GT) + (size_t)bh * NCH * 4096; bf16* ht = (bf16*)(F.ws + WS_HT) + (size_t)bh * NCH * 4096;
    const int nu = 32 * n0 + c;
#if WKV_EXP == 45
    {
        const bf16* ha = gt + (size_t)(NCH - 1) * 4096 + (size_t)nu * 64; const bf16* hx = ht + (size_t)(NCH - 1) * 4096 + (size_t)nu * 64;
        float* so = (float*)(F.ws + WS_WKVP) + (size_t)bh * 4096 + (size_t)nu * 64;
        for (int i = hh; i < 64; i += 2) so[i] += bf2f(ha[i]) - bf2f(hx[i]);
        return;
    }
#endif
    f32x16 S[2]; S[0] = f32x16{}; S[1] = f32x16{};
#ifndef WKB_DEPTH
#define WKB_DEPTH 3
#endif
    v4u gqA[2][4], gqB[2][4]; unsigned long long hqA[2][4], hqB[2][4];
#if WKB_DEPTH == 3
    v4u gqC[2][4]; unsigned long long hqC[2][4];
#endif
    const unsigned char* gtb = (const unsigned char*)gt; unsigned char* htb = (unsigned char*)ht;
#define WKB_LOAD(gq, hq, cc) do { const unsigned char* g_ = gtb + (size_t)(cc) * 8192 + lane * 16; const unsigned char* h_ = htb + (size_t)(cc) * 8192 + n0 * 4096 + lane * 8; \
        _Pragma("unroll") for (int m = 0; m < 2; ++m) { \
            _Pragma("unroll") for (int ks = 0; ks < 4; ++ks) gq[m][ks] = *(const GAS v4u*)(g_ + (ks * 2 + m) * 1024); \
            _Pragma("unroll") for (int q = 0; q < 4; ++q) hq[m][q] = *(const GAS unsigned long long*)(h_ + (m * 4 + q) * 512); } } while (0)
#define WKB_STEP(gq, hq, chv) do { const int ch = (chv); \
        bf16x8 SB[4]; \
        _Pragma("unroll") for (int m = 0; m < 2; ++m) \
            _Pragma("unroll") for (int s = 0; s < 2; ++s) { v4u w; w.x = cvtpkn(S[m][8 * s + 0], S[m][8 * s + 1]); w.y = cvtpkn(S[m][8 * s + 2], S[m][8 * s + 3]); w.z = cvtpkn(S[m][8 * s + 4], S[m][8 * s + 5]); w.w = cvtpkn(S[m][8 * s + 6], S[m][8 * s + 7]); SB[2 * m + s] = __builtin_bit_cast(bf16x8, w); } \
        f32x16 N[2]; \
        _Pragma("unroll") for (int m = 0; m < 2; ++m) \
            _Pragma("unroll") for (int q = 0; q < 4; ++q) { const unsigned long long w = hq[m][q]; N[m][4 * q] = lo16((unsigned)w); N[m][4 * q + 1] = hi16((unsigned)w); N[m][4 * q + 2] = lo16((unsigned)(w >> 32)); N[m][4 * q + 3] = hi16((unsigned)(w >> 32)); } \
        _Pragma("unroll") for (int m = 0; m < 2; ++m) \
            _Pragma("unroll") for (int ks = 0; ks < 4; ++ks) N[m] = __builtin_amdgcn_mfma_f32_32x32x16_bf16(__builtin_bit_cast(bf16x8, gq[m][ks]), SB[ks], N[m], 0, 0, 0); \
        if (ch + WKB_DEPTH < NCH) { \
            if (ch + WKB_DEPTH == NCH - 1) {     \
                while (__hip_atomic_load(tflag, __ATOMIC_RELAXED, __HIP_MEMORY_SCOPE_AGENT) == 0u) __builtin_amdgcn_s_sleep(4); \
                __builtin_amdgcn_fence(__ATOMIC_ACQUIRE, "agent"); } \
            WKB_LOAD(gq, hq, ch + WKB_DEPTH); } \
        if (ch > 0) {     \
            unsigned char* sp = htb + (size_t)(ch - 1) * 8192 + n0 * 4096 + lane * 16; \
            _Pragma("unroll") for (int ks = 0; ks < 4; ++ks) *(GAS bf16x8*)(sp + ks * 1024) = SB[ks]; } \
        mfma_fence2(N[0], N[1]); \
        S[0] = N[0]; S[1] = N[1]; } while (0)
#if WKB_DEPTH == 3
    WKB_LOAD(gqA, hqA, 0); WKB_LOAD(gqB, hqB, 1); WKB_LOAD(gqC, hqC, 2);
    static_assert(NCH == 65, "stage B step schedule");
#pragma unroll 1
    for (int ch0 = 0; ch0 < 63; ch0 += 3) { WKB_STEP(gqA, hqA, ch0); WKB_STEP(gqB, hqB, ch0 + 1); WKB_STEP(gqC, hqC, ch0 + 2); }
    WKB_STEP(gqA, hqA, 63); WKB_STEP(gqB, hqB, 64);
#else
    WKB_LOAD(gqA, hqA, 0); WKB_LOAD(gqB, hqB, 1);
    static_assert(NCH == 65, "stage B step schedule");
#pragma unroll 1
    for (int ch0 = 0; ch0 < 64; ch0 += 2) { WKB_STEP(gqA, hqA, ch0); WKB_STEP(gqB, hqB, ch0 + 1); }
    WKB_STEP(gqA, hqA, 64);
#endif
#undef WKB_STEP
#undef WKB_LOAD
#if WKV_EXP == 2 || WKV_EXP == 4 || WKV_EXP == 10
    float* so = (float*)(F.ws + WS_KST) + (size_t)bh * 4096 + (size_t)nu * 64;
#else
    float* so = (float*)(F.ws + WS_WKVP) + (size_t)bh * 4096 + (size_t)nu * 64;
#endif
#pragma unroll
    for (int m = 0; m < 2; ++m)
#pragma unroll
        for (int q = 0; q < 4; ++q) *(GAS f32x4*)(so + 32 * m + 8 * q + 4 * hh) = (f32x4){S[m][4 * q], S[m][4 * q + 1], S[m][4 * q + 2], S[m][4 * q + 3]};
}

__device__ __forceinline__ void stageC_unit(Frame& F, int uidx, int lane) {
    asm volatile("" : "+v"(lane));
    const int c = lane & 31, hh = lane >> 5;
    const int ch = uidx % NCH, bh = uidx / NCH, h = bh % NH, b = bh / NH;
    const int row0 = b * LP + 64 * ch, nvalid = (LP - 64 * ch) < 64 ? (LP - 64 * ch) : 64;
    const bf16* Vb = (const bf16*)(F.dob + DO_V);
    const bf16* Gb = (const bf16*)(F.ws + WS_G); bf16* og2 = (bf16*)(F.dob + DO_OG2);
    const unsigned char* wyf = F.ws + WS_WYF + (size_t)uidx * 8192; const unsigned char* y0f = F.ws + WS_Y0F + (size_t)uidx * 8192;
    const size_t rbase = (size_t)row0 * DM + h * HD;
    unsigned long long vq[2][2][4], gq[2][2][4]; float rkv[2];
#define WKC_PREF(n) do { rkv[n] = ((const GAS float*)(F.ws + WS_RK))[(size_t)(row0 + 32 * (n) + c) * 16 + h]; \
        _Pragma("unroll") for (int m = 0; m < 2; ++m) \
            _Pragma("unroll") for (int q = 0; q < 4; ++q) { const size_t e = (size_t)(row0 + 32 * (n) + c) * DM + h * HD + 32 * m + 8 * q + 4 * hh; vq[n][m][q] = *(const GAS unsigned long long*)(Vb + e); gq[n][m][q] = *(const GAS unsigned long long*)(Gb + e); } } while (0)
    WKC_PREF(0);
    f32x16 acc[2][2];
#pragma unroll
    for (int m = 0; m < 2; ++m)
#pragma unroll
        for (int n = 0; n < 2; ++n)
#pragma unroll
            for (int q = 0; q < 4; ++q) { const unsigned long long w = *(const GAS unsigned long long*)(y0f + ((m * 2 + n) * 4 + q) * 512 + lane * 8);
                acc[m][n][4 * q] = lo16((unsigned)w); acc[m][n][4 * q + 1] = hi16((unsigned)w); acc[m][n][4 * q + 2] = lo16((unsigned)(w >> 32)); acc[m][n][4 * q + 3] = hi16((unsigned)(w >> 32)); }
    if (ch > 0) {
        const unsigned char* sc = F.ws + WS_HT + (size_t)(uidx - 1) * 8192;
        bf16x8 SA[4][2], WB[4][2];
#pragma unroll
        for (int ks = 0; ks < 4; ++ks)
#pragma unroll
            for (int t = 0; t < 2; ++t) { SA[ks][t] = *(const GAS bf16x8*)(sc + t * 4096 + ks * 1024 + lane * 16); WB[ks][t] = *(const GAS bf16x8*)(wyf + (ks * 2 + t) * 1024 + lane * 16); }
        mm64(acc, SA, WB);
    }
    WKV_FENCE();
    WKC_PREF(1);
#undef WKC_PREF
    float s[2], mean[2], rstd[2];
#pragma unroll
    for (int n = 0; n < 2; ++n) { float t = 0.f;
#pragma unroll
        for (int m = 0; m < 2; ++m)
#pragma unroll
            for (int r = 0; r < 16; ++r) t += acc[m][n][r];
        t += __shfl_xor(t, 32); mean[n] = t * (1.f / 64.f); float v = 0.f;
#pragma unroll
        for (int m = 0; m < 2; ++m)
#pragma unroll
            for (int r = 0; r < 16; ++r) { const float d = acc[m][n][r] - mean[n]; v += d * d; }
        v += __shfl_xor(v, 32); rstd[n] = __builtin_amdgcn_rsqf(v * (1.f / 64.f) + GN_EPS); s[n] = 0.f; }
    (void)s;
#pragma unroll
    for (int n = 0; n < 2; ++n) { const int j = 32 * n + c;
        if (j < nvalid) {
            const float rk = rkv[n];
#pragma unroll
            for (int m = 0; m < 2; ++m)
#pragma unroll
                for (int q = 0; q < 4; ++q) { const int nu0 = h * HD + 32 * m + 8 * q + 4 * hh; const size_t e = (size_t)(row0 + j) * DM + nu0;
                    const f32x4 lg = *(const GAS f32x4*)(F.ln_g + nu0), lb = *(const GAS f32x4*)(F.ln_b + nu0);
                    const unsigned long long vw = vq[n][m][q], gw = gq[n][m][q];
                    const float vv[4] = {lo16((unsigned)vw), hi16((unsigned)vw), lo16((unsigned)(vw >> 32)), hi16((unsigned)(vw >> 32))};
                    const float gg[4] = {lo16((unsigned)gw), hi16((unsigned)gw), lo16((unsigned)(gw >> 32)), hi16((unsigned)(gw >> 32))};
                    float o[4];
#pragma unroll
                    for (int i = 0; i < 4; ++i) { const float yn = (acc[m][n][4 * q + i] - mean[n]) * rstd[n] * lg[i] + lb[i] + rk * vv[i]; o[i] = yn * gg[i] * __builtin_amdgcn_rcpf(1.0f + __builtin_amdgcn_exp2f(-1.4426950408889634f * gg[i])); }
                    *(GAS unsigned long long*)(og2 + e) = (unsigned long long)cvtpkn(o[0], o[1]) | ((unsigned long long)cvtpkn(o[2], o[3]) << 32); } } }
}
}
__device__ __forceinline__ void p8a_wkvA(Frame& F) {
#if WKV_VAR == 7
    if (F.wave >= 2) return;
#pragma unroll 1
    for (int u = F.wave * F.G + F.vcu; u < wkv::NUNITS; u += 2 * F.G) wkv::stageA_unit(F, u, F.lane, F.wave, false, F.wave);
#else
    const bool sync = WKV_LOCKSTEP && (NB * NH * (wkv::NCH - 1)) % (NWAVES * F.G) == 0;
#pragma unroll 1
    for (int u = F.wave * F.G + F.vcu; u < NB * NH * (wkv::NCH - 1); u += NWAVES * F.G) wkv::stageA_unit(F, (u >> 6) * wkv::NCH + (u & 63), F.lane, F.wave, sync, F.wave);
#endif
}
__device__ __forceinline__ void p8b_wkvB(Frame& F, int mode, unsigned* tflags) {
    LAS float* wl = (LAS float*)(F.lds + RING_OFF) + F.wave * 2048;
    static_assert(DSEQ == 4, "wkv_seq4_unit");
    const int NBW = 2 * NB * NH, NTW = NB * NH;
    const bool bwave = (F.wave == 1 && F.vcu < NBW), twave = (F.wave == 2 && F.vcu < NTW);
    if ((mode & 1) && bwave) {
        if (!(F.skip & 16)) wkv::stageB_unit(F, F.vcu, F.lane, tflags + (F.vcu >> 1));
        __builtin_amdgcn_fence(__ATOMIC_RELEASE, "agent");
        if (F.lane == 0) __hip_atomic_fetch_add(tflags + 64 + (F.vcu >> 1), 1u, __ATOMIC_RELAXED, __HIP_MEMORY_SCOPE_AGENT);
    }
    if ((mode & 1) && twave) {
        if (!(F.skip & 8)) wkv::stageA_unit(F, F.vcu * wkv::NCH + (wkv::NCH - 1), F.lane, F.wave, false, 4);
        __builtin_amdgcn_fence(__ATOMIC_RELEASE, "agent");
        if (F.lane == 0) __hip_atomic_store(tflags + F.vcu, 1u, __ATOMIC_RELAXED, __HIP_MEMORY_SCOPE_AGENT);
    }
    int sid, nslots, u_hi;
    if (F.vcu >= NBW) { sid = 2 * NBW + (F.vcu - NBW) * NWAVES + F.wave; nslots = (F.G - NBW) * NWAVES; u_hi = DBATCH * NH; }
    else if (F.wave >= 6) { sid = F.vcu * 2 + (F.wave - 6); nslots = DBATCH * NH; u_hi = 2 * NBW; }
    else { sid = 0; nslots = 1; u_hi = 0; }
    if (!(mode & 2) || (F.skip & 32)) u_hi = 0;
#pragma unroll 1
    for (int u = sid; u < u_hi; u += nslots) {
        const int sb = u / NH, h = u % NH;
#if WKV_SEQ4
        wkv_seq4_unit(F, wl, MPR + sb * DSEQ, h, F.state_wkv + (size_t)u * 4096, F.out + O_WKVS + (size_t)u * 4096, F.lane);
#else
        wkv_seq_unit(F, wl, MPR + sb * DSEQ, DSEQ, h, F.state_wkv + (size_t)u * 4096, F.out + O_WKVS + (size_t)u * 4096, F.lane);
#endif
    }
}
__device__ __forceinline__ void p8c_wkvC(Frame& F, bool tailmode, unsigned* tflags) {
    int u, uend, ustep;
    if (tailmode) {
        const bool twave = (F.wave == 2 && F.vcu < NB * NH);
        u = F.vcu; uend = (twave && !(F.skip & 8)) ? F.vcu + 1 : 0; ustep = 1;
        if (twave) { while (__hip_atomic_load(tflags + 64 + F.vcu, __ATOMIC_RELAXED, __HIP_MEMORY_SCOPE_AGENT) < 2u) __builtin_amdgcn_s_sleep(8);
            __builtin_amdgcn_fence(__ATOMIC_ACQUIRE, "agent"); }
    } else { u = F.wave * F.G + F.vcu; uend = NB * NH * (wkv::NCH - 1); ustep = NWAVES * F.G; }
#pragma unroll 1
    for (; u < uend; u += ustep) wkv::stageC_unit(F, tailmode ? u * wkv::NCH + (wkv::NCH - 1) : (u >> 6) * wkv::NCH + (u & 63), F.lane);
}
#ifndef PROBE_REPS
#define PROBE_REPS 0
#define PROBE_PHASE 0
#endif
#ifndef WKV_SPLIT4
#define WKV_SPLIT4 0
#endif
#ifndef WKV_FLOW
#define WKV_FLOW 0
#endif
#ifndef PROBE_STEP
#define PROBE_STEP 0
#endif
#ifndef WKV_ZERO_ROWS
#define WKV_ZERO_ROWS 0
#endif
#ifndef WKV_DELAY
#define WKV_DELAY 0
#endif
#ifndef WKV_EXP
#define WKV_EXP 0
#endif
#ifndef MK_ONE_LAUNCH
#define MK_ONE_LAUNCH 1
#endif
constexpr int N_PHASES = 11;
struct Args { const float* in[27]; float* out; unsigned char* ws; int ph_lo, ph_hi, li, pad; };
__device__ __forceinline__ bool in_phase(int lo, int hi, int k) { asm volatile("" : "+s"(lo), "+s"(hi)); return lo <= k && k < hi; }
__global__ void __launch_bounds__(NWAVES * 64, 2) mega_fwd(Args args) {
    extern __shared__ __attribute__((aligned(16))) unsigned char lds[];
    Frame F;
    F.lds = (LAS unsigned char*)lds;
    F.MISC = (volatile LAS unsigned*)(F.lds + MISC_OFF);
    F.tid = threadIdx.x; F.lane = F.tid & 63; F.wave = __builtin_amdgcn_readfirstlane(F.tid >> 6);
    F.G = gridDim.x; { const int bx = blockIdx.x; F.vcu = (F.G % 8 == 0) ? (bx % 8) * (F.G / 8) + bx / 8 : bx; }
    F.ws = args.ws; F.out = args.out; F.dob = (unsigned char*)args.out;
    F.ctl = (gu32*)(F.ws + WS_CTL); F.skip = args.pad >> 8;
    F.xp = args.in[0]; F.xs = args.in[1]; F.cache_k = args.in[2]; F.cache_v = args.in[3]; F.state_wkv = args.in[4]; F.state_shift = args.in[5];
    F.meta = args.in[6]; F.table = args.in[7]; F.norm_gain = args.in[8]; F.final_gain = args.in[9]; F.a_w_in = args.in[10]; F.sinks = args.in[11]; F.a_w_out = args.in[12];
    F.mu = args.in[13]; F.r_w_in = args.in[14]; F.w0 = args.in[15]; F.w1 = args.in[16]; F.w2 = args.in[17]; F.a0 = args.in[18]; F.a1 = args.in[19]; F.a2 = args.in[20];
    F.k_k = args.in[21]; F.k_a = args.in[22]; F.r_k = args.in[23]; F.ln_g = args.in[24]; F.ln_b = args.in[25]; F.r_w_out = args.in[26];
    for (int u = F.tid; u < (LDS_BYTES - LDSCTL_OFF) / 4; u += NWAVES * 64) ((LAS unsigned*)(F.lds + LDSCTL_OFF))[u] = 0u;
    __syncthreads();
    XcdBarrier bar; bar.bar = (unsigned*)(F.ctl + CW_BAR) + args.li * XCD_BAR_WORDS; bar.x = 0; bar.st = nullptr;
    const int lo = args.ph_lo, hi = args.ph_hi;
    if (hi - lo > 1 || lo == 8) bar = xcd_barrier_post((unsigned*)(F.ctl + CW_BAR) + args.li * XCD_BAR_WORDS, F.MISC + 8);
#define late_weights ((gridDim.x == 256) && (args.ph_lo == 0) && (args.ph_hi > 3))
#define early_windows ((gridDim.x == 256) && (args.ph_lo <= 8) && (args.ph_hi > 10))
#define split4 (WKV_SPLIT4 && (gridDim.x == 256) && (args.ph_lo <= 9) && (args.ph_hi > 10))
#define flow (WKV_FLOW && (gridDim.x == 256) && (args.ph_hi - args.ph_lo > 1))
#define rc2 ((unsigned*)(args.ws + WS_CTL) + CW_RC2 + args.li * 256)
#define rc4 ((unsigned*)(args.ws + WS_CTL) + CW_RC4 + args.li * 256)
#define IN(k) (lo <= (k) && (k) < hi)
#define SEAM(k) do { if (IN(k) && IN((k) + 1)) xcd_barrier(bar); } while (0)
    bf16* XA = (bf16*)(F.ws + WS_XA); bf16* QKVG = (bf16*)(F.ws + WS_QKVG); bf16* H1 = (bf16*)(F.ws + WS_H1);
    bf16* Rb = (bf16*)(F.dob); bf16* Kb = (bf16*)(F.dob + DO_K); bf16* Vb = (bf16*)(F.dob + DO_V); bf16* Gb = (bf16*)(F.ws + WS_G);

    if (IN(0)) { p0_prologue(F, late_weights ? 0 : 2, F.vcu * NWAVES + F.wave, F.G * NWAVES); } SEAM(0);
    if (IN(1)) {
        pg8::Gemm g{XA, (const bf16*)(F.ws + WS_WAIN), MPAD, LDQ, DM, 1 << 30, 0}; pg8::StaticOrder S; S.init(MPAD, LDQ, F.G, (int)blockIdx.x);
        pg8::EpiBf16G E{QKVG, QKVG, QKVG, QKVG, LDQ, 64, MPAD, 4, QSCALE};
        pg8::gemm_phase<pg8::EpiBf16G, pg8::StaticOrder, true, true>(F.lds + RING_OFF, g, S, E);
        if (late_weights) { const int full = ((MPAD / 256) * (LDQ / 256)) % 256, bx = (int)blockIdx.x; if (bx >= full) p0_prologue(F, 3, (bx - full) * NWAVES + F.wave, (256 - full) * NWAVES); }
    } SEAM(1);
    if (IN(2)) { p2_attention(F, false); } SEAM(2);
    if (IN(3)) {
        pg8::Gemm g{XA, (const bf16*)(F.ws + WS_WAOUT), MPAD, DM, DM, 1 << 30, 0};
        pg8::EpiResB E{nullptr, H1, F.meta, F.xp, F.xs, MTOK};
        if (flow) { pg8::SplitOrder S; S.init(MPAD, DM, F.G, (int)blockIdx.x, rc2); pg8::gemm_phase<pg8::EpiResB, pg8::SplitOrder, true, true>(F.lds + RING_OFF, g, S, E); }
        else { pg8::StaticOrder S; S.init(MPAD, DM, F.G, (int)blockIdx.x); pg8::gemm_phase<pg8::EpiResB, pg8::StaticOrder, true, true>(F.lds + RING_OFF, g, S, E); }
        if (late_weights) { const int nsec = ((MPAD / 256) * (DM / 256)) % 256, bx = (int)blockIdx.x; if (bx >= nsec) p0_prologue(F, 1, (bx - nsec) * NWAVES + F.wave, (256 - nsec) * NWAVES); }
    } if (IN(3) && IN(4) && !flow) xcd_barrier(bar);
    if (IN(4)) { p4_mix(F); } if (IN(4) && IN(6)) xcd_barrier(bar);
    if (IN(6)) {
        {
            pg8::Gemm g{(const bf16*)(F.ws + WS_MIX), (const bf16*)(F.ws + WS_WRIN), MPAD, 4 * DM, DM, 4, MIX_STRIDE};
            pg8::EpiBf16G E{Rb, Kb, Vb, Gb, DM, 4, MTOK, 0, 1.f};
            const int bx = (int)blockIdx.x; const int uq = bx < 48 ? bx : (bx < 113 ? -1 : (bx < 120 ? 48 + (bx - 113) : (bx < 123 ? -1 : 55 + (bx - 123))));
            if (F.G == 256) { pg8::TailFreeOrder S; S.init(MPAD, 4 * DM, F.G, bx, uq, 188); pg8::gemm_phase<pg8::EpiBf16G, pg8::TailFreeOrder, true, true>(F.lds + RING_OFF, g, S, E); }
            else { pg8::StaticOrder S; S.init(MPAD, 4 * DM, F.G, bx); pg8::gemm_phase<pg8::EpiBf16G, pg8::StaticOrder, true, true>(F.lds + RING_OFF, g, S, E); }
        }
        __syncthreads();
        if (!(F.skip & 128))
        {
            const int rot = (((MPAD / 256) * (4 * DM / 256)) % F.G + 7) & ~7;
            const int cid = ((int)blockIdx.x - rot + 4 * F.G) % F.G;
            unsigned* ucnt = (unsigned*)(args.ws + WS_CTL) + CW_UCNT + args.li * 8;
            pg8::Gemm g{(const bf16*)(F.dob + DO_XN1), (const bf16*)(F.ws + WS_W1A1), U_SROW, 256, DM, 1 << 30, 0}; pg8::CountOrder S; S.init(U_SROW, 256, F.G, cid, ucnt);
            pg8::EpiF32 E{(float*)(F.ws + WS_U), 256};
            pg8::gemm_phase<pg8::EpiF32, pg8::CountOrder, true, true>(F.lds + RING_OFF, g, S, E);
            __syncthreads();
            pg8::Gemm g2{(const bf16*)(F.ws + WS_XN1S), (const bf16*)(F.ws + WS_W1A1), 768, 256, DM, 1 << 30, 0}; pg8::CountOrder S2; S2.init(768, 256, F.G, (cid - 72 + F.G) % F.G, ucnt);
            pg8::EpiF32 E2{(float*)(F.ws + WS_U) + (size_t)U_SROW * 256, 256};
            pg8::gemm_phase<pg8::EpiF32, pg8::CountOrder, true, true>(F.lds + RING_OFF, g2, S2, E2);
            if (IN(7) && !(F.skip & 128)) {
                __syncthreads();
                if (F.tid < 64) { while (__hip_atomic_load(ucnt, __ATOMIC_RELAXED, __HIP_MEMORY_SCOPE_AGENT) < (unsigned)(U_SROW / 256 + 3)) __builtin_amdgcn_s_sleep(8); __builtin_amdgcn_fence(__ATOMIC_ACQUIRE, "agent"); }
                __syncthreads();
                p5_lora1_combine(F);
            }
        }
    } if (IN(6) && IN(8)) xcd_barrier(bar);
    if (IN(8)) {
#if WKV_EXP == 40 || WKV_EXP == 45
        const int nst = 4; const int prog[4] = {3, 6, 0, 1};
#elif WKV_EXP >= 30
        const int nst = 3; const int prog[4] = {3, 0, 1, 1};
#elif WKV_EXP == 21
        const int nst = 4; const int prog[4] = {0, 1, 2, 4};
#elif WKV_EXP == 0
        const int nst = 3; const int prog[4] = {0, 1, 2, 2};
#elif WKV_EXP == 1
        const int nst = 3; const int prog[4] = {3, 0, 1, 1};
#elif WKV_EXP == 16 || WKV_EXP == 19
        const int nst = 2; const int prog[4] = {3, 1, 1, 1};
#elif WKV_EXP == 10
        const int nst = 4; const int prog[4] = {3, 0, 4, 5};
#elif WKV_EXP == 5 || WKV_EXP == 12
        const int nst = 3; const int prog[4] = {3, 0, 4, 4};
#elif WKV_EXP == 4 || WKV_EXP == 7 || WKV_EXP == 8 || WKV_EXP == 14 || WKV_EXP == 15
        const int nst = 3; const int prog[4] = {3, 0, 1, 1};
#elif WKV_EXP == 2
        const int nst = 4; const int prog[4] = {3, 0, 1, 2};
#else
        const int nst = 2; const int prog[4] = {3, 4, 4, 4};
#endif
#pragma unroll 1
        for (int st = 0; st < nst; ++st) {
            const int kind = st == 0 ? prog[0] : st == 1 ? prog[1] : st == 2 ? prog[2] : prog[3];
            if ((args.pad & 255) && st + 1 != (args.pad & 255)) continue;
            unsigned* tflags = (unsigned*)(F.ctl + CW_TFLAG) + args.li * 128;
            if (kind == 0) p8a_wkvA(F);
            else { if (kind != 2) p8b_wkvB(F, 3, tflags); p8c_wkvC(F, kind != 2, tflags); }
            if (st + 1 < nst && !args.pad) xcd_barrier(bar);
        }
    } SEAM(8);
#if WKV_ZERO_ROWS
    if (blockIdx.x == 0) { bf16* o_ = (bf16*)(F.ws + WS_OG2) + (size_t)16864 * DM; for (int i = F.tid; i < 32 * DM; i += NWAVES * 64) o_[i] = 0; }
    xcd_barrier(bar);
#endif
#if WKV_DELAY
    { const unsigned long long t0_ = __builtin_amdgcn_s_memrealtime(); while (__builtin_amdgcn_s_memrealtime() - t0_ < 20000ull) __builtin_amdgcn_s_sleep(8); }
#endif
    if (IN(9)) {
        pg8::Gemm g{(const bf16*)(F.dob + DO_OG2), (const bf16*)(F.ws + WS_WROUT), MPAD, DM, DM, 1 << 30, 0};
        pg8::EpiResB E{H1, H1, F.meta, F.xp, F.xs, MTOK};
        if (split4) { pg8::SplitOrder S; S.init(MPAD, DM, F.G, (int)blockIdx.x, nullptr, 1); pg8::gemm_phase<pg8::EpiResB, pg8::SplitOrder, true, true>(F.lds + RING_OFF, g, S, E); }
        else { pg8::StaticOrder S; S.init(MPAD, DM, F.G, (int)blockIdx.x); pg8::gemm_phase<pg8::EpiResB, pg8::StaticOrder, true, true>(F.lds + RING_OFF, g, S, E); }
        if (early_windows) { const int nsec = ((MPAD / 256) * (DM / 256)) % 256, bx = (int)blockIdx.x; if (bx >= nsec) p8_sample_windows(F, (bx - nsec) * (NWAVES * 64) + F.tid, (256 - nsec) * (NWAVES * 64)); }
    } if (IN(9) && IN(10)) xcd_barrier(bar);
#ifdef EXTRA_BARRIERS
    if (hi - lo > 1) { for (int e_ = 0; e_ < EXTRA_BARRIERS; ++e_) xcd_barrier(bar); }
#endif
    if (IN(10)) {
        if (split4) {
            { pg8::Gemm g{(const bf16*)(F.dob + DO_OG2), (const bf16*)(F.ws + WS_WROUT), MPAD, DM, DM, 1 << 30, 0}; pg8::EpiResB E{H1, H1, F.meta, F.xp, F.xs, MTOK};
              pg8::SplitOrder S; S.init(MPAD, DM, F.G, (int)blockIdx.x, nullptr, 2); pg8::gemm_phase<pg8::EpiResB, pg8::SplitOrder, true, true>(F.lds + RING_OFF, g, S, E); }
            p8_final(F, 1, false);
            xcd_barrier(bar);
            p8_final(F, 2, !early_windows);
        } else p8_final(F, 0, !early_windows);
    }
#undef IN
#undef SEAM
}

extern "C" void kernel_launch(void* const* d_in, const int* in_sizes, int n_in, void* d_out, int out_size, void* d_ws, size_t ws_size, hipStream_t stream) {
    static int grid = 0;
    if (grid == 0) {
        if (n_in != 27 || (size_t)out_size != O_END || ws_size < WS_END) { fprintf(stderr, "kernel_launch: unexpected shapes n_in %d out %d ws %zu\n", n_in, out_size, ws_size); grid = -1; return; }
        int dev = 0, cus = 0, per_cu = 0;
        if (hipGetDevice(&dev) != hipSuccess || hipDeviceGetAttribute(&cus, hipDeviceAttributeMultiprocessorCount, dev) != hipSuccess) { grid = -1; return; }
        if (hipFuncSetAttribute((const void*)mega_fwd, hipFuncAttributeMaxDynamicSharedMemorySize, LDS_BYTES) != hipSuccess) { fprintf(stderr, "kernel_launch: hipFuncSetAttribute failed\n"); grid = -1; return; }
        if (hipOccupancyMaxActiveBlocksPerMultiprocessor(&per_cu, (const void*)mega_fwd, NWAVES * 64, LDS_BYTES) != hipSuccess || per_cu < 1) fprintf(stderr, "kernel_launch: occupancy query says %d\n", per_cu);
        (void)hipGetLastError();
        grid = cus;
    }
    if (grid < 0) return;
    if (hipMemsetAsync((char*)d_ws + WS_CTL, 0, CTL_ZERO_BYTES, stream) != hipSuccess) return;
    Args a{};
    for (int i = 0; i < 27; ++i) a.in[i] = (const float*)d_in[i];
    a.out = (float*)d_out; a.ws = (unsigned char*)d_ws;
#if PROBE_REPS > 0
    for (int r_ = 0; r_ < PROBE_REPS; ++r_) { a.ph_lo = PROBE_PHASE; a.ph_hi = PROBE_PHASE + 1; a.li = 1 + r_; a.pad = PROBE_STEP; hipLaunchKernelGGL(mega_fwd, dim3(grid), dim3(NWAVES * 64), LDS_BYTES, stream, a); }
#endif
#if MK_ONE_LAUNCH
    a.ph_lo = 0; a.ph_hi = N_PHASES; a.li = 0; a.pad = 0;
    hipLaunchKernelGGL(mega_fwd, dim3(grid), dim3(NWAVES * 64), LDS_BYTES, stream, a);
#else
    for (int p = 0; p < N_PHASES; ++p) { a.ph_lo = p; a.ph_hi = p + 1; a.li = p;
        hipLaunchKernelGGL(mega_fwd, dim3(grid), dim3(NWAVES * 64), LDS_BYTES, stream, a); }
#endif
}
```
